# Optimizing an MI355X kernel written in HIP

```python
import math
import jax, jax.numpy as jnp
from jax import lax
import numpy as np

D_MODEL = 2048
BATCH = 1
SEQ = 16384
DEPTH = 2

N_DIFF_HEADS = 8
DIFF_HEAD_DIM = 64
DIFF_V_DIM = 2 * DIFF_HEAD_DIM
ATTN_WIDTH = N_DIFF_HEADS * 2 * DIFF_HEAD_DIM
N_FNET_GROUPS = 8
FNET_GROUP_DIM = 128
FNET_WIDTH = N_FNET_GROUPS * FNET_GROUP_DIM
IN_PROJ_WIDTH = 3 * ATTN_WIDTH + FNET_WIDTH
N_BRANCHES = 2
D_FF = 5632
N_SUBLAYERS = 3
N_MOD = 3
ROPE_THETA = 10000.0
Q_BLOCK = 128
NORM_EPS = 1e-6
SUBLN_EPS = 1e-5
LAMBDA_STD = 0.1
MACARON_WEIGHT = 0.5

kernel_name = "hybrid_diffattn_fnet_macaron_encoder"


def rms_norm(x, g, eps=NORM_EPS):
    xf = x.astype(jnp.float32)
    y = xf * lax.rsqrt(jnp.mean(xf * xf, axis=-1, keepdims=True) + eps)
    return (y * g.astype(jnp.float32)).astype(x.dtype)


def modulate(xn, shift, scale):
    return xn * (1.0 + scale[:, None, :]) + shift[:, None, :]


def rope_tables(seq, dim):
    pos = jnp.arange(seq, dtype=jnp.float32)
    inv_freq = ROPE_THETA ** (-jnp.arange(0, dim, 2, dtype=jnp.float32) / dim)
    ang = pos[:, None] * inv_freq[None, :]
    return jnp.cos(ang), jnp.sin(ang)


def apply_rope(t, cos, sin):
    half = t.shape[-1] // 2
    tf = t.astype(jnp.float32)
    t1, t2 = tf[..., :half], tf[..., half:]
    c = cos[None, :, None, None, :]
    s = sin[None, :, None, None, :]
    out = jnp.concatenate([t1 * c - t2 * s, t2 * c + t1 * s], axis=-1)
    return out.astype(t.dtype)


def swiglu(h, w_in, w_out):
    gu = h @ w_in
    g, u = jnp.split(gu, 2, axis=-1)
    return (jax.nn.silu(g) * u) @ w_out


def diff_attention(q, k, v, lam, lambda_init, subln_g):
    b, s, h, _, dh = q.shape
    n_blocks = s // Q_BLOCK
    scale = dh ** -0.5
    qb = q.reshape(b, n_blocks, Q_BLOCK, h, 2, dh).transpose(1, 0, 2, 3, 4, 5)

    def block(q_blk):
        sc = jnp.einsum('bqhmd,bkhmd->bhmqk', q_blk, k,
                        preferred_element_type=jnp.float32) * scale
        p = jax.nn.softmax(sc, axis=-1)
        a = p[:, :, 0] - lam * p[:, :, 1]
        return jnp.einsum('bhqk,bkhe->bqhe', a.astype(v.dtype), v)

    o = lax.map(block, qb)
    o = o.transpose(1, 0, 2, 3, 4).reshape(b, s, h, 2 * dh)
    o = rms_norm(o, subln_g, SUBLN_EPS) * (1.0 - lambda_init)
    return o.reshape(b, s, h * 2 * dh)


def fourier_mix(u):
    b, s, _ = u.shape
    uf = u.astype(jnp.float32).reshape(b, s, N_FNET_GROUPS, FNET_GROUP_DIM)
    y = jnp.fft.fftn(uf, axes=(1, 3), norm="ortho").real
    return y.reshape(b, s, FNET_WIDTH).astype(u.dtype)


def setup_inputs(seed: int = 0) -> dict:
    key = jax.random.key(seed)
    ks = jax.random.split(key, 20)
    L, D, F = DEPTH, D_MODEL, D_FF
    nrm = lambda k, shape, fan_in, mult=1.0: jax.random.normal(k, shape, jnp.float32) * (mult * fan_in ** -0.5)
    return {
        "x": jax.random.normal(ks[0], (BATCH, SEQ, D), jnp.float32),
        "c": jax.random.normal(ks[1], (BATCH, D), jnp.float32),
        "ada_w": nrm(ks[2], (L, D, N_SUBLAYERS * N_MOD * D), D, 0.5),
        "ada_b": 0.01 * jax.random.normal(ks[3], (L, N_SUBLAYERS * N_MOD * D), jnp.float32),
        "pre_norm_g": 1.0 + 0.02 * jax.random.normal(ks[4], (L, N_SUBLAYERS, D), jnp.float32),
        "post_norm_g": 1.0 + 0.02 * jax.random.normal(ks[5], (L, N_SUBLAYERS, D), jnp.float32),
        "ffn1_w_in": nrm(ks[6], (L, D, 2 * F), D),
        "ffn1_w_out": nrm(ks[7], (L, F, D), F),
        "mix_w_in": nrm(ks[8], (L, D, IN_PROJ_WIDTH), D),
        "lambda_qk": LAMBDA_STD * jax.random.normal(ks[9], (L, 4, DIFF_HEAD_DIM), jnp.float32),
        "subln_g": 1.0 + 0.02 * jax.random.normal(ks[10], (L, DIFF_V_DIM), jnp.float32),
        "attn_proj": nrm(ks[11], (L, ATTN_WIDTH, D), ATTN_WIDTH),
        "fnet_proj": nrm(ks[12], (L, FNET_WIDTH, D), FNET_WIDTH),
        "branch_gate_w": nrm(ks[13], (L, D, N_BRANCHES * D), D),
        "branch_gate_b": 0.01 * jax.random.normal(ks[14], (L, N_BRANCHES * D), jnp.float32),
        "mix_w_out": nrm(ks[15], (L, D, D), D),
        "ffn2_w_in": nrm(ks[16], (L, D, 2 * F), D),
        "ffn2_w_out": nrm(ks[17], (L, F, D), F),
    }


def reference(x, c, ada_w, ada_b, pre_norm_g, post_norm_g, ffn1_w_in, ffn1_w_out, mix_w_in,
              lambda_qk, subln_g, attn_proj, fnet_proj, branch_gate_w, branch_gate_b, mix_w_out,
              ffn2_w_in, ffn2_w_out):
    b, s, d = x.shape
    cos, sin = rope_tables(s, DIFF_HEAD_DIM)
    c_act = jax.nn.silu(c)
    for l in range(DEPTH):
        lambda_init = 0.8 - 0.6 * math.exp(-0.3 * l)
        mod = (c_act @ ada_w[l] + ada_b[l]).reshape(b, N_SUBLAYERS, N_MOD, d)

        h = modulate(rms_norm(x, pre_norm_g[l, 0]), mod[:, 0, 0], mod[:, 0, 1])
        y = swiglu(h, ffn1_w_in[l], ffn1_w_out[l])
        x = x + MACARON_WEIGHT * mod[:, 0, 2][:, None, :] * rms_norm(y, post_norm_g[l, 0])

        h = modulate(rms_norm(x, pre_norm_g[l, 1]), mod[:, 1, 0], mod[:, 1, 1])
        z = h @ mix_w_in[l]
        q, k, v, u = jnp.split(z, [ATTN_WIDTH, 2 * ATTN_WIDTH, 3 * ATTN_WIDTH], axis=-1)
        q = apply_rope(q.reshape(b, s, N_DIFF_HEADS, 2, DIFF_HEAD_DIM), cos, sin)
        k = apply_rope(k.reshape(b, s, N_DIFF_HEADS, 2, DIFF_HEAD_DIM), cos, sin)
        v = v.reshape(b, s, N_DIFF_HEADS, DIFF_V_DIM)
        lq = lambda_qk[l].astype(jnp.float32)
        lam = jnp.exp(jnp.sum(lq[0] * lq[1])) - jnp.exp(jnp.sum(lq[2] * lq[3])) + lambda_init
        y_attn = diff_attention(q, k, v, lam, lambda_init, subln_g[l]) @ attn_proj[l]
        y_fnet = fourier_mix(u) @ fnet_proj[l]
        gates = jax.nn.sigmoid(h @ branch_gate_w[l] + branch_gate_b[l])
        g_attn, g_fnet = jnp.split(gates, 2, axis=-1)
        y = (g_attn * y_attn + g_fnet * y_fnet) @ mix_w_out[l]
        x = x + mod[:, 1, 2][:, None, :] * rms_norm(y, post_norm_g[l, 1])

        h = modulate(rms_norm(x, pre_norm_g[l, 2]), mod[:, 2, 0], mod[:, 2, 1])
        y = swiglu(h, ffn2_w_in[l], ffn2_w_out[l])
        x = x + MACARON_WEIGHT * mod[:, 2, 2][:, None, :] * rms_norm(y, post_norm_g[l, 2])
    return x
```

```cpp
#include <hip/hip_runtime.h>
#include <hip/hip_bf16.h>
#include <cstdio>
#include <cstdint>
#include <cmath>
namespace pg8 {
#define PG8_LAS __attribute__((address_space(3)))
typedef unsigned short bf16_t;
typedef short bf16x8 __attribute__((ext_vector_type(8)));
typedef float f32x4 __attribute__((ext_vector_type(4)));
typedef unsigned u32x4 __attribute__((ext_vector_type(4)));
constexpr int BM = 256, BK = 64, HALF = 128, HTB = HALF * BK * 2  , STAGE_BYTES = 8 * HTB, NXCD = 8, WGM = 8;

__host__ __device__ __forceinline__ int lds_byte(int r, int c) { const int st = (r >> 4) * 2 + (c >> 5), rr = r & 15, cc = c & 31, ob = rr * 64 + cc * 2; return st * 1024 + (ob ^ (((ob >> 9) & 1) << 5)); }
__host__ __device__ __forceinline__ void stage_rc(int b, int& R, int& C) { const int st = b / 1024, sb = b % 1024, swz = sb ^ (((sb >> 9) & 1) << 5); R = (st >> 1) * 16 + swz / 64; C = (st & 1) * 32 + (swz % 64) / 2; }
__host__ __device__ __forceinline__ int perm32(int rho) { const int n = rho >> 4, i = rho & 15; return 8 * (i >> 2) + 4 * n + (i & 3); }

struct Unit { int pm, pn; };
struct Gemm { const bf16_t* A; const bf16_t* Bt; int M, N, K; };

struct StaticOrder {
    int nM, nN, nwg, G, c;
    __host__ __device__ void init(int M, int N, int G_, int c_) { nM = M / BM; nN = N / BM; nwg = nM * nN; G = G_; c = c_; }
    __host__ __device__ bool next(int i, Unit& u) const {
        const long L = (long)i * G + c; if (L >= nwg) return false;
        int wgid = (int)L; { const int q = nwg / NXCD, r = nwg % NXCD, xcd = wgid % NXCD, off = wgid / NXCD; wgid = (xcd < r ? xcd * (q + 1) : r * (q + 1) + (xcd - r) * q) + off; }
        const int nig = WGM * nN, gid = wgid / nig, fm = gid * WGM, gsz = (nM - fm) < WGM ? (nM - fm) : WGM;
        u.pm = fm + ((wgid % nig) % gsz); u.pn = (wgid % nig) / gsz; return true;
    }
    __device__ __forceinline__ void a_ready(const Unit&) const {}
    __device__ __forceinline__ void done(const Unit&) const {}
};

typedef float cvt_f32x2 __attribute__((ext_vector_type(2))); typedef __bf16 cvt_bf16x2 __attribute__((ext_vector_type(2)));
__device__ __forceinline__ unsigned cvt_pk_bf16(float lo, float hi) { const cvt_f32x2 v = {lo, hi}; return __builtin_bit_cast(unsigned, __builtin_convertvector(v, cvt_bf16x2)); }
typedef float f32x2 __attribute__((ext_vector_type(2)));
__device__ __forceinline__ float bf_lo(unsigned w) { return __builtin_bit_cast(float, w << 16); }
__device__ __forceinline__ float bf_hi(unsigned w) { return __builtin_bit_cast(float, w & 0xffff0000u); }
__device__ __forceinline__ float sigmoid_f(float v) { return __builtin_amdgcn_rcpf(1.0f + __builtin_amdgcn_exp2f(v * -1.4426950408889634f)); }
__device__ __forceinline__ u32x4 pack8(const f32x4 a, const f32x4 b) { u32x4 w; w.x = cvt_pk_bf16(a[0], a[1]); w.y = cvt_pk_bf16(a[2], a[3]); w.z = cvt_pk_bf16(b[0], b[1]); w.w = cvt_pk_bf16(b[2], b[3]); return w; }

struct EpiPlain {
    static constexpr bool PERM = true, AFTER_DRAIN = false;
    bf16_t* O; int ldc;
    __device__ __forceinline__ void operator()(const f32x4 (&acc)[2][2][4][2], const Unit& u, int wr, int wc, int fr, int fq) const {
        const int row0 = u.pm * BM + wr * 64 + fr, col0 = u.pn * BM + wc * 32 + 8 * fq;
#pragma unroll
        for (int ai = 0; ai < 2; ++ai)
#pragma unroll
            for (int m = 0; m < 4; ++m) { bf16_t* rowp = O + (size_t)(row0 + ai * HALF + m * 16) * ldc + col0;
#pragma unroll
                for (int bj = 0; bj < 2; ++bj) *(u32x4*)(rowp + bj * HALF) = pack8(acc[ai][bj][m][0], acc[ai][bj][m][1]); }
    }
};
struct EpiSwiGLU {
    static constexpr bool PERM = true, AFTER_DRAIN = false;
    bf16_t* O; int ldc;
    __device__ __forceinline__ void operator()(const f32x4 (&acc)[2][2][4][2], const Unit& u, int wr, int wc, int fr, int fq) const {
        const int row0 = u.pm * BM + wr * 64 + fr, col0 = u.pn * HALF + wc * 32 + 8 * fq;
#pragma unroll
        for (int ai = 0; ai < 2; ++ai)
#pragma unroll
            for (int m = 0; m < 4; ++m) { bf16_t* rowp = O + (size_t)(row0 + ai * HALF + m * 16) * ldc + col0;
                f32x4 o[2];
#pragma unroll
                for (int n = 0; n < 2; ++n) { const f32x4 g = acc[ai][0][m][n], up = acc[ai][1][m][n];
#pragma unroll
                    for (int e = 0; e < 4; ++e) o[n][e] = g[e] * sigmoid_f(g[e]) * up[e]; }
                *(u32x4*)rowp = pack8(o[0], o[1]); }
    }
};
struct EpiMix {
    static constexpr bool PERM = true, AFTER_DRAIN = false;
    bf16_t *Q, *K, *V, *U, *G; const float* cosT; const float* sinT; const float* gbias;
    __device__ __forceinline__ void operator()(const f32x4 (&acc)[2][2][4][2], const Unit& u, int wr, int wc, int fr, int fq) const {
        const int pn = u.pn, row0 = u.pm * BM + wr * 64 + fr;
        if (pn < 8) {
            bf16_t* base = (pn < 4 ? Q : K) + ((pn & 3) * 4 + wc) * 64 + 8 * fq;
#pragma unroll
            for (int ai = 0; ai < 2; ++ai)
#pragma unroll
                for (int m = 0; m < 4; ++m) { const int row = row0 + ai * HALF + m * 16;
                    const f32x4 c0 = *(const f32x4*)(cosT + (size_t)row * 32 + 8 * fq), c1 = *(const f32x4*)(cosT + (size_t)row * 32 + 8 * fq + 4);
                    const f32x4 s0 = *(const f32x4*)(sinT + (size_t)row * 32 + 8 * fq), s1 = *(const f32x4*)(sinT + (size_t)row * 32 + 8 * fq + 4);
                    const f32x4 x1a = acc[ai][0][m][0], x1b = acc[ai][0][m][1], x2a = acc[ai][1][m][0], x2b = acc[ai][1][m][1];
                    const f32x4 o1a = x1a * c0 - x2a * s0, o1b = x1b * c1 - x2b * s1, o2a = x2a * c0 + x1a * s0, o2b = x2b * c1 + x1b * s1;
                    bf16_t* rowp = base + (size_t)row * 1024;
                    *(u32x4*)rowp = pack8(o1a, o1b); *(u32x4*)(rowp + 32) = pack8(o2a, o2b); }
        } else if (pn < 16) {
            bf16_t* base = (pn < 12 ? V : U) + (pn & 3) * BM + wc * 32 + 8 * fq;
#pragma unroll
            for (int ai = 0; ai < 2; ++ai)
#pragma unroll
                for (int m = 0; m < 4; ++m) { bf16_t* rowp = base + (size_t)(row0 + ai * HALF + m * 16) * 1024;
#pragma unroll
                    for (int bj = 0; bj < 2; ++bj) *(u32x4*)(rowp + bj * HALF) = pack8(acc[ai][bj][m][0], acc[ai][bj][m][1]); }
        } else {
            const int col0 = (pn - 16) * BM + wc * 32 + 8 * fq;
            f32x4 bv[2][2];
#pragma unroll
            for (int bj = 0; bj < 2; ++bj)
#pragma unroll
                for (int n = 0; n < 2; ++n) bv[bj][n] = *(const f32x4*)(gbias + col0 + bj * HALF + 4 * n);
#pragma unroll
            for (int ai = 0; ai < 2; ++ai)
#pragma unroll
                for (int m = 0; m < 4; ++m) { bf16_t* rowp = G + (size_t)(row0 + ai * HALF + m * 16) * 4096 + col0;
#pragma unroll
                    for (int bj = 0; bj < 2; ++bj) { f32x4 o[2];
#pragma unroll
                        for (int n = 0; n < 2; ++n) { const f32x4 v = acc[ai][bj][m][n] + bv[bj][n];
#pragma unroll
                            for (int e = 0; e < 4; ++e) o[n][e] = sigmoid_f(v[e]); }
                        *(u32x4*)(rowp + bj * HALF) = pack8(o[0], o[1]); } }
        }
    }
};
struct EpiGate {
    static constexpr bool PERM = true, AFTER_DRAIN = false;
    const bf16_t* gate; const bf16_t* addend; bf16_t* O;
    __device__ __forceinline__ void operator()(const f32x4 (&acc)[2][2][4][2], const Unit& u, int wr, int wc, int fr, int fq) const {
        const int row0 = u.pm * BM + wr * 64 + fr, col0 = u.pn * BM + wc * 32 + 8 * fq;
#pragma unroll
        for (int ai = 0; ai < 2; ++ai)
#pragma unroll
            for (int m = 0; m < 4; ++m) { const size_t row = (size_t)(row0 + ai * HALF + m * 16);
#pragma unroll
                for (int bj = 0; bj < 2; ++bj) { const u32x4 gw = *(const u32x4*)(gate + row * 4096 + col0 + bj * HALF);
                    f32x4 a = acc[ai][bj][m][0], b = acc[ai][bj][m][1];
                    a[0] *= bf_lo(gw.x); a[1] *= bf_hi(gw.x); a[2] *= bf_lo(gw.y); a[3] *= bf_hi(gw.y); b[0] *= bf_lo(gw.z); b[1] *= bf_hi(gw.z); b[2] *= bf_lo(gw.w); b[3] *= bf_hi(gw.w);
                    if (addend) { const u32x4 tw = *(const u32x4*)(addend + row * 2048 + col0 + bj * HALF);
                        a[0] += bf_lo(tw.x); a[1] += bf_hi(tw.x); a[2] += bf_lo(tw.y); a[3] += bf_hi(tw.y); b[0] += bf_lo(tw.z); b[1] += bf_hi(tw.z); b[2] += bf_lo(tw.w); b[3] += bf_hi(tw.w); }
                    *(u32x4*)(O + row * 2048 + col0 + bj * HALF) = pack8(a, b); } }
    }
};

template <class Epi, class Sched, bool ALIGN_EPI = false, bool SP2 = false>
__device__ __forceinline__ void gemm_phase(PG8_LAS unsigned char* lds, const Gemm g, const Sched& S, const Epi& E) {
    int tid = threadIdx.x; asm volatile("" : "+v"(tid));
    const int wid = __builtin_amdgcn_readfirstlane(tid >> 6), lane = tid & 63, wr = wid >> 2, wc = wid & 3, fr = lane & 15, fq = lane >> 4;
    const int K = g.K, nt = K / BK;
    unsigned voffA[2], voffB[2];
#pragma unroll
    for (int i = 0; i < 2; ++i) { int R, C; stage_rc(tid * 16 + i * 8192, R, C); const int Rb = Epi::PERM ? ((R & ~31) + perm32(R & 31)) : R;
        voffA[i] = (unsigned)(R * K + C) * 2u; voffB[i] = (unsigned)(Rb * K + C) * 2u; }
    const size_t kstep = (size_t)(BK * 2);
    const size_t hstep = (size_t)HALF * K * 2;
    const size_t tstep = 2 * hstep;
    const unsigned ldsw = (unsigned)wid * 1024u;
    const int aoff = lds_byte(wr * 64 + fr, fq * 8), boff = lds_byte(wc * 32 + fr, fq * 8);
#define PG8_SA(b, h) (((b) * 2 + (h)) * HTB)
#define PG8_SB(b, h) ((4 + (b) * 2 + (h)) * HTB)
#define PG8_STAGE(bufoff, gbase, voff) do { _Pragma("unroll") for (int _i = 0; _i < 2; ++_i) \
        __builtin_amdgcn_global_load_lds((const unsigned*)((const char*)(gbase) + (voff)[_i]), (PG8_LAS unsigned*)(lds + (bufoff) + ldsw + _i * 8192), 16, 0, 0); } while (0)
#define PG8_LDA(dst, b, h) do { _Pragma("unroll") for (int m = 0; m < 4; ++m) _Pragma("unroll") for (int k = 0; k < 2; ++k) dst[m][k] = *(const PG8_LAS bf16x8*)(lds + PG8_SA(b, h) + aoff + m * 2048 + k * 1024); } while (0)
#define PG8_LDB(dst, b, h) do { _Pragma("unroll") for (int n = 0; n < 2; ++n) _Pragma("unroll") for (int k = 0; k < 2; ++k) dst[n][k] = *(const PG8_LAS bf16x8*)(lds + PG8_SB(b, h) + boff + n * 2048 + k * 1024); } while (0)
#define PG8_MMA(ai, bj, At, Bt) do { __builtin_amdgcn_s_setprio(1); _Pragma("unroll") for (int m = 0; m < 4; ++m) _Pragma("unroll") for (int n = 0; n < 2; ++n) _Pragma("unroll") for (int k = 0; k < 2; ++k) \
        acc[ai][bj][m][n] = __builtin_amdgcn_mfma_f32_16x16x32_bf16(Bt[n][k], At[m][k], acc[ai][bj][m][n], 0, 0, 0); __builtin_amdgcn_s_setprio(0); } while (0)
#define PG8_WAIT_V(n) asm volatile("s_waitcnt vmcnt(" #n ")" ::: "memory")
#define PG8_WAIT_L(n) asm volatile("s_waitcnt lgkmcnt(" #n ")" ::: "memory")
#define PG8_BAR __builtin_amdgcn_s_barrier()
#define PG8_SCHED __builtin_amdgcn_sched_barrier(0)
    Unit cur, nxt; int ui = 0;
    if (!S.next(0, cur)) return;
    f32x4 acc[2][2][4][2];
#pragma unroll
    for (int a = 0; a < 2; ++a)
#pragma unroll
        for (int b = 0; b < 2; ++b)
#pragma unroll
            for (int m = 0; m < 4; ++m)
#pragma unroll
                for (int n = 0; n < 2; ++n) acc[a][b][m][n] = (f32x4){0.f, 0.f, 0.f, 0.f};
    bf16x8 At[4][2], B0[2][2], B1[2][2];
    const char* cA = (const char*)g.A + (size_t)cur.pm * tstep; const char* cB = (const char*)g.Bt + (size_t)cur.pn * tstep;
    S.a_ready(cur);
    if constexpr (SP2) {
        PG8_STAGE(PG8_SB(0, 0), cB, voffB); PG8_STAGE(PG8_SB(0, 1), cB + hstep, voffB); PG8_STAGE(PG8_SA(0, 0), cA, voffA); PG8_STAGE(PG8_SA(0, 1), cA + hstep, voffA);
        if (wr == 1) PG8_BAR;
        PG8_WAIT_V(2); PG8_BAR;
        PG8_STAGE(PG8_SB(1, 0), cB + kstep, voffB); PG8_STAGE(PG8_SA(1, 0), cA + kstep, voffA); PG8_STAGE(PG8_SB(1, 1), cB + hstep + kstep, voffB);
        PG8_WAIT_V(6); PG8_BAR;
    } else {
        PG8_STAGE(PG8_SB(0, 0), cB, voffB); PG8_STAGE(PG8_SA(0, 0), cA, voffA); PG8_STAGE(PG8_SB(0, 1), cB + hstep, voffB); PG8_STAGE(PG8_SA(0, 1), cA + hstep, voffA);
        if (wr == 1) PG8_BAR;
        PG8_WAIT_V(4); PG8_BAR;
        PG8_STAGE(PG8_SB(1, 0), cB + kstep, voffB); PG8_STAGE(PG8_SA(1, 0), cA + kstep, voffA); PG8_STAGE(PG8_SB(1, 1), cB + hstep + kstep, voffB);
        PG8_WAIT_V(6); PG8_BAR;
    }
    for (;;) {
        const bool has_next = S.next(ui + 1, nxt);
        const char* nA = has_next ? (const char*)g.A + (size_t)nxt.pm * tstep : cA; const char* nB = has_next ? (const char*)g.Bt + (size_t)nxt.pn * tstep : cB;
        for (int t = 0; t < nt; t += 2) {
            const bool last = (t == nt - 2);
            const char* a1 = cA + (size_t)(t + 1) * kstep;
            const char* a2 = last ? nA : cA + (size_t)(t + 2) * kstep; const char* b2 = last ? nB : cB + (size_t)(t + 2) * kstep;
            const char* a3 = a2 + kstep; const char* b3 = b2 + kstep;
            if (last && has_next) S.a_ready(nxt);
            if constexpr (SP2) {
            PG8_LDB(B0, 0, 0); PG8_LDB(B1, 0, 1); PG8_SCHED; PG8_LDA(At, 0, 0); PG8_STAGE(PG8_SA(1, 1), a1 + hstep, voffA);
            PG8_WAIT_V(8); PG8_WAIT_L(0); PG8_BAR; PG8_MMA(0, 0, At, B0); PG8_MMA(0, 1, At, B1); PG8_BAR; PG8_SCHED;
            PG8_LDA(At, 0, 1); PG8_STAGE(PG8_SB(0, 0), b2, voffB); PG8_STAGE(PG8_SB(0, 1), b2 + hstep, voffB); PG8_STAGE(PG8_SA(0, 0), a2, voffA);
            PG8_WAIT_V(8); PG8_WAIT_L(0); PG8_BAR; PG8_MMA(1, 0, At, B0); PG8_MMA(1, 1, At, B1); PG8_BAR; PG8_SCHED;
            PG8_LDB(B0, 1, 0); PG8_LDB(B1, 1, 1); PG8_SCHED; PG8_LDA(At, 1, 0); PG8_STAGE(PG8_SA(0, 1), a2 + hstep, voffA);
            PG8_WAIT_V(8); PG8_WAIT_L(0); PG8_BAR; PG8_MMA(0, 0, At, B0); PG8_MMA(0, 1, At, B1); PG8_BAR; PG8_SCHED;
            PG8_LDA(At, 1, 1); PG8_STAGE(PG8_SB(1, 0), b3, voffB); PG8_STAGE(PG8_SB(1, 1), b3 + hstep, voffB); PG8_STAGE(PG8_SA(1, 0), a3, voffA);
            PG8_WAIT_V(8); PG8_WAIT_L(0); PG8_BAR; PG8_MMA(1, 0, At, B0); PG8_MMA(1, 1, At, B1); PG8_BAR; PG8_SCHED;
            } else {
            PG8_LDB(B0, 0, 0); PG8_SCHED; PG8_LDA(At, 0, 0); PG8_STAGE(PG8_SA(1, 1), a1 + hstep, voffA);
            PG8_WAIT_L(8); PG8_BAR; PG8_WAIT_L(0); PG8_MMA(0, 0, At, B0); PG8_BAR; PG8_SCHED;
            PG8_LDB(B1, 0, 1); PG8_STAGE(PG8_SB(0, 0), b2, voffB);
            PG8_BAR; PG8_WAIT_L(0); PG8_MMA(0, 1, At, B1); PG8_BAR;
            PG8_LDA(At, 0, 1); PG8_STAGE(PG8_SA(0, 0), a2, voffA);
            PG8_BAR; PG8_WAIT_L(0); PG8_MMA(1, 0, At, B0); PG8_BAR; PG8_SCHED;
            PG8_STAGE(PG8_SB(0, 1), b2 + hstep, voffB);
            PG8_WAIT_V(6); PG8_BAR; PG8_MMA(1, 1, At, B1); PG8_BAR;
            PG8_LDB(B0, 1, 0); PG8_SCHED; PG8_LDA(At, 1, 0); PG8_STAGE(PG8_SA(0, 1), a2 + hstep, voffA);
            PG8_WAIT_L(8); PG8_BAR; PG8_WAIT_L(0); PG8_MMA(0, 0, At, B0); PG8_BAR; PG8_SCHED;
            PG8_LDB(B1, 1, 1); PG8_STAGE(PG8_SB(1, 0), b3, voffB);
            PG8_BAR; PG8_WAIT_L(0); PG8_MMA(0, 1, At, B1); PG8_BAR;
            PG8_LDA(At, 1, 1); PG8_STAGE(PG8_SA(1, 0), a3, voffA);
            PG8_BAR; PG8_WAIT_L(0); PG8_MMA(1, 0, At, B0); PG8_BAR; PG8_SCHED;
            PG8_STAGE(PG8_SB(1, 1), b3 + hstep, voffB);
            PG8_WAIT_V(6); PG8_BAR; PG8_MMA(1, 1, At, B1); PG8_BAR;
            }
        }
        if constexpr (ALIGN_EPI) { if (wr == 0) PG8_BAR; }
        if constexpr (!Epi::AFTER_DRAIN) { E(acc, cur, wr, wc, fr, fq); S.done(cur); }
        if (!has_next) break;
#pragma unroll
        for (int a = 0; a < 2; ++a)
#pragma unroll
            for (int b = 0; b < 2; ++b)
#pragma unroll
                for (int m = 0; m < 4; ++m)
#pragma unroll
                    for (int n = 0; n < 2; ++n) acc[a][b][m][n] = (f32x4){0.f, 0.f, 0.f, 0.f};
        cur = nxt; cA = nA; cB = nB; ++ui;
        if constexpr (ALIGN_EPI) { if (wr == 1) PG8_BAR; }
    }
    PG8_WAIT_V(0);
    if constexpr (!ALIGN_EPI) { if (wr == 0) PG8_BAR; }
    PG8_BAR;
    if constexpr (Epi::AFTER_DRAIN) { E.fused(acc, cur, wr, wc, fr, fq, lds, wid, lane); S.done(cur); }
#undef PG8_SA
#undef PG8_SB
#undef PG8_STAGE
#undef PG8_LDA
#undef PG8_LDB
#undef PG8_MMA
#undef PG8_WAIT_V
#undef PG8_WAIT_L
#undef PG8_BAR
#undef PG8_SCHED
}
}
namespace dattn {
#define DA_LAS __attribute__((address_space(3)))
typedef unsigned short bf16_t;
using bf16x8 = __attribute__((ext_vector_type(8))) short;
using s16x4  = __attribute__((ext_vector_type(4))) short;
using f32x16 = __attribute__((ext_vector_type(16))) float;
using u32x4  = __attribute__((ext_vector_type(4))) unsigned;
constexpr int NW = 8, QBLK = 32, KVBLK = 64, PITCH = 1024, LDO = 2048;
constexpr float SCALE = 0.125f;
constexpr float THR = 8.f;
constexpr int SHM_V = KVBLK * 128 * 2, SHM_K = KVBLK * 64 * 2;
constexpr int OFF_V = 0, OFF_K = 2 * SHM_V, OFF_WS = 2 * SHM_V + 2 * SHM_K, LDS_BYTES = OFF_WS + NW * 64 * 4;
#define DA_KSWZ(row, colB) ((row) * 128 + ((colB) ^ ((((row) >> 1) & 7) << 4)))
#define DA_SBAR() __builtin_amdgcn_sched_barrier(0)
__device__ __forceinline__ int crow(int r, int hi) { return (r & 3) + 8 * (r >> 2) + 4 * hi; }
typedef float cvt_f32x2 __attribute__((ext_vector_type(2))); typedef __bf16 cvt_bf16x2 __attribute__((ext_vector_type(2)));
__device__ __forceinline__ unsigned cvtpk(float lo, float hi) { const cvt_f32x2 v = {lo, hi}; return __builtin_bit_cast(unsigned, __builtin_convertvector(v, cvt_bf16x2)); }
__device__ __forceinline__ void partialSM(f32x16& p0, f32x16& p1, float& m_reg, float& mn, float& alpha) {
  constexpr float C = SCALE * 1.4426950408889634f;
  float pmax = p0[0];
#pragma unroll
  for (int r = 1; r < 16; ++r) pmax = fmaxf(pmax, p0[r]);
#pragma unroll
  for (int r = 0; r < 16; ++r) pmax = fmaxf(pmax, p1[r]);
  { auto rr = __builtin_amdgcn_permlane32_swap(__float_as_uint(pmax), __float_as_uint(pmax), false, false);
    pmax = fmaxf(__uint_as_float(rr[0]), __uint_as_float(rr[1])); }
  if (__builtin_expect(__all(pmax - m_reg <= THR / SCALE), 1)) { mn = m_reg; alpha = 1.f; }
  else { mn = fmaxf(m_reg, pmax); alpha = __builtin_amdgcn_exp2f((m_reg - mn) * C); m_reg = mn; }
  float mnC = -mn * C;
#pragma unroll
  for (int r = 0; r < 16; ++r) p0[r] = fmaf(p0[r], C, mnC);
#pragma unroll
  for (int r = 0; r < 16; ++r) p1[r] = fmaf(p1[r], C, mnC);
#pragma unroll
  for (int r = 0; r < 16; ++r) p0[r] = __builtin_amdgcn_exp2f(p0[r]);
}
__device__ __forceinline__ void finishSM(f32x16& p0, f32x16& p1, float alpha, float& l_reg, bf16x8& pa0, bf16x8& pa1, bf16x8& pa2, bf16x8& pa3) {
#pragma unroll
  for (int r = 0; r < 16; ++r) p1[r] = __builtin_amdgcn_exp2f(p1[r]);
  float ps = 0;
#pragma unroll
  for (int r = 0; r < 16; ++r) ps += p0[r];
#pragma unroll
  for (int r = 0; r < 16; ++r) ps += p1[r];
  { auto rr = __builtin_amdgcn_permlane32_swap(__float_as_uint(ps), __float_as_uint(ps), false, false);
    ps = __uint_as_float(rr[0]) + __uint_as_float(rr[1]); }
  l_reg = l_reg * alpha + ps;
#define DA_PK4(P, BASE, OUT) do { unsigned a0 = cvtpk(P[BASE + 0], P[BASE + 1]), a1 = cvtpk(P[BASE + 2], P[BASE + 3]);   \
    unsigned b0 = cvtpk(P[BASE + 4], P[BASE + 5]), b1 = cvtpk(P[BASE + 6], P[BASE + 7]);                              \
    auto r0 = __builtin_amdgcn_permlane32_swap(a0, b0, false, false); auto r1 = __builtin_amdgcn_permlane32_swap(a1, b1, false, false); \
    u32x4 w = {r0[0], r1[0], r0[1], r1[1]}; OUT = __builtin_bit_cast(bf16x8, w); } while (0)
  DA_PK4(p0, 0, pa0); DA_PK4(p0, 8, pa1); DA_PK4(p1, 0, pa2); DA_PK4(p1, 8, pa3);
}
__device__ __forceinline__ void qkt(f32x16& p0, f32x16& p1, const DA_LAS char* Ks, const bf16x8* qr, int r32, int hi) {
  p0 = f32x16{}; p1 = f32x16{};
#pragma unroll
  for (int d0 = 0; d0 < 4; ++d0) { const int cb = d0 * 32 + hi * 16;
    const bf16x8 b0 = *(const DA_LAS bf16x8*)(Ks + DA_KSWZ(r32, cb));
    const bf16x8 b1 = *(const DA_LAS bf16x8*)(Ks + DA_KSWZ(32 + r32, cb));
    p0 = __builtin_amdgcn_mfma_f32_32x32x16_bf16(b0, qr[d0], p0, 0, 0, 0);
    p1 = __builtin_amdgcn_mfma_f32_32x32x16_bf16(b1, qr[d0], p1, 0, 0, 0); }
}
__device__ __forceinline__ int v_st(int k, int c) { const int kk = (k & ~0xC) | ((k & 4) << 1) | ((k & 8) >> 1); return ((kk >> 3) * 4 + (c >> 5)) * 512 + ((kk & 7) * 32 + (c & 31)) * 2; }
__device__ __forceinline__ int v_rd_base(int lane) { return ((lane & 3) << 3) | (((lane >> 2) & 3) << 6) | (((lane >> 4) & 1) << 5) | (((lane >> 5) & 1) << 8); }
constexpr int v_rd_off(int d0, int ks, int half) { return d0 * 512 + ks * 4096 + half * 2048; }
template <int OFF> __device__ __forceinline__ s16x4 tr_read(int vb) {
  s16x4 r; asm volatile("ds_read_b64_tr_b16 %0, %1 offset:%2" : "=&v"(r) : "v"(vb), "i"(OFF) : "memory"); return r;
}
#define DA_PK(L, H) (bf16x8){L[0], L[1], L[2], L[3], H[0], H[1], H[2], H[3]}
template <int D0> __device__ __forceinline__ void pv_one(f32x16& od, int vb, bf16x8 pa0, bf16x8 pa1, bf16x8 pa2, bf16x8 pa3) {
  const s16x4 l0 = tr_read<v_rd_off(D0, 0, 0)>(vb), h0 = tr_read<v_rd_off(D0, 0, 1)>(vb), l1 = tr_read<v_rd_off(D0, 1, 0)>(vb), h1 = tr_read<v_rd_off(D0, 1, 1)>(vb);
  const s16x4 l2 = tr_read<v_rd_off(D0, 2, 0)>(vb), h2 = tr_read<v_rd_off(D0, 2, 1)>(vb), l3 = tr_read<v_rd_off(D0, 3, 0)>(vb), h3 = tr_read<v_rd_off(D0, 3, 1)>(vb);
  asm volatile("s_waitcnt lgkmcnt(0)" ::: "memory"); DA_SBAR();
  od = __builtin_amdgcn_mfma_f32_32x32x16_bf16(pa0, DA_PK(l0, h0), od, 0, 0, 0);
  od = __builtin_amdgcn_mfma_f32_32x32x16_bf16(pa1, DA_PK(l1, h1), od, 0, 0, 0);
  od = __builtin_amdgcn_mfma_f32_32x32x16_bf16(pa2, DA_PK(l2, h2), od, 0, 0, 0);
  od = __builtin_amdgcn_mfma_f32_32x32x16_bf16(pa3, DA_PK(l3, h3), od, 0, 0, 0);
}
__device__ __forceinline__ void pv_d0(f32x16* o, int vb, bf16x8 pa0, bf16x8 pa1, bf16x8 pa2, bf16x8 pa3) {
  pv_one<0>(o[0], vb, pa0, pa1, pa2, pa3); pv_one<1>(o[1], vb, pa0, pa1, pa2, pa3); pv_one<2>(o[2], vb, pa0, pa1, pa2, pa3); pv_one<3>(o[3], vb, pa0, pa1, pa2, pa3);
}
__device__ __forceinline__ void attn_unit(const bf16_t* __restrict__ Qb, const bf16_t* __restrict__ Kh, const bf16_t* __restrict__ Vh, float* __restrict__ Ob, int seq, DA_LAS char* lds) {
  int tid = threadIdx.x; asm volatile("" : "+v"(tid));
  const int wid = __builtin_amdgcn_readfirstlane(tid >> 6), lane = tid & 63, r32 = lane & 31, hi = lane >> 5;
  DA_LAS char* V_lds = lds + OFF_V; DA_LAS char* K_lds = lds + OFF_K;
  DA_LAS float* ws = (DA_LAS float*)(lds + OFF_WS) + wid * 64; DA_LAS float* li_l = ws; DA_LAS float* al_l = ws + 32;
  float m_reg = -1e30f, l_reg = 0; f32x16 o[4] = {}; bf16x8 qr[4];
  const bf16_t* Qw = Qb + (long)(wid * QBLK + r32) * PITCH + hi * 8;
#pragma unroll
  for (int d0 = 0; d0 < 4; ++d0) qr[d0] = *(const bf16x8*)(Qw + d0 * 16);
  const int sr = tid >> 4, sc = (tid & 15) * 8, vst0 = v_st(sr, sc), vst1 = v_st(32 + sr, sc);
  const int kr = tid >> 3, kc = (tid & 7) * 8, kst = DA_KSWZ(kr, kc * 2);
  const int vb0 = (int)(unsigned)(size_t)V_lds + v_rd_base(lane);
  struct { bf16x8 vs0, vs1, ks0; } sr_[2];
#define DA_SLOAD(i, k0) do { sr_[i].vs0 = *(const bf16x8*)(&Vh[(long)((k0) + sr) * PITCH + sc]); sr_[i].vs1 = *(const bf16x8*)(&Vh[(long)((k0) + 32 + sr) * PITCH + sc]); \
    sr_[i].ks0 = *(const bf16x8*)(&Kh[(long)((k0) + kr) * PITCH + kc]); } while (0)
#define DA_SWRITE(b, i) do { *(DA_LAS bf16x8*)(V_lds + (b) * SHM_V + vst0) = sr_[i].vs0; *(DA_LAS bf16x8*)(V_lds + (b) * SHM_V + vst1) = sr_[i].vs1; \
    *(DA_LAS bf16x8*)(K_lds + (b) * SHM_K + kst) = sr_[i].ks0; } while (0)
#define DA_SWAIT() asm volatile("s_waitcnt vmcnt(3)" ::: "memory")
#define DA_RESC(a) do { if (__any((a) < 1.f)) { if (hi == 0) al_l[r32] = (a); asm volatile("s_waitcnt lgkmcnt(0)" ::: "memory"); \
    _Pragma("unroll") for (int d = 0; d < 4; ++d) _Pragma("unroll") for (int r = 0; r < 16; ++r) o[d][r] *= al_l[crow(r, hi)]; } } while (0)
  f32x16 pA0, pA1, pB0, pB1; float mnA, mnB, alA, alB; bf16x8 pa0, pa1, pa2, pa3; const int NT = seq / KVBLK;
  constexpr int SE = 0, SO = 1;
  DA_SLOAD(SE, 0); asm volatile("s_waitcnt vmcnt(0)" ::: "memory"); DA_SWRITE(0, SE); __syncthreads();
  qkt(pA0, pA1, K_lds, qr, r32, hi); partialSM(pA0, pA1, m_reg, mnA, alA);
  DA_SLOAD(SO, KVBLK); if (2 < NT) DA_SLOAD(SE, 2 * KVBLK);
  DA_SWAIT(); DA_SWRITE(1, SO); __syncthreads();
  for (int j = 1; j + 1 < NT; j += 2) {
    DA_SBAR(); qkt(pB0, pB1, K_lds + SHM_K, qr, r32, hi);
    finishSM(pA0, pA1, alA, l_reg, pa0, pa1, pa2, pa3); DA_SBAR();
    DA_SLOAD(SO, (j + 2) * KVBLK); DA_SBAR();
    pv_d0(o, vb0, pa0, pa1, pa2, pa3); partialSM(pB0, pB1, m_reg, mnB, alB);
    __syncthreads(); DA_SWAIT(); DA_SWRITE(0, SE);
    DA_RESC(alB); __syncthreads();
    DA_SBAR(); qkt(pA0, pA1, K_lds, qr, r32, hi);
    finishSM(pB0, pB1, alB, l_reg, pa0, pa1, pa2, pa3); DA_SBAR();
    if (j + 3 < NT) DA_SLOAD(SE, (j + 3) * KVBLK); DA_SBAR();
    pv_d0(o, vb0 + SHM_V, pa0, pa1, pa2, pa3); partialSM(pA0, pA1, m_reg, mnA, alA);
    __syncthreads(); DA_SWAIT(); DA_SWRITE(1, SO);
    DA_RESC(alA); __syncthreads();
  }
  DA_SBAR(); qkt(pB0, pB1, K_lds + SHM_K, qr, r32, hi);
  finishSM(pA0, pA1, alA, l_reg, pa0, pa1, pa2, pa3); DA_SBAR();
  pv_d0(o, vb0, pa0, pa1, pa2, pa3); partialSM(pB0, pB1, m_reg, mnB, alB);
  __syncthreads(); DA_RESC(alB);
  finishSM(pB0, pB1, alB, l_reg, pa0, pa1, pa2, pa3); DA_SBAR();
  pv_d0(o, vb0 + SHM_V, pa0, pa1, pa2, pa3);
  if (hi == 0) li_l[r32] = l_reg; asm volatile("s_waitcnt lgkmcnt(0)" ::: "memory");
  float rli[16];
#pragma unroll
  for (int r = 0; r < 16; ++r) rli[r] = __builtin_amdgcn_rcpf(li_l[crow(r, hi)]);
  float* Ow = Ob + (long)(wid * QBLK) * LDO;
#pragma unroll
  for (int r = 0; r < 16; ++r) { const int orow = crow(r, hi);
#pragma unroll
    for (int d0 = 0; d0 < 4; ++d0) Ow[(long)orow * LDO + d0 * 32 + r32] = o[d0][r] * rli[r]; }
  asm volatile("s_waitcnt lgkmcnt(0)" ::: "memory"); __syncthreads();
#undef DA_SLOAD
#undef DA_SWRITE
#undef DA_SWAIT
#undef DA_RESC
}
}

constexpr int NWAVES = 8;
constexpr int SEQ = 16384, DM = 2048, FF = 5632, AW = 1024, NHEAD = 8, FW = 1024, NGRP = 8, GD = 128, DEPTH = 2;
constexpr int NMOD = 9 * DM;
constexpr int KSPLIT = 16;
constexpr float NORM_EPS = 1e-6f, SUBLN_EPS = 1e-5f;

constexpr size_t MiB = 1u << 20;
constexpr size_t WS_CTL = 0, CTL_ZERO_BYTES = 1 * MiB;
constexpr size_t WS_COS = 1 * MiB, WS_SIN = 3 * MiB;
constexpr size_t WS_DFTC = 5 * MiB, WS_DFTS = 5 * MiB + 32768, WS_TW = 5 * MiB + 65536;
constexpr size_t WS_MODP = 6 * MiB;
constexpr size_t WS_MODF = 9 * MiB;
constexpr size_t WS_LAM = WS_MODF + (size_t)DEPTH * 9 * DM * 4;
constexpr size_t WS_W = 10 * MiB, W_LAYER = 180 * MiB;
constexpr size_t W_1IN = 0, W_1OUT = 44 * MiB, W_MIX = 66 * MiB, W_AP = 98 * MiB, W_FP = 102 * MiB, W_MO = 106 * MiB, W_2IN = 114 * MiB, W_2OUT = 158 * MiB;
constexpr size_t WS_H = 370 * MiB, WS_Y = 434 * MiB, WS_ACT = 498 * MiB, WS_M1 = 674 * MiB, WS_O = 802 * MiB, WS_END = 930 * MiB;
constexpr size_t WS_TRE = WS_Y, WS_TIM = WS_Y + 32 * MiB;
constexpr size_t WS_GATE = WS_ACT;
constexpr size_t WS_Q = WS_M1, WS_K = WS_M1 + 32 * MiB, WS_V = WS_M1 + 64 * MiB, WS_U = WS_M1 + 96 * MiB;
constexpr size_t WS_YF = WS_M1, WS_AO = WS_M1 + 32 * MiB, WS_MG = WS_M1 + 64 * MiB;
constexpr size_t WS_TT = WS_O;
constexpr int CW_TMO = 0, CW_CODE = 1, CW_BAR = 4096, CW_CHK = 16384;

constexpr int RING_OFF = 0, PHASE_LDS = 143360;
constexpr int LDSCTL_OFF = PHASE_LDS, MISC_OFF = LDSCTL_OFF + 320;
constexpr int LDS_BYTES = 147456;
static_assert(MISC_OFF + 128 <= LDS_BYTES, "LDS map");

#define GAS __attribute__((address_space(1)))
#define LAS __attribute__((address_space(3)))
typedef unsigned short bf16;
typedef unsigned v4u __attribute__((ext_vector_type(4)));
typedef unsigned v2u __attribute__((ext_vector_type(2)));
typedef float f32x4 __attribute__((ext_vector_type(4)));
typedef float f32x16 __attribute__((ext_vector_type(16)));
typedef short bf16x8 __attribute__((ext_vector_type(8)));
typedef short s16x4 __attribute__((ext_vector_type(4)));
typedef GAS unsigned gu32;
#define RLX_AGENT __ATOMIC_RELAXED, __HIP_MEMORY_SCOPE_AGENT
#define LDS_WAIT() asm volatile("s_waitcnt lgkmcnt(0)" ::: "memory")
#define VM_WAIT() asm volatile("s_waitcnt vmcnt(0)" ::: "memory")
__device__ __forceinline__ unsigned f2bf(float f) { unsigned u = __builtin_bit_cast(unsigned, f); return (u + 0x7fffu + ((u >> 16) & 1u)) >> 16; }
__device__ __forceinline__ unsigned pk2(float lo, float hi) { return f2bf(lo) | (f2bf(hi) << 16); }
__device__ __forceinline__ float bfl(unsigned w) { return __builtin_bit_cast(float, w << 16); }
__device__ __forceinline__ float bfh(unsigned w) { return __builtin_bit_cast(float, w & 0xffff0000u); }
__device__ __forceinline__ float wave_sum(float v) {
#pragma unroll
    for (int o = 1; o < 64; o <<= 1) v += __shfl_xor(v, o);
    return v;
}
__device__ __forceinline__ void sincos_turns(double t, double& s, double& c) {
    t -= floor(t);
    const double q = floor(t * 4.0 + 0.5);
    const double x = (t - q * 0.25) * 6.283185307179586476925286766559;
    const double x2 = x * x;
    double sp = -1.0 / 1307674368000.0; sp = sp * x2 + 1.0 / 6227020800.0; sp = sp * x2 - 1.0 / 39916800.0; sp = sp * x2 + 1.0 / 362880.0; sp = sp * x2 - 1.0 / 5040.0; sp = sp * x2 + 1.0 / 120.0; sp = sp * x2 - 1.0 / 6.0; sp = sp * x2 + 1.0;
    const double sx = sp * x;
    double cp = 1.0 / 20922789888000.0; cp = cp * x2 - 1.0 / 87178291200.0; cp = cp * x2 + 1.0 / 479001600.0; cp = cp * x2 - 1.0 / 3628800.0; cp = cp * x2 + 1.0 / 40320.0; cp = cp * x2 - 1.0 / 720.0; cp = cp * x2 + 1.0 / 24.0; cp = cp * x2 - 0.5; cp = cp * x2 + 1.0;
    const int qi = ((int)q) & 3;
    s = (qi == 0) ? sx : (qi == 1) ? cp : (qi == 2) ? -sx : -cp;
    c = (qi == 0) ? cp : (qi == 1) ? -sx : (qi == 2) ? -cp : sx;
}
__constant__ float ROPE_INV_FREQ[32] = {1.f,0.749894261f,0.562341332f,0.421696514f,0.316227764f,0.237137377f,0.177827939f,0.133352131f,0.100000001f,0.0749894157f,0.0562341325f,0.0421696529f,0.0316227749f,0.0237137377f,0.0177827943f,0.0133352149f,0.00999999978f,0.00749894185f,0.00562341325f,0.00421696482f,0.00316227763f,0.00237137359f,0.00177827943f,0.00133352145f,0.00100000005f,0.000749894243f,0.000562341302f,0.000421696517f,0.000316227757f,0.00023713737f,0.00017782794f,0.00013335215f};

#define XB_TMO      128
#define XB_XCNT(j)  (256  + 64 * (j))
#define XB_XSUB(j)  (1280 + 64 * (j))
#define XB_XGEN(j)  (2304 + 64 * (j))
#define XB_TOP      3328
#define XB_TOPGEN   3392
#define XCD_BAR_WORDS 3456
#define XB_SPIN_CAP (1u << 18)

__device__ __forceinline__ unsigned xb_ld(unsigned* p)              { return __hip_atomic_load(p, __ATOMIC_RELAXED, __HIP_MEMORY_SCOPE_AGENT); }
__device__ __forceinline__ unsigned xb_add(unsigned* p, unsigned v) { return __hip_atomic_fetch_add(p, v, __ATOMIC_RELAXED, __HIP_MEMORY_SCOPE_AGENT); }
__device__ __forceinline__ unsigned xb_xcc_id() { return (unsigned)__builtin_amdgcn_s_getreg((3 << 11) | 20) & 0xFu; }
#define XB_SPIN(cond, bar) do { unsigned _sp = 0; while (cond) { __builtin_amdgcn_s_sleep(1); \
    if ((++_sp & 255u) == 0u) { if (xb_ld(&(bar)[XB_TMO])) break; if (_sp > XB_SPIN_CAP) { atomicAdd(&(bar)[XB_TMO], 1u); break; } } } } while (0)

struct XcdBarrier {
    unsigned* bar; unsigned x;
    volatile LAS unsigned* st;
};

__device__ __forceinline__ XcdBarrier xcd_barrier_post(unsigned* bar, volatile LAS unsigned* st) {
    XcdBarrier b; b.bar = bar; b.x = xb_xcc_id(); b.st = st;
    if (threadIdx.x == 0) (void)xb_add(&bar[XB_XCNT(b.x)], 1u);
    return b;
}
__device__ __forceinline__ void xcd_barrier_complete(unsigned* bar, unsigned x, unsigned& nloc, unsigned& nx) {
    const unsigned G = gridDim.x * gridDim.y * gridDim.z;
    unsigned sum, cnt, mine, sp = 0u;
    for (;;) {
        sum = 0u; cnt = 0u; mine = 0u;
#pragma unroll
        for (unsigned j = 0; j < 16; ++j) { const unsigned c = xb_ld(&bar[XB_XCNT(j)]); sum += c; cnt += (c > 0u) ? 1u : 0u; mine = (j == x) ? c : mine; }
        if (sum == G) break;
        __builtin_amdgcn_s_sleep(1);
        if ((++sp & 255u) == 0u) { if (xb_ld(&bar[XB_TMO])) break; if (sp > XB_SPIN_CAP) { atomicAdd(&bar[XB_TMO], 1u); break; } }
    }
    nloc = mine > 0u ? mine : 1u; nx = cnt > 0u ? cnt : 1u;
}

__device__ __forceinline__ void xcd_barrier(const XcdBarrier& b) {
    asm volatile("s_waitcnt vmcnt(0)" ::: "memory");
    __syncthreads();
    if (threadIdx.x == 0) {
        unsigned* bar = b.bar;
        __builtin_amdgcn_s_waitcnt(0);
        unsigned nloc = b.st[0], nx = b.st[1];
        if (nloc == 0u) { xcd_barrier_complete(bar, b.x, nloc, nx); b.st[0] = nloc; b.st[1] = nx; }
        const unsigned old = xb_add(&bar[XB_XSUB(b.x)], 1u);
        const unsigned gen = old / nloc;
        if (old + 1u == (gen + 1u) * nloc) {
            __builtin_amdgcn_fence(__ATOMIC_RELEASE, "agent");
            asm volatile("s_waitcnt vmcnt(0)" ::: "memory");
            const unsigned og = xb_add(&bar[XB_TOP], 1u);
            const unsigned tg = og / nx;
            if (og + 1u == (tg + 1u) * nx) xb_add(&bar[XB_TOPGEN], 1u);
            else XB_SPIN(xb_ld(&bar[XB_TOPGEN]) == tg, bar);
            __builtin_amdgcn_fence(__ATOMIC_ACQUIRE, "agent");
            xb_add(&bar[XB_XGEN(b.x)], 1u);
            asm volatile("s_waitcnt vmcnt(0)" ::: "memory");
        } else {
            XB_SPIN(xb_ld(&bar[XB_XGEN(b.x)]) == gen, bar);
            __builtin_amdgcn_fence(__ATOMIC_ACQUIRE, "agent");
            asm volatile("s_waitcnt vmcnt(0)" ::: "memory");
        }
    }
    __syncthreads();
}
struct Frame {
    LAS unsigned char* lds;
    volatile LAS unsigned* MISC;
    gu32* ctl;
    int tid, lane, wave;
    int vcu, G;
    unsigned char* ws;
};

__device__ __forceinline__ int wt_row(int mode, int row_off, int n0) {
    if (mode == 1) { const int up = n0 >= FF ? 1 : 0, j = n0 - up * FF; return (j >> 7) * 256 + up * 128 + (j & 127); }
    if (mode == 2) { if (n0 < 2048) { const int ch = n0 >> 6, d = n0 & 63; return 256 * (ch >> 2) + 128 * (d >> 5) + 32 * (ch & 3) + (d & 31); } return n0; }
    return row_off + n0;
}
__device__ __forceinline__ void p0_transpose_item(const float* W, int K, int N, bf16* WT, int mode, int row_off, LAS float* scr, int item, int lane) {
    const int nblk = N / 32, kb = item / nblk, nb = item % nblk, k0 = 64 * kb, n0 = 32 * nb;
#pragma unroll 8
    for (int i = 0; i < 32; ++i) { const int kk = 2 * i + (lane >> 5); scr[kk * 33 + (lane & 31)] = W[(size_t)(k0 + kk) * N + n0 + (lane & 31)]; }
    LDS_WAIT(); asm volatile("" ::: "memory");
    const int c = lane & 7, rbase = wt_row(mode, row_off, n0);
#pragma unroll
    for (int j = 0; j < 4; ++j) { const int n = (lane >> 3) + 8 * j; const LAS float* s = scr + (8 * c) * 33 + n;
        v4u o; o.x = pk2(s[0 * 33], s[1 * 33]); o.y = pk2(s[2 * 33], s[3 * 33]); o.z = pk2(s[4 * 33], s[5 * 33]); o.w = pk2(s[6 * 33], s[7 * 33]);
        *(GAS v4u*)(WT + (size_t)(rbase + n) * K + k0 + 8 * c) = o; }
    LDS_WAIT(); asm volatile("" ::: "memory");
}
struct In18 { const float* p[18]; };
__device__ __forceinline__ void p0_prologue(Frame& F, const In18& in) {
    LAS float* scr = (LAS float*)(F.lds + RING_OFF + F.wave * 16384);
    const int gw = F.vcu * NWAVES + F.wave, NGW = F.G * NWAVES;
    constexpr int I0 = 32 * 352, I1 = 88 * 64, I2 = 32 * 128, I3 = 32 * 128, I4 = 16 * 64, I5 = 16 * 64, I6 = 32 * 64, IL = 2 * I0 + 2 * I1 + I2 + I3 + I4 + I5 + I6;
    for (int it = gw; it < DEPTH * IL; it += NGW) {
        const int l = it / IL; int r = it % IL;
        bf16* wl = (bf16*)(F.ws + WS_W + (size_t)l * W_LAYER);
        if (r < I0) { p0_transpose_item(in.p[6] + (size_t)l * DM * 2 * FF, DM, 2 * FF, (bf16*)((unsigned char*)wl + W_1IN), 1, 0, scr, r, F.lane); continue; } r -= I0;
        if (r < I1) { p0_transpose_item(in.p[7] + (size_t)l * FF * DM, FF, DM, (bf16*)((unsigned char*)wl + W_1OUT), 0, 0, scr, r, F.lane); continue; } r -= I1;
        if (r < I2) { p0_transpose_item(in.p[8] + (size_t)l * DM * 4096, DM, 4096, (bf16*)((unsigned char*)wl + W_MIX), 2, 0, scr, r, F.lane); continue; } r -= I2;
        if (r < I3) { p0_transpose_item(in.p[13] + (size_t)l * DM * 4096, DM, 4096, (bf16*)((unsigned char*)wl + W_MIX), 0, 4096, scr, r, F.lane); continue; } r -= I3;
        if (r < I4) { p0_transpose_item(in.p[11] + (size_t)l * AW * DM, AW, DM, (bf16*)((unsigned char*)wl + W_AP), 0, 0, scr, r, F.lane); continue; } r -= I4;
        if (r < I5) { p0_transpose_item(in.p[12] + (size_t)l * FW * DM, FW, DM, (bf16*)((unsigned char*)wl + W_FP), 0, 0, scr, r, F.lane); continue; } r -= I5;
        if (r < I6) { p0_transpose_item(in.p[15] + (size_t)l * DM * DM, DM, DM, (bf16*)((unsigned char*)wl + W_MO), 0, 0, scr, r, F.lane); continue; } r -= I6;
        if (r < I0) { p0_transpose_item(in.p[16] + (size_t)l * DM * 2 * FF, DM, 2 * FF, (bf16*)((unsigned char*)wl + W_2IN), 1, 0, scr, r, F.lane); continue; } r -= I0;
        p0_transpose_item(in.p[17] + (size_t)l * FF * DM, FF, DM, (bf16*)((unsigned char*)wl + W_2OUT), 0, 0, scr, r, F.lane);
    }
    {
        constexpr int NCB = NMOD / 256, KR = DM / KSPLIT;
        const float* cvec = in.p[1]; float* modp = (float*)(F.ws + WS_MODP);
        for (int it = gw; it < DEPTH * NCB * KSPLIT; it += NGW) {
            const int l = it / (NCB * KSPLIT), r = it % (NCB * KSPLIT), ks = r / NCB, cb = r % NCB, c0 = cb * 256 + 4 * F.lane, k0 = ks * KR;
            const float* W = in.p[2] + (size_t)l * DM * NMOD + (size_t)k0 * NMOD + c0;
            f32x4 acc = {0.f, 0.f, 0.f, 0.f};
#pragma unroll 8
            for (int k = 0; k < KR; ++k) { const float cv = cvec[k0 + k]; const float ca = cv * __builtin_amdgcn_rcpf(1.0f + __builtin_amdgcn_exp2f(cv * -1.4426950408889634f));
                const f32x4 w = *(const GAS f32x4*)(W + (size_t)k * NMOD); acc += w * ca; }
            *(GAS f32x4*)(modp + (size_t)(l * KSPLIT + ks) * NMOD + c0) = acc;
        }
    }
    {
        const int gt = F.vcu * (NWAVES * 64) + F.tid, NT = F.G * NWAVES * 64;
        float* cosT = (float*)(F.ws + WS_COS); float* sinT = (float*)(F.ws + WS_SIN);
        for (int idx = gt; idx < SEQ * 32; idx += NT) { const int pos = idx >> 5, i = idx & 31; const float ang = (float)pos * ROPE_INV_FREQ[i];
            double s, c; sincos_turns((double)ang * 0.15915494309189533576888376337251, s, c); cosT[idx] = (float)c; sinT[idx] = (float)s; }
        bf16* dC = (bf16*)(F.ws + WS_DFTC); bf16* dS = (bf16*)(F.ws + WS_DFTS); float* tw = (float*)(F.ws + WS_TW);
        for (int idx = gt; idx < 128 * 128; idx += NT) { const int a = idx >> 7, b = idx & 127; double s, c;
            sincos_turns((double)((a * b) & 127) * (1.0 / 128.0), s, c); dC[idx] = (bf16)f2bf((float)c); dS[idx] = (bf16)f2bf((float)s);
            sincos_turns((double)(a * b) * (1.0 / 16384.0), s, c); tw[2 * idx] = (float)c; tw[2 * idx + 1] = (float)s; }
    }
}
__device__ __forceinline__ void p1_modfin(Frame& F, const In18& in) {
    const int gt = F.vcu * (NWAVES * 64) + F.tid, NT = F.G * NWAVES * 64;
    const float* modp = (const float*)(F.ws + WS_MODP); float* modf = (float*)(F.ws + WS_MODF);
    for (int idx = gt; idx < DEPTH * 3 * DM; idx += NT) { const int l = idx / (3 * DM), s = (idx / DM) % 3, c = idx % DM, base = s * 3 * DM + c;
        float sh = in.p[3][l * NMOD + base], sc = in.p[3][l * NMOD + base + DM], gt_ = in.p[3][l * NMOD + base + 2 * DM];
        for (int ks = 0; ks < KSPLIT; ++ks) { const float* q = modp + (size_t)(l * KSPLIT + ks) * NMOD + base; sh += q[0]; sc += q[DM]; gt_ += q[2 * DM]; }
        const float gpre = in.p[4][(l * 3 + s) * DM + c], gpost = in.p[5][(l * 3 + s) * DM + c];
        float* o = modf + (size_t)((l * 3 + s) * 3) * DM + c;
        o[0] = gpre * (1.0f + sc); o[DM] = sh; o[2 * DM] = (s == 1 ? 1.0f : 0.5f) * gt_ * gpost; }
    if (blockIdx.x == 0 && F.wave < DEPTH) { const int l = F.wave; const float* lq = in.p[9] + l * 256;
        const float sa = wave_sum(lq[F.lane] * lq[64 + F.lane]), sb = wave_sum(lq[128 + F.lane] * lq[192 + F.lane]);
        const float linit = l == 0 ? 0.2f : 0.35550906758f;
        if (F.lane == 0) { float* lamv = (float*)(F.ws + WS_LAM); lamv[l] = __builtin_amdgcn_exp2f(sa * 1.4426950408889634f) - __builtin_amdgcn_exp2f(sb * 1.4426950408889634f) + linit; lamv[2 + l] = 1.0f - linit; } }
}
template <bool HAS_Y, bool HAS_H>
__device__ __forceinline__ void norm_phase(Frame& F, const float* xin, float* xout, const bf16* y, bf16* h, const float* Gv, const float* Av, const float* Bv) {
    int lane = F.lane; asm volatile("" : "+v"(lane));
    const int gw = F.vcu * NWAVES + F.wave, NGW = F.G * NWAVES;
    f32x4 g[8], a[8], b[8];
#pragma unroll
    for (int j = 0; j < 8; ++j) { if (HAS_Y) g[j] = *(const GAS f32x4*)(Gv + 4 * lane + 256 * j); if (HAS_H) { a[j] = *(const GAS f32x4*)(Av + 4 * lane + 256 * j); b[j] = *(const GAS f32x4*)(Bv + 4 * lane + 256 * j); } }
    for (int row = gw; row < SEQ; row += NGW) {
        f32x4 x[8];
#pragma unroll
        for (int j = 0; j < 8; ++j) x[j] = *(const GAS f32x4*)(xin + (size_t)row * DM + 4 * lane + 256 * j);
        if (HAS_Y) {
            f32x4 yv[8]; float ss = 0.f;
#pragma unroll
            for (int j = 0; j < 8; ++j) { const v2u w = *(const GAS v2u*)(y + (size_t)row * DM + 4 * lane + 256 * j); yv[j] = (f32x4){bfl(w.x), bfh(w.x), bfl(w.y), bfh(w.y)};
                ss += (yv[j].x * yv[j].x + yv[j].y * yv[j].y) + (yv[j].z * yv[j].z + yv[j].w * yv[j].w); }
            const float ry = 1.0f / sqrtf(wave_sum(ss) * (1.0f / DM) + NORM_EPS);
#pragma unroll
            for (int j = 0; j < 8; ++j) x[j] = x[j] + g[j] * yv[j] * ry;
        }
#pragma unroll
        for (int j = 0; j < 8; ++j) *(GAS f32x4*)(xout + (size_t)row * DM + 4 * lane + 256 * j) = x[j];
        if (HAS_H) {
            float ss = 0.f;
#pragma unroll
            for (int j = 0; j < 8; ++j) ss += (x[j].x * x[j].x + x[j].y * x[j].y) + (x[j].z * x[j].z + x[j].w * x[j].w);
            const float rx = 1.0f / sqrtf(wave_sum(ss) * (1.0f / DM) + NORM_EPS);
#pragma unroll
            for (int j = 0; j < 8; ++j) { const f32x4 v = x[j] * rx * a[j] + b[j]; v2u w; w.x = pk2(v.x, v.y); w.y = pk2(v.z, v.w); *(GAS v2u*)(h + (size_t)row * DM + 4 * lane + 256 * j) = w; }
        }
    }
}
__device__ __forceinline__ void combine_phase(Frame& F, const float* O, bf16* AO, const float* subg, float lam, float oscale) {
    int lane = F.lane; asm volatile("" : "+v"(lane));
    const int gw = F.vcu * NWAVES + F.wave, NGW = F.G * NWAVES, hh = lane >> 3, e0 = (lane & 7) * 16;
    f32x4 g[4];
#pragma unroll
    for (int j = 0; j < 4; ++j) g[j] = *(const GAS f32x4*)(subg + e0 + 4 * j) * oscale;
    for (int row = gw; row < SEQ; row += NGW) {
        const float* p0 = O + (size_t)row * 2048 + hh * 256 + e0;
        f32x4 o[4]; float ss = 0.f;
#pragma unroll
        for (int j = 0; j < 4; ++j) { const f32x4 a = *(const GAS f32x4*)(p0 + 4 * j), b = *(const GAS f32x4*)(p0 + 128 + 4 * j); o[j] = a - b * lam; ss += (o[j].x * o[j].x + o[j].y * o[j].y) + (o[j].z * o[j].z + o[j].w * o[j].w); }
        ss += __shfl_xor(ss, 1); ss += __shfl_xor(ss, 2); ss += __shfl_xor(ss, 4);
        const float r = 1.0f / sqrtf(ss * (1.0f / 128.0f) + SUBLN_EPS);
        v4u w0, w1; { const f32x4 v0 = o[0] * r * g[0], v1 = o[1] * r * g[1], v2 = o[2] * r * g[2], v3 = o[3] * r * g[3];
            w0.x = pk2(v0.x, v0.y); w0.y = pk2(v0.z, v0.w); w0.z = pk2(v1.x, v1.y); w0.w = pk2(v1.z, v1.w); w1.x = pk2(v2.x, v2.y); w1.y = pk2(v2.z, v2.w); w1.z = pk2(v3.x, v3.y); w1.w = pk2(v3.z, v3.w); }
        bf16* op = AO + (size_t)row * 1024 + hh * 128 + e0;
        *(GAS v4u*)op = w0; *(GAS v4u*)(op + 8) = w1;
    }
}
template <int DD> __device__ __forceinline__ void fft_mm2(f32x16& aR, f32x16& aI, int vb, const bf16x8* Ca, const bf16x8* Sa) {
    using namespace dattn;
    const s16x4 l0 = tr_read<v_rd_off(DD, 0, 0)>(vb), h0 = tr_read<v_rd_off(DD, 0, 1)>(vb), l1 = tr_read<v_rd_off(DD, 1, 0)>(vb), h1 = tr_read<v_rd_off(DD, 1, 1)>(vb);
    const s16x4 l2 = tr_read<v_rd_off(DD, 2, 0)>(vb), h2 = tr_read<v_rd_off(DD, 2, 1)>(vb), l3 = tr_read<v_rd_off(DD, 3, 0)>(vb), h3 = tr_read<v_rd_off(DD, 3, 1)>(vb);
    asm volatile("s_waitcnt lgkmcnt(0)" ::: "memory"); __builtin_amdgcn_sched_barrier(0);
    const bf16x8 b0 = DA_PK(l0, h0), b1 = DA_PK(l1, h1), b2 = DA_PK(l2, h2), b3 = DA_PK(l3, h3);
    aR = __builtin_amdgcn_mfma_f32_32x32x16_bf16(Ca[0], b0, aR, 0, 0, 0); aI = __builtin_amdgcn_mfma_f32_32x32x16_bf16(Sa[0], b0, aI, 0, 0, 0);
    aR = __builtin_amdgcn_mfma_f32_32x32x16_bf16(Ca[1], b1, aR, 0, 0, 0); aI = __builtin_amdgcn_mfma_f32_32x32x16_bf16(Sa[1], b1, aI, 0, 0, 0);
    aR = __builtin_amdgcn_mfma_f32_32x32x16_bf16(Ca[2], b2, aR, 0, 0, 0); aI = __builtin_amdgcn_mfma_f32_32x32x16_bf16(Sa[2], b2, aI, 0, 0, 0);
    aR = __builtin_amdgcn_mfma_f32_32x32x16_bf16(Ca[3], b3, aR, 0, 0, 0); aI = __builtin_amdgcn_mfma_f32_32x32x16_bf16(Sa[3], b3, aI, 0, 0, 0);
}
__device__ __forceinline__ void fftA_phase(Frame& F, const bf16* U, bf16* TRE, bf16* TIM, const bf16* dftC, const bf16* dftS, const float* TW) {
    using namespace dattn;
    int tid = threadIdx.x; asm volatile("" : "+v"(tid));
    const int wid = __builtin_amdgcn_readfirstlane(tid >> 6), lane = tid & 63, r32 = lane & 31, hi = lane >> 5, kb = wid & 3, ch = wid >> 2;
    bf16x8 Cf[8], Sf[8];
#pragma unroll
    for (int i = 0; i < 8; ++i) { Cf[i] = *(const bf16x8*)(dftC + (32 * kb + r32) * 128 + 16 * i + 8 * hi); Sf[i] = *(const bf16x8*)(dftS + (32 * kb + r32) * 128 + 16 * i + 8 * hi); }
    const int sr = tid >> 4, sc = (tid & 15) * 8, vst0 = v_st(sr, sc), vst1 = v_st(32 + sr, sc);
    LAS unsigned char* L = F.lds + RING_OFF;
    const int vb = (int)(unsigned)(size_t)L + v_rd_base(lane) + ch * 1024;
    for (int unit = F.vcu; unit < 128 * NGRP; unit += F.G) {
        const int n2 = unit >> 3, g = unit & 7;
        const bf16* src = U + (size_t)n2 * 1024 + g * 128 + sc;
        const bf16x8 x0 = *(const bf16x8*)(src + (size_t)sr * 131072), x1 = *(const bf16x8*)(src + (size_t)(32 + sr) * 131072), x2 = *(const bf16x8*)(src + (size_t)(64 + sr) * 131072), x3 = *(const bf16x8*)(src + (size_t)(96 + sr) * 131072);
        *(LAS bf16x8*)(L + vst0) = x0; *(LAS bf16x8*)(L + vst1) = x1; *(LAS bf16x8*)(L + 16384 + vst0) = x2; *(LAS bf16x8*)(L + 16384 + vst1) = x3;
        LDS_WAIT(); __syncthreads();
        f32x16 PR[2] = {}, PI[2] = {};
        fft_mm2<0>(PR[0], PI[0], vb, Cf, Sf); fft_mm2<1>(PR[1], PI[1], vb, Cf, Sf);
        fft_mm2<0>(PR[0], PI[0], vb + 16384, Cf + 4, Sf + 4); fft_mm2<1>(PR[1], PI[1], vb + 16384, Cf + 4, Sf + 4);
        LDS_WAIT(); __syncthreads();
        const float* tw = TW + (size_t)(n2 * 128 + 32 * kb + 4 * hi) * 2;
#pragma unroll
        for (int rg = 0; rg < 4; ++rg) { const f32x4 t0 = *(const GAS f32x4*)(tw + 16 * rg), t1 = *(const GAS f32x4*)(tw + 16 * rg + 4);
            const float cc[4] = {t0.x, t0.z, t1.x, t1.z}, ss[4] = {t0.y, t0.w, t1.y, t1.w};
#pragma unroll
            for (int e = 0; e < 4; ++e) { const int r = 4 * rg + e, k1 = 32 * kb + 8 * rg + 4 * hi + e; const size_t rowo = (size_t)(k1 * 128 + n2) * 1024 + g * 128 + 64 * ch + r32;
#pragma unroll
                for (int dd = 0; dd < 2; ++dd) { const float pr = PR[dd][r], pi = PI[dd][r]; TRE[rowo + 32 * dd] = (bf16)f2bf(pr * cc[e] - pi * ss[e]); TIM[rowo + 32 * dd] = (bf16)f2bf(-(pr * ss[e] + pi * cc[e])); } } }
    }
}
__device__ __forceinline__ void fftB_phase(Frame& F, const bf16* TRE, const bf16* TIM, bf16* YF, const bf16* dftC, const bf16* dftS) {
    using namespace dattn;
    constexpr int WSTR = 272, OFF_WR = 65536, OFF_WI = 65536 + 128 * WSTR;
    constexpr float NORMF = 6.905339660024878e-4f;
    int tid = threadIdx.x; asm volatile("" : "+v"(tid));
    const int wid = __builtin_amdgcn_readfirstlane(tid >> 6), lane = tid & 63, r32 = lane & 31, hi = lane >> 5, kb = wid & 3, ch = wid >> 2;
    bf16x8 Cf[8], Sf[8];
#pragma unroll
    for (int i = 0; i < 8; ++i) { Cf[i] = *(const bf16x8*)(dftC + (32 * kb + r32) * 128 + 16 * i + 8 * hi); Sf[i] = *(const bf16x8*)(dftS + (32 * kb + r32) * 128 + 16 * i + 8 * hi); }
    const int sr = tid >> 4, sc = (tid & 15) * 8, vst0 = v_st(sr, sc), vst1 = v_st(32 + sr, sc);
    LAS unsigned char* L = F.lds + RING_OFF;
    const int vb = (int)(unsigned)(size_t)L + v_rd_base(lane) + ch * 1024;
    for (int unit = F.vcu; unit < 128 * NGRP; unit += F.G) {
        const int k1 = unit >> 3, g = unit & 7;
        const size_t so = (size_t)(k1 * 128) * 1024 + g * 128 + sc;
        bf16x8 zr[4], zi[4];
#pragma unroll
        for (int q = 0; q < 4; ++q) { zr[q] = *(const bf16x8*)(TRE + so + (size_t)(32 * q + sr) * 1024); zi[q] = *(const bf16x8*)(TIM + so + (size_t)(32 * q + sr) * 1024); }
        *(LAS bf16x8*)(L + vst0) = zr[0]; *(LAS bf16x8*)(L + vst1) = zr[1]; *(LAS bf16x8*)(L + 16384 + vst0) = zr[2]; *(LAS bf16x8*)(L + 16384 + vst1) = zr[3];
        *(LAS bf16x8*)(L + 32768 + vst0) = zi[0]; *(LAS bf16x8*)(L + 32768 + vst1) = zi[1]; *(LAS bf16x8*)(L + 49152 + vst0) = zi[2]; *(LAS bf16x8*)(L + 49152 + vst1) = zi[3];
        LDS_WAIT(); __syncthreads();
        f32x16 WR[2] = {}, WI[2] = {}, WX[2] = {};
        fft_mm2<0>(WR[0], WX[0], vb, Cf, Sf); fft_mm2<1>(WR[1], WX[1], vb, Cf, Sf);
        fft_mm2<0>(WR[0], WX[0], vb + 16384, Cf + 4, Sf + 4); fft_mm2<1>(WR[1], WX[1], vb + 16384, Cf + 4, Sf + 4);
        fft_mm2<0>(WI[0], WR[0], vb + 32768, Cf, Sf); fft_mm2<1>(WI[1], WR[1], vb + 32768, Cf, Sf);
        fft_mm2<0>(WI[0], WR[0], vb + 49152, Cf + 4, Sf + 4); fft_mm2<1>(WI[1], WR[1], vb + 49152, Cf + 4, Sf + 4);
        WI[0] -= WX[0]; WI[1] -= WX[1];
#pragma unroll
        for (int dd = 0; dd < 2; ++dd)
#pragma unroll
            for (int r = 0; r < 16; ++r) { const int k2 = 32 * kb + crow(r, hi), j = 64 * ch + 32 * dd + r32;
                *(LAS unsigned short*)(L + OFF_WR + k2 * WSTR + j * 2) = (unsigned short)f2bf(WR[dd][r]); *(LAS unsigned short*)(L + OFF_WI + k2 * WSTR + j * 2) = (unsigned short)f2bf(WI[dd][r]); }
        LDS_WAIT(); __syncthreads();
        f32x16 Y[2] = {};
#pragma unroll
        for (int kk = 0; kk < 2; ++kk) { const int rb = (64 * ch + 32 * kk + r32) * WSTR + 16 * hi;
#pragma unroll
            for (int jc = 0; jc < 8; ++jc) { const bf16x8 aR = *(const LAS bf16x8*)(L + OFF_WR + rb + 32 * jc), aI = *(const LAS bf16x8*)(L + OFF_WI + rb + 32 * jc);
                Y[kk] = __builtin_amdgcn_mfma_f32_32x32x16_bf16(aR, Cf[jc], Y[kk], 0, 0, 0); Y[kk] = __builtin_amdgcn_mfma_f32_32x32x16_bf16(aI, Sf[jc], Y[kk], 0, 0, 0); } }
#pragma unroll
        for (int kk = 0; kk < 2; ++kk)
#pragma unroll
            for (int r = 0; r < 16; ++r) { const int k2 = 64 * ch + 32 * kk + crow(r, hi); YF[(size_t)(k1 + 128 * k2) * 1024 + g * 128 + 32 * kb + r32] = (bf16)f2bf(Y[kk][r] * NORMF); }
    }
}
#ifndef PHMASK
#define PHMASK 0xffffffffu
#endif
#define PH(k) (((PHMASK) >> (k)) & 1u)
struct Args { const float* in[18]; float* out; unsigned char* ws; };
__global__ void __launch_bounds__(NWAVES * 64, 2) enc_fwd(Args args) {
    extern __shared__ __attribute__((aligned(16))) unsigned char lds[];
    Frame F;
    F.lds = (LAS unsigned char*)lds;
    F.MISC = (volatile LAS unsigned*)(F.lds + MISC_OFF);
    F.tid = threadIdx.x; F.lane = F.tid & 63; F.wave = __builtin_amdgcn_readfirstlane(F.tid >> 6);
    F.G = gridDim.x; { const int bx = blockIdx.x; F.vcu = (F.G % 8 == 0) ? (bx % 8) * (F.G / 8) + bx / 8 : bx; }
    F.ws = args.ws;
    unsigned char* ws = args.ws;
    F.ctl = (gu32*)(ws + WS_CTL);
    In18 in;
#pragma unroll
    for (int i = 0; i < 18; ++i) in.p[i] = args.in[i];
    for (int u = F.tid; u < (LDS_BYTES - LDSCTL_OFF) / 4; u += NWAVES * 64) ((LAS unsigned*)(F.lds + LDSCTL_OFF))[u] = 0u;
    __syncthreads();
    XcdBarrier bar = xcd_barrier_post((unsigned*)(F.ctl + CW_BAR), F.MISC + 8);
#define GRID_BAR() xcd_barrier(bar)

    float* const xres = args.out;
    bf16* const HB = (bf16*)(ws + WS_H); bf16* const YB = (bf16*)(ws + WS_Y); bf16* const ACT = (bf16*)(ws + WS_ACT);
    bf16* const QB = (bf16*)(ws + WS_Q); bf16* const KB = (bf16*)(ws + WS_K); bf16* const VB = (bf16*)(ws + WS_V); bf16* const UB = (bf16*)(ws + WS_U);
    bf16* const GB = (bf16*)(ws + WS_GATE); float* const OB = (float*)(ws + WS_O);
    bf16* const TRE = (bf16*)(ws + WS_TRE); bf16* const TIM = (bf16*)(ws + WS_TIM);
    bf16* const YF = (bf16*)(ws + WS_YF); bf16* const AO = (bf16*)(ws + WS_AO); bf16* const MG = (bf16*)(ws + WS_MG); bf16* const TT = (bf16*)(ws + WS_TT);
    const float* const modf = (const float*)(ws + WS_MODF); const float* const lamv = (const float*)(ws + WS_LAM);
    const float* const cosT = (const float*)(ws + WS_COS); const float* const sinT = (const float*)(ws + WS_SIN);
    const bf16* const dftC = (const bf16*)(ws + WS_DFTC); const bf16* const dftS = (const bf16*)(ws + WS_DFTS); const float* const TW = (const float*)(ws + WS_TW);
#define MODF(l, s, k) (modf + (size_t)(((l) * 3 + (s)) * 3 + (k)) * DM)

    if (PH(0)) p0_prologue(F, in);
    GRID_BAR();
    if (PH(1)) p1_modfin(F, in);
    GRID_BAR();
    if (PH(2)) norm_phase<false, true>(F, in.p[0], xres, nullptr, HB, nullptr, MODF(0, 0, 0), MODF(0, 0, 1));
    GRID_BAR();

    for (int l = 0; l < DEPTH; ++l) {
        const unsigned char* wl = ws + WS_W + (size_t)l * W_LAYER;
        { pg8::Gemm g{HB, (const bf16*)(wl + W_1IN), SEQ, 2 * FF, DM}; pg8::StaticOrder S; S.init(SEQ, 2 * FF, F.G, (int)blockIdx.x);
          pg8::EpiSwiGLU E{ACT, FF};
          if (PH(3)) pg8::gemm_phase<pg8::EpiSwiGLU, pg8::StaticOrder, true, true>(F.lds + RING_OFF, g, S, E); GRID_BAR(); }
        { pg8::Gemm g{ACT, (const bf16*)(wl + W_1OUT), SEQ, DM, FF}; pg8::StaticOrder S; S.init(SEQ, DM, F.G, (int)blockIdx.x);
          pg8::EpiPlain E{YB, DM};
          if (PH(4)) pg8::gemm_phase<pg8::EpiPlain, pg8::StaticOrder, true, true>(F.lds + RING_OFF, g, S, E); GRID_BAR(); }
        if (PH(5)) norm_phase<true, true>(F, xres, xres, YB, HB, MODF(l, 0, 2), MODF(l, 1, 0), MODF(l, 1, 1)); GRID_BAR();
        { pg8::Gemm g{HB, (const bf16*)(wl + W_MIX), SEQ, 8192, DM}; pg8::StaticOrder S; S.init(SEQ, 8192, F.G, (int)blockIdx.x);
          pg8::EpiMix E{QB, KB, VB, UB, GB, cosT, sinT, in.p[14] + (size_t)l * 4096};
          if (PH(6)) pg8::gemm_phase<pg8::EpiMix, pg8::StaticOrder, true, true>(F.lds + RING_OFF, g, S, E); GRID_BAR(); }
        {
            const int xcd = F.vcu >> 5, j = F.vcu & 31;
            if (!PH(7)) {} else if (F.G == 256) {
#pragma unroll 1
                for (int i = 0; i < 4; ++i) { const int vh = 2 * xcd + (i >> 1), qb = (i & 1) * 32 + j;
                    dattn::attn_unit(QB + (size_t)(qb * 256) * 1024 + vh * 64, KB + vh * 64, VB + (vh >> 1) * 128, OB + (size_t)(qb * 256) * 2048 + vh * 128, SEQ, (LAS char*)(F.lds + RING_OFF)); }
            } else {
#pragma unroll 1
                for (int un = F.vcu; un < 1024; un += F.G) { const int vh = un >> 6, qb = un & 63;
                    dattn::attn_unit(QB + (size_t)(qb * 256) * 1024 + vh * 64, KB + vh * 64, VB + (vh >> 1) * 128, OB + (size_t)(qb * 256) * 2048 + vh * 128, SEQ, (LAS char*)(F.lds + RING_OFF)); }
            }
            if (PH(8)) fftA_phase(F, UB, TRE, TIM, dftC, dftS, TW);
            GRID_BAR();
        }
        if (PH(9)) fftB_phase(F, TRE, TIM, YF, dftC, dftS);
        if (PH(10)) combine_phase(F, OB, AO, in.p[10] + (size_t)l * 128, lamv[l], lamv[2 + l]);
        GRID_BAR();
        { pg8::Gemm g{AO, (const bf16*)(wl + W_AP), SEQ, DM, AW}; pg8::StaticOrder S; S.init(SEQ, DM, F.G, (int)blockIdx.x);
          pg8::EpiGate E{GB, nullptr, TT};
          if (PH(11)) pg8::gemm_phase<pg8::EpiGate, pg8::StaticOrder, true, true>(F.lds + RING_OFF, g, S, E); GRID_BAR(); }
        { pg8::Gemm g{YF, (const bf16*)(wl + W_FP), SEQ, DM, FW}; pg8::StaticOrder S; S.init(SEQ, DM, F.G, (int)blockIdx.x);
          pg8::EpiGate E{GB + 2048, TT, MG};
          if (PH(12)) pg8::gemm_phase<pg8::EpiGate, pg8::StaticOrder, true, true>(F.lds + RING_OFF, g, S, E); GRID_BAR(); }
        { pg8::Gemm g{MG, (const bf16*)(wl + W_MO), SEQ, DM, DM}; pg8::StaticOrder S; S.init(SEQ, DM, F.G, (int)blockIdx.x);
          pg8::EpiPlain E{YB, DM};
          if (PH(13)) pg8::gemm_phase<pg8::EpiPlain, pg8::StaticOrder, true, true>(F.lds + RING_OFF, g, S, E); GRID_BAR(); }
        if (PH(14)) norm_phase<true, true>(F, xres, xres, YB, HB, MODF(l, 1, 2), MODF(l, 2, 0), MODF(l, 2, 1)); GRID_BAR();
        { pg8::Gemm g{HB, (const bf16*)(wl + W_2IN), SEQ, 2 * FF, DM}; pg8::StaticOrder S; S.init(SEQ, 2 * FF, F.G, (int)blockIdx.x);
          pg8::EpiSwiGLU E{ACT, FF};
          if (PH(15)) pg8::gemm_phase<pg8::EpiSwiGLU, pg8::StaticOrder, true, true>(F.lds + RING_OFF, g, S, E); GRID_BAR(); }
        { pg8::Gemm g{ACT, (const bf16*)(wl + W_2OUT), SEQ, DM, FF}; pg8::StaticOrder S; S.init(SEQ, DM, F.G, (int)blockIdx.x);
          pg8::EpiPlain E{YB, DM};
          if (PH(16)) pg8::gemm_phase<pg8::EpiPlain, pg8::StaticOrder, true, true>(F.lds + RING_OFF, g, S, E); GRID_BAR(); }
        if (l + 1 < DEPTH) { if (PH(17)) norm_phase<true, true>(F, xres, xres, YB, HB, MODF(l, 2, 2), MODF(l + 1, 0, 0), MODF(l + 1, 0, 1)); GRID_BAR(); }
        else if (PH(17)) norm_phase<true, false>(F, xres, xres, YB, nullptr, MODF(l, 2, 2), nullptr, nullptr);
    }
    if (blockIdx.x == 0 && F.wave == 0) { VM_WAIT(); if (__hip_atomic_load((gu32*)((unsigned*)(F.ctl + CW_BAR) + XB_TMO), RLX_AGENT) != 0u) { const float q = __builtin_nanf(""); for (int c = F.lane; c < DM; c += 64) xres[c] = q; } }
}

extern "C" void kernel_launch(void* const* d_in, const int* in_sizes, int n_in, void* d_out, int out_size, void* d_ws, size_t ws_size, hipStream_t stream) {
    static int grid = 0;
    if (grid == 0) {
        if (n_in != 18 || in_sizes[0] != SEQ * DM || out_size != SEQ * DM || ws_size < WS_END) { fprintf(stderr, "kernel_launch: unexpected shapes: n_in %d in0 %d out %d ws %zu (need %zu)\n", n_in, n_in > 0 ? in_sizes[0] : -1, out_size, ws_size, (size_t)WS_END); grid = -1; return; }
        int dev = 0, cus = 0, per_cu = 0;
        if (hipGetDevice(&dev) != hipSuccess || hipDeviceGetAttribute(&cus, hipDeviceAttributeMultiprocessorCount, dev) != hipSuccess) { grid = -1; return; }
        if (hipFuncSetAttribute((const void*)enc_fwd, hipFuncAttributeMaxDynamicSharedMemorySize, LDS_BYTES) != hipSuccess) { fprintf(stderr, "kernel_launch: hipFuncSetAttribute failed\n"); grid = -1; return; }
        if (hipOccupancyMaxActiveBlocksPerMultiprocessor(&per_cu, (const void*)enc_fwd, NWAVES * 64, LDS_BYTES) != hipSuccess || per_cu < 1) { fprintf(stderr, "kernel_launch: occupancy query reports %d blocks per CU\n", per_cu); }
        (void)hipGetLastError();
        grid = cus;
    }
    if (grid < 0) return;
#ifdef DBG_ZERO_WS
    if (hipMemsetAsync((char*)d_ws, 0, WS_END, stream) != hipSuccess) return;
#else
    if (hipMemsetAsync((char*)d_ws + WS_CTL, 0, CTL_ZERO_BYTES, stream) != hipSuccess) return;
#endif
    Args a{};
    for (int i = 0; i < 18; ++i) a.in[i] = (const float*)d_in[i];
    a.out = (float*)d_out; a.ws = (unsigned char*)d_ws;
    hipLaunchKernelGGL(enc_fwd, dim3(grid), dim3(NWAVES * 64), LDS_BYTES, stream, a);
    const hipError_t le = hipPeekAtLastError();
    if (le != hipSuccess) fprintf(stderr, "kernel_launch: launch failed: %s\n", hipGetErrorName(le));
}
```

```cpp
#include <hip/hip_runtime.h>
#include <hip/hip_bf16.h>
#include <cstdio>
#include <cstdint>
#include <cmath>
namespace pg8 {
#define PG8_LAS __attribute__((address_space(3)))
typedef unsigned short bf16_t;
typedef short bf16x8 __attribute__((ext_vector_type(8)));
typedef float f32x4 __attribute__((ext_vector_type(4)));
typedef unsigned u32x4 __attribute__((ext_vector_type(4)));
constexpr int BM = 256, BK = 64, HALF = 128, HTB = HALF * BK * 2  , STAGE_BYTES = 8 * HTB, NXCD = 8, WGM = 8;

__host__ __device__ __forceinline__ int lds_byte(int r, int c) { const int st = (r >> 4) * 2 + (c >> 5), rr = r & 15, cc = c & 31, ob = rr * 64 + cc * 2; return st * 1024 + (ob ^ (((ob >> 9) & 1) << 5)); }
__host__ __device__ __forceinline__ void stage_rc(int b, int& R, int& C) { const int st = b / 1024, sb = b % 1024, swz = sb ^ (((sb >> 9) & 1) << 5); R = (st >> 1) * 16 + swz / 64; C = (st & 1) * 32 + (swz % 64) / 2; }
__host__ __device__ __forceinline__ int perm32(int rho) { const int n = rho >> 4, i = rho & 15; return 8 * (i >> 2) + 4 * n + (i & 3); }

struct Unit { int pm, pn; };
struct Gemm { const bf16_t* A; const bf16_t* Bt; int M, N, K; };

struct StaticOrder {
    int nM, nN, nwg, G, c;
    __host__ __device__ void init(int M, int N, int G_, int c_) { nM = M / BM; nN = N / BM; nwg = nM * nN; G = G_; c = c_; }
    __host__ __device__ bool next(int i, Unit& u) const {
        const long L = (long)i * G + c; if (L >= nwg) return false;
        int wgid = (int)L; { const int q = nwg / NXCD, r = nwg % NXCD, xcd = wgid % NXCD, off = wgid / NXCD; wgid = (xcd < r ? xcd * (q + 1) : r * (q + 1) + (xcd - r) * q) + off; }
        const int nig = WGM * nN, gid = wgid / nig, fm = gid * WGM, gsz = (nM - fm) < WGM ? (nM - fm) : WGM;
        u.pm = fm + ((wgid % nig) % gsz); u.pn = (wgid % nig) / gsz; return true;
    }
    __device__ __forceinline__ void a_ready(const Unit&) const {}
    __device__ __forceinline__ void done(const Unit&) const {}
};

typedef float cvt_f32x2 __attribute__((ext_vector_type(2))); typedef __bf16 cvt_bf16x2 __attribute__((ext_vector_type(2)));
__device__ __forceinline__ unsigned cvt_pk_bf16(float lo, float hi) { const cvt_f32x2 v = {lo, hi}; return __builtin_bit_cast(unsigned, __builtin_convertvector(v, cvt_bf16x2)); }
typedef float f32x2 __attribute__((ext_vector_type(2)));
__device__ __forceinline__ float bf_lo(unsigned w) { return __builtin_bit_cast(float, w << 16); }
__device__ __forceinline__ float bf_hi(unsigned w) { return __builtin_bit_cast(float, w & 0xffff0000u); }
__device__ __forceinline__ float sigmoid_f(float v) { return __builtin_amdgcn_rcpf(1.0f + __builtin_amdgcn_exp2f(v * -1.4426950408889634f)); }
__device__ __forceinline__ u32x4 pack8(const f32x4 a, const f32x4 b) { u32x4 w; w.x = cvt_pk_bf16(a[0], a[1]); w.y = cvt_pk_bf16(a[2], a[3]); w.z = cvt_pk_bf16(b[0], b[1]); w.w = cvt_pk_bf16(b[2], b[3]); return w; }

struct EpiPlain {
    static constexpr bool PERM = true, AFTER_DRAIN = false;
    bf16_t* O; int ldc;
    __device__ __forceinline__ void operator()(const f32x4 (&acc)[2][2][4][2], const Unit& u, int wr, int wc, int fr, int fq) const {
        const int row0 = u.pm * BM + wr * 64 + fr, col0 = u.pn * BM + wc * 32 + 8 * fq;
#pragma unroll
        for (int ai = 0; ai < 2; ++ai)
#pragma unroll
            for (int m = 0; m < 4; ++m) { bf16_t* rowp = O + (size_t)(row0 + ai * HALF + m * 16) * ldc + col0;
#pragma unroll
                for (int bj = 0; bj < 2; ++bj) *(u32x4*)(rowp + bj * HALF) = pack8(acc[ai][bj][m][0], acc[ai][bj][m][1]); }
    }
};
struct EpiSwiGLU {
    static constexpr bool PERM = true, AFTER_DRAIN = false;
    bf16_t* O; int ldc;
    __device__ __forceinline__ void operator()(const f32x4 (&acc)[2][2][4][2], const Unit& u, int wr, int wc, int fr, int fq) const {
        const int row0 = u.pm * BM + wr * 64 + fr, col0 = u.pn * HALF + wc * 32 + 8 * fq;
#pragma unroll
        for (int ai = 0; ai < 2; ++ai)
#pragma unroll
            for (int m = 0; m < 4; ++m) { bf16_t* rowp = O + (size_t)(row0 + ai * HALF + m * 16) * ldc + col0;
                f32x4 o[2];
#pragma unroll
                for (int n = 0; n < 2; ++n) { const f32x4 g = acc[ai][0][m][n], up = acc[ai][1][m][n];
#pragma unroll
                    for (int e = 0; e < 4; ++e) o[n][e] = g[e] * sigmoid_f(g[e]) * up[e]; }
                *(u32x4*)rowp = pack8(o[0], o[1]); }
    }
};
struct EpiMix {
    static constexpr bool PERM = true, AFTER_DRAIN = false;
    bf16_t *Q, *K, *V, *U, *G; const float* cosT; const float* sinT; const float* gbias;
    __device__ __forceinline__ void operator()(const f32x4 (&acc)[2][2][4][2], const Unit& u, int wr, int wc, int fr, int fq) const {
        const int pn = u.pn, row0 = u.pm * BM + wr * 64 + fr;
        if (pn < 8) {
            bf16_t* base = (pn < 4 ? Q : K) + ((pn & 3) * 4 + wc) * 64 + 8 * fq;
            const float qs = pn < 4 ? 0.18033688011112042f : 1.0f;
#pragma unroll
            for (int ai = 0; ai < 2; ++ai)
#pragma unroll
                for (int m = 0; m < 4; ++m) { const int row = row0 + ai * HALF + m * 16;
                    const f32x4 c0 = *(const f32x4*)(cosT + (size_t)row * 32 + 8 * fq), c1 = *(const f32x4*)(cosT + (size_t)row * 32 + 8 * fq + 4);
                    const f32x4 s0 = *(const f32x4*)(sinT + (size_t)row * 32 + 8 * fq), s1 = *(const f32x4*)(sinT + (size_t)row * 32 + 8 * fq + 4);
                    const f32x4 x1a = acc[ai][0][m][0], x1b = acc[ai][0][m][1], x2a = acc[ai][1][m][0], x2b = acc[ai][1][m][1];
                    const f32x4 o1a = (x1a * c0 - x2a * s0) * qs, o1b = (x1b * c1 - x2b * s1) * qs, o2a = (x2a * c0 + x1a * s0) * qs, o2b = (x2b * c1 + x1b * s1) * qs;
                    bf16_t* rowp = base + (size_t)row * 1024;
                    *(u32x4*)rowp = pack8(o1a, o1b); *(u32x4*)(rowp + 32) = pack8(o2a, o2b); }
        } else if (pn < 16) {
            bf16_t* base = (pn < 12 ? V : U) + (pn & 3) * BM + wc * 32 + 8 * fq;
#pragma unroll
            for (int ai = 0; ai < 2; ++ai)
#pragma unroll
                for (int m = 0; m < 4; ++m) { bf16_t* rowp = base + (size_t)(row0 + ai * HALF + m * 16) * 1024;
#pragma unroll
                    for (int bj = 0; bj < 2; ++bj) *(u32x4*)(rowp + bj * HALF) = pack8(acc[ai][bj][m][0], acc[ai][bj][m][1]); }
        } else {
            const int col0 = (pn - 16) * BM + wc * 32 + 8 * fq;
            f32x4 bv[2][2];
#pragma unroll
            for (int bj = 0; bj < 2; ++bj)
#pragma unroll
                for (int n = 0; n < 2; ++n) bv[bj][n] = *(const f32x4*)(gbias + col0 + bj * HALF + 4 * n);
#pragma unroll
            for (int ai = 0; ai < 2; ++ai)
#pragma unroll
                for (int m = 0; m < 4; ++m) { bf16_t* rowp = G + (size_t)(row0 + ai * HALF + m * 16) * 4096 + col0;
#pragma unroll
                    for (int bj = 0; bj < 2; ++bj) { f32x4 o[2];
#pragma unroll
                        for (int n = 0; n < 2; ++n) { const f32x4 v = acc[ai][bj][m][n] + bv[bj][n];
#pragma unroll
                            for (int e = 0; e < 4; ++e) o[n][e] = sigmoid_f(v[e]); }
                        *(u32x4*)(rowp + bj * HALF) = pack8(o[0], o[1]); } }
        }
    }
};
struct EpiGate {
    static constexpr bool PERM = true, AFTER_DRAIN = false;
    const bf16_t* gate; const bf16_t* addend; bf16_t* O;
    __device__ __forceinline__ void operator()(const f32x4 (&acc)[2][2][4][2], const Unit& u, int wr, int wc, int fr, int fq) const {
        const int row0 = u.pm * BM + wr * 64 + fr, col0 = u.pn * BM + wc * 32 + 8 * fq;
#pragma unroll
        for (int ai = 0; ai < 2; ++ai)
#pragma unroll
            for (int m = 0; m < 4; ++m) { const size_t row = (size_t)(row0 + ai * HALF + m * 16);
#pragma unroll
                for (int bj = 0; bj < 2; ++bj) { const u32x4 gw = *(const u32x4*)(gate + row * 4096 + col0 + bj * HALF);
                    f32x4 a = acc[ai][bj][m][0], b = acc[ai][bj][m][1];
                    a[0] *= bf_lo(gw.x); a[1] *= bf_hi(gw.x); a[2] *= bf_lo(gw.y); a[3] *= bf_hi(gw.y); b[0] *= bf_lo(gw.z); b[1] *= bf_hi(gw.z); b[2] *= bf_lo(gw.w); b[3] *= bf_hi(gw.w);
                    if (addend) { const u32x4 tw = *(const u32x4*)(addend + row * 2048 + col0 + bj * HALF);
                        a[0] += bf_lo(tw.x); a[1] += bf_hi(tw.x); a[2] += bf_lo(tw.y); a[3] += bf_hi(tw.y); b[0] += bf_lo(tw.z); b[1] += bf_hi(tw.z); b[2] += bf_lo(tw.w); b[3] += bf_hi(tw.w); }
                    *(u32x4*)(O + row * 2048 + col0 + bj * HALF) = pack8(a, b); } }
    }
};

template <class Epi, class Sched, bool ALIGN_EPI = false, bool SP2 = false>
__device__ __forceinline__ void gemm_phase(PG8_LAS unsigned char* lds, const Gemm g, const Sched& S, const Epi& E) {
    int tid = threadIdx.x; asm volatile("" : "+v"(tid));
    const int wid = __builtin_amdgcn_readfirstlane(tid >> 6), lane = tid & 63, wr = wid >> 2, wc = wid & 3, fr = lane & 15, fq = lane >> 4;
    const int K = g.K, nt = K / BK;
    unsigned voffA[2], voffB[2];
#pragma unroll
    for (int i = 0; i < 2; ++i) { int R, C; stage_rc(tid * 16 + i * 8192, R, C); const int Rb = Epi::PERM ? ((R & ~31) + perm32(R & 31)) : R;
        voffA[i] = (unsigned)(R * K + C) * 2u; voffB[i] = (unsigned)(Rb * K + C) * 2u; }
    const size_t kstep = (size_t)(BK * 2);
    const size_t hstep = (size_t)HALF * K * 2;
    const size_t tstep = 2 * hstep;
    const unsigned ldsw = (unsigned)wid * 1024u;
    const int aoff = lds_byte(wr * 64 + fr, fq * 8), boff = lds_byte(wc * 32 + fr, fq * 8);
#define PG8_SA(b, h) (((b) * 2 + (h)) * HTB)
#define PG8_SB(b, h) ((4 + (b) * 2 + (h)) * HTB)
#define PG8_STAGE(bufoff, gbase, voff) do { _Pragma("unroll") for (int _i = 0; _i < 2; ++_i) \
        __builtin_amdgcn_global_load_lds((const unsigned*)((const char*)(gbase) + (voff)[_i]), (PG8_LAS unsigned*)(lds + (bufoff) + ldsw + _i * 8192), 16, 0, 0); } while (0)
#define PG8_LDA(dst, b, h) do { _Pragma("unroll") for (int m = 0; m < 4; ++m) _Pragma("unroll") for (int k = 0; k < 2; ++k) dst[m][k] = *(const PG8_LAS bf16x8*)(lds + PG8_SA(b, h) + aoff + m * 2048 + k * 1024); } while (0)
#define PG8_LDB(dst, b, h) do { _Pragma("unroll") for (int n = 0; n < 2; ++n) _Pragma("unroll") for (int k = 0; k < 2; ++k) dst[n][k] = *(const PG8_LAS bf16x8*)(lds + PG8_SB(b, h) + boff + n * 2048 + k * 1024); } while (0)
#define PG8_MMA(ai, bj, At, Bt) do { __builtin_amdgcn_s_setprio(1); _Pragma("unroll") for (int m = 0; m < 4; ++m) _Pragma("unroll") for (int n = 0; n < 2; ++n) _Pragma("unroll") for (int k = 0; k < 2; ++k) \
        acc[ai][bj][m][n] = __builtin_amdgcn_mfma_f32_16x16x32_bf16(Bt[n][k], At[m][k], acc[ai][bj][m][n], 0, 0, 0); __builtin_amdgcn_s_setprio(0); } while (0)
#define PG8_WAIT_V(n) asm volatile("s_waitcnt vmcnt(" #n ")" ::: "memory")
#define PG8_WAIT_L(n) asm volatile("s_waitcnt lgkmcnt(" #n ")" ::: "memory")
#define PG8_BAR __builtin_amdgcn_s_barrier()
#define PG8_SCHED __builtin_amdgcn_sched_barrier(0)
    Unit cur, nxt; int ui = 0;
    if (!S.next(0, cur)) return;
    f32x4 acc[2][2][4][2];
#pragma unroll
    for (int a = 0; a < 2; ++a)
#pragma unroll
        for (int b = 0; b < 2; ++b)
#pragma unroll
            for (int m = 0; m < 4; ++m)
#pragma unroll
                for (int n = 0; n < 2; ++n) acc[a][b][m][n] = (f32x4){0.f, 0.f, 0.f, 0.f};
    bf16x8 At[4][2], B0[2][2], B1[2][2];
    const char* cA = (const char*)g.A + (size_t)cur.pm * tstep; const char* cB = (const char*)g.Bt + (size_t)cur.pn * tstep;
    S.a_ready(cur);
    if constexpr (SP2) {
        PG8_STAGE(PG8_SB(0, 0), cB, voffB); PG8_STAGE(PG8_SB(0, 1), cB + hstep, voffB); PG8_STAGE(PG8_SA(0, 0), cA, voffA); PG8_STAGE(PG8_SA(0, 1), cA + hstep, voffA);
        if (wr == 1) PG8_BAR;
        PG8_WAIT_V(2); PG8_BAR;
        PG8_STAGE(PG8_SB(1, 0), cB + kstep, voffB); PG8_STAGE(PG8_SA(1, 0), cA + kstep, voffA); PG8_STAGE(PG8_SB(1, 1), cB + hstep + kstep, voffB);
        PG8_WAIT_V(6); PG8_BAR;
    } else {
        PG8_STAGE(PG8_SB(0, 0), cB, voffB); PG8_STAGE(PG8_SA(0, 0), cA, voffA); PG8_STAGE(PG8_SB(0, 1), cB + hstep, voffB); PG8_STAGE(PG8_SA(0, 1), cA + hstep, voffA);
        if (wr == 1) PG8_BAR;
        PG8_WAIT_V(4); PG8_BAR;
        PG8_STAGE(PG8_SB(1, 0), cB + kstep, voffB); PG8_STAGE(PG8_SA(1, 0), cA + kstep, voffA); PG8_STAGE(PG8_SB(1, 1), cB + hstep + kstep, voffB);
        PG8_WAIT_V(6); PG8_BAR;
    }
    for (;;) {
        const bool has_next = S.next(ui + 1, nxt);
        const char* nA = has_next ? (const char*)g.A + (size_t)nxt.pm * tstep : cA; const char* nB = has_next ? (const char*)g.Bt + (size_t)nxt.pn * tstep : cB;
        for (int t = 0; t < nt; t += 2) {
            const bool last = (t == nt - 2);
            const char* a1 = cA + (size_t)(t + 1) * kstep;
            const char* a2 = last ? nA : cA + (size_t)(t + 2) * kstep; const char* b2 = last ? nB : cB + (size_t)(t + 2) * kstep;
            const char* a3 = a2 + kstep; const char* b3 = b2 + kstep;
            if (last && has_next) S.a_ready(nxt);
            if constexpr (SP2) {
            PG8_LDB(B0, 0, 0); PG8_LDB(B1, 0, 1); PG8_SCHED; PG8_LDA(At, 0, 0); PG8_STAGE(PG8_SA(1, 1), a1 + hstep, voffA);
            PG8_WAIT_V(8); PG8_WAIT_L(0); PG8_BAR; PG8_MMA(0, 0, At, B0); PG8_MMA(0, 1, At, B1); PG8_BAR; PG8_SCHED;
            PG8_LDA(At, 0, 1); PG8_STAGE(PG8_SB(0, 0), b2, voffB); PG8_STAGE(PG8_SB(0, 1), b2 + hstep, voffB); PG8_STAGE(PG8_SA(0, 0), a2, voffA);
            PG8_WAIT_V(8); PG8_WAIT_L(0); PG8_BAR; PG8_MMA(1, 0, At, B0); PG8_MMA(1, 1, At, B1); PG8_BAR; PG8_SCHED;
            PG8_LDB(B0, 1, 0); PG8_LDB(B1, 1, 1); PG8_SCHED; PG8_LDA(At, 1, 0); PG8_STAGE(PG8_SA(0, 1), a2 + hstep, voffA);
            PG8_WAIT_V(8); PG8_WAIT_L(0); PG8_BAR; PG8_MMA(0, 0, At, B0); PG8_MMA(0, 1, At, B1); PG8_BAR; PG8_SCHED;
            PG8_LDA(At, 1, 1); PG8_STAGE(PG8_SB(1, 0), b3, voffB); PG8_STAGE(PG8_SB(1, 1), b3 + hstep, voffB); PG8_STAGE(PG8_SA(1, 0), a3, voffA);
            PG8_WAIT_V(8); PG8_WAIT_L(0); PG8_BAR; PG8_MMA(1, 0, At, B0); PG8_MMA(1, 1, At, B1); PG8_BAR; PG8_SCHED;
            } else {
            PG8_LDB(B0, 0, 0); PG8_SCHED; PG8_LDA(At, 0, 0); PG8_STAGE(PG8_SA(1, 1), a1 + hstep, voffA);
            PG8_WAIT_L(8); PG8_BAR; PG8_WAIT_L(0); PG8_MMA(0, 0, At, B0); PG8_BAR; PG8_SCHED;
            PG8_LDB(B1, 0, 1); PG8_STAGE(PG8_SB(0, 0), b2, voffB);
            PG8_BAR; PG8_WAIT_L(0); PG8_MMA(0, 1, At, B1); PG8_BAR;
            PG8_LDA(At, 0, 1); PG8_STAGE(PG8_SA(0, 0), a2, voffA);
            PG8_BAR; PG8_WAIT_L(0); PG8_MMA(1, 0, At, B0); PG8_BAR; PG8_SCHED;
            PG8_STAGE(PG8_SB(0, 1), b2 + hstep, voffB);
            PG8_WAIT_V(6); PG8_BAR; PG8_MMA(1, 1, At, B1); PG8_BAR;
            PG8_LDB(B0, 1, 0); PG8_SCHED; PG8_LDA(At, 1, 0); PG8_STAGE(PG8_SA(0, 1), a2 + hstep, voffA);
            PG8_WAIT_L(8); PG8_BAR; PG8_WAIT_L(0); PG8_MMA(0, 0, At, B0); PG8_BAR; PG8_SCHED;
            PG8_LDB(B1, 1, 1); PG8_STAGE(PG8_SB(1, 0), b3, voffB);
            PG8_BAR; PG8_WAIT_L(0); PG8_MMA(0, 1, At, B1); PG8_BAR;
            PG8_LDA(At, 1, 1); PG8_STAGE(PG8_SA(1, 0), a3, voffA);
            PG8_BAR; PG8_WAIT_L(0); PG8_MMA(1, 0, At, B0); PG8_BAR; PG8_SCHED;
            PG8_STAGE(PG8_SB(1, 1), b3 + hstep, voffB);
            PG8_WAIT_V(6); PG8_BAR; PG8_MMA(1, 1, At, B1); PG8_BAR;
            }
        }
        if constexpr (ALIGN_EPI) { if (wr == 0) PG8_BAR; }
        if constexpr (!Epi::AFTER_DRAIN) { E(acc, cur, wr, wc, fr, fq); S.done(cur); }
        if (!has_next) break;
#pragma unroll
        for (int a = 0; a < 2; ++a)
#pragma unroll
            for (int b = 0; b < 2; ++b)
#pragma unroll
                for (int m = 0; m < 4; ++m)
#pragma unroll
                    for (int n = 0; n < 2; ++n) acc[a][b][m][n] = (f32x4){0.f, 0.f, 0.f, 0.f};
        cur = nxt; cA = nA; cB = nB; ++ui;
        if constexpr (ALIGN_EPI) { if (wr == 1) PG8_BAR; }
    }
    PG8_WAIT_V(0);
    if constexpr (!ALIGN_EPI) { if (wr == 0) PG8_BAR; }
    PG8_BAR;
    if constexpr (Epi::AFTER_DRAIN) { E.fused(acc, cur, wr, wc, fr, fq, lds, wid, lane); S.done(cur); }
#undef PG8_SA
#undef PG8_SB
#undef PG8_STAGE
#undef PG8_LDA
#undef PG8_LDB
#undef PG8_MMA
#undef PG8_WAIT_V
#undef PG8_WAIT_L
#undef PG8_BAR
#undef PG8_SCHED
}
}
namespace dattn {
#define DA_LAS __attribute__((address_space(3)))
typedef unsigned short bf16_t;
using bf16x8 = __attribute__((ext_vector_type(8))) short;
using s16x4  = __attribute__((ext_vector_type(4))) short;
using f32x16 = __attribute__((ext_vector_type(16))) float;
using u32x4  = __attribute__((ext_vector_type(4))) unsigned;
constexpr int NW = 8, QBLK = 32, KVBLK = 64, PITCH = 1024, LDO = 2048;
constexpr float SCALE = 0.125f;
constexpr float THR = 8.f;
constexpr int SHM_V = KVBLK * 128 * 2, SHM_K = KVBLK * 64 * 2;
constexpr int OFF_V = 0, OFF_K = 2 * SHM_V, OFF_WS = 2 * SHM_V + 2 * SHM_K, LDS_BYTES = OFF_WS + NW * 64 * 4;
#define DA_KSWZ(row, colB) ((row) * 128 + ((colB) ^ ((((row) >> 1) & 7) << 4)))
#define DA_SBAR() __builtin_amdgcn_sched_barrier(0)
__device__ __forceinline__ int crow(int r, int hi) { return (r & 3) + 8 * (r >> 2) + 4 * hi; }
typedef float cvt_f32x2 __attribute__((ext_vector_type(2))); typedef __bf16 cvt_bf16x2 __attribute__((ext_vector_type(2)));
__device__ __forceinline__ unsigned cvtpk(float lo, float hi) { const cvt_f32x2 v = {lo, hi}; return __builtin_bit_cast(unsigned, __builtin_convertvector(v, cvt_bf16x2)); }
constexpr float THR2 = THR * 1.4426950408889634f;
template <bool FIRST>
__device__ __forceinline__ void partialSM(f32x16& p0, f32x16& p1, float& mhat, f32x16& negm, float& alpha) {
  float pmax = fmaxf(p0[0], p0[1]);
#pragma unroll
  for (int r = 2; r < 16; ++r) pmax = fmaxf(pmax, p0[r]);
#pragma unroll
  for (int r = 0; r < 16; ++r) pmax = fmaxf(pmax, p1[r]);
  { auto rr = __builtin_amdgcn_permlane32_swap(__float_as_uint(pmax), __float_as_uint(pmax), false, false);
    pmax = fmaxf(__uint_as_float(rr[0]), __uint_as_float(rr[1])); }
  alpha = 1.f;
  if (FIRST || __builtin_expect(__any(pmax > THR2), 0)) {
    const float dl = FIRST ? pmax : fmaxf(pmax, 0.f);
    mhat += dl;
#pragma unroll
    for (int r = 0; r < 16; ++r) { p0[r] -= dl; p1[r] -= dl; }
#pragma unroll
    for (int r = 0; r < 16; ++r) negm[r] = -mhat;
    if (!FIRST) alpha = __builtin_amdgcn_exp2f(-dl);
  }
#pragma unroll
  for (int r = 0; r < 16; ++r) p0[r] = __builtin_amdgcn_exp2f(p0[r]);
}
__device__ __forceinline__ void finishSM(f32x16& p0, f32x16& p1, bf16x8& pa0, bf16x8& pa1, bf16x8& pa2, bf16x8& pa3) {
#pragma unroll
  for (int r = 0; r < 16; ++r) p1[r] = __builtin_amdgcn_exp2f(p1[r]);
#define DA_PK4(P, BASE, OUT) do { unsigned a0 = cvtpk(P[BASE + 0], P[BASE + 1]), a1 = cvtpk(P[BASE + 2], P[BASE + 3]);   \
    unsigned b0 = cvtpk(P[BASE + 4], P[BASE + 5]), b1 = cvtpk(P[BASE + 6], P[BASE + 7]);                              \
    auto r0 = __builtin_amdgcn_permlane32_swap(a0, b0, false, false); auto r1 = __builtin_amdgcn_permlane32_swap(a1, b1, false, false); \
    u32x4 w = {r0[0], r1[0], r0[1], r1[1]}; OUT = __builtin_bit_cast(bf16x8, w); } while (0)
  DA_PK4(p0, 0, pa0); DA_PK4(p0, 8, pa1); DA_PK4(p1, 0, pa2); DA_PK4(p1, 8, pa3);
}
__device__ __forceinline__ void qkt(f32x16& p0, f32x16& p1, const DA_LAS char* Ks, const bf16x8* qr, const f32x16& negm, int r32, int hi) {
#pragma unroll
  for (int d0 = 0; d0 < 4; ++d0) { const int cb = d0 * 32 + hi * 16;
    const bf16x8 b0 = *(const DA_LAS bf16x8*)(Ks + DA_KSWZ(r32, cb));
    const bf16x8 b1 = *(const DA_LAS bf16x8*)(Ks + DA_KSWZ(32 + r32, cb));
    p0 = __builtin_amdgcn_mfma_f32_32x32x16_bf16(b0, qr[d0], d0 == 0 ? negm : p0, 0, 0, 0);
    p1 = __builtin_amdgcn_mfma_f32_32x32x16_bf16(b1, qr[d0], d0 == 0 ? negm : p1, 0, 0, 0); }
}
__device__ __forceinline__ int v_st(int k, int c) { const int kk = (k & ~0xC) | ((k & 4) << 1) | ((k & 8) >> 1); return ((kk >> 3) * 4 + (c >> 5)) * 512 + ((kk & 7) * 32 + (c & 31)) * 2; }
__device__ __forceinline__ int v_rd_base(int lane) { return ((lane & 3) << 3) | (((lane >> 2) & 3) << 6) | (((lane >> 4) & 1) << 5) | (((lane >> 5) & 1) << 8); }
constexpr int v_rd_off(int d0, int ks, int half) { return d0 * 512 + ks * 4096 + half * 2048; }
template <int OFF> __device__ __forceinline__ s16x4 tr_read(int vb) {
  s16x4 r; asm volatile("ds_read_b64_tr_b16 %0, %1 offset:%2" : "=&v"(r) : "v"(vb), "i"(OFF) : "memory"); return r;
}
#define DA_PK(L, H) (bf16x8){L[0], L[1], L[2], L[3], H[0], H[1], H[2], H[3]}
template <int D0> __device__ __forceinline__ void pv_one(f32x16& od, int vb, bf16x8 pa0, bf16x8 pa1, bf16x8 pa2, bf16x8 pa3) {
  const s16x4 l0 = tr_read<v_rd_off(D0, 0, 0)>(vb), h0 = tr_read<v_rd_off(D0, 0, 1)>(vb), l1 = tr_read<v_rd_off(D0, 1, 0)>(vb), h1 = tr_read<v_rd_off(D0, 1, 1)>(vb);
  const s16x4 l2 = tr_read<v_rd_off(D0, 2, 0)>(vb), h2 = tr_read<v_rd_off(D0, 2, 1)>(vb), l3 = tr_read<v_rd_off(D0, 3, 0)>(vb), h3 = tr_read<v_rd_off(D0, 3, 1)>(vb);
  asm volatile("s_waitcnt lgkmcnt(0)" ::: "memory"); DA_SBAR();
  od = __builtin_amdgcn_mfma_f32_32x32x16_bf16(pa0, DA_PK(l0, h0), od, 0, 0, 0);
  od = __builtin_amdgcn_mfma_f32_32x32x16_bf16(pa1, DA_PK(l1, h1), od, 0, 0, 0);
  od = __builtin_amdgcn_mfma_f32_32x32x16_bf16(pa2, DA_PK(l2, h2), od, 0, 0, 0);
  od = __builtin_amdgcn_mfma_f32_32x32x16_bf16(pa3, DA_PK(l3, h3), od, 0, 0, 0);
}
__device__ __forceinline__ void pv_d0(f32x16* o, int vb, bf16x8 pa0, bf16x8 pa1, bf16x8 pa2, bf16x8 pa3) {
  pv_one<0>(o[0], vb, pa0, pa1, pa2, pa3); pv_one<1>(o[1], vb, pa0, pa1, pa2, pa3);
  { const bf16x8 ones = {0x3F80, 0x3F80, 0x3F80, 0x3F80, 0x3F80, 0x3F80, 0x3F80, 0x3F80};
    o[4] = __builtin_amdgcn_mfma_f32_32x32x16_bf16(pa0, ones, o[4], 0, 0, 0); o[4] = __builtin_amdgcn_mfma_f32_32x32x16_bf16(pa1, ones, o[4], 0, 0, 0);
    o[4] = __builtin_amdgcn_mfma_f32_32x32x16_bf16(pa2, ones, o[4], 0, 0, 0); o[4] = __builtin_amdgcn_mfma_f32_32x32x16_bf16(pa3, ones, o[4], 0, 0, 0); }
  pv_one<2>(o[2], vb, pa0, pa1, pa2, pa3); pv_one<3>(o[3], vb, pa0, pa1, pa2, pa3);
}
__device__ __forceinline__ void attn_unit(const bf16_t* __restrict__ Qb, const bf16_t* __restrict__ Kh, const bf16_t* __restrict__ Vh, float* __restrict__ Ob, int seq, DA_LAS char* lds) {
  int tid = threadIdx.x; asm volatile("" : "+v"(tid));
  const int wid = __builtin_amdgcn_readfirstlane(tid >> 6), lane = tid & 63, r32 = lane & 31, hi = lane >> 5;
  DA_LAS char* V_lds = lds + OFF_V; DA_LAS char* K_lds = lds + OFF_K;
  DA_LAS float* al_l = (DA_LAS float*)(lds + OFF_WS) + wid * 64;
  float mhat = 0.f; f32x16 o[5] = {}; f32x16 negm = {}; bf16x8 qr[4];
  const bf16_t* Qw = Qb + (long)(wid * QBLK + r32) * PITCH + hi * 8;
#pragma unroll
  for (int d0 = 0; d0 < 4; ++d0) qr[d0] = *(const bf16x8*)(Qw + d0 * 16);
  const int sr = tid >> 4, sc = (tid & 15) * 8, vst0 = v_st(sr, sc), vst1 = v_st(32 + sr, sc);
  const int kr = tid >> 3, kc = (tid & 7) * 8, kst = DA_KSWZ(kr, kc * 2);
  const int vb0 = (int)(unsigned)(size_t)V_lds + v_rd_base(lane);
  struct { bf16x8 vs0, vs1, ks0; } sr_[1];
#define DA_SLOAD(i, k0) do { sr_[i].vs0 = *(const bf16x8*)(&Vh[(long)((k0) + sr) * PITCH + sc]); sr_[i].vs1 = *(const bf16x8*)(&Vh[(long)((k0) + 32 + sr) * PITCH + sc]); \
    sr_[i].ks0 = *(const bf16x8*)(&Kh[(long)((k0) + kr) * PITCH + kc]); } while (0)
#define DA_SWRITE(b, i) do { *(DA_LAS bf16x8*)(V_lds + (b) * SHM_V + vst0) = sr_[i].vs0; *(DA_LAS bf16x8*)(V_lds + (b) * SHM_V + vst1) = sr_[i].vs1; \
    *(DA_LAS bf16x8*)(K_lds + (b) * SHM_K + kst) = sr_[i].ks0; } while (0)
#define DA_SWAIT() asm volatile("s_waitcnt vmcnt(0)" ::: "memory")
#define DA_RESC(a) do { if (__any((a) < 1.f)) { if (hi == 0) al_l[r32] = (a); asm volatile("s_waitcnt lgkmcnt(0)" ::: "memory"); \
    _Pragma("unroll") for (int d = 0; d < 5; ++d) _Pragma("unroll") for (int r = 0; r < 16; ++r) o[d][r] *= al_l[crow(r, hi)]; } } while (0)
  f32x16 pA0, pA1, pB0, pB1; float alA, alB; bf16x8 pa0, pa1, pa2, pa3; const int NT = seq / KVBLK;
  constexpr int SE = 0, SO = 0;
  DA_SLOAD(SE, 0); asm volatile("s_waitcnt vmcnt(0)" ::: "memory"); DA_SWRITE(0, SE); __syncthreads();
  qkt(pA0, pA1, K_lds, qr, negm, r32, hi); partialSM<true>(pA0, pA1, mhat, negm, alA);
  DA_SLOAD(SO, KVBLK);
  DA_SWAIT(); DA_SWRITE(1, SO); __syncthreads();
  for (int j = 1; j + 1 < NT; j += 2) {
    DA_SBAR(); qkt(pB0, pB1, K_lds + SHM_K, qr, negm, r32, hi);
    finishSM(pA0, pA1, pa0, pa1, pa2, pa3); DA_SBAR();
    DA_SLOAD(SE, (j + 1) * KVBLK); DA_SBAR();
    pv_d0(o, vb0, pa0, pa1, pa2, pa3); partialSM<false>(pB0, pB1, mhat, negm, alB);
    __syncthreads(); DA_SWAIT(); DA_SWRITE(0, SE);
    DA_RESC(alB); __syncthreads();
    DA_SBAR(); qkt(pA0, pA1, K_lds, qr, negm, r32, hi);
    finishSM(pB0, pB1, pa0, pa1, pa2, pa3); DA_SBAR();
    DA_SLOAD(SO, (j + 2) * KVBLK); DA_SBAR();
    pv_d0(o, vb0 + SHM_V, pa0, pa1, pa2, pa3); partialSM<false>(pA0, pA1, mhat, negm, alA);
    __syncthreads(); DA_SWAIT(); DA_SWRITE(1, SO);
    DA_RESC(alA); __syncthreads();
  }
  DA_SBAR(); qkt(pB0, pB1, K_lds + SHM_K, qr, negm, r32, hi);
  finishSM(pA0, pA1, pa0, pa1, pa2, pa3); DA_SBAR();
  pv_d0(o, vb0, pa0, pa1, pa2, pa3); partialSM<false>(pB0, pB1, mhat, negm, alB);
  __syncthreads(); DA_RESC(alB);
  finishSM(pB0, pB1, pa0, pa1, pa2, pa3); DA_SBAR();
  pv_d0(o, vb0 + SHM_V, pa0, pa1, pa2, pa3);
  float* Ow = Ob + (long)(wid * QBLK) * LDO;
#pragma unroll
  for (int r = 0; r < 16; ++r) { const int orow = crow(r, hi); const float rl = __builtin_amdgcn_rcpf(o[4][r]);
#pragma unroll
    for (int d0 = 0; d0 < 4; ++d0) Ow[(long)orow * LDO + d0 * 32 + r32] = o[d0][r] * rl; }
  asm volatile("s_waitcnt lgkmcnt(0)" ::: "memory"); __syncthreads();
#undef DA_SLOAD
#undef DA_SWRITE
#undef DA_SWAIT
#undef DA_RESC
}
}

constexpr int NWAVES = 8;
constexpr int SEQ = 16384, DM = 2048, FF = 5632, AW = 1024, NHEAD = 8, FW = 1024, NGRP = 8, GD = 128, DEPTH = 2;
constexpr int NMOD = 9 * DM;
constexpr int KSPLIT = 16;
constexpr float NORM_EPS = 1e-6f, SUBLN_EPS = 1e-5f;

constexpr size_t MiB = 1u << 20;
constexpr size_t WS_CTL = 0, CTL_ZERO_BYTES = 1 * MiB;
constexpr size_t WS_COS = 1 * MiB, WS_SIN = 3 * MiB;
constexpr size_t WS_DFTC = 5 * MiB, WS_DFTS = 5 * MiB + 32768, WS_TW = 5 * MiB + 65536;
constexpr size_t WS_MODP = 6 * MiB;
constexpr size_t WS_MODF = 9 * MiB;
constexpr size_t WS_LAM = WS_MODF + (size_t)DEPTH * 9 * DM * 4;
constexpr size_t WS_W = 10 * MiB, W_LAYER = 180 * MiB;
constexpr size_t W_1IN = 0, W_1OUT = 44 * MiB, W_MIX = 66 * MiB, W_AP = 98 * MiB, W_FP = 102 * MiB, W_MO = 106 * MiB, W_2IN = 114 * MiB, W_2OUT = 158 * MiB;
constexpr size_t WS_H = 370 * MiB, WS_Y = 434 * MiB, WS_ACT = 498 * MiB, WS_M1 = 674 * MiB, WS_O = 802 * MiB, WS_END = 930 * MiB;
constexpr size_t WS_TRE = WS_Y, WS_TIM = WS_Y + 32 * MiB;
constexpr size_t WS_GATE = WS_ACT;
constexpr size_t WS_Q = WS_M1, WS_K = WS_M1 + 32 * MiB, WS_V = WS_M1 + 64 * MiB, WS_U = WS_M1 + 96 * MiB;
constexpr size_t WS_YF = WS_M1, WS_AO = WS_M1 + 32 * MiB, WS_MG = WS_M1 + 64 * MiB;
constexpr size_t WS_TT = WS_O;
constexpr int CW_TMO = 0, CW_CODE = 1, CW_BAR = 4096, CW_CHK = 16384;

constexpr int RING_OFF = 0, PHASE_LDS = 143360;
constexpr int LDSCTL_OFF = PHASE_LDS, MISC_OFF = LDSCTL_OFF + 320;
constexpr int LDS_BYTES = 147456;
static_assert(MISC_OFF + 128 <= LDS_BYTES, "LDS map");

#define GAS __attribute__((address_space(1)))
#define LAS __attribute__((address_space(3)))
typedef unsigned short bf16;
typedef unsigned v4u __attribute__((ext_vector_type(4)));
typedef unsigned v2u __attribute__((ext_vector_type(2)));
typedef float f32x4 __attribute__((ext_vector_type(4)));
typedef float f32x16 __attribute__((ext_vector_type(16)));
typedef short bf16x8 __attribute__((ext_vector_type(8)));
typedef short s16x4 __attribute__((ext_vector_type(4)));
typedef GAS unsigned gu32;
#define RLX_AGENT __ATOMIC_RELAXED, __HIP_MEMORY_SCOPE_AGENT
#define LDS_WAIT() asm volatile("s_waitcnt lgkmcnt(0)" ::: "memory")
#define VM_WAIT() asm volatile("s_waitcnt vmcnt(0)" ::: "memory")
__device__ __forceinline__ unsigned f2bf(float f) { unsigned u = __builtin_bit_cast(unsigned, f); return (u + 0x7fffu + ((u >> 16) & 1u)) >> 16; }
__device__ __forceinline__ unsigned pk2(float lo, float hi) { return f2bf(lo) | (f2bf(hi) << 16); }
__device__ __forceinline__ float bfl(unsigned w) { return __builtin_bit_cast(float, w << 16); }
__device__ __forceinline__ float bfh(unsigned w) { return __builtin_bit_cast(float, w & 0xffff0000u); }
__device__ __forceinline__ float wave_sum(float v) {
#pragma unroll
    for (int o = 1; o < 64; o <<= 1) v += __shfl_xor(v, o);
    return v;
}
__device__ __forceinline__ void sincos_turns(double t, double& s, double& c) {
    t -= floor(t);
    const double q = floor(t * 4.0 + 0.5);
    const double x = (t - q * 0.25) * 6.283185307179586476925286766559;
    const double x2 = x * x;
    double sp = -1.0 / 1307674368000.0; sp = sp * x2 + 1.0 / 6227020800.0; sp = sp * x2 - 1.0 / 39916800.0; sp = sp * x2 + 1.0 / 362880.0; sp = sp * x2 - 1.0 / 5040.0; sp = sp * x2 + 1.0 / 120.0; sp = sp * x2 - 1.0 / 6.0; sp = sp * x2 + 1.0;
    const double sx = sp * x;
    double cp = 1.0 / 20922789888000.0; cp = cp * x2 - 1.0 / 87178291200.0; cp = cp * x2 + 1.0 / 479001600.0; cp = cp * x2 - 1.0 / 3628800.0; cp = cp * x2 + 1.0 / 40320.0; cp = cp * x2 - 1.0 / 720.0; cp = cp * x2 + 1.0 / 24.0; cp = cp * x2 - 0.5; cp = cp * x2 + 1.0;
    const int qi = ((int)q) & 3;
    s = (qi == 0) ? sx : (qi == 1) ? cp : (qi == 2) ? -sx : -cp;
    c = (qi == 0) ? cp : (qi == 1) ? -sx : (qi == 2) ? -cp : sx;
}
__constant__ float ROPE_INV_FREQ[32] = {1.f,0.749894261f,0.562341332f,0.421696514f,0.316227764f,0.237137377f,0.177827939f,0.133352131f,0.100000001f,0.0749894157f,0.0562341325f,0.0421696529f,0.0316227749f,0.0237137377f,0.0177827943f,0.0133352149f,0.00999999978f,0.00749894185f,0.00562341325f,0.00421696482f,0.00316227763f,0.00237137359f,0.00177827943f,0.00133352145f,0.00100000005f,0.000749894243f,0.000562341302f,0.000421696517f,0.000316227757f,0.00023713737f,0.00017782794f,0.00013335215f};

#define XB_TMO      128
#define XB_XCNT(j)  (256  + 64 * (j))
#define XB_XSUB(j)  (1280 + 64 * (j))
#define XB_XGEN(j)  (2304 + 64 * (j))
#define XB_TOP      3328
#define XB_TOPGEN   3392
#define XCD_BAR_WORDS 3456
#define XB_SPIN_CAP (1u << 18)

__device__ __forceinline__ unsigned xb_ld(unsigned* p)              { return __hip_atomic_load(p, __ATOMIC_RELAXED, __HIP_MEMORY_SCOPE_AGENT); }
__device__ __forceinline__ unsigned xb_add(unsigned* p, unsigned v) { return __hip_atomic_fetch_add(p, v, __ATOMIC_RELAXED, __HIP_MEMORY_SCOPE_AGENT); }
__device__ __forceinline__ unsigned xb_xcc_id() { return (unsigned)__builtin_amdgcn_s_getreg((3 << 11) | 20) & 0xFu; }
#define XB_SPIN(cond, bar) do { unsigned _sp = 0; while (cond) { __builtin_amdgcn_s_sleep(1); \
    if ((++_sp & 255u) == 0u) { if (xb_ld(&(bar)[XB_TMO])) break; if (_sp > XB_SPIN_CAP) { atomicAdd(&(bar)[XB_TMO], 1u); break; } } } } while (0)

struct XcdBarrier {
    unsigned* bar; unsigned x;
    volatile LAS unsigned* st;
};

__device__ __forceinline__ XcdBarrier xcd_barrier_post(unsigned* bar, volatile LAS unsigned* st) {
    XcdBarrier b; b.bar = bar; b.x = xb_xcc_id(); b.st = st;
    if (threadIdx.x == 0) (void)xb_add(&bar[XB_XCNT(b.x)], 1u);
    return b;
}
__device__ __forceinline__ void xcd_barrier_complete(unsigned* bar, unsigned x, unsigned& nloc, unsigned& nx) {
    const unsigned G = gridDim.x * gridDim.y * gridDim.z;
    unsigned sum, cnt, mine, sp = 0u;
    for (;;) {
        sum = 0u; cnt = 0u; mine = 0u;
#pragma unroll
        for (unsigned j = 0; j < 16; ++j) { const unsigned c = xb_ld(&bar[XB_XCNT(j)]); sum += c; cnt += (c > 0u) ? 1u : 0u; mine = (j == x) ? c : mine; }
        if (sum == G) break;
        __builtin_amdgcn_s_sleep(1);
        if ((++sp & 255u) == 0u) { if (xb_ld(&bar[XB_TMO])) break; if (sp > XB_SPIN_CAP) { atomicAdd(&bar[XB_TMO], 1u); break; } }
    }
    nloc = mine > 0u ? mine : 1u; nx = cnt > 0u ? cnt : 1u;
}

__device__ __forceinline__ void xcd_barrier(const XcdBarrier& b) {
    asm volatile("s_waitcnt vmcnt(0)" ::: "memory");
    __syncthreads();
    if (threadIdx.x == 0) {
        unsigned* bar = b.bar;
        __builtin_amdgcn_s_waitcnt(0);
        unsigned nloc = b.st[0], nx = b.st[1];
        if (nloc == 0u) { xcd_barrier_complete(bar, b.x, nloc, nx); b.st[0] = nloc; b.st[1] = nx; }
        const unsigned old = xb_add(&bar[XB_XSUB(b.x)], 1u);
        const unsigned gen = old / nloc;
        if (old + 1u == (gen + 1u) * nloc) {
            __builtin_amdgcn_fence(__ATOMIC_RELEASE, "agent");
            asm volatile("s_waitcnt vmcnt(0)" ::: "memory");
            const unsigned og = xb_add(&bar[XB_TOP], 1u);
            const unsigned tg = og / nx;
            if (og + 1u == (tg + 1u) * nx) xb_add(&bar[XB_TOPGEN], 1u);
            else XB_SPIN(xb_ld(&bar[XB_TOPGEN]) == tg, bar);
            __builtin_amdgcn_fence(__ATOMIC_ACQUIRE, "agent");
            xb_add(&bar[XB_XGEN(b.x)], 1u);
            asm volatile("s_waitcnt vmcnt(0)" ::: "memory");
        } else {
            XB_SPIN(xb_ld(&bar[XB_XGEN(b.x)]) == gen, bar);
            __builtin_amdgcn_fence(__ATOMIC_ACQUIRE, "agent");
            asm volatile("s_waitcnt vmcnt(0)" ::: "memory");
        }
    }
    __syncthreads();
}
struct Frame {
    LAS unsigned char* lds;
    volatile LAS unsigned* MISC;
    gu32* ctl;
    int tid, lane, wave;
    int vcu, G;
    unsigned char* ws;
};

__device__ __forceinline__ int wt_row(int mode, int row_off, int n0) {
    if (mode == 1) { const int up = n0 >= FF ? 1 : 0, j = n0 - up * FF; return (j >> 7) * 256 + up * 128 + (j & 127); }
    if (mode == 2) { if (n0 < 2048) { const int ch = n0 >> 6, d = n0 & 63; return 256 * (ch >> 2) + 128 * (d >> 5) + 32 * (ch & 3) + (d & 31); } return n0; }
    return row_off + n0;
}
__device__ __forceinline__ void p0_transpose_item(const float* W, int K, int N, bf16* WT, int mode, int row_off, LAS float* scr, int item, int lane) {
    const int nblk = N / 32, kb = item / nblk, nb = item % nblk, k0 = 64 * kb, n0 = 32 * nb;
#pragma unroll 8
    for (int i = 0; i < 32; ++i) { const int kk = 2 * i + (lane >> 5); scr[kk * 33 + (lane & 31)] = W[(size_t)(k0 + kk) * N + n0 + (lane & 31)]; }
    LDS_WAIT(); asm volatile("" ::: "memory");
    const int c = lane & 7, rbase = wt_row(mode, row_off, n0);
#pragma unroll
    for (int j = 0; j < 4; ++j) { const int n = (lane >> 3) + 8 * j; const LAS float* s = scr + (8 * c) * 33 + n;
        v4u o; o.x = pk2(s[0 * 33], s[1 * 33]); o.y = pk2(s[2 * 33], s[3 * 33]); o.z = pk2(s[4 * 33], s[5 * 33]); o.w = pk2(s[6 * 33], s[7 * 33]);
        *(GAS v4u*)(WT + (size_t)(rbase + n) * K + k0 + 8 * c) = o; }
    LDS_WAIT(); asm volatile("" ::: "memory");
}
struct In18 { const float* p[18]; };
__device__ __forceinline__ void p0_prologue(Frame& F, const In18& in) {
    LAS float* scr = (LAS float*)(F.lds + RING_OFF + F.wave * 16384);
    const int gw = F.vcu * NWAVES + F.wave, NGW = F.G * NWAVES;
    constexpr int I0 = 32 * 352, I1 = 88 * 64, I2 = 32 * 128, I3 = 32 * 128, I4 = 16 * 64, I5 = 16 * 64, I6 = 32 * 64, IL = 2 * I0 + 2 * I1 + I2 + I3 + I4 + I5 + I6;
    for (int it = gw; it < DEPTH * IL; it += NGW) {
        const int l = it / IL; int r = it % IL;
        bf16* wl = (bf16*)(F.ws + WS_W + (size_t)l * W_LAYER);
        if (r < I0) { p0_transpose_item(in.p[6] + (size_t)l * DM * 2 * FF, DM, 2 * FF, (bf16*)((unsigned char*)wl + W_1IN), 1, 0, scr, r, F.lane); continue; } r -= I0;
        if (r < I1) { p0_transpose_item(in.p[7] + (size_t)l * FF * DM, FF, DM, (bf16*)((unsigned char*)wl + W_1OUT), 0, 0, scr, r, F.lane); continue; } r -= I1;
        if (r < I2) { p0_transpose_item(in.p[8] + (size_t)l * DM * 4096, DM, 4096, (bf16*)((unsigned char*)wl + W_MIX), 2, 0, scr, r, F.lane); continue; } r -= I2;
        if (r < I3) { p0_transpose_item(in.p[13] + (size_t)l * DM * 4096, DM, 4096, (bf16*)((unsigned char*)wl + W_MIX), 0, 4096, scr, r, F.lane); continue; } r -= I3;
        if (r < I4) { p0_transpose_item(in.p[11] + (size_t)l * AW * DM, AW, DM, (bf16*)((unsigned char*)wl + W_AP), 0, 0, scr, r, F.lane); continue; } r -= I4;
        if (r < I5) { p0_transpose_item(in.p[12] + (size_t)l * FW * DM, FW, DM, (bf16*)((unsigned char*)wl + W_FP), 0, 0, scr, r, F.lane); continue; } r -= I5;
        if (r < I6) { p0_transpose_item(in.p[15] + (size_t)l * DM * DM, DM, DM, (bf16*)((unsigned char*)wl + W_MO), 0, 0, scr, r, F.lane); continue; } r -= I6;
        if (r < I0) { p0_transpose_item(in.p[16] + (size_t)l * DM * 2 * FF, DM, 2 * FF, (bf16*)((unsigned char*)wl + W_2IN), 1, 0, scr, r, F.lane); continue; } r -= I0;
        p0_transpose_item(in.p[17] + (size_t)l * FF * DM, FF, DM, (bf16*)((unsigned char*)wl + W_2OUT), 0, 0, scr, r, F.lane);
    }
    {
        constexpr int NCB = NMOD / 256, KR = DM / KSPLIT;
        const float* cvec = in.p[1]; float* modp = (float*)(F.ws + WS_MODP);
        for (int it = gw; it < DEPTH * NCB * KSPLIT; it += NGW) {
            const int l = it / (NCB * KSPLIT), r = it % (NCB * KSPLIT), ks = r / NCB, cb = r % NCB, c0 = cb * 256 + 4 * F.lane, k0 = ks * KR;
            const float* W = in.p[2] + (size_t)l * DM * NMOD + (size_t)k0 * NMOD + c0;
            f32x4 acc = {0.f, 0.f, 0.f, 0.f};
#pragma unroll 8
            for (int k = 0; k < KR; ++k) { const float cv = cvec[k0 + k]; const float ca = cv * __builtin_amdgcn_rcpf(1.0f + __builtin_amdgcn_exp2f(cv * -1.4426950408889634f));
                const f32x4 w = *(const GAS f32x4*)(W + (size_t)k * NMOD); acc += w * ca; }
            *(GAS f32x4*)(modp + (size_t)(l * KSPLIT + ks) * NMOD + c0) = acc;
        }
    }
    {
        const int gt = F.vcu * (NWAVES * 64) + F.tid, NT = F.G * NWAVES * 64;
        float* cosT = (float*)(F.ws + WS_COS); float* sinT = (float*)(F.ws + WS_SIN);
        for (int idx = gt; idx < SEQ * 32; idx += NT) { const int pos = idx >> 5, i = idx & 31; const float ang = (float)pos * ROPE_INV_FREQ[i];
            double s, c; sincos_turns((double)ang * 0.15915494309189533576888376337251, s, c); cosT[idx] = (float)c; sinT[idx] = (float)s; }
        bf16* dC = (bf16*)(F.ws + WS_DFTC); bf16* dS = (bf16*)(F.ws + WS_DFTS); float* tw = (float*)(F.ws + WS_TW);
        for (int idx = gt; idx < 128 * 128; idx += NT) { const int a = idx >> 7, b = idx & 127; double s, c;
            sincos_turns((double)((a * b) & 127) * (1.0 / 128.0), s, c); dC[idx] = (bf16)f2bf((float)c); dS[idx] = (bf16)f2bf((float)s);
            sincos_turns((double)(a * b) * (1.0 / 16384.0), s, c); tw[2 * idx] = (float)c; tw[2 * idx + 1] = (float)s; }
    }
}
__device__ __forceinline__ void p1_modfin(Frame& F, const In18& in) {
    const int gt = F.vcu * (NWAVES * 64) + F.tid, NT = F.G * NWAVES * 64;
    const float* modp = (const float*)(F.ws + WS_MODP); float* modf = (float*)(F.ws + WS_MODF);
    for (int idx = gt; idx < DEPTH * 3 * DM; idx += NT) { const int l = idx / (3 * DM), s = (idx / DM) % 3, c = idx % DM, base = s * 3 * DM + c;
        float sh = in.p[3][l * NMOD + base], sc = in.p[3][l * NMOD + base + DM], gt_ = in.p[3][l * NMOD + base + 2 * DM];
        for (int ks = 0; ks < KSPLIT; ++ks) { const float* q = modp + (size_t)(l * KSPLIT + ks) * NMOD + base; sh += q[0]; sc += q[DM]; gt_ += q[2 * DM]; }
        const float gpre = in.p[4][(l * 3 + s) * DM + c], gpost = in.p[5][(l * 3 + s) * DM + c];
        float* o = modf + (size_t)((l * 3 + s) * 3) * DM + c;
        o[0] = gpre * (1.0f + sc); o[DM] = sh; o[2 * DM] = (s == 1 ? 1.0f : 0.5f) * gt_ * gpost; }
    if (blockIdx.x == 0 && F.wave < DEPTH) { const int l = F.wave; const float* lq = in.p[9] + l * 256;
        const float sa = wave_sum(lq[F.lane] * lq[64 + F.lane]), sb = wave_sum(lq[128 + F.lane] * lq[192 + F.lane]);
        const float linit = l == 0 ? 0.2f : 0.35550906758f;
        if (F.lane == 0) { float* lamv = (float*)(F.ws + WS_LAM); lamv[l] = __builtin_amdgcn_exp2f(sa * 1.4426950408889634f) - __builtin_amdgcn_exp2f(sb * 1.4426950408889634f) + linit; lamv[2 + l] = 1.0f - linit; } }
}
template <bool HAS_Y, bool HAS_H>
__device__ __forceinline__ void norm_phase(Frame& F, const float* xin, float* xout, const bf16* y, bf16* h, const float* Gv, const float* Av, const float* Bv) {
    int lane = F.lane; asm volatile("" : "+v"(lane));
    const int gw = F.vcu * NWAVES + F.wave, NGW = F.G * NWAVES;
    f32x4 g[8], a[8], b[8];
#pragma unroll
    for (int j = 0; j < 8; ++j) { if (HAS_Y) g[j] = *(const GAS f32x4*)(Gv + 4 * lane + 256 * j); if (HAS_H) { a[j] = *(const GAS f32x4*)(Av + 4 * lane + 256 * j); b[j] = *(const GAS f32x4*)(Bv + 4 * lane + 256 * j); } }
    for (int row = gw; row < SEQ; row += NGW) {
        f32x4 x[8];
#pragma unroll
        for (int j = 0; j < 8; ++j) x[j] = *(const GAS f32x4*)(xin + (size_t)row * DM + 4 * lane + 256 * j);
        if (HAS_Y) {
            f32x4 yv[8]; float ss = 0.f;
#pragma unroll
            for (int j = 0; j < 8; ++j) { const v2u w = *(const GAS v2u*)(y + (size_t)row * DM + 4 * lane + 256 * j); yv[j] = (f32x4){bfl(w.x), bfh(w.x), bfl(w.y), bfh(w.y)};
                ss += (yv[j].x * yv[j].x + yv[j].y * yv[j].y) + (yv[j].z * yv[j].z + yv[j].w * yv[j].w); }
            const float ry = 1.0f / sqrtf(wave_sum(ss) * (1.0f / DM) + NORM_EPS);
#pragma unroll
            for (int j = 0; j < 8; ++j) x[j] = x[j] + g[j] * yv[j] * ry;
        }
#pragma unroll
        for (int j = 0; j < 8; ++j) *(GAS f32x4*)(xout + (size_t)row * DM + 4 * lane + 256 * j) = x[j];
        if (HAS_H) {
            float ss = 0.f;
#pragma unroll
            for (int j = 0; j < 8; ++j) ss += (x[j].x * x[j].x + x[j].y * x[j].y) + (x[j].z * x[j].z + x[j].w * x[j].w);
            const float rx = 1.0f / sqrtf(wave_sum(ss) * (1.0f / DM) + NORM_EPS);
#pragma unroll
            for (int j = 0; j < 8; ++j) { const f32x4 v = x[j] * rx * a[j] + b[j]; v2u w; w.x = pk2(v.x, v.y); w.y = pk2(v.z, v.w); *(GAS v2u*)(h + (size_t)row * DM + 4 * lane + 256 * j) = w; }
        }
    }
}
__device__ __forceinline__ void combine_phase(Frame& F, const float* O, bf16* AO, const float* subg, float lam, float oscale) {
    int lane = F.lane; asm volatile("" : "+v"(lane));
    const int gw = F.vcu * NWAVES + F.wave, NGW = F.G * NWAVES, hh = lane >> 3, e0 = (lane & 7) * 16;
    f32x4 g[4];
#pragma unroll
    for (int j = 0; j < 4; ++j) g[j] = *(const GAS f32x4*)(subg + e0 + 4 * j) * oscale;
    for (int row = gw; row < SEQ; row += NGW) {
        const float* p0 = O + (size_t)row * 2048 + hh * 256 + e0;
        f32x4 o[4]; float ss = 0.f;
#pragma unroll
        for (int j = 0; j < 4; ++j) { const f32x4 a = *(const GAS f32x4*)(p0 + 4 * j), b = *(const GAS f32x4*)(p0 + 128 + 4 * j); o[j] = a - b * lam; ss += (o[j].x * o[j].x + o[j].y * o[j].y) + (o[j].z * o[j].z + o[j].w * o[j].w); }
        ss += __shfl_xor(ss, 1); ss += __shfl_xor(ss, 2); ss += __shfl_xor(ss, 4);
        const float r = 1.0f / sqrtf(ss * (1.0f / 128.0f) + SUBLN_EPS);
        v4u w0, w1; { const f32x4 v0 = o[0] * r * g[0], v1 = o[1] * r * g[1], v2 = o[2] * r * g[2], v3 = o[3] * r * g[3];
            w0.x = pk2(v0.x, v0.y); w0.y = pk2(v0.z, v0.w); w0.z = pk2(v1.x, v1.y); w0.w = pk2(v1.z, v1.w); w1.x = pk2(v2.x, v2.y); w1.y = pk2(v2.z, v2.w); w1.z = pk2(v3.x, v3.y); w1.w = pk2(v3.z, v3.w); }
        bf16* op = AO + (size_t)row * 1024 + hh * 128 + e0;
        *(GAS v4u*)op = w0; *(GAS v4u*)(op + 8) = w1;
    }
}
template <int DD> __device__ __forceinline__ void fft_mm2(f32x16& aR, f32x16& aI, int vb, const bf16x8* Ca, const bf16x8* Sa) {
    using namespace dattn;
    const s16x4 l0 = tr_read<v_rd_off(DD, 0, 0)>(vb), h0 = tr_read<v_rd_off(DD, 0, 1)>(vb), l1 = tr_read<v_rd_off(DD, 1, 0)>(vb), h1 = tr_read<v_rd_off(DD, 1, 1)>(vb);
    const s16x4 l2 = tr_read<v_rd_off(DD, 2, 0)>(vb), h2 = tr_read<v_rd_off(DD, 2, 1)>(vb), l3 = tr_read<v_rd_off(DD, 3, 0)>(vb), h3 = tr_read<v_rd_off(DD, 3, 1)>(vb);
    asm volatile("s_waitcnt lgkmcnt(0)" ::: "memory"); __builtin_amdgcn_sched_barrier(0);
    const bf16x8 b0 = DA_PK(l0, h0), b1 = DA_PK(l1, h1), b2 = DA_PK(l2, h2), b3 = DA_PK(l3, h3);
    aR = __builtin_amdgcn_mfma_f32_32x32x16_bf16(Ca[0], b0, aR, 0, 0, 0); aI = __builtin_amdgcn_mfma_f32_32x32x16_bf16(Sa[0], b0, aI, 0, 0, 0);
    aR = __builtin_amdgcn_mfma_f32_32x32x16_bf16(Ca[1], b1, aR, 0, 0, 0); aI = __builtin_amdgcn_mfma_f32_32x32x16_bf16(Sa[1], b1, aI, 0, 0, 0);
    aR = __builtin_amdgcn_mfma_f32_32x32x16_bf16(Ca[2], b2, aR, 0, 0, 0); aI = __builtin_amdgcn_mfma_f32_32x32x16_bf16(Sa[2], b2, aI, 0, 0, 0);
    aR = __builtin_amdgcn_mfma_f32_32x32x16_bf16(Ca[3], b3, aR, 0, 0, 0); aI = __builtin_amdgcn_mfma_f32_32x32x16_bf16(Sa[3], b3, aI, 0, 0, 0);
}
__device__ __forceinline__ void fftA_phase(Frame& F, const bf16* U, bf16* TRE, bf16* TIM, const bf16* dftC, const bf16* dftS, const float* TW) {
    using namespace dattn;
    int tid = threadIdx.x; asm volatile("" : "+v"(tid));
    const int wid = __builtin_amdgcn_readfirstlane(tid >> 6), lane = tid & 63, r32 = lane & 31, hi = lane >> 5, kb = wid & 3, ch = wid >> 2;
    bf16x8 Cf[8], Sf[8];
#pragma unroll
    for (int i = 0; i < 8; ++i) { Cf[i] = *(const bf16x8*)(dftC + (32 * kb + r32) * 128 + 16 * i + 8 * hi); Sf[i] = *(const bf16x8*)(dftS + (32 * kb + r32) * 128 + 16 * i + 8 * hi); }
    const int sr = tid >> 4, sc = (tid & 15) * 8, vst0 = v_st(sr, sc), vst1 = v_st(32 + sr, sc);
    LAS unsigned char* L = F.lds + RING_OFF;
    const int vb = (int)(unsigned)(size_t)L + v_rd_base(lane) + ch * 1024;
    for (int unit = F.vcu; unit < 128 * NGRP; unit += F.G) {
        const int n2 = unit >> 3, g = unit & 7;
        const bf16* src = U + (size_t)n2 * 1024 + g * 128 + sc;
        const bf16x8 x0 = *(const bf16x8*)(src + (size_t)sr * 131072), x1 = *(const bf16x8*)(src + (size_t)(32 + sr) * 131072), x2 = *(const bf16x8*)(src + (size_t)(64 + sr) * 131072), x3 = *(const bf16x8*)(src + (size_t)(96 + sr) * 131072);
        *(LAS bf16x8*)(L + vst0) = x0; *(LAS bf16x8*)(L + vst1) = x1; *(LAS bf16x8*)(L + 16384 + vst0) = x2; *(LAS bf16x8*)(L + 16384 + vst1) = x3;
        LDS_WAIT(); __syncthreads();
        f32x16 PR[2] = {}, PI[2] = {};
        fft_mm2<0>(PR[0], PI[0], vb, Cf, Sf); fft_mm2<1>(PR[1], PI[1], vb, Cf, Sf);
        fft_mm2<0>(PR[0], PI[0], vb + 16384, Cf + 4, Sf + 4); fft_mm2<1>(PR[1], PI[1], vb + 16384, Cf + 4, Sf + 4);
        LDS_WAIT(); __syncthreads();
        const float* tw = TW + (size_t)(n2 * 128 + 32 * kb + 4 * hi) * 2;
#pragma unroll
        for (int rg = 0; rg < 4; ++rg) { const f32x4 t0 = *(const GAS f32x4*)(tw + 16 * rg), t1 = *(const GAS f32x4*)(tw + 16 * rg + 4);
            const float cc[4] = {t0.x, t0.z, t1.x, t1.z}, ss[4] = {t0.y, t0.w, t1.y, t1.w};
#pragma unroll
            for (int e = 0; e < 4; ++e) { const int r = 4 * rg + e, k1 = 32 * kb + 8 * rg + 4 * hi + e; const size_t rowo = (size_t)(k1 * 128 + n2) * 1024 + g * 128 + 64 * ch + r32;
#pragma unroll
                for (int dd = 0; dd < 2; ++dd) { const float pr = PR[dd][r], pi = PI[dd][r]; TRE[rowo + 32 * dd] = (bf16)f2bf(pr * cc[e] - pi * ss[e]); TIM[rowo + 32 * dd] = (bf16)f2bf(-(pr * ss[e] + pi * cc[e])); } } }
    }
}
__device__ __forceinline__ void fftB_phase(Frame& F, const bf16* TRE, const bf16* TIM, bf16* YF, const bf16* dftC, const bf16* dftS) {
    using namespace dattn;
    constexpr int WSTR = 272, OFF_WR = 65536, OFF_WI = 65536 + 128 * WSTR;
    constexpr float NORMF = 6.905339660024878e-4f;
    int tid = threadIdx.x; asm volatile("" : "+v"(tid));
    const int wid = __builtin_amdgcn_readfirstlane(tid >> 6), lane = tid & 63, r32 = lane & 31, hi = lane >> 5, kb = wid & 3, ch = wid >> 2;
    bf16x8 Cf[8], Sf[8];
#pragma unroll
    for (int i = 0; i < 8; ++i) { Cf[i] = *(const bf16x8*)(dftC + (32 * kb + r32) * 128 + 16 * i + 8 * hi); Sf[i] = *(const bf16x8*)(dftS + (32 * kb + r32) * 128 + 16 * i + 8 * hi); }
    const int sr = tid >> 4, sc = (tid & 15) * 8, vst0 = v_st(sr, sc), vst1 = v_st(32 + sr, sc);
    LAS unsigned char* L = F.lds + RING_OFF;
    const int vb = (int)(unsigned)(size_t)L + v_rd_base(lane) + ch * 1024;
    for (int unit = F.vcu; unit < 128 * NGRP; unit += F.G) {
        const int k1 = unit >> 3, g = unit & 7;
        const size_t so = (size_t)(k1 * 128) * 1024 + g * 128 + sc;
        bf16x8 zr[4], zi[4];
#pragma unroll
        for (int q = 0; q < 4; ++q) { zr[q] = *(const bf16x8*)(TRE + so + (size_t)(32 * q + sr) * 1024); zi[q] = *(const bf16x8*)(TIM + so + (size_t)(32 * q + sr) * 1024); }
        *(LAS bf16x8*)(L + vst0) = zr[0]; *(LAS bf16x8*)(L + vst1) = zr[1]; *(LAS bf16x8*)(L + 16384 + vst0) = zr[2]; *(LAS bf16x8*)(L + 16384 + vst1) = zr[3];
        *(LAS bf16x8*)(L + 32768 + vst0) = zi[0]; *(LAS bf16x8*)(L + 32768 + vst1) = zi[1]; *(LAS bf16x8*)(L + 49152 + vst0) = zi[2]; *(LAS bf16x8*)(L + 49152 + vst1) = zi[3];
        LDS_WAIT(); __syncthreads();
        f32x16 WR[2] = {}, WI[2] = {}, WX[2] = {};
        fft_mm2<0>(WR[0], WX[0], vb, Cf, Sf); fft_mm2<1>(WR[1], WX[1], vb, Cf, Sf);
        fft_mm2<0>(WR[0], WX[0], vb + 16384, Cf + 4, Sf + 4); fft_mm2<1>(WR[1], WX[1], vb + 16384, Cf + 4, Sf + 4);
        fft_mm2<0>(WI[0], WR[0], vb + 32768, Cf, Sf); fft_mm2<1>(WI[1], WR[1], vb + 32768, Cf, Sf);
        fft_mm2<0>(WI[0], WR[0], vb + 49152, Cf + 4, Sf + 4); fft_mm2<1>(WI[1], WR[1], vb + 49152, Cf + 4, Sf + 4);
        WI[0] -= WX[0]; WI[1] -= WX[1];
#pragma unroll
        for (int dd = 0; dd < 2; ++dd)
#pragma unroll
            for (int r = 0; r < 16; ++r) { const int k2 = 32 * kb + crow(r, hi), j = 64 * ch + 32 * dd + r32;
                *(LAS unsigned short*)(L + OFF_WR + k2 * WSTR + j * 2) = (unsigned short)f2bf(WR[dd][r]); *(LAS unsigned short*)(L + OFF_WI + k2 * WSTR + j * 2) = (unsigned short)f2bf(WI[dd][r]); }
        LDS_WAIT(); __syncthreads();
        f32x16 Y[2] = {};
#pragma unroll
        for (int kk = 0; kk < 2; ++kk) { const int rb = (64 * ch + 32 * kk + r32) * WSTR + 16 * hi;
#pragma unroll
            for (int jc = 0; jc < 8; ++jc) { const bf16x8 aR = *(const LAS bf16x8*)(L + OFF_WR + rb + 32 * jc), aI = *(const LAS bf16x8*)(L + OFF_WI + rb + 32 * jc);
                Y[kk] = __builtin_amdgcn_mfma_f32_32x32x16_bf16(aR, Cf[jc], Y[kk], 0, 0, 0); Y[kk] = __builtin_amdgcn_mfma_f32_32x32x16_bf16(aI, Sf[jc], Y[kk], 0, 0, 0); } }
#pragma unroll
        for (int kk = 0; kk < 2; ++kk)
#pragma unroll
            for (int r = 0; r < 16; ++r) { const int k2 = 64 * ch + 32 * kk + crow(r, hi); YF[(size_t)(k1 + 128 * k2) * 1024 + g * 128 + 32 * kb + r32] = (bf16)f2bf(Y[kk][r] * NORMF); }
    }
}
#ifndef PHMASK
#define PHMASK 0xffffffffu
#endif
#define PH(k) (((PHMASK) >> (k)) & 1u)
#ifndef PHREPM
#define PHREPM 0u
#endif
#define REP(k) _Pragma("unroll 1") for (int rep_ = 0; rep_ < (int)(1u + (((PHREPM) >> (k)) & 1u)); ++rep_)
struct Args { const float* in[18]; float* out; unsigned char* ws; };
__global__ void __launch_bounds__(NWAVES * 64, 2) enc_fwd(Args args) {
    extern __shared__ __attribute__((aligned(16))) unsigned char lds[];
    Frame F;
    F.lds = (LAS unsigned char*)lds;
    F.MISC = (volatile LAS unsigned*)(F.lds + MISC_OFF);
    F.tid = threadIdx.x; F.lane = F.tid & 63; F.wave = __builtin_amdgcn_readfirstlane(F.tid >> 6);
    F.G = gridDim.x; { const int bx = blockIdx.x; F.vcu = (F.G % 8 == 0) ? (bx % 8) * (F.G / 8) + bx / 8 : bx; }
    F.ws = args.ws;
    unsigned char* ws = args.ws;
    F.ctl = (gu32*)(ws + WS_CTL);
    In18 in;
#pragma unroll
    for (int i = 0; i < 18; ++i) in.p[i] = args.in[i];
    for (int u = F.tid; u < (LDS_BYTES - LDSCTL_OFF) / 4; u += NWAVES * 64) ((LAS unsigned*)(F.lds + LDSCTL_OFF))[u] = 0u;
    __syncthreads();
    XcdBarrier bar = xcd_barrier_post((unsigned*)(F.ctl + CW_BAR), F.MISC + 8);
#define GRID_BAR() xcd_barrier(bar)

    float* const xres = args.out;
    bf16* const HB = (bf16*)(ws + WS_H); bf16* const YB = (bf16*)(ws + WS_Y); bf16* const ACT = (bf16*)(ws + WS_ACT);
    bf16* const QB = (bf16*)(ws + WS_Q); bf16* const KB = (bf16*)(ws + WS_K); bf16* const VB = (bf16*)(ws + WS_V); bf16* const UB = (bf16*)(ws + WS_U);
    bf16* const GB = (bf16*)(ws + WS_GATE); float* const OB = (float*)(ws + WS_O);
    bf16* const TRE = (bf16*)(ws + WS_TRE); bf16* const TIM = (bf16*)(ws + WS_TIM);
    bf16* const YF = (bf16*)(ws + WS_YF); bf16* const AO = (bf16*)(ws + WS_AO); bf16* const MG = (bf16*)(ws + WS_MG); bf16* const TT = (bf16*)(ws + WS_TT);
    const float* const modf = (const float*)(ws + WS_MODF); const float* const lamv = (const float*)(ws + WS_LAM);
    const float* const cosT = (const float*)(ws + WS_COS); const float* const sinT = (const float*)(ws + WS_SIN);
    const bf16* const dftC = (const bf16*)(ws + WS_DFTC); const bf16* const dftS = (const bf16*)(ws + WS_DFTS); const float* const TW = (const float*)(ws + WS_TW);
#define MODF(l, s, k) (modf + (size_t)(((l) * 3 + (s)) * 3 + (k)) * DM)

    REP(0) if (PH(0)) p0_prologue(F, in);
    GRID_BAR();
    REP(1) if (PH(1)) p1_modfin(F, in);
    GRID_BAR();
    REP(2) if (PH(2)) norm_phase<false, true>(F, in.p[0], xres, nullptr, HB, nullptr, MODF(0, 0, 0), MODF(0, 0, 1));
    GRID_BAR();

    for (int l = 0; l < DEPTH; ++l) {
        const unsigned char* wl = ws + WS_W + (size_t)l * W_LAYER;
        { pg8::Gemm g{HB, (const bf16*)(wl + W_1IN), SEQ, 2 * FF, DM}; pg8::StaticOrder S; S.init(SEQ, 2 * FF, F.G, (int)blockIdx.x);
          pg8::EpiSwiGLU E{ACT, FF};
          REP(3) if (PH(3)) pg8::gemm_phase<pg8::EpiSwiGLU, pg8::StaticOrder, true, true>(F.lds + RING_OFF, g, S, E); GRID_BAR(); }
        { pg8::Gemm g{ACT, (const bf16*)(wl + W_1OUT), SEQ, DM, FF}; pg8::StaticOrder S; S.init(SEQ, DM, F.G, (int)blockIdx.x);
          pg8::EpiPlain E{YB, DM};
          REP(4) if (PH(4)) pg8::gemm_phase<pg8::EpiPlain, pg8::StaticOrder, true, true>(F.lds + RING_OFF, g, S, E); GRID_BAR(); }
        if (PH(5)) norm_phase<true, true>(F, xres, xres, YB, HB, MODF(l, 0, 2), MODF(l, 1, 0), MODF(l, 1, 1)); GRID_BAR();
        { pg8::Gemm g{HB, (const bf16*)(wl + W_MIX), SEQ, 8192, DM}; pg8::StaticOrder S; S.init(SEQ, 8192, F.G, (int)blockIdx.x);
          pg8::EpiMix E{QB, KB, VB, UB, GB, cosT, sinT, in.p[14] + (size_t)l * 4096};
          REP(6) if (PH(6)) pg8::gemm_phase<pg8::EpiMix, pg8::StaticOrder, true, true>(F.lds + RING_OFF, g, S, E); GRID_BAR(); }
        {
            const int xcd = F.vcu >> 5, j = F.vcu & 31;
            REP(7) if (!PH(7)) {} else if (F.G == 256) {
#pragma unroll 1
                for (int i = 0; i < 4; ++i) { const int vh = 2 * xcd + (i >> 1), qb = (i & 1) * 32 + j;
                    dattn::attn_unit(QB + (size_t)(qb * 256) * 1024 + vh * 64, KB + vh * 64, VB + (vh >> 1) * 128, OB + (size_t)(qb * 256) * 2048 + vh * 128, SEQ, (LAS char*)(F.lds + RING_OFF)); }
            } else {
#pragma unroll 1
                for (int un = F.vcu; un < 1024; un += F.G) { const int vh = un >> 6, qb = un & 63;
                    dattn::attn_unit(QB + (size_t)(qb * 256) * 1024 + vh * 64, KB + vh * 64, VB + (vh >> 1) * 128, OB + (size_t)(qb * 256) * 2048 + vh * 128, SEQ, (LAS char*)(F.lds + RING_OFF)); }
            }
            REP(8) if (PH(8)) fftA_phase(F, UB, TRE, TIM, dftC, dftS, TW);
            GRID_BAR();
        }
        REP(9) if (PH(9)) fftB_phase(F, TRE, TIM, YF, dftC, dftS);
        REP(10) if (PH(10)) combine_phase(F, OB, AO, in.p[10] + (size_t)l * 128, lamv[l], lamv[2 + l]);
        GRID_BAR();
        { pg8::Gemm g{AO, (const bf16*)(wl + W_AP), SEQ, DM, AW}; pg8::StaticOrder S; S.init(SEQ, DM, F.G, (int)blockIdx.x);
          pg8::EpiGate E{GB, nullptr, TT};
          REP(11) if (PH(11)) pg8::gemm_phase<pg8::EpiGate, pg8::StaticOrder, true, true>(F.lds + RING_OFF, g, S, E); GRID_BAR(); }
        { pg8::Gemm g{YF, (const bf16*)(wl + W_FP), SEQ, DM, FW}; pg8::StaticOrder S; S.init(SEQ, DM, F.G, (int)blockIdx.x);
          pg8::EpiGate E{GB + 2048, TT, MG};
          REP(12) if (PH(12)) pg8::gemm_phase<pg8::EpiGate, pg8::StaticOrder, true, true>(F.lds + RING_OFF, g, S, E); GRID_BAR(); }
        { pg8::Gemm g{MG, (const bf16*)(wl + W_MO), SEQ, DM, DM}; pg8::StaticOrder S; S.init(SEQ, DM, F.G, (int)blockIdx.x);
          pg8::EpiPlain E{YB, DM};
          REP(13) if (PH(13)) pg8::gemm_phase<pg8::EpiPlain, pg8::StaticOrder, true, true>(F.lds + RING_OFF, g, S, E); GRID_BAR(); }
        if (PH(14)) norm_phase<true, true>(F, xres, xres, YB, HB, MODF(l, 1, 2), MODF(l, 2, 0), MODF(l, 2, 1)); GRID_BAR();
        { pg8::Gemm g{HB, (const bf16*)(wl + W_2IN), SEQ, 2 * FF, DM}; pg8::StaticOrder S; S.init(SEQ, 2 * FF, F.G, (int)blockIdx.x);
          pg8::EpiSwiGLU E{ACT, FF};
          REP(15) if (PH(15)) pg8::gemm_phase<pg8::EpiSwiGLU, pg8::StaticOrder, true, true>(F.lds + RING_OFF, g, S, E); GRID_BAR(); }
        { pg8::Gemm g{ACT, (const bf16*)(wl + W_2OUT), SEQ, DM, FF}; pg8::StaticOrder S; S.init(SEQ, DM, F.G, (int)blockIdx.x);
          pg8::EpiPlain E{YB, DM};
          REP(16) if (PH(16)) pg8::gemm_phase<pg8::EpiPlain, pg8::StaticOrder, true, true>(F.lds + RING_OFF, g, S, E); GRID_BAR(); }
        if (l + 1 < DEPTH) { if (PH(17)) norm_phase<true, true>(F, xres, xres, YB, HB, MODF(l, 2, 2), MODF(l + 1, 0, 0), MODF(l + 1, 0, 1)); GRID_BAR(); }
        else if (PH(17)) norm_phase<true, false>(F, xres, xres, YB, nullptr, MODF(l, 2, 2), nullptr, nullptr);
    }
    if (blockIdx.x == 0 && F.wave == 0) { VM_WAIT(); if (__hip_atomic_load((gu32*)((unsigned*)(F.ctl + CW_BAR) + XB_TMO), RLX_AGENT) != 0u) { const float q = __builtin_nanf(""); for (int c = F.lane; c < DM; c += 64) xres[c] = q; } }
}

extern "C" void kernel_launch(void* const* d_in, const int* in_sizes, int n_in, void* d_out, int out_size, void* d_ws, size_t ws_size, hipStream_t stream) {
    static int grid = 0;
    if (grid == 0) {
        if (n_in != 18 || in_sizes[0] != SEQ * DM || out_size != SEQ * DM || ws_size < WS_END) { fprintf(stderr, "kernel_launch: unexpected shapes: n_in %d in0 %d out %d ws %zu (need %zu)\n", n_in, n_in > 0 ? in_sizes[0] : -1, out_size, ws_size, (size_t)WS_END); grid = -1; return; }
        int dev = 0, cus = 0, per_cu = 0;
        if (hipGetDevice(&dev) != hipSuccess || hipDeviceGetAttribute(&cus, hipDeviceAttributeMultiprocessorCount, dev) != hipSuccess) { grid = -1; return; }
        if (hipFuncSetAttribute((const void*)enc_fwd, hipFuncAttributeMaxDynamicSharedMemorySize, LDS_BYTES) != hipSuccess) { fprintf(stderr, "kernel_launch: hipFuncSetAttribute failed\n"); grid = -1; return; }
        if (hipOccupancyMaxActiveBlocksPerMultiprocessor(&per_cu, (const void*)enc_fwd, NWAVES * 64, LDS_BYTES) != hipSuccess || per_cu < 1) { fprintf(stderr, "kernel_launch: occupancy query reports %d blocks per CU\n", per_cu); }
        (void)hipGetLastError();
        grid = cus;
    }
    if (grid < 0) return;
#ifdef DBG_ZERO_WS
    if (hipMemsetAsync((char*)d_ws, 0, WS_END, stream) != hipSuccess) return;
#else
    if (hipMemsetAsync((char*)d_ws + WS_CTL, 0, CTL_ZERO_BYTES, stream) != hipSuccess) return;
#endif
    Args a{};
    for (int i = 0; i < 18; ++i) a.in[i] = (const float*)d_in[i];
    a.out = (float*)d_out; a.ws = (unsigned char*)d_ws;
    hipLaunchKernelGGL(enc_fwd, dim3(grid), dim3(NWAVES * 64), LDS_BYTES, stream, a);
    const hipError_t le = hipPeekAtLastError();
    if (le != hipSuccess) fprintf(stderr, "kernel_launch: launch failed: %s\n", hipGetErrorName(le));
}
```

```cpp
#include <hip/hip_runtime.h>
#include <hip/hip_bf16.h>
#include <cstdio>
#include <cstdint>
#include <cmath>
namespace pg8 {
#define PG8_LAS __attribute__((address_space(3)))
typedef unsigned short bf16_t;
typedef short bf16x8 __attribute__((ext_vector_type(8)));
typedef float f32x4 __attribute__((ext_vector_type(4)));
typedef unsigned u32x4 __attribute__((ext_vector_type(4)));
constexpr int BM = 256, BK = 64, HALF = 128, HTB = HALF * BK * 2  , STAGE_BYTES = 8 * HTB, NXCD = 8, WGM = 8;

__host__ __device__ __forceinline__ int lds_byte(int r, int c) { const int st = (r >> 4) * 2 + (c >> 5), rr = r & 15, cc = c & 31, ob = rr * 64 + cc * 2; return st * 1024 + (ob ^ (((ob >> 9) & 1) << 5)); }
__host__ __device__ __forceinline__ void stage_rc(int b, int& R, int& C) { const int st = b / 1024, sb = b % 1024, swz = sb ^ (((sb >> 9) & 1) << 5); R = (st >> 1) * 16 + swz / 64; C = (st & 1) * 32 + (swz % 64) / 2; }
__host__ __device__ __forceinline__ int perm32(int rho) { const int n = rho >> 4, i = rho & 15; return 8 * (i >> 2) + 4 * n + (i & 3); }

struct Unit { int pm, pn; };
struct Gemm { const bf16_t* A; const bf16_t* Bt; int M, N, K; };

struct StaticOrder {
    int nM, nN, nwg, G, c;
    __host__ __device__ void init(int M, int N, int G_, int c_) { nM = M / BM; nN = N / BM; nwg = nM * nN; G = G_; c = c_; }
    __host__ __device__ bool next(int i, Unit& u) const {
        const long L = (long)i * G + c; if (L >= nwg) return false;
        int wgid = (int)L; { const int q = nwg / NXCD, r = nwg % NXCD, xcd = wgid % NXCD, off = wgid / NXCD; wgid = (xcd < r ? xcd * (q + 1) : r * (q + 1) + (xcd - r) * q) + off; }
        const int nig = WGM * nN, gid = wgid / nig, fm = gid * WGM, gsz = (nM - fm) < WGM ? (nM - fm) : WGM;
        u.pm = fm + ((wgid % nig) % gsz); u.pn = (wgid % nig) / gsz; return true;
    }
    __device__ __forceinline__ void a_ready(const Unit&) const {}
    __device__ __forceinline__ void done(const Unit&) const {}
};

typedef float cvt_f32x2 __attribute__((ext_vector_type(2))); typedef __bf16 cvt_bf16x2 __attribute__((ext_vector_type(2)));
__device__ __forceinline__ unsigned cvt_pk_bf16(float lo, float hi) { const cvt_f32x2 v = {lo, hi}; return __builtin_bit_cast(unsigned, __builtin_convertvector(v, cvt_bf16x2)); }
typedef float f32x2 __attribute__((ext_vector_type(2)));
__device__ __forceinline__ float bf_lo(unsigned w) { return __builtin_bit_cast(float, w << 16); }
__device__ __forceinline__ float bf_hi(unsigned w) { return __builtin_bit_cast(float, w & 0xffff0000u); }
__device__ __forceinline__ float sigmoid_f(float v) { return __builtin_amdgcn_rcpf(1.0f + __builtin_amdgcn_exp2f(v * -1.4426950408889634f)); }
__device__ __forceinline__ u32x4 pack8(const f32x4 a, const f32x4 b) { u32x4 w; w.x = cvt_pk_bf16(a[0], a[1]); w.y = cvt_pk_bf16(a[2], a[3]); w.z = cvt_pk_bf16(b[0], b[1]); w.w = cvt_pk_bf16(b[2], b[3]); return w; }

struct EpiPlain {
    static constexpr bool PERM = true, AFTER_DRAIN = false;
    bf16_t* O; int ldc;
    __device__ __forceinline__ void operator()(const f32x4 (&acc)[2][2][4][2], const Unit& u, int wr, int wc, int fr, int fq) const {
        const int row0 = u.pm * BM + wr * 64 + fr, col0 = u.pn * BM + wc * 32 + 8 * fq;
#pragma unroll
        for (int ai = 0; ai < 2; ++ai)
#pragma unroll
            for (int m = 0; m < 4; ++m) { bf16_t* rowp = O + (size_t)(row0 + ai * HALF + m * 16) * ldc + col0;
#pragma unroll
                for (int bj = 0; bj < 2; ++bj) *(u32x4*)(rowp + bj * HALF) = pack8(acc[ai][bj][m][0], acc[ai][bj][m][1]); }
    }
};
struct EpiSwiGLU {
    static constexpr bool PERM = true, AFTER_DRAIN = false;
    bf16_t* O; int ldc;
    __device__ __forceinline__ void operator()(const f32x4 (&acc)[2][2][4][2], const Unit& u, int wr, int wc, int fr, int fq) const {
        const int row0 = u.pm * BM + wr * 64 + fr, col0 = u.pn * HALF + wc * 32 + 8 * fq;
#pragma unroll
        for (int ai = 0; ai < 2; ++ai)
#pragma unroll
            for (int m = 0; m < 4; ++m) { bf16_t* rowp = O + (size_t)(row0 + ai * HALF + m * 16) * ldc + col0;
                f32x4 o[2];
#pragma unroll
                for (int n = 0; n < 2; ++n) { const f32x4 g = acc[ai][0][m][n], up = acc[ai][1][m][n];
#pragma unroll
                    for (int e = 0; e < 4; ++e) o[n][e] = g[e] * sigmoid_f(g[e]) * up[e]; }
                *(u32x4*)rowp = pack8(o[0], o[1]); }
    }
};
struct EpiMix {
    static constexpr bool PERM = true, AFTER_DRAIN = false;
    bf16_t *Q, *K, *V, *U, *G; const float* cosT; const float* sinT; const float* gbias;
    __device__ __forceinline__ void operator()(const f32x4 (&acc)[2][2][4][2], const Unit& u, int wr, int wc, int fr, int fq) const {
        const int pn = u.pn, row0 = u.pm * BM + wr * 64 + fr;
        if (pn < 8) {
            bf16_t* base = (pn < 4 ? Q : K) + ((pn & 3) * 4 + wc) * 64 + 8 * fq;
            const float qs = pn < 4 ? 0.18033688011112042f : 1.0f;
#pragma unroll
            for (int ai = 0; ai < 2; ++ai)
#pragma unroll
                for (int m = 0; m < 4; ++m) { const int row = row0 + ai * HALF + m * 16;
                    const f32x4 c0 = *(const f32x4*)(cosT + (size_t)row * 32 + 8 * fq), c1 = *(const f32x4*)(cosT + (size_t)row * 32 + 8 * fq + 4);
                    const f32x4 s0 = *(const f32x4*)(sinT + (size_t)row * 32 + 8 * fq), s1 = *(const f32x4*)(sinT + (size_t)row * 32 + 8 * fq + 4);
                    const f32x4 x1a = acc[ai][0][m][0], x1b = acc[ai][0][m][1], x2a = acc[ai][1][m][0], x2b = acc[ai][1][m][1];
                    const f32x4 o1a = (x1a * c0 - x2a * s0) * qs, o1b = (x1b * c1 - x2b * s1) * qs, o2a = (x2a * c0 + x1a * s0) * qs, o2b = (x2b * c1 + x1b * s1) * qs;
                    bf16_t* rowp = base + (size_t)row * 1024;
                    *(u32x4*)rowp = pack8(o1a, o1b); *(u32x4*)(rowp + 32) = pack8(o2a, o2b); }
        } else if (pn < 16) {
            bf16_t* base = (pn < 12 ? V : U) + (pn & 3) * BM + wc * 32 + 8 * fq;
#pragma unroll
            for (int ai = 0; ai < 2; ++ai)
#pragma unroll
                for (int m = 0; m < 4; ++m) { bf16_t* rowp = base + (size_t)(row0 + ai * HALF + m * 16) * 1024;
#pragma unroll
                    for (int bj = 0; bj < 2; ++bj) *(u32x4*)(rowp + bj * HALF) = pack8(acc[ai][bj][m][0], acc[ai][bj][m][1]); }
        } else {
            const int col0 = (pn - 16) * BM + wc * 32 + 8 * fq;
            f32x4 bv[2][2];
#pragma unroll
            for (int bj = 0; bj < 2; ++bj)
#pragma unroll
                for (int n = 0; n < 2; ++n) bv[bj][n] = *(const f32x4*)(gbias + col0 + bj * HALF + 4 * n);
#pragma unroll
            for (int ai = 0; ai < 2; ++ai)
#pragma unroll
                for (int m = 0; m < 4; ++m) { bf16_t* rowp = G + (size_t)(row0 + ai * HALF + m * 16) * 4096 + col0;
#pragma unroll
                    for (int bj = 0; bj < 2; ++bj) { f32x4 o[2];
#pragma unroll
                        for (int n = 0; n < 2; ++n) { const f32x4 v = acc[ai][bj][m][n] + bv[bj][n];
#pragma unroll
                            for (int e = 0; e < 4; ++e) o[n][e] = sigmoid_f(v[e]); }
                        *(u32x4*)(rowp + bj * HALF) = pack8(o[0], o[1]); } }
        }
    }
};
struct EpiGate {
    static constexpr bool PERM = true, AFTER_DRAIN = false;
    const bf16_t* gate; const bf16_t* addend; bf16_t* O;
    __device__ __forceinline__ void operator()(const f32x4 (&acc)[2][2][4][2], const Unit& u, int wr, int wc, int fr, int fq) const {
        const int row0 = u.pm * BM + wr * 64 + fr, col0 = u.pn * BM + wc * 32 + 8 * fq;
#pragma unroll
        for (int ai = 0; ai < 2; ++ai)
#pragma unroll
            for (int m = 0; m < 4; ++m) { const size_t row = (size_t)(row0 + ai * HALF + m * 16);
#pragma unroll
                for (int bj = 0; bj < 2; ++bj) { const u32x4 gw = *(const u32x4*)(gate + row * 4096 + col0 + bj * HALF);
                    f32x4 a = acc[ai][bj][m][0], b = acc[ai][bj][m][1];
                    a[0] *= bf_lo(gw.x); a[1] *= bf_hi(gw.x); a[2] *= bf_lo(gw.y); a[3] *= bf_hi(gw.y); b[0] *= bf_lo(gw.z); b[1] *= bf_hi(gw.z); b[2] *= bf_lo(gw.w); b[3] *= bf_hi(gw.w);
                    if (addend) { const u32x4 tw = *(const u32x4*)(addend + row * 2048 + col0 + bj * HALF);
                        a[0] += bf_lo(tw.x); a[1] += bf_hi(tw.x); a[2] += bf_lo(tw.y); a[3] += bf_hi(tw.y); b[0] += bf_lo(tw.z); b[1] += bf_hi(tw.z); b[2] += bf_lo(tw.w); b[3] += bf_hi(tw.w); }
                    *(u32x4*)(O + row * 2048 + col0 + bj * HALF) = pack8(a, b); } }
    }
};

template <class Epi, class Sched, bool ALIGN_EPI = false, bool SP2 = false>
__device__ __forceinline__ void gemm_phase(PG8_LAS unsigned char* lds, const Gemm g, const Sched& S, const Epi& E) {
    int tid = threadIdx.x; asm volatile("" : "+v"(tid));
    const int wid = __builtin_amdgcn_readfirstlane(tid >> 6), lane = tid & 63, wr = wid >> 2, wc = wid & 3, fr = lane & 15, fq = lane >> 4;
    const int K = g.K, nt = K / BK;
    unsigned voffA[2], voffB[2];
#pragma unroll
    for (int i = 0; i < 2; ++i) { int R, C; stage_rc(tid * 16 + i * 8192, R, C); const int Rb = Epi::PERM ? ((R & ~31) + perm32(R & 31)) : R;
        voffA[i] = (unsigned)(R * K + C) * 2u; voffB[i] = (unsigned)(Rb * K + C) * 2u; }
    const size_t kstep = (size_t)(BK * 2);
    const size_t hstep = (size_t)HALF * K * 2;
    const size_t tstep = 2 * hstep;
    const unsigned ldsw = (unsigned)wid * 1024u;
    const int aoff = lds_byte(wr * 64 + fr, fq * 8), boff = lds_byte(wc * 32 + fr, fq * 8);
#define PG8_SA(b, h) (((b) * 2 + (h)) * HTB)
#define PG8_SB(b, h) ((4 + (b) * 2 + (h)) * HTB)
#define PG8_STAGE(bufoff, gbase, voff) do { _Pragma("unroll") for (int _i = 0; _i < 2; ++_i) \
        __builtin_amdgcn_global_load_lds((const unsigned*)((const char*)(gbase) + (voff)[_i]), (PG8_LAS unsigned*)(lds + (bufoff) + ldsw + _i * 8192), 16, 0, 0); } while (0)
#define PG8_LDA(dst, b, h) do { _Pragma("unroll") for (int m = 0; m < 4; ++m) _Pragma("unroll") for (int k = 0; k < 2; ++k) dst[m][k] = *(const PG8_LAS bf16x8*)(lds + PG8_SA(b, h) + aoff + m * 2048 + k * 1024); } while (0)
#define PG8_LDB(dst, b, h) do { _Pragma("unroll") for (int n = 0; n < 2; ++n) _Pragma("unroll") for (int k = 0; k < 2; ++k) dst[n][k] = *(const PG8_LAS bf16x8*)(lds + PG8_SB(b, h) + boff + n * 2048 + k * 1024); } while (0)
#define PG8_MMA(ai, bj, At, Bt) do { __builtin_amdgcn_s_setprio(1); _Pragma("unroll") for (int m = 0; m < 4; ++m) _Pragma("unroll") for (int n = 0; n < 2; ++n) _Pragma("unroll") for (int k = 0; k < 2; ++k) \
        acc[ai][bj][m][n] = __builtin_amdgcn_mfma_f32_16x16x32_bf16(Bt[n][k], At[m][k], acc[ai][bj][m][n], 0, 0, 0); __builtin_amdgcn_s_setprio(0); } while (0)
#define PG8_WAIT_V(n) asm volatile("s_waitcnt vmcnt(" #n ")" ::: "memory")
#define PG8_WAIT_L(n) asm volatile("s_waitcnt lgkmcnt(" #n ")" ::: "memory")
#define PG8_BAR __builtin_amdgcn_s_barrier()
#define PG8_SCHED __builtin_amdgcn_sched_barrier(0)
    Unit cur, nxt; int ui = 0;
    if (!S.next(0, cur)) return;
    f32x4 acc[2][2][4][2];
#pragma unroll
    for (int a = 0; a < 2; ++a)
#pragma unroll
        for (int b = 0; b < 2; ++b)
#pragma unroll
            for (int m = 0; m < 4; ++m)
#pragma unroll
                for (int n = 0; n < 2; ++n) acc[a][b][m][n] = (f32x4){0.f, 0.f, 0.f, 0.f};
    bf16x8 At[4][2], B0[2][2], B1[2][2];
    const char* cA = (const char*)g.A + (size_t)cur.pm * tstep; const char* cB = (const char*)g.Bt + (size_t)cur.pn * tstep;
    S.a_ready(cur);
    if constexpr (SP2) {
        PG8_STAGE(PG8_SB(0, 0), cB, voffB); PG8_STAGE(PG8_SB(0, 1), cB + hstep, voffB); PG8_STAGE(PG8_SA(0, 0), cA, voffA); PG8_STAGE(PG8_SA(0, 1), cA + hstep, voffA);
        if (wr == 1) PG8_BAR;
        PG8_WAIT_V(2); PG8_BAR;
        PG8_STAGE(PG8_SB(1, 0), cB + kstep, voffB); PG8_STAGE(PG8_SA(1, 0), cA + kstep, voffA); PG8_STAGE(PG8_SB(1, 1), cB + hstep + kstep, voffB);
        PG8_WAIT_V(6); PG8_BAR;
    } else {
        PG8_STAGE(PG8_SB(0, 0), cB, voffB); PG8_STAGE(PG8_SA(0, 0), cA, voffA); PG8_STAGE(PG8_SB(0, 1), cB + hstep, voffB); PG8_STAGE(PG8_SA(0, 1), cA + hstep, voffA);
        if (wr == 1) PG8_BAR;
        PG8_WAIT_V(4); PG8_BAR;
        PG8_STAGE(PG8_SB(1, 0), cB + kstep, voffB); PG8_STAGE(PG8_SA(1, 0), cA + kstep, voffA); PG8_STAGE(PG8_SB(1, 1), cB + hstep + kstep, voffB);
        PG8_WAIT_V(6); PG8_BAR;
    }
    for (;;) {
        const bool has_next = S.next(ui + 1, nxt);
        const char* nA = has_next ? (const char*)g.A + (size_t)nxt.pm * tstep : cA; const char* nB = has_next ? (const char*)g.Bt + (size_t)nxt.pn * tstep : cB;
        for (int t = 0; t < nt; t += 2) {
            const bool last = (t == nt - 2);
            const char* a1 = cA + (size_t)(t + 1) * kstep;
            const char* a2 = last ? nA : cA + (size_t)(t + 2) * kstep; const char* b2 = last ? nB : cB + (size_t)(t + 2) * kstep;
            const char* a3 = a2 + kstep; const char* b3 = b2 + kstep;
            if (last && has_next) S.a_ready(nxt);
            if constexpr (SP2) {
            PG8_LDB(B0, 0, 0); PG8_LDB(B1, 0, 1); PG8_SCHED; PG8_LDA(At, 0, 0); PG8_STAGE(PG8_SA(1, 1), a1 + hstep, voffA);
            PG8_WAIT_V(8); PG8_WAIT_L(0); PG8_BAR; PG8_MMA(0, 0, At, B0); PG8_MMA(0, 1, At, B1); PG8_BAR; PG8_SCHED;
            PG8_LDA(At, 0, 1); PG8_STAGE(PG8_SB(0, 0), b2, voffB); PG8_STAGE(PG8_SB(0, 1), b2 + hstep, voffB); PG8_STAGE(PG8_SA(0, 0), a2, voffA);
            PG8_WAIT_V(8); PG8_WAIT_L(0); PG8_BAR; PG8_MMA(1, 0, At, B0); PG8_MMA(1, 1, At, B1); PG8_BAR; PG8_SCHED;
            PG8_LDB(B0, 1, 0); PG8_LDB(B1, 1, 1); PG8_SCHED; PG8_LDA(At, 1, 0); PG8_STAGE(PG8_SA(0, 1), a2 + hstep, voffA);
            PG8_WAIT_V(8); PG8_WAIT_L(0); PG8_BAR; PG8_MMA(0, 0, At, B0); PG8_MMA(0, 1, At, B1); PG8_BAR; PG8_SCHED;
            PG8_LDA(At, 1, 1); PG8_STAGE(PG8_SB(1, 0), b3, voffB); PG8_STAGE(PG8_SB(1, 1), b3 + hstep, voffB); PG8_STAGE(PG8_SA(1, 0), a3, voffA);
            PG8_WAIT_V(8); PG8_WAIT_L(0); PG8_BAR; PG8_MMA(1, 0, At, B0); PG8_MMA(1, 1, At, B1); PG8_BAR; PG8_SCHED;
            } else {
            PG8_LDB(B0, 0, 0); PG8_SCHED; PG8_LDA(At, 0, 0); PG8_STAGE(PG8_SA(1, 1), a1 + hstep, voffA);
            PG8_WAIT_L(8); PG8_BAR; PG8_WAIT_L(0); PG8_MMA(0, 0, At, B0); PG8_BAR; PG8_SCHED;
            PG8_LDB(B1, 0, 1); PG8_STAGE(PG8_SB(0, 0), b2, voffB);
            PG8_BAR; PG8_WAIT_L(0); PG8_MMA(0, 1, At, B1); PG8_BAR;
            PG8_LDA(At, 0, 1); PG8_STAGE(PG8_SA(0, 0), a2, voffA);
            PG8_BAR; PG8_WAIT_L(0); PG8_MMA(1, 0, At, B0); PG8_BAR; PG8_SCHED;
            PG8_STAGE(PG8_SB(0, 1), b2 + hstep, voffB);
            PG8_WAIT_V(6); PG8_BAR; PG8_MMA(1, 1, At, B1); PG8_BAR;
            PG8_LDB(B0, 1, 0); PG8_SCHED; PG8_LDA(At, 1, 0); PG8_STAGE(PG8_SA(0, 1), a2 + hstep, voffA);
            PG8_WAIT_L(8); PG8_BAR; PG8_WAIT_L(0); PG8_MMA(0, 0, At, B0); PG8_BAR; PG8_SCHED;
            PG8_LDB(B1, 1, 1); PG8_STAGE(PG8_SB(1, 0), b3, voffB);
            PG8_BAR; PG8_WAIT_L(0); PG8_MMA(0, 1, At, B1); PG8_BAR;
            PG8_LDA(At, 1, 1); PG8_STAGE(PG8_SA(1, 0), a3, voffA);
            PG8_BAR; PG8_WAIT_L(0); PG8_MMA(1, 0, At, B0); PG8_BAR; PG8_SCHED;
            PG8_STAGE(PG8_SB(1, 1), b3 + hstep, voffB);
            PG8_WAIT_V(6); PG8_BAR; PG8_MMA(1, 1, At, B1); PG8_BAR;
            }
        }
        if constexpr (ALIGN_EPI) { if (wr == 0) PG8_BAR; }
        if constexpr (!Epi::AFTER_DRAIN) { E(acc, cur, wr, wc, fr, fq); S.done(cur); }
        if (!has_next) break;
#pragma unroll
        for (int a = 0; a < 2; ++a)
#pragma unroll
            for (int b = 0; b < 2; ++b)
#pragma unroll
                for (int m = 0; m < 4; ++m)
#pragma unroll
                    for (int n = 0; n < 2; ++n) acc[a][b][m][n] = (f32x4){0.f, 0.f, 0.f, 0.f};
        cur = nxt; cA = nA; cB = nB; ++ui;
        if constexpr (ALIGN_EPI) { if (wr == 1) PG8_BAR; }
    }
    PG8_WAIT_V(0);
    if constexpr (!ALIGN_EPI) { if (wr == 0) PG8_BAR; }
    PG8_BAR;
    if constexpr (Epi::AFTER_DRAIN) { E.fused(acc, cur, wr, wc, fr, fq, lds, wid, lane); S.done(cur); }
#undef PG8_SA
#undef PG8_SB
#undef PG8_STAGE
#undef PG8_LDA
#undef PG8_LDB
#undef PG8_MMA
#undef PG8_WAIT_V
#undef PG8_WAIT_L
#undef PG8_BAR
#undef PG8_SCHED
}
}
namespace dattn {
#define DA_LAS __attribute__((address_space(3)))
typedef unsigned short bf16_t;
using bf16x8 = __attribute__((ext_vector_type(8))) short;
using s16x4  = __attribute__((ext_vector_type(4))) short;
using f32x16 = __attribute__((ext_vector_type(16))) float;
using u32x4  = __attribute__((ext_vector_type(4))) unsigned;
constexpr int NW = 8, QBLK = 32, KVBLK = 64, PITCH = 1024, LDO = 2048;
constexpr float SCALE = 0.125f;
constexpr float THR = 8.f;
constexpr int SHM_V = KVBLK * 128 * 2, SHM_K = KVBLK * 64 * 2;
constexpr int NSLOT = 3, OFF_V = 0, OFF_K = NSLOT * SHM_V, OFF_WS = NSLOT * (SHM_V + SHM_K), LDS_BYTES = OFF_WS + NW * 64 * 4;
#define DA_KSWZ(row, colB) ((row) * 128 + ((colB) ^ ((((row) >> 1) & 7) << 4)))
#define DA_SBAR() __builtin_amdgcn_sched_barrier(0)
__device__ __forceinline__ int crow(int r, int hi) { return (r & 3) + 8 * (r >> 2) + 4 * hi; }
typedef float cvt_f32x2 __attribute__((ext_vector_type(2))); typedef __bf16 cvt_bf16x2 __attribute__((ext_vector_type(2)));
__device__ __forceinline__ unsigned cvtpk(float lo, float hi) { const cvt_f32x2 v = {lo, hi}; return __builtin_bit_cast(unsigned, __builtin_convertvector(v, cvt_bf16x2)); }
constexpr float THR2 = THR * 1.4426950408889634f;
__device__ __forceinline__ void softmax_tile(f32x16& p0, f32x16& p1, float& mhat, bool first, float& alpha, float& l_reg, bf16x8& pa0, bf16x8& pa1, bf16x8& pa2, bf16x8& pa3) {
  float pmax = fmaxf(p0[0], p0[1]);
#pragma unroll
  for (int r = 2; r < 16; ++r) pmax = fmaxf(pmax, p0[r]);
#pragma unroll
  for (int r = 0; r < 16; ++r) pmax = fmaxf(pmax, p1[r]);
  { auto rr = __builtin_amdgcn_permlane32_swap(__float_as_uint(pmax), __float_as_uint(pmax), false, false);
    pmax = fmaxf(__uint_as_float(rr[0]), __uint_as_float(rr[1])); }
  alpha = 1.f;
  if (first || __builtin_expect(__any(pmax > THR2), 0)) {
    const float dl = first ? pmax : fmaxf(pmax, 0.f);
    mhat += dl;
#pragma unroll
    for (int r = 0; r < 16; ++r) { p0[r] -= dl; p1[r] -= dl; }
    alpha = first ? 1.f : __builtin_amdgcn_exp2f(-dl);
  }
#pragma unroll
  for (int r = 0; r < 16; ++r) p0[r] = __builtin_amdgcn_exp2f(p0[r]);
#pragma unroll
  for (int r = 0; r < 16; ++r) p1[r] = __builtin_amdgcn_exp2f(p1[r]);
  { float ps = (p0[0] + p0[1]) + (p1[0] + p1[1]);
#pragma unroll
    for (int r = 2; r < 16; r += 2) ps += (p0[r] + p0[r + 1]) + (p1[r] + p1[r + 1]);
    l_reg = l_reg * alpha + ps; }
#define DA_PK4(P, BASE, OUT) do { unsigned a0 = cvtpk(P[BASE + 0], P[BASE + 1]), a1 = cvtpk(P[BASE + 2], P[BASE + 3]);   \
    unsigned b0 = cvtpk(P[BASE + 4], P[BASE + 5]), b1 = cvtpk(P[BASE + 6], P[BASE + 7]);                              \
    auto r0 = __builtin_amdgcn_permlane32_swap(a0, b0, false, false); auto r1 = __builtin_amdgcn_permlane32_swap(a1, b1, false, false); \
    u32x4 w = {r0[0], r1[0], r0[1], r1[1]}; OUT = __builtin_bit_cast(bf16x8, w); } while (0)
  DA_PK4(p0, 0, pa0); DA_PK4(p0, 8, pa1); DA_PK4(p1, 0, pa2); DA_PK4(p1, 8, pa3);
  { const float nm = -mhat;
#pragma unroll
    for (int r = 0; r < 16; ++r) { p0[r] = nm; p1[r] = nm; } }
}
__device__ __forceinline__ void glds16(const void* gsrc, unsigned lds_dst) { unsigned keep;
  asm volatile("s_mov_b32 %0, m0\n\ts_mov_b32 m0, %2\n\ts_nop 0\n\tglobal_load_lds_dwordx4 %1, off\n\ts_mov_b32 m0, %0" : "=&s"(keep) : "v"(gsrc), "s"(lds_dst) : "memory"); }
#define DA_WAIT_BAR(N) do { __builtin_amdgcn_sched_barrier(0); asm volatile("s_waitcnt vmcnt(" #N ") lgkmcnt(0)\n\ts_barrier" ::: "memory"); __builtin_amdgcn_sched_barrier(0); } while (0)
__device__ __forceinline__ void qkt(f32x16& p0, f32x16& p1, const DA_LAS char* Ks, const bf16x8* qr, const f32x16& negm, int r32, int hi) {
#pragma unroll
  for (int d0 = 0; d0 < 4; ++d0) { const int cb = d0 * 32 + hi * 16;
    const bf16x8 b0 = *(const DA_LAS bf16x8*)(Ks + DA_KSWZ(r32, cb));
    const bf16x8 b1 = *(const DA_LAS bf16x8*)(Ks + DA_KSWZ(32 + r32, cb));
    p0 = __builtin_amdgcn_mfma_f32_32x32x16_bf16(b0, qr[d0], d0 == 0 ? negm : p0, 0, 0, 0);
    p1 = __builtin_amdgcn_mfma_f32_32x32x16_bf16(b1, qr[d0], d0 == 0 ? negm : p1, 0, 0, 0); }
}
__device__ __forceinline__ int v_st(int k, int c) { const int kk = (k & ~0xC) | ((k & 4) << 1) | ((k & 8) >> 1); return ((kk >> 3) * 4 + (c >> 5)) * 512 + ((kk & 7) * 32 + (c & 31)) * 2; }
__device__ __forceinline__ int v_rd_base(int lane) { return ((lane & 3) << 3) | (((lane >> 2) & 3) << 6) | (((lane >> 4) & 1) << 5) | (((lane >> 5) & 1) << 8); }
constexpr int v_rd_off(int d0, int ks, int half) { return d0 * 512 + ks * 4096 + half * 2048; }
template <int OFF> __device__ __forceinline__ s16x4 tr_read(int vb) {
  s16x4 r; asm volatile("ds_read_b64_tr_b16 %0, %1 offset:%2" : "=&v"(r) : "v"(vb), "i"(OFF) : "memory"); return r;
}
#define DA_PK(L, H) (bf16x8){L[0], L[1], L[2], L[3], H[0], H[1], H[2], H[3]}
template <int D0> __device__ __forceinline__ void pv_one(f32x16& od, int vb, bf16x8 pa0, bf16x8 pa1, bf16x8 pa2, bf16x8 pa3) {
  const s16x4 l0 = tr_read<v_rd_off(D0, 0, 0)>(vb), h0 = tr_read<v_rd_off(D0, 0, 1)>(vb), l1 = tr_read<v_rd_off(D0, 1, 0)>(vb), h1 = tr_read<v_rd_off(D0, 1, 1)>(vb);
  const s16x4 l2 = tr_read<v_rd_off(D0, 2, 0)>(vb), h2 = tr_read<v_rd_off(D0, 2, 1)>(vb), l3 = tr_read<v_rd_off(D0, 3, 0)>(vb), h3 = tr_read<v_rd_off(D0, 3, 1)>(vb);
  asm volatile("s_waitcnt lgkmcnt(0)" ::: "memory"); DA_SBAR();
  od = __builtin_amdgcn_mfma_f32_32x32x16_bf16(pa0, DA_PK(l0, h0), od, 0, 0, 0);
  od = __builtin_amdgcn_mfma_f32_32x32x16_bf16(pa1, DA_PK(l1, h1), od, 0, 0, 0);
  od = __builtin_amdgcn_mfma_f32_32x32x16_bf16(pa2, DA_PK(l2, h2), od, 0, 0, 0);
  od = __builtin_amdgcn_mfma_f32_32x32x16_bf16(pa3, DA_PK(l3, h3), od, 0, 0, 0);
}
__device__ __forceinline__ void pv_d0(f32x16* o, int vb, bf16x8 pa0, bf16x8 pa1, bf16x8 pa2, bf16x8 pa3) {
  pv_one<0>(o[0], vb, pa0, pa1, pa2, pa3); pv_one<1>(o[1], vb, pa0, pa1, pa2, pa3);
  { const bf16x8 ones = {0x3F80, 0x3F80, 0x3F80, 0x3F80, 0x3F80, 0x3F80, 0x3F80, 0x3F80};
    o[4] = __builtin_amdgcn_mfma_f32_32x32x16_bf16(pa0, ones, o[4], 0, 0, 0); o[4] = __builtin_amdgcn_mfma_f32_32x32x16_bf16(pa1, ones, o[4], 0, 0, 0);
    o[4] = __builtin_amdgcn_mfma_f32_32x32x16_bf16(pa2, ones, o[4], 0, 0, 0); o[4] = __builtin_amdgcn_mfma_f32_32x32x16_bf16(pa3, ones, o[4], 0, 0, 0); }
  pv_one<2>(o[2], vb, pa0, pa1, pa2, pa3); pv_one<3>(o[3], vb, pa0, pa1, pa2, pa3);
}
template <int KS> __device__ __forceinline__ void ld_vfr(s16x4 (&l)[4], s16x4 (&h)[4], int vb) {
  l[0] = tr_read<v_rd_off(0, KS, 0)>(vb); h[0] = tr_read<v_rd_off(0, KS, 1)>(vb); l[1] = tr_read<v_rd_off(1, KS, 0)>(vb); h[1] = tr_read<v_rd_off(1, KS, 1)>(vb);
  l[2] = tr_read<v_rd_off(2, KS, 0)>(vb); h[2] = tr_read<v_rd_off(2, KS, 1)>(vb); l[3] = tr_read<v_rd_off(3, KS, 0)>(vb); h[3] = tr_read<v_rd_off(3, KS, 1)>(vb);
}
__device__ __forceinline__ void mma_vchunk(f32x16* o, const s16x4 (&l)[4], const s16x4 (&h)[4], bf16x8 pa) {
  o[0] = __builtin_amdgcn_mfma_f32_32x32x16_bf16(pa, DA_PK(l[0], h[0]), o[0], 0, 0, 0); o[1] = __builtin_amdgcn_mfma_f32_32x32x16_bf16(pa, DA_PK(l[1], h[1]), o[1], 0, 0, 0);
  o[2] = __builtin_amdgcn_mfma_f32_32x32x16_bf16(pa, DA_PK(l[2], h[2]), o[2], 0, 0, 0); o[3] = __builtin_amdgcn_mfma_f32_32x32x16_bf16(pa, DA_PK(l[3], h[3]), o[3], 0, 0, 0);
}
#define DA_LGKM(N) do { asm volatile("s_waitcnt lgkmcnt(" #N ")" ::: "memory"); DA_SBAR(); } while (0)
template <bool HAS_QK, bool HAS_PV>
__device__ __forceinline__ void m_segment(f32x16& p0, f32x16& p1, const DA_LAS char* Ks, const bf16x8* qr, const f32x16& negm, f32x16* o, int vb, bf16x8 pa0, bf16x8 pa1, bf16x8 pa2, bf16x8 pa3, int r32, int hi) {
  bf16x8 kf0[4], kf1[4]; s16x4 la[4], ha[4], lb[4], hb[4];
  __builtin_amdgcn_s_setprio(2);
  if (HAS_QK) {
#pragma unroll
    for (int d0 = 0; d0 < 4; ++d0) { const int cb = d0 * 32 + hi * 16; kf0[d0] = *(const DA_LAS bf16x8*)(Ks + DA_KSWZ(r32, cb)); kf1[d0] = *(const DA_LAS bf16x8*)(Ks + DA_KSWZ(32 + r32, cb)); }
    DA_SBAR();
  }
  if (HAS_QK) {
    DA_LGKM(0);
#pragma unroll
    for (int d0 = 0; d0 < 2; ++d0) { p0 = __builtin_amdgcn_mfma_f32_32x32x16_bf16(kf0[d0], qr[d0], d0 == 0 ? negm : p0, 0, 0, 0); p1 = __builtin_amdgcn_mfma_f32_32x32x16_bf16(kf1[d0], qr[d0], d0 == 0 ? negm : p1, 0, 0, 0); }
    DA_SBAR();
  }
  if (HAS_PV) ld_vfr<0>(la, ha, vb);
  if (HAS_QK) {
#pragma unroll
    for (int d0 = 2; d0 < 4; ++d0) { p0 = __builtin_amdgcn_mfma_f32_32x32x16_bf16(kf0[d0], qr[d0], p0, 0, 0, 0); p1 = __builtin_amdgcn_mfma_f32_32x32x16_bf16(kf1[d0], qr[d0], p1, 0, 0, 0); }
  }
  if (HAS_PV) {
    DA_SBAR(); ld_vfr<1>(lb, hb, vb); DA_LGKM(8); mma_vchunk(o, la, ha, pa0); DA_SBAR();
    ld_vfr<2>(la, ha, vb); DA_LGKM(8); mma_vchunk(o, lb, hb, pa1); DA_SBAR();
    ld_vfr<3>(lb, hb, vb); DA_LGKM(8); mma_vchunk(o, la, ha, pa2); DA_SBAR();
    DA_LGKM(0); mma_vchunk(o, lb, hb, pa3);
  }
  __builtin_amdgcn_s_setprio(0);
}
struct Pre { bf16x8 kf0[2], kf1[2]; };
template <int OFF> __device__ __forceinline__ bf16x8 lds_rd128(int a) { bf16x8 r; asm volatile("ds_read_b128 %0, %1 offset:%2" : "=&v"(r) : "v"(a), "i"(OFF) : "memory"); return r; }
__device__ __forceinline__ void prefetch_k(Pre& P, int kbase, int r32, int hi) {
  const int sw = ((r32 >> 1) & 7) << 4, a0 = kbase + r32 * 128 + ((hi * 16) ^ sw), a1 = kbase + r32 * 128 + ((32 + hi * 16) ^ sw);
  P.kf0[0] = lds_rd128<0>(a0); P.kf1[0] = lds_rd128<4096>(a0); P.kf0[1] = lds_rd128<0>(a1); P.kf1[1] = lds_rd128<4096>(a1);
}
template <bool HAS_QK, bool HAS_PV>
__device__ __forceinline__ void m_segment2(f32x16& p0, f32x16& p1, Pre& P, int kbase, const bf16x8* qr, f32x16* o, int vb, bf16x8 pa0, bf16x8 pa1, bf16x8 pa2, bf16x8 pa3, int r32, int hi) {
  s16x4 l0[4], h0[4], l1[4], h1[4], l2[4], h2[4], l3[4], h3[4]; bf16x8 k20, k21, k30, k31;
  __builtin_amdgcn_s_setprio(2);
  if (HAS_QK) { const int sw = ((r32 >> 1) & 7) << 4, a2 = kbase + r32 * 128 + ((64 + hi * 16) ^ sw), a3 = kbase + r32 * 128 + ((96 + hi * 16) ^ sw);
    k20 = lds_rd128<0>(a2); k21 = lds_rd128<4096>(a2); k30 = lds_rd128<0>(a3); k31 = lds_rd128<4096>(a3); }
  if (HAS_PV) ld_vfr<0>(l0, h0, vb);
  if (HAS_QK) {
    DA_SBAR();
    p0 = __builtin_amdgcn_mfma_f32_32x32x16_bf16(P.kf0[0], qr[0], p0, 0, 0, 0); p1 = __builtin_amdgcn_mfma_f32_32x32x16_bf16(P.kf1[0], qr[0], p1, 0, 0, 0);
    p0 = __builtin_amdgcn_mfma_f32_32x32x16_bf16(P.kf0[1], qr[1], p0, 0, 0, 0); p1 = __builtin_amdgcn_mfma_f32_32x32x16_bf16(P.kf1[1], qr[1], p1, 0, 0, 0);
    DA_SBAR();
    if (HAS_PV) { DA_LGKM(8); ld_vfr<1>(l1, h1, vb); } else DA_LGKM(0);
    p0 = __builtin_amdgcn_mfma_f32_32x32x16_bf16(k20, qr[2], p0, 0, 0, 0); p1 = __builtin_amdgcn_mfma_f32_32x32x16_bf16(k21, qr[2], p1, 0, 0, 0);
    p0 = __builtin_amdgcn_mfma_f32_32x32x16_bf16(k30, qr[3], p0, 0, 0, 0); p1 = __builtin_amdgcn_mfma_f32_32x32x16_bf16(k31, qr[3], p1, 0, 0, 0);
    DA_SBAR();
  } else if (HAS_PV) ld_vfr<1>(l1, h1, vb);
  if (HAS_PV) {
    DA_LGKM(8); ld_vfr<2>(l2, h2, vb); mma_vchunk(o, l0, h0, pa0); DA_SBAR();
    DA_LGKM(8); ld_vfr<3>(l3, h3, vb); mma_vchunk(o, l1, h1, pa1); DA_SBAR();
    DA_LGKM(8); mma_vchunk(o, l2, h2, pa2); DA_SBAR();
    DA_LGKM(0); mma_vchunk(o, l3, h3, pa3);
  }
  __builtin_amdgcn_s_setprio(0);
}
__device__ __forceinline__ void attn_unit(const bf16_t* __restrict__ Qb, const bf16_t* __restrict__ Kh, const bf16_t* __restrict__ Vh, float* __restrict__ Ob, int seq, DA_LAS char* lds) {
  int tid = threadIdx.x; asm volatile("" : "+v"(tid));
  const int wid = __builtin_amdgcn_readfirstlane(tid >> 6), lane = tid & 63, r32 = lane & 31, hi = lane >> 5;
  const bool grpA = wid < 4;
  const DA_LAS char* V_lds = lds + OFF_V; const DA_LAS char* K_lds = lds + OFF_K;
  DA_LAS float* al_l = (DA_LAS float*)(lds + OFF_WS) + wid * 64;
  const unsigned lds0 = (unsigned)(size_t)lds;
  const int krow = 8 * wid + (lane >> 3), kpiece = (lane & 7) ^ ((krow >> 1) & 7);
  const bf16_t* ksrc = Kh + (long)krow * PITCH + kpiece * 8;
  const int vkk = 8 * wid + ((lane & 31) >> 2), vkey = (vkk & ~0xC) | ((vkk & 4) << 1) | ((vkk & 8) >> 1);
  const bf16_t* vsrc = Vh + (long)vkey * PITCH + (lane >> 5) * 32 + (lane & 3) * 8;
  const unsigned kdst = lds0 + OFF_K + wid * 1024, vdst = lds0 + OFF_V + wid * 2048;
#define DA_DMA_K(t, slot) glds16(ksrc + (long)(t) * KVBLK * PITCH, (unsigned)__builtin_amdgcn_readfirstlane(kdst + (slot) * SHM_K))
#define DA_DMA_V(t, slot) do { glds16(vsrc + (long)(t) * KVBLK * PITCH, (unsigned)__builtin_amdgcn_readfirstlane(vdst + (slot) * SHM_V)); \
    glds16(vsrc + (long)(t) * KVBLK * PITCH + 64, (unsigned)__builtin_amdgcn_readfirstlane(vdst + (slot) * SHM_V + 1024)); } while (0)
  const int NT = seq / KVBLK;
  DA_DMA_K(0, 0); DA_DMA_K(1, 1); DA_DMA_V(0, 0);
  float mhat = 0.f, alpha = 1.f, l_reg = 0.f; f32x16 o[4] = {}; bf16x8 qr[4]; f32x16 p0 = {}, p1 = {}; bf16x8 pa0, pa1, pa2, pa3;
  const bf16_t* Qw = Qb + (long)(wid * QBLK + r32) * PITCH + hi * 8;
#pragma unroll
  for (int d0 = 0; d0 < 4; ++d0) qr[d0] = *(const bf16x8*)(Qw + d0 * 16);
  const int vb0 = (int)(unsigned)(size_t)V_lds + v_rd_base(lane);
#define DA_RESC(a) do { if (__any((a) < 1.f)) { if (hi == 0) al_l[r32] = (a); asm volatile("s_waitcnt lgkmcnt(0)" ::: "memory"); \
    _Pragma("unroll") for (int d = 0; d < 4; ++d) _Pragma("unroll") for (int r = 0; r < 16; ++r) o[d][r] *= al_l[crow(r, hi)]; } } while (0)
#define DA_SEG_V(first) do { softmax_tile(p0, p1, mhat, (first), alpha, l_reg, pa0, pa1, pa2, pa3); DA_RESC(alpha); } while (0)
  asm volatile("s_waitcnt vmcnt(3)" ::: "memory");
  DA_WAIT_BAR(3);
  int m0 = 0, m1 = 1, m2 = 2;
  Pre P; const int kb0 = (int)(unsigned)(size_t)K_lds;
#define DA_PREF_K(slot) prefetch_k(P, kb0 + (slot) * SHM_K, r32, hi)
  if (grpA) {
    DA_DMA_K(2, 2); DA_DMA_V(1, 1);
    DA_PREF_K(0); DA_LGKM(0);
    m_segment2<true, false>(p0, p1, P, kb0, qr, o, vb0, pa0, pa1, pa2, pa3, r32, hi);
    DA_WAIT_BAR(3);
    DA_PREF_K(1);
    DA_SEG_V(true);
    DA_WAIT_BAR(3);
    DA_DMA_K(3, 0); DA_DMA_V(2, 2);
    m_segment2<true, true>(p0, p1, P, kb0 + SHM_K, qr, o, vb0, pa0, pa1, pa2, pa3, r32, hi);
    DA_WAIT_BAR(3);
    m0 = 1; m1 = 2; m2 = 0;
#pragma unroll 1
    for (int t = 1; t + 1 < NT; ++t) {
      DA_PREF_K(m1);
      DA_SEG_V(false);
      DA_WAIT_BAR(3);
      if (t + 3 < NT) DA_DMA_K(t + 3, m0);
      if (t + 2 < NT) DA_DMA_V(t + 2, m2);
      m_segment2<true, true>(p0, p1, P, kb0 + m1 * SHM_K, qr, o, vb0 + m0 * SHM_V, pa0, pa1, pa2, pa3, r32, hi);
      if (t + 3 < NT) DA_WAIT_BAR(3); else DA_WAIT_BAR(0);
      { const int mm = m0; m0 = m1; m1 = m2; m2 = mm; }
    }

    DA_SEG_V(false);
    DA_WAIT_BAR(0);
    m_segment2<false, true>(p0, p1, P, kb0, qr, o, vb0 + m0 * SHM_V, pa0, pa1, pa2, pa3, r32, hi);
  } else {
    DA_DMA_K(2, 2); DA_DMA_V(1, 1);
    DA_PREF_K(0);
    DA_WAIT_BAR(3);
    m_segment2<true, false>(p0, p1, P, kb0, qr, o, vb0, pa0, pa1, pa2, pa3, r32, hi);
    DA_WAIT_BAR(3);
    DA_DMA_K(3, 0); DA_DMA_V(2, 2);
    DA_PREF_K(1);
    DA_SEG_V(true);
    DA_WAIT_BAR(3);
    m0 = 1; m1 = 2; m2 = 0;
#pragma unroll 1
    for (int t = 1; t + 1 < NT; ++t) {
      m_segment2<true, true>(p0, p1, P, kb0 + m0 * SHM_K, qr, o, vb0 + m2 * SHM_V, pa0, pa1, pa2, pa3, r32, hi);
      DA_WAIT_BAR(3);
      if (t + 3 < NT) DA_DMA_K(t + 3, m0);
      if (t + 2 < NT) DA_DMA_V(t + 2, m2);
      DA_PREF_K(m1);
      DA_SEG_V(false);
      if (t + 3 < NT) DA_WAIT_BAR(3); else DA_WAIT_BAR(0);
      { const int mm = m0; m0 = m1; m1 = m2; m2 = mm; }
    }
    m_segment2<true, true>(p0, p1, P, kb0 + m0 * SHM_K, qr, o, vb0 + m2 * SHM_V, pa0, pa1, pa2, pa3, r32, hi);
    DA_WAIT_BAR(0);

    DA_SEG_V(false);
    m_segment2<false, true>(p0, p1, P, kb0, qr, o, vb0 + m0 * SHM_V, pa0, pa1, pa2, pa3, r32, hi);
  }
#undef DA_PREF_K
  { auto rr = __builtin_amdgcn_permlane32_swap(__float_as_uint(l_reg), __float_as_uint(l_reg), false, false); l_reg = __uint_as_float(rr[0]) + __uint_as_float(rr[1]); }
  if (hi == 0) al_l[r32] = l_reg; asm volatile("s_waitcnt lgkmcnt(0)" ::: "memory");
  float* Ow = Ob + (long)(wid * QBLK) * LDO;
#pragma unroll
  for (int r = 0; r < 16; ++r) { const int orow = crow(r, hi); const float rl = __builtin_amdgcn_rcpf(al_l[orow]);
#pragma unroll
    for (int d0 = 0; d0 < 4; ++d0) Ow[(long)orow * LDO + d0 * 32 + r32] = o[d0][r] * rl; }
  DA_WAIT_BAR(0);
#undef DA_DMA_K
#undef DA_DMA_V
#undef DA_RESC
#undef DA_SEG_V
}
}

constexpr int NWAVES = 8;
constexpr int SEQ = 16384, DM = 2048, FF = 5632, AW = 1024, NHEAD = 8, FW = 1024, NGRP = 8, GD = 128, DEPTH = 2;
constexpr int NMOD = 9 * DM;
constexpr int KSPLIT = 16;
constexpr float NORM_EPS = 1e-6f, SUBLN_EPS = 1e-5f;

constexpr size_t MiB = 1u << 20;
constexpr size_t WS_CTL = 0, CTL_ZERO_BYTES = 1 * MiB;
constexpr size_t WS_COS = 1 * MiB, WS_SIN = 3 * MiB;
constexpr size_t WS_DFTC = 5 * MiB, WS_DFTS = 5 * MiB + 32768, WS_TW = 5 * MiB + 65536;
constexpr size_t WS_MODP = 6 * MiB;
constexpr size_t WS_MODF = 9 * MiB;
constexpr size_t WS_LAM = WS_MODF + (size_t)DEPTH * 9 * DM * 4;
constexpr size_t WS_W = 10 * MiB, W_LAYER = 180 * MiB;
constexpr size_t W_1IN = 0, W_1OUT = 44 * MiB, W_MIX = 66 * MiB, W_AP = 98 * MiB, W_FP = 102 * MiB, W_MO = 106 * MiB, W_2IN = 114 * MiB, W_2OUT = 158 * MiB;
constexpr size_t WS_H = 370 * MiB, WS_Y = 434 * MiB, WS_ACT = 498 * MiB, WS_M1 = 674 * MiB, WS_O = 802 * MiB, WS_END = 930 * MiB;
constexpr size_t WS_TRE = WS_Y, WS_TIM = WS_Y + 32 * MiB;
constexpr size_t WS_GATE = WS_ACT;
constexpr size_t WS_Q = WS_M1, WS_K = WS_M1 + 32 * MiB, WS_V = WS_M1 + 64 * MiB, WS_U = WS_M1 + 96 * MiB;
constexpr size_t WS_YF = WS_M1, WS_AO = WS_M1 + 32 * MiB, WS_MG = WS_M1 + 64 * MiB;
constexpr size_t WS_TT = WS_O;
constexpr int CW_TMO = 0, CW_CODE = 1, CW_BAR = 4096, CW_CHK = 16384;

constexpr int RING_OFF = 0, PHASE_LDS = 143360;
constexpr int LDSCTL_OFF = PHASE_LDS, MISC_OFF = LDSCTL_OFF + 320;
constexpr int LDS_BYTES = 147456;
static_assert(MISC_OFF + 128 <= LDS_BYTES, "LDS map");

#define GAS __attribute__((address_space(1)))
#define LAS __attribute__((address_space(3)))
typedef unsigned short bf16;
typedef unsigned v4u __attribute__((ext_vector_type(4)));
typedef unsigned v2u __attribute__((ext_vector_type(2)));
typedef float f32x4 __attribute__((ext_vector_type(4)));
typedef float f32x16 __attribute__((ext_vector_type(16)));
typedef short bf16x8 __attribute__((ext_vector_type(8)));
typedef short s16x4 __attribute__((ext_vector_type(4)));
typedef GAS unsigned gu32;
#define RLX_AGENT __ATOMIC_RELAXED, __HIP_MEMORY_SCOPE_AGENT
#define LDS_WAIT() asm volatile("s_waitcnt lgkmcnt(0)" ::: "memory")
#define VM_WAIT() asm volatile("s_waitcnt vmcnt(0)" ::: "memory")
__device__ __forceinline__ unsigned f2bf(float f) { unsigned u = __builtin_bit_cast(unsigned, f); return (u + 0x7fffu + ((u >> 16) & 1u)) >> 16; }
__device__ __forceinline__ unsigned pk2(float lo, float hi) { return f2bf(lo) | (f2bf(hi) << 16); }
__device__ __forceinline__ float bfl(unsigned w) { return __builtin_bit_cast(float, w << 16); }
__device__ __forceinline__ float bfh(unsigned w) { return __builtin_bit_cast(float, w & 0xffff0000u); }
__device__ __forceinline__ float wave_sum(float v) {
#pragma unroll
    for (int o = 1; o < 64; o <<= 1) v += __shfl_xor(v, o);
    return v;
}
__device__ __forceinline__ void sincos_turns(double t, double& s, double& c) {
    t -= floor(t);
    const double q = floor(t * 4.0 + 0.5);
    const double x = (t - q * 0.25) * 6.283185307179586476925286766559;
    const double x2 = x * x;
    double sp = -1.0 / 1307674368000.0; sp = sp * x2 + 1.0 / 6227020800.0; sp = sp * x2 - 1.0 / 39916800.0; sp = sp * x2 + 1.0 / 362880.0; sp = sp * x2 - 1.0 / 5040.0; sp = sp * x2 + 1.0 / 120.0; sp = sp * x2 - 1.0 / 6.0; sp = sp * x2 + 1.0;
    const double sx = sp * x;
    double cp = 1.0 / 20922789888000.0; cp = cp * x2 - 1.0 / 87178291200.0; cp = cp * x2 + 1.0 / 479001600.0; cp = cp * x2 - 1.0 / 3628800.0; cp = cp * x2 + 1.0 / 40320.0; cp = cp * x2 - 1.0 / 720.0; cp = cp * x2 + 1.0 / 24.0; cp = cp * x2 - 0.5; cp = cp * x2 + 1.0;
    const int qi = ((int)q) & 3;
    s = (qi == 0) ? sx : (qi == 1) ? cp : (qi == 2) ? -sx : -cp;
    c = (qi == 0) ? cp : (qi == 1) ? -sx : (qi == 2) ? -cp : sx;
}
__constant__ float ROPE_INV_FREQ[32] = {1.f,0.749894261f,0.562341332f,0.421696514f,0.316227764f,0.237137377f,0.177827939f,0.133352131f,0.100000001f,0.0749894157f,0.0562341325f,0.0421696529f,0.0316227749f,0.0237137377f,0.0177827943f,0.0133352149f,0.00999999978f,0.00749894185f,0.00562341325f,0.00421696482f,0.00316227763f,0.00237137359f,0.00177827943f,0.00133352145f,0.00100000005f,0.000749894243f,0.000562341302f,0.000421696517f,0.000316227757f,0.00023713737f,0.00017782794f,0.00013335215f};

#define XB_TMO      128
#define XB_XCNT(j)  (256  + 64 * (j))
#define XB_XSUB(j)  (1280 + 64 * (j))
#define XB_XGEN(j)  (2304 + 64 * (j))
#define XB_TOP      3328
#define XB_TOPGEN   3392
#define XCD_BAR_WORDS 3456
#define XB_SPIN_CAP (1u << 18)

__device__ __forceinline__ unsigned xb_ld(unsigned* p)              { return __hip_atomic_load(p, __ATOMIC_RELAXED, __HIP_MEMORY_SCOPE_AGENT); }
__device__ __forceinline__ unsigned xb_add(unsigned* p, unsigned v) { return __hip_atomic_fetch_add(p, v, __ATOMIC_RELAXED, __HIP_MEMORY_SCOPE_AGENT); }
__device__ __forceinline__ unsigned xb_xcc_id() { return (unsigned)__builtin_amdgcn_s_getreg((3 << 11) | 20) & 0xFu; }
#define XB_SPIN(cond, bar) do { unsigned _sp = 0; while (cond) { __builtin_amdgcn_s_sleep(1); \
    if ((++_sp & 255u) == 0u) { if (xb_ld(&(bar)[XB_TMO])) break; if (_sp > XB_SPIN_CAP) { atomicAdd(&(bar)[XB_TMO], 1u); break; } } } } while (0)

struct XcdBarrier {
    unsigned* bar; unsigned x;
    volatile LAS unsigned* st;
};

__device__ __forceinline__ XcdBarrier xcd_barrier_post(unsigned* bar, volatile LAS unsigned* st) {
    XcdBarrier b; b.bar = bar; b.x = xb_xcc_id(); b.st = st;
    if (threadIdx.x == 0) (void)xb_add(&bar[XB_XCNT(b.x)], 1u);
    return b;
}
__device__ __forceinline__ void xcd_barrier_complete(unsigned* bar, unsigned x, unsigned& nloc, unsigned& nx) {
    const unsigned G = gridDim.x * gridDim.y * gridDim.z;
    unsigned sum, cnt, mine, sp = 0u;
    for (;;) {
        sum = 0u; cnt = 0u; mine = 0u;
#pragma unroll
        for (unsigned j = 0; j < 16; ++j) { const unsigned c = xb_ld(&bar[XB_XCNT(j)]); sum += c; cnt += (c > 0u) ? 1u : 0u; mine = (j == x) ? c : mine; }
        if (sum == G) break;
        __builtin_amdgcn_s_sleep(1);
        if ((++sp & 255u) == 0u) { if (xb_ld(&bar[XB_TMO])) break; if (sp > XB_SPIN_CAP) { atomicAdd(&bar[XB_TMO], 1u); break; } }
    }
    nloc = mine > 0u ? mine : 1u; nx = cnt > 0u ? cnt : 1u;
}

__device__ __forceinline__ void xcd_barrier(const XcdBarrier& b) {
    asm volatile("s_waitcnt vmcnt(0)" ::: "memory");
    __syncthreads();
    if (threadIdx.x == 0) {
        unsigned* bar = b.bar; unsigned bx = b.x; asm volatile("" : "+s"(bx));
        __builtin_amdgcn_s_waitcnt(0);
        unsigned nloc = b.st[0], nx = b.st[1];
        if (nloc == 0u) { xcd_barrier_complete(bar, bx, nloc, nx); b.st[0] = nloc; b.st[1] = nx; }
        const unsigned old = xb_add(&bar[XB_XSUB(bx)], 1u);
        const unsigned gen = old / nloc;
        if (old + 1u == (gen + 1u) * nloc) {
            __builtin_amdgcn_fence(__ATOMIC_RELEASE, "agent");
            asm volatile("s_waitcnt vmcnt(0)" ::: "memory");
            const unsigned og = xb_add(&bar[XB_TOP], 1u);
            const unsigned tg = og / nx;
            if (og + 1u == (tg + 1u) * nx) xb_add(&bar[XB_TOPGEN], 1u);
            else XB_SPIN(xb_ld(&bar[XB_TOPGEN]) == tg, bar);
            __builtin_amdgcn_fence(__ATOMIC_ACQUIRE, "agent");
            xb_add(&bar[XB_XGEN(bx)], 1u);
            asm volatile("s_waitcnt vmcnt(0)" ::: "memory");
        } else {
            XB_SPIN(xb_ld(&bar[XB_XGEN(bx)]) == gen, bar);
            __builtin_amdgcn_fence(__ATOMIC_ACQUIRE, "agent");
            asm volatile("s_waitcnt vmcnt(0)" ::: "memory");
        }
    }
    __syncthreads();
}
struct Frame {
    LAS unsigned char* lds;
    volatile LAS unsigned* MISC;
    gu32* ctl;
    int tid, lane, wave;
    int vcu, G;
    unsigned char* ws;
};

__device__ __forceinline__ int wt_row(int mode, int row_off, int n0) {
    if (mode == 1) { const int up = n0 >= FF ? 1 : 0, j = n0 - up * FF; return (j >> 7) * 256 + up * 128 + (j & 127); }
    if (mode == 2) { if (n0 < 2048) { const int ch = n0 >> 6, d = n0 & 63; return 256 * (ch >> 2) + 128 * (d >> 5) + 32 * (ch & 3) + (d & 31); } return n0; }
    return row_off + n0;
}
__device__ __forceinline__ void p0_transpose_item(const float* W, int K, int N, bf16* WT, int mode, int row_off, LAS float* scr, int item, int lane) {
    const int nblk = N / 32, kb = item / nblk, nb = item % nblk, k0 = 64 * kb, n0 = 32 * nb;
#pragma unroll 8
    for (int i = 0; i < 32; ++i) { const int kk = 2 * i + (lane >> 5); scr[kk * 33 + (lane & 31)] = W[(size_t)(k0 + kk) * N + n0 + (lane & 31)]; }
    LDS_WAIT(); asm volatile("" ::: "memory");
    const int c = lane & 7, rbase = wt_row(mode, row_off, n0);
#pragma unroll
    for (int j = 0; j < 4; ++j) { const int n = (lane >> 3) + 8 * j; const LAS float* s = scr + (8 * c) * 33 + n;
        v4u o; o.x = pk2(s[0 * 33], s[1 * 33]); o.y = pk2(s[2 * 33], s[3 * 33]); o.z = pk2(s[4 * 33], s[5 * 33]); o.w = pk2(s[6 * 33], s[7 * 33]);
        *(GAS v4u*)(WT + (size_t)(rbase + n) * K + k0 + 8 * c) = o; }
    LDS_WAIT(); asm volatile("" ::: "memory");
}
struct In18 { const float* p[18]; };
__device__ __forceinline__ void p0_prologue(Frame& F, const In18& in) {
    LAS float* scr = (LAS float*)(F.lds + RING_OFF + F.wave * 16384);
    const int gw = F.vcu * NWAVES + F.wave, NGW = F.G * NWAVES;
    constexpr int I0 = 32 * 352, I1 = 88 * 64, I2 = 32 * 128, I3 = 32 * 128, I4 = 16 * 64, I5 = 16 * 64, I6 = 32 * 64, IL = 2 * I0 + 2 * I1 + I2 + I3 + I4 + I5 + I6;
    for (int it = gw; it < DEPTH * IL; it += NGW) {
        const int l = it / IL; int r = it % IL;
        bf16* wl = (bf16*)(F.ws + WS_W + (size_t)l * W_LAYER);
        if (r < I0) { p0_transpose_item(in.p[6] + (size_t)l * DM * 2 * FF, DM, 2 * FF, (bf16*)((unsigned char*)wl + W_1IN), 1, 0, scr, r, F.lane); continue; } r -= I0;
        if (r < I1) { p0_transpose_item(in.p[7] + (size_t)l * FF * DM, FF, DM, (bf16*)((unsigned char*)wl + W_1OUT), 0, 0, scr, r, F.lane); continue; } r -= I1;
        if (r < I2) { p0_transpose_item(in.p[8] + (size_t)l * DM * 4096, DM, 4096, (bf16*)((unsigned char*)wl + W_MIX), 2, 0, scr, r, F.lane); continue; } r -= I2;
        if (r < I3) { p0_transpose_item(in.p[13] + (size_t)l * DM * 4096, DM, 4096, (bf16*)((unsigned char*)wl + W_MIX), 0, 4096, scr, r, F.lane); continue; } r -= I3;
        if (r < I4) { p0_transpose_item(in.p[11] + (size_t)l * AW * DM, AW, DM, (bf16*)((unsigned char*)wl + W_AP), 0, 0, scr, r, F.lane); continue; } r -= I4;
        if (r < I5) { p0_transpose_item(in.p[12] + (size_t)l * FW * DM, FW, DM, (bf16*)((unsigned char*)wl + W_FP), 0, 0, scr, r, F.lane); continue; } r -= I5;
        if (r < I6) { p0_transpose_item(in.p[15] + (size_t)l * DM * DM, DM, DM, (bf16*)((unsigned char*)wl + W_MO), 0, 0, scr, r, F.lane); continue; } r -= I6;
        if (r < I0) { p0_transpose_item(in.p[16] + (size_t)l * DM * 2 * FF, DM, 2 * FF, (bf16*)((unsigned char*)wl + W_2IN), 1, 0, scr, r, F.lane); continue; } r -= I0;
        p0_transpose_item(in.p[17] + (size_t)l * FF * DM, FF, DM, (bf16*)((unsigned char*)wl + W_2OUT), 0, 0, scr, r, F.lane);
    }
    {
        constexpr int NCB = NMOD / 256, KR = DM / KSPLIT;
        const float* cvec = in.p[1]; float* modp = (float*)(F.ws + WS_MODP);
        for (int it = gw; it < DEPTH * NCB * KSPLIT; it += NGW) {
            const int l = it / (NCB * KSPLIT), r = it % (NCB * KSPLIT), ks = r / NCB, cb = r % NCB, c0 = cb * 256 + 4 * F.lane, k0 = ks * KR;
            const float* W = in.p[2] + (size_t)l * DM * NMOD + (size_t)k0 * NMOD + c0;
            f32x4 acc = {0.f, 0.f, 0.f, 0.f};
#pragma unroll 8
            for (int k = 0; k < KR; ++k) { const float cv = cvec[k0 + k]; const float ca = cv * __builtin_amdgcn_rcpf(1.0f + __builtin_amdgcn_exp2f(cv * -1.4426950408889634f));
                const f32x4 w = *(const GAS f32x4*)(W + (size_t)k * NMOD); acc += w * ca; }
            *(GAS f32x4*)(modp + (size_t)(l * KSPLIT + ks) * NMOD + c0) = acc;
        }
    }
    {
        const int gt = F.vcu * (NWAVES * 64) + F.tid, NT = F.G * NWAVES * 64;
        float* cosT = (float*)(F.ws + WS_COS); float* sinT = (float*)(F.ws + WS_SIN);
        for (int idx = gt; idx < SEQ * 32; idx += NT) { const int pos = idx >> 5, i = idx & 31; const float ang = (float)pos * ROPE_INV_FREQ[i];
            double s, c; sincos_turns((double)ang * 0.15915494309189533576888376337251, s, c); cosT[idx] = (float)c; sinT[idx] = (float)s; }
        bf16* dC = (bf16*)(F.ws + WS_DFTC); bf16* dS = (bf16*)(F.ws + WS_DFTS); float* tw = (float*)(F.ws + WS_TW);
        for (int idx = gt; idx < 128 * 128; idx += NT) { const int a = idx >> 7, b = idx & 127; double s, c;
            sincos_turns((double)((a * b) & 127) * (1.0 / 128.0), s, c); dC[idx] = (bf16)f2bf((float)c); dS[idx] = (bf16)f2bf((float)s);
            sincos_turns((double)(a * b) * (1.0 / 16384.0), s, c); tw[2 * idx] = (float)c; tw[2 * idx + 1] = (float)s; }
    }
}
__device__ __forceinline__ void p1_modfin(Frame& F, const In18& in) {
    const int gt = F.vcu * (NWAVES * 64) + F.tid, NT = F.G * NWAVES * 64;
    const float* modp = (const float*)(F.ws + WS_MODP); float* modf = (float*)(F.ws + WS_MODF);
    for (int idx = gt; idx < DEPTH * 3 * DM; idx += NT) { const int l = idx / (3 * DM), s = (idx / DM) % 3, c = idx % DM, base = s * 3 * DM + c;
        float sh = in.p[3][l * NMOD + base], sc = in.p[3][l * NMOD + base + DM], gt_ = in.p[3][l * NMOD + base + 2 * DM];
        for (int ks = 0; ks < KSPLIT; ++ks) { const float* q = modp + (size_t)(l * KSPLIT + ks) * NMOD + base; sh += q[0]; sc += q[DM]; gt_ += q[2 * DM]; }
        const float gpre = in.p[4][(l * 3 + s) * DM + c], gpost = in.p[5][(l * 3 + s) * DM + c];
        float* o = modf + (size_t)((l * 3 + s) * 3) * DM + c;
        o[0] = gpre * (1.0f + sc); o[DM] = sh; o[2 * DM] = (s == 1 ? 1.0f : 0.5f) * gt_ * gpost; }
    if (blockIdx.x == 0 && F.wave < DEPTH) { const int l = F.wave; const float* lq = in.p[9] + l * 256;
        const float sa = wave_sum(lq[F.lane] * lq[64 + F.lane]), sb = wave_sum(lq[128 + F.lane] * lq[192 + F.lane]);
        const float linit = l == 0 ? 0.2f : 0.35550906758f;
        if (F.lane == 0) { float* lamv = (float*)(F.ws + WS_LAM); lamv[l] = __builtin_amdgcn_exp2f(sa * 1.4426950408889634f) - __builtin_amdgcn_exp2f(sb * 1.4426950408889634f) + linit; lamv[2 + l] = 1.0f - linit; } }
}
template <bool HAS_Y, bool HAS_H>
__device__ __forceinline__ void norm_phase(Frame& F, const float* xin, float* xout, const bf16* y, bf16* h, const float* Gv, const float* Av, const float* Bv) {
    int lane = F.lane; asm volatile("" : "+v"(lane));
    const int gw = F.vcu * NWAVES + F.wave, NGW = F.G * NWAVES;
    f32x4 g[8], a[8], b[8];
#pragma unroll
    for (int j = 0; j < 8; ++j) { if (HAS_Y) g[j] = *(const GAS f32x4*)(Gv + 4 * lane + 256 * j); if (HAS_H) { a[j] = *(const GAS f32x4*)(Av + 4 * lane + 256 * j); b[j] = *(const GAS f32x4*)(Bv + 4 * lane + 256 * j); } }
    for (int row = gw; row < SEQ; row += NGW) {
        f32x4 x[8];
#pragma unroll
        for (int j = 0; j < 8; ++j) x[j] = *(const GAS f32x4*)(xin + (size_t)row * DM + 4 * lane + 256 * j);
        if (HAS_Y) {
            f32x4 yv[8]; float ss = 0.f;
#pragma unroll
            for (int j = 0; j < 8; ++j) { const v2u w = *(const GAS v2u*)(y + (size_t)row * DM + 4 * lane + 256 * j); yv[j] = (f32x4){bfl(w.x), bfh(w.x), bfl(w.y), bfh(w.y)};
                ss += (yv[j].x * yv[j].x + yv[j].y * yv[j].y) + (yv[j].z * yv[j].z + yv[j].w * yv[j].w); }
            const float ry = 1.0f / sqrtf(wave_sum(ss) * (1.0f / DM) + NORM_EPS);
#pragma unroll
            for (int j = 0; j < 8; ++j) x[j] = x[j] + g[j] * yv[j] * ry;
        }
#pragma unroll
        for (int j = 0; j < 8; ++j) *(GAS f32x4*)(xout + (size_t)row * DM + 4 * lane + 256 * j) = x[j];
        if (HAS_H) {
            float ss = 0.f;
#pragma unroll
            for (int j = 0; j < 8; ++j) ss += (x[j].x * x[j].x + x[j].y * x[j].y) + (x[j].z * x[j].z + x[j].w * x[j].w);
            const float rx = 1.0f / sqrtf(wave_sum(ss) * (1.0f / DM) + NORM_EPS);
#pragma unroll
            for (int j = 0; j < 8; ++j) { const f32x4 v = x[j] * rx * a[j] + b[j]; v2u w; w.x = pk2(v.x, v.y); w.y = pk2(v.z, v.w); *(GAS v2u*)(h + (size_t)row * DM + 4 * lane + 256 * j) = w; }
        }
    }
}
__device__ __forceinline__ void combine_phase(Frame& F, const float* O, bf16* AO, const float* subg, float lam, float oscale) {
    int lane = F.lane; asm volatile("" : "+v"(lane));
    const int gw = F.vcu * NWAVES + F.wave, NGW = F.G * NWAVES, hh = lane >> 3, e0 = (lane & 7) * 16;
    f32x4 g[4];
#pragma unroll
    for (int j = 0; j < 4; ++j) g[j] = *(const GAS f32x4*)(subg + e0 + 4 * j) * oscale;
    for (int row = gw; row < SEQ; row += NGW) {
        const float* p0 = O + (size_t)row * 2048 + hh * 256 + e0;
        f32x4 o[4]; float ss = 0.f;
#pragma unroll
        for (int j = 0; j < 4; ++j) { const f32x4 a = *(const GAS f32x4*)(p0 + 4 * j), b = *(const GAS f32x4*)(p0 + 128 + 4 * j); o[j] = a - b * lam; ss += (o[j].x * o[j].x + o[j].y * o[j].y) + (o[j].z * o[j].z + o[j].w * o[j].w); }
        ss += __shfl_xor(ss, 1); ss += __shfl_xor(ss, 2); ss += __shfl_xor(ss, 4);
        const float r = 1.0f / sqrtf(ss * (1.0f / 128.0f) + SUBLN_EPS);
        v4u w0, w1; { const f32x4 v0 = o[0] * r * g[0], v1 = o[1] * r * g[1], v2 = o[2] * r * g[2], v3 = o[3] * r * g[3];
            w0.x = pk2(v0.x, v0.y); w0.y = pk2(v0.z, v0.w); w0.z = pk2(v1.x, v1.y); w0.w = pk2(v1.z, v1.w); w1.x = pk2(v2.x, v2.y); w1.y = pk2(v2.z, v2.w); w1.z = pk2(v3.x, v3.y); w1.w = pk2(v3.z, v3.w); }
        bf16* op = AO + (size_t)row * 1024 + hh * 128 + e0;
        *(GAS v4u*)op = w0; *(GAS v4u*)(op + 8) = w1;
    }
}
template <int DD> __device__ __forceinline__ void fft_mm2(f32x16& aR, f32x16& aI, int vb, const bf16x8* Ca, const bf16x8* Sa) {
    using namespace dattn;
    const s16x4 l0 = tr_read<v_rd_off(DD, 0, 0)>(vb), h0 = tr_read<v_rd_off(DD, 0, 1)>(vb), l1 = tr_read<v_rd_off(DD, 1, 0)>(vb), h1 = tr_read<v_rd_off(DD, 1, 1)>(vb);
    const s16x4 l2 = tr_read<v_rd_off(DD, 2, 0)>(vb), h2 = tr_read<v_rd_off(DD, 2, 1)>(vb), l3 = tr_read<v_rd_off(DD, 3, 0)>(vb), h3 = tr_read<v_rd_off(DD, 3, 1)>(vb);
    asm volatile("s_waitcnt lgkmcnt(0)" ::: "memory"); __builtin_amdgcn_sched_barrier(0);
    const bf16x8 b0 = DA_PK(l0, h0), b1 = DA_PK(l1, h1), b2 = DA_PK(l2, h2), b3 = DA_PK(l3, h3);
    aR = __builtin_amdgcn_mfma_f32_32x32x16_bf16(Ca[0], b0, aR, 0, 0, 0); aI = __builtin_amdgcn_mfma_f32_32x32x16_bf16(Sa[0], b0, aI, 0, 0, 0);
    aR = __builtin_amdgcn_mfma_f32_32x32x16_bf16(Ca[1], b1, aR, 0, 0, 0); aI = __builtin_amdgcn_mfma_f32_32x32x16_bf16(Sa[1], b1, aI, 0, 0, 0);
    aR = __builtin_amdgcn_mfma_f32_32x32x16_bf16(Ca[2], b2, aR, 0, 0, 0); aI = __builtin_amdgcn_mfma_f32_32x32x16_bf16(Sa[2], b2, aI, 0, 0, 0);
    aR = __builtin_amdgcn_mfma_f32_32x32x16_bf16(Ca[3], b3, aR, 0, 0, 0); aI = __builtin_amdgcn_mfma_f32_32x32x16_bf16(Sa[3], b3, aI, 0, 0, 0);
}
__device__ __forceinline__ void fftA_phase(Frame& F, const bf16* U, bf16* TRE, bf16* TIM, const bf16* dftC, const bf16* dftS, const float* TW) {
    using namespace dattn;
    int tid = threadIdx.x; asm volatile("" : "+v"(tid));
    const int wid = __builtin_amdgcn_readfirstlane(tid >> 6), lane = tid & 63, r32 = lane & 31, hi = lane >> 5, kb = wid & 3, ch = wid >> 2;
    bf16x8 Cf[8], Sf[8];
#pragma unroll
    for (int i = 0; i < 8; ++i) { Cf[i] = *(const bf16x8*)(dftC + (32 * kb + r32) * 128 + 16 * i + 8 * hi); Sf[i] = *(const bf16x8*)(dftS + (32 * kb + r32) * 128 + 16 * i + 8 * hi); }
    const int sr = tid >> 4, sc = (tid & 15) * 8, vst0 = v_st(sr, sc), vst1 = v_st(32 + sr, sc);
    LAS unsigned char* L = F.lds + RING_OFF;
    const int vb = (int)(unsigned)(size_t)L + v_rd_base(lane) + ch * 1024;
    for (int unit = F.vcu; unit < 128 * NGRP; unit += F.G) {
        const int n2 = unit >> 3, g = unit & 7;
        const bf16* src = U + (size_t)n2 * 1024 + g * 128 + sc;
        const bf16x8 x0 = *(const bf16x8*)(src + (size_t)sr * 131072), x1 = *(const bf16x8*)(src + (size_t)(32 + sr) * 131072), x2 = *(const bf16x8*)(src + (size_t)(64 + sr) * 131072), x3 = *(const bf16x8*)(src + (size_t)(96 + sr) * 131072);
        *(LAS bf16x8*)(L + vst0) = x0; *(LAS bf16x8*)(L + vst1) = x1; *(LAS bf16x8*)(L + 16384 + vst0) = x2; *(LAS bf16x8*)(L + 16384 + vst1) = x3;
        LDS_WAIT(); __syncthreads();
        f32x16 PR[2] = {}, PI[2] = {};
        fft_mm2<0>(PR[0], PI[0], vb, Cf, Sf); fft_mm2<1>(PR[1], PI[1], vb, Cf, Sf);
        fft_mm2<0>(PR[0], PI[0], vb + 16384, Cf + 4, Sf + 4); fft_mm2<1>(PR[1], PI[1], vb + 16384, Cf + 4, Sf + 4);
        LDS_WAIT(); __syncthreads();
        const float* tw = TW + (size_t)(n2 * 128 + 32 * kb + 4 * hi) * 2;
#pragma unroll
        for (int rg = 0; rg < 4; ++rg) { const f32x4 t0 = *(const GAS f32x4*)(tw + 16 * rg), t1 = *(const GAS f32x4*)(tw + 16 * rg + 4);
            const float cc[4] = {t0.x, t0.z, t1.x, t1.z}, ss[4] = {t0.y, t0.w, t1.y, t1.w};
#pragma unroll
            for (int e = 0; e < 4; ++e) { const int r = 4 * rg + e, k1 = 32 * kb + 8 * rg + 4 * hi + e; const size_t rowo = (size_t)(k1 * 128 + n2) * 1024 + g * 128 + 64 * ch + r32;
#pragma unroll
                for (int dd = 0; dd < 2; ++dd) { const float pr = PR[dd][r], pi = PI[dd][r]; TRE[rowo + 32 * dd] = (bf16)f2bf(pr * cc[e] - pi * ss[e]); TIM[rowo + 32 * dd] = (bf16)f2bf(-(pr * ss[e] + pi * cc[e])); } } }
    }
}
__device__ __forceinline__ void fftB_phase(Frame& F, const bf16* TRE, const bf16* TIM, bf16* YF, const bf16* dftC, const bf16* dftS) {
    using namespace dattn;
    constexpr int WSTR = 272, OFF_WR = 65536, OFF_WI = 65536 + 128 * WSTR;
    constexpr float NORMF = 6.905339660024878e-4f;
    int tid = threadIdx.x; asm volatile("" : "+v"(tid));
    const int wid = __builtin_amdgcn_readfirstlane(tid >> 6), lane = tid & 63, r32 = lane & 31, hi = lane >> 5, kb = wid & 3, ch = wid >> 2;
    bf16x8 Cf[8], Sf[8];
#pragma unroll
    for (int i = 0; i < 8; ++i) { Cf[i] = *(const bf16x8*)(dftC + (32 * kb + r32) * 128 + 16 * i + 8 * hi); Sf[i] = *(const bf16x8*)(dftS + (32 * kb + r32) * 128 + 16 * i + 8 * hi); }
    const int sr = tid >> 4, sc = (tid & 15) * 8, vst0 = v_st(sr, sc), vst1 = v_st(32 + sr, sc);
    LAS unsigned char* L = F.lds + RING_OFF;
    const int vb = (int)(unsigned)(size_t)L + v_rd_base(lane) + ch * 1024;
    for (int unit = F.vcu; unit < 128 * NGRP; unit += F.G) {
        const int k1 = unit >> 3, g = unit & 7;
        const size_t so = (size_t)(k1 * 128) * 1024 + g * 128 + sc;
        bf16x8 zr[4], zi[4];
#pragma unroll
        for (int q = 0; q < 4; ++q) { zr[q] = *(const bf16x8*)(TRE + so + (size_t)(32 * q + sr) * 1024); zi[q] = *(const bf16x8*)(TIM + so + (size_t)(32 * q + sr) * 1024); }
        *(LAS bf16x8*)(L + vst0) = zr[0]; *(LAS bf16x8*)(L + vst1) = zr[1]; *(LAS bf16x8*)(L + 16384 + vst0) = zr[2]; *(LAS bf16x8*)(L + 16384 + vst1) = zr[3];
        *(LAS bf16x8*)(L + 32768 + vst0) = zi[0]; *(LAS bf16x8*)(L + 32768 + vst1) = zi[1]; *(LAS bf16x8*)(L + 49152 + vst0) = zi[2]; *(LAS bf16x8*)(L + 49152 + vst1) = zi[3];
        LDS_WAIT(); __syncthreads();
        f32x16 WR[2] = {}, WI[2] = {}, WX[2] = {};
        fft_mm2<0>(WR[0], WX[0], vb, Cf, Sf); fft_mm2<1>(WR[1], WX[1], vb, Cf, Sf);
        fft_mm2<0>(WR[0], WX[0], vb + 16384, Cf + 4, Sf + 4); fft_mm2<1>(WR[1], WX[1], vb + 16384, Cf + 4, Sf + 4);
        fft_mm2<0>(WI[0], WR[0], vb + 32768, Cf, Sf); fft_mm2<1>(WI[1], WR[1], vb + 32768, Cf, Sf);
        fft_mm2<0>(WI[0], WR[0], vb + 49152, Cf + 4, Sf + 4); fft_mm2<1>(WI[1], WR[1], vb + 49152, Cf + 4, Sf + 4);
        WI[0] -= WX[0]; WI[1] -= WX[1];
#pragma unroll
        for (int dd = 0; dd < 2; ++dd)
#pragma unroll
            for (int r = 0; r < 16; ++r) { const int k2 = 32 * kb + crow(r, hi), j = 64 * ch + 32 * dd + r32;
                *(LAS unsigned short*)(L + OFF_WR + k2 * WSTR + j * 2) = (unsigned short)f2bf(WR[dd][r]); *(LAS unsigned short*)(L + OFF_WI + k2 * WSTR + j * 2) = (unsigned short)f2bf(WI[dd][r]); }
        LDS_WAIT(); __syncthreads();
        f32x16 Y[2] = {};
#pragma unroll
        for (int kk = 0; kk < 2; ++kk) { const int rb = (64 * ch + 32 * kk + r32) * WSTR + 16 * hi;
#pragma unroll
            for (int jc = 0; jc < 8; ++jc) { const bf16x8 aR = *(const LAS bf16x8*)(L + OFF_WR + rb + 32 * jc), aI = *(const LAS bf16x8*)(L + OFF_WI + rb + 32 * jc);
                Y[kk] = __builtin_amdgcn_mfma_f32_32x32x16_bf16(aR, Cf[jc], Y[kk], 0, 0, 0); Y[kk] = __builtin_amdgcn_mfma_f32_32x32x16_bf16(aI, Sf[jc], Y[kk], 0, 0, 0); } }
#pragma unroll
        for (int kk = 0; kk < 2; ++kk)
#pragma unroll
            for (int r = 0; r < 16; ++r) { const int k2 = 64 * ch + 32 * kk + crow(r, hi); YF[(size_t)(k1 + 128 * k2) * 1024 + g * 128 + 32 * kb + r32] = (bf16)f2bf(Y[kk][r] * NORMF); }
    }
}
#ifndef PHMASK
#define PHMASK 0xffffffffu
#endif
#define PH(k) (((PHMASK) >> (k)) & 1u)
#ifndef PHREPM
#define PHREPM 0u
#endif
#define REP(k) _Pragma("unroll 1") for (int rep_ = 0; rep_ < (int)(1u + (((PHREPM) >> (k)) & 1u)); ++rep_)
struct Args { const float* in[18]; float* out; unsigned char* ws; };
__global__ void __launch_bounds__(NWAVES * 64, 2) enc_fwd(Args args) {
    extern __shared__ __attribute__((aligned(16))) unsigned char lds[];
    Frame F;
    F.lds = (LAS unsigned char*)lds;
    F.MISC = (volatile LAS unsigned*)(F.lds + MISC_OFF);
    F.tid = threadIdx.x; F.lane = F.tid & 63; F.wave = __builtin_amdgcn_readfirstlane(F.tid >> 6);
    F.G = gridDim.x; { const int bx = blockIdx.x; F.vcu = (F.G % 8 == 0) ? (bx % 8) * (F.G / 8) + bx / 8 : bx; }
    F.ws = args.ws;
    unsigned char* ws = args.ws;
    F.ctl = (gu32*)(ws + WS_CTL);
    In18 in;
#pragma unroll
    for (int i = 0; i < 18; ++i) in.p[i] = args.in[i];
    for (int u = F.tid; u < (LDS_BYTES - LDSCTL_OFF) / 4; u += NWAVES * 64) ((LAS unsigned*)(F.lds + LDSCTL_OFF))[u] = 0u;
    __syncthreads();
    XcdBarrier bar = xcd_barrier_post((unsigned*)(F.ctl + CW_BAR), F.MISC + 8);
#define GRID_BAR() xcd_barrier(bar)

    float* const xres = args.out;
    bf16* const HB = (bf16*)(ws + WS_H); bf16* const YB = (bf16*)(ws + WS_Y); bf16* const ACT = (bf16*)(ws + WS_ACT);
    bf16* const QB = (bf16*)(ws + WS_Q); bf16* const KB = (bf16*)(ws + WS_K); bf16* const VB = (bf16*)(ws + WS_V); bf16* const UB = (bf16*)(ws + WS_U);
    bf16* const GB = (bf16*)(ws + WS_GATE); float* const OB = (float*)(ws + WS_O);
    bf16* const TRE = (bf16*)(ws + WS_TRE); bf16* const TIM = (bf16*)(ws + WS_TIM);
    bf16* const YF = (bf16*)(ws + WS_YF); bf16* const AO = (bf16*)(ws + WS_AO); bf16* const MG = (bf16*)(ws + WS_MG); bf16* const TT = (bf16*)(ws + WS_TT);
    const float* const modf = (const float*)(ws + WS_MODF); const float* const lamv = (const float*)(ws + WS_LAM);
    const float* const cosT = (const float*)(ws + WS_COS); const float* const sinT = (const float*)(ws + WS_SIN);
    const bf16* const dftC = (const bf16*)(ws + WS_DFTC); const bf16* const dftS = (const bf16*)(ws + WS_DFTS); const float* const TW = (const float*)(ws + WS_TW);
#define MODF(l, s, k) (modf + (size_t)(((l) * 3 + (s)) * 3 + (k)) * DM)

    REP(0) if (PH(0)) p0_prologue(F, in);
    GRID_BAR();
    REP(1) if (PH(1)) p1_modfin(F, in);
    GRID_BAR();
    REP(2) if (PH(2)) norm_phase<false, true>(F, in.p[0], xres, nullptr, HB, nullptr, MODF(0, 0, 0), MODF(0, 0, 1));
    GRID_BAR();

    for (int l = 0; l < DEPTH; ++l) {
        const unsigned char* wl = ws + WS_W + (size_t)l * W_LAYER;
        { pg8::Gemm g{HB, (const bf16*)(wl + W_1IN), SEQ, 2 * FF, DM}; pg8::StaticOrder S; S.init(SEQ, 2 * FF, F.G, (int)blockIdx.x);
          pg8::EpiSwiGLU E{ACT, FF};
          REP(3) if (PH(3)) pg8::gemm_phase<pg8::EpiSwiGLU, pg8::StaticOrder, true, true>(F.lds + RING_OFF, g, S, E); GRID_BAR(); }
        { pg8::Gemm g{ACT, (const bf16*)(wl + W_1OUT), SEQ, DM, FF}; pg8::StaticOrder S; S.init(SEQ, DM, F.G, (int)blockIdx.x);
          pg8::EpiPlain E{YB, DM};
          REP(4) if (PH(4)) pg8::gemm_phase<pg8::EpiPlain, pg8::StaticOrder, true, true>(F.lds + RING_OFF, g, S, E); GRID_BAR(); }
        if (PH(5)) norm_phase<true, true>(F, xres, xres, YB, HB, MODF(l, 0, 2), MODF(l, 1, 0), MODF(l, 1, 1)); GRID_BAR();
        { pg8::Gemm g{HB, (const bf16*)(wl + W_MIX), SEQ, 8192, DM}; pg8::StaticOrder S; S.init(SEQ, 8192, F.G, (int)blockIdx.x);
          pg8::EpiMix E{QB, KB, VB, UB, GB, cosT, sinT, in.p[14] + (size_t)l * 4096};
          REP(6) if (PH(6)) pg8::gemm_phase<pg8::EpiMix, pg8::StaticOrder, true, true>(F.lds + RING_OFF, g, S, E); GRID_BAR(); }
        {
            const int xcd = F.vcu >> 5, j = F.vcu & 31;
            REP(7) if (!PH(7)) {} else if (F.G == 256) {
#pragma unroll 1
                for (int i = 0; i < 4; ++i) { const int vh = 2 * xcd + (i >> 1), qb = (i & 1) * 32 + j;
                    dattn::attn_unit(QB + (size_t)(qb * 256) * 1024 + vh * 64, KB + vh * 64, VB + (vh >> 1) * 128, OB + (size_t)(qb * 256) * 2048 + vh * 128, SEQ, (LAS char*)(F.lds + RING_OFF)); }
            } else {
#pragma unroll 1
                for (int un = F.vcu; un < 1024; un += F.G) { const int vh = un >> 6, qb = un & 63;
                    dattn::attn_unit(QB + (size_t)(qb * 256) * 1024 + vh * 64, KB + vh * 64, VB + (vh >> 1) * 128, OB + (size_t)(qb * 256) * 2048 + vh * 128, SEQ, (LAS char*)(F.lds + RING_OFF)); }
            }
            REP(8) if (PH(8)) fftA_phase(F, UB, TRE, TIM, dftC, dftS, TW);
            GRID_BAR();
        }
        REP(9) if (PH(9)) fftB_phase(F, TRE, TIM, YF, dftC, dftS);
        REP(10) if (PH(10)) combine_phase(F, OB, AO, in.p[10] + (size_t)l * 128, lamv[l], lamv[2 + l]);
        GRID_BAR();
        { pg8::Gemm g{AO, (const bf16*)(wl + W_AP), SEQ, DM, AW}; pg8::StaticOrder S; S.init(SEQ, DM, F.G, (int)blockIdx.x);
          pg8::EpiGate E{GB, nullptr, TT};
          REP(11) if (PH(11)) pg8::gemm_phase<pg8::EpiGate, pg8::StaticOrder, true, true>(F.lds + RING_OFF, g, S, E); GRID_BAR(); }
        { pg8::Gemm g{YF, (const bf16*)(wl + W_FP), SEQ, DM, FW}; pg8::StaticOrder S; S.init(SEQ, DM, F.G, (int)blockIdx.x);
          pg8::EpiGate E{GB + 2048, TT, MG};
          REP(12) if (PH(12)) pg8::gemm_phase<pg8::EpiGate, pg8::StaticOrder, true, true>(F.lds + RING_OFF, g, S, E); GRID_BAR(); }
        { pg8::Gemm g{MG, (const bf16*)(wl + W_MO), SEQ, DM, DM}; pg8::StaticOrder S; S.init(SEQ, DM, F.G, (int)blockIdx.x);
          pg8::EpiPlain E{YB, DM};
          REP(13) if (PH(13)) pg8::gemm_phase<pg8::EpiPlain, pg8::StaticOrder, true, true>(F.lds + RING_OFF, g, S, E); GRID_BAR(); }
        if (PH(14)) norm_phase<true, true>(F, xres, xres, YB, HB, MODF(l, 1, 2), MODF(l, 2, 0), MODF(l, 2, 1)); GRID_BAR();
        { pg8::Gemm g{HB, (const bf16*)(wl + W_2IN), SEQ, 2 * FF, DM}; pg8::StaticOrder S; S.init(SEQ, 2 * FF, F.G, (int)blockIdx.x);
          pg8::EpiSwiGLU E{ACT, FF};
          REP(15) if (PH(15)) pg8::gemm_phase<pg8::EpiSwiGLU, pg8::StaticOrder, true, true>(F.lds + RING_OFF, g, S, E); GRID_BAR(); }
        { pg8::Gemm g{ACT, (const bf16*)(wl + W_2OUT), SEQ, DM, FF}; pg8::StaticOrder S; S.init(SEQ, DM, F.G, (int)blockIdx.x);
          pg8::EpiPlain E{YB, DM};
          REP(16) if (PH(16)) pg8::gemm_phase<pg8::EpiPlain, pg8::StaticOrder, true, true>(F.lds + RING_OFF, g, S, E); GRID_BAR(); }
        if (l + 1 < DEPTH) { if (PH(17)) norm_phase<true, true>(F, xres, xres, YB, HB, MODF(l, 2, 2), MODF(l + 1, 0, 0), MODF(l + 1, 0, 1)); GRID_BAR(); }
        else if (PH(17)) norm_phase<true, false>(F, xres, xres, YB, nullptr, MODF(l, 2, 2), nullptr, nullptr);
    }
    if (blockIdx.x == 0 && F.wave == 0) { VM_WAIT(); if (__hip_atomic_load((gu32*)((unsigned*)(F.ctl + CW_BAR) + XB_TMO), RLX_AGENT) != 0u) { const float q = __builtin_nanf(""); for (int c = F.lane; c < DM; c += 64) xres[c] = q; } }
}

extern "C" void kernel_launch(void* const* d_in, const int* in_sizes, int n_in, void* d_out, int out_size, void* d_ws, size_t ws_size, hipStream_t stream) {
    static int grid = 0;
    if (grid == 0) {
        if (n_in != 18 || in_sizes[0] != SEQ * DM || out_size != SEQ * DM || ws_size < WS_END) { fprintf(stderr, "kernel_launch: unexpected shapes: n_in %d in0 %d out %d ws %zu (need %zu)\n", n_in, n_in > 0 ? in_sizes[0] : -1, out_size, ws_size, (size_t)WS_END); grid = -1; return; }
        int dev = 0, cus = 0, per_cu = 0;
        if (hipGetDevice(&dev) != hipSuccess || hipDeviceGetAttribute(&cus, hipDeviceAttributeMultiprocessorCount, dev) != hipSuccess) { grid = -1; return; }
        if (hipFuncSetAttribute((const void*)enc_fwd, hipFuncAttributeMaxDynamicSharedMemorySize, LDS_BYTES) != hipSuccess) { fprintf(stderr, "kernel_launch: hipFuncSetAttribute failed\n"); grid = -1; return; }
        if (hipOccupancyMaxActiveBlocksPerMultiprocessor(&per_cu, (const void*)enc_fwd, NWAVES * 64, LDS_BYTES) != hipSuccess || per_cu < 1) { fprintf(stderr, "kernel_launch: occupancy query reports %d blocks per CU\n", per_cu); }
        (void)hipGetLastError();
        grid = cus;
    }
    if (grid < 0) return;
#ifdef DBG_ZERO_WS
    if (hipMemsetAsync((char*)d_ws, 0, WS_END, stream) != hipSuccess) return;
#else
    if (hipMemsetAsync((char*)d_ws + WS_CTL, 0, CTL_ZERO_BYTES, stream) != hipSuccess) return;
#endif
    Args a{};
    for (int i = 0; i < 18; ++i) a.in[i] = (const float*)d_in[i];
    a.out = (float*)d_out; a.ws = (unsigned char*)d_ws;
    hipLaunchKernelGGL(enc_fwd, dim3(grid), dim3(NWAVES * 64), LDS_BYTES, stream, a);
    const hipError_t le = hipPeekAtLastError();
    if (le != hipSuccess) fprintf(stderr, "kernel_launch: launch failed: %s\n", hipGetErrorName(le));
}
```

```cpp
#include <hip/hip_runtime.h>
#include <hip/hip_bf16.h>
#include <cstdio>
#include <cstdint>
#include <cmath>
namespace pg8 {
#define PG8_LAS __attribute__((address_space(3)))
typedef unsigned short bf16_t;
typedef short bf16x8 __attribute__((ext_vector_type(8)));
typedef float f32x4 __attribute__((ext_vector_type(4)));
typedef unsigned u32x4 __attribute__((ext_vector_type(4)));
constexpr int BM = 256, BK = 64, HALF = 128, HTB = HALF * BK * 2  , STAGE_BYTES = 8 * HTB, NXCD = 8, WGM = 8;

__host__ __device__ __forceinline__ int lds_byte(int r, int c) { const int st = (r >> 4) * 2 + (c >> 5), rr = r & 15, cc = c & 31, ob = rr * 64 + cc * 2; return st * 1024 + (ob ^ (((ob >> 9) & 1) << 5)); }
__host__ __device__ __forceinline__ void stage_rc(int b, int& R, int& C) { const int st = b / 1024, sb = b % 1024, swz = sb ^ (((sb >> 9) & 1) << 5); R = (st >> 1) * 16 + swz / 64; C = (st & 1) * 32 + (swz % 64) / 2; }
__host__ __device__ __forceinline__ int perm32(int rho) { const int n = rho >> 4, i = rho & 15; return 8 * (i >> 2) + 4 * n + (i & 3); }

struct Unit { int pm, pn; };
struct Gemm { const bf16_t* A; const bf16_t* Bt; int M, N, K; };

struct StaticOrder {
    int nM, nN, nwg, G, c;
    __host__ __device__ void init(int M, int N, int G_, int c_) { nM = M / BM; nN = N / BM; nwg = nM * nN; G = G_; c = c_; }
    __host__ __device__ bool next(int i, Unit& u) const {
        const long L = (long)i * G + c; if (L >= nwg) return false;
        int wgid = (int)L; { const int q = nwg / NXCD, r = nwg % NXCD, xcd = wgid % NXCD, off = wgid / NXCD; wgid = (xcd < r ? xcd * (q + 1) : r * (q + 1) + (xcd - r) * q) + off; }
        const int nig = WGM * nN, gid = wgid / nig, fm = gid * WGM, gsz = (nM - fm) < WGM ? (nM - fm) : WGM;
        u.pm = fm + ((wgid % nig) % gsz); u.pn = (wgid % nig) / gsz; return true;
    }
    __device__ __forceinline__ void a_ready(const Unit&) const {}
    __device__ __forceinline__ void done(const Unit&) const {}
};

typedef float cvt_f32x2 __attribute__((ext_vector_type(2))); typedef __bf16 cvt_bf16x2 __attribute__((ext_vector_type(2)));
__device__ __forceinline__ unsigned cvt_pk_bf16(float lo, float hi) { const cvt_f32x2 v = {lo, hi}; return __builtin_bit_cast(unsigned, __builtin_convertvector(v, cvt_bf16x2)); }
typedef float f32x2 __attribute__((ext_vector_type(2)));
__device__ __forceinline__ float bf_lo(unsigned w) { return __builtin_bit_cast(float, w << 16); }
__device__ __forceinline__ float bf_hi(unsigned w) { return __builtin_bit_cast(float, w & 0xffff0000u); }
__device__ __forceinline__ float sigmoid_f(float v) { return __builtin_amdgcn_rcpf(1.0f + __builtin_amdgcn_exp2f(v * -1.4426950408889634f)); }
__device__ __forceinline__ u32x4 pack8(const f32x4 a, const f32x4 b) { u32x4 w; w.x = cvt_pk_bf16(a[0], a[1]); w.y = cvt_pk_bf16(a[2], a[3]); w.z = cvt_pk_bf16(b[0], b[1]); w.w = cvt_pk_bf16(b[2], b[3]); return w; }

struct EpiPlain {
    static constexpr bool PERM = true, AFTER_DRAIN = false; static constexpr int NST = 16;
    bf16_t* O; int ldc;
    __device__ __forceinline__ void operator()(const f32x4 (&acc)[2][2][4][2], const Unit& u, int wr, int wc, int fr, int fq) const {
        const int row0 = u.pm * BM + wr * 64 + fr, col0 = u.pn * BM + wc * 32 + 8 * fq;
#pragma unroll
        for (int ai = 0; ai < 2; ++ai)
#pragma unroll
            for (int m = 0; m < 4; ++m) { bf16_t* rowp = O + (size_t)(row0 + ai * HALF + m * 16) * ldc + col0;
#pragma unroll
                for (int bj = 0; bj < 2; ++bj) *(u32x4*)(rowp + bj * HALF) = pack8(acc[ai][bj][m][0], acc[ai][bj][m][1]); }
    }
};
struct EpiSwiGLU {
    static constexpr bool PERM = true, AFTER_DRAIN = false; static constexpr int NST = 8;
    bf16_t* O; int ldc;
    __device__ __forceinline__ void operator()(const f32x4 (&acc)[2][2][4][2], const Unit& u, int wr, int wc, int fr, int fq) const {
        const int row0 = u.pm * BM + wr * 64 + fr, col0 = u.pn * HALF + wc * 32 + 8 * fq;
#pragma unroll
        for (int ai = 0; ai < 2; ++ai)
#pragma unroll
            for (int m = 0; m < 4; ++m) { bf16_t* rowp = O + (size_t)(row0 + ai * HALF + m * 16) * ldc + col0;
                f32x4 o[2];
#pragma unroll
                for (int n = 0; n < 2; ++n) { const f32x4 g = acc[ai][0][m][n], up = acc[ai][1][m][n];
#pragma unroll
                    for (int e = 0; e < 4; ++e) o[n][e] = g[e] * sigmoid_f(g[e]) * up[e]; }
                *(u32x4*)rowp = pack8(o[0], o[1]); }
    }
};
struct EpiMix {
    static constexpr bool PERM = true, AFTER_DRAIN = false; static constexpr int NST = 16;
    bf16_t *Q, *K, *V, *U, *G; const float* cosT; const float* sinT; const float* gbias;
    __device__ __forceinline__ void operator()(const f32x4 (&acc)[2][2][4][2], const Unit& u, int wr, int wc, int fr, int fq) const {
        const int pn = u.pn, row0 = u.pm * BM + wr * 64 + fr;
        if (pn < 8) {
            bf16_t* base = (pn < 4 ? Q : K) + ((pn & 3) * 4 + wc) * 64 + 8 * fq;
            const float qs = pn < 4 ? 0.18033688011112042f : 1.0f;
#pragma unroll
            for (int ai = 0; ai < 2; ++ai) {
                f32x4 cc[4][2], ss[4][2];
#pragma unroll
                for (int m = 0; m < 4; ++m) { const int row = row0 + ai * HALF + m * 16;
                    cc[m][0] = *(const f32x4*)(cosT + (size_t)row * 32 + 8 * fq); cc[m][1] = *(const f32x4*)(cosT + (size_t)row * 32 + 8 * fq + 4);
                    ss[m][0] = *(const f32x4*)(sinT + (size_t)row * 32 + 8 * fq); ss[m][1] = *(const f32x4*)(sinT + (size_t)row * 32 + 8 * fq + 4); }
#pragma unroll
                for (int m = 0; m < 4; ++m) { const int row = row0 + ai * HALF + m * 16;
                    const f32x4 c0 = cc[m][0], c1 = cc[m][1], s0 = ss[m][0], s1 = ss[m][1];
                    const f32x4 x1a = acc[ai][0][m][0], x1b = acc[ai][0][m][1], x2a = acc[ai][1][m][0], x2b = acc[ai][1][m][1];
                    const f32x4 o1a = (x1a * c0 - x2a * s0) * qs, o1b = (x1b * c1 - x2b * s1) * qs, o2a = (x2a * c0 + x1a * s0) * qs, o2b = (x2b * c1 + x1b * s1) * qs;
                    bf16_t* rowp = base + (size_t)row * 1024;
                    *(u32x4*)rowp = pack8(o1a, o1b); *(u32x4*)(rowp + 32) = pack8(o2a, o2b); }
            }
        } else if (pn < 16) {
            bf16_t* base = (pn < 12 ? V : U) + (pn & 3) * BM + wc * 32 + 8 * fq;
#pragma unroll
            for (int ai = 0; ai < 2; ++ai)
#pragma unroll
                for (int m = 0; m < 4; ++m) { bf16_t* rowp = base + (size_t)(row0 + ai * HALF + m * 16) * 1024;
#pragma unroll
                    for (int bj = 0; bj < 2; ++bj) *(u32x4*)(rowp + bj * HALF) = pack8(acc[ai][bj][m][0], acc[ai][bj][m][1]); }
        } else {
            const int col0 = (pn - 16) * BM + wc * 32 + 8 * fq;
            f32x4 bv[2][2];
#pragma unroll
            for (int bj = 0; bj < 2; ++bj)
#pragma unroll
                for (int n = 0; n < 2; ++n) bv[bj][n] = *(const f32x4*)(gbias + col0 + bj * HALF + 4 * n);
#pragma unroll
            for (int ai = 0; ai < 2; ++ai)
#pragma unroll
                for (int m = 0; m < 4; ++m) { bf16_t* rowp = G + (size_t)(row0 + ai * HALF + m * 16) * 4096 + col0;
#pragma unroll
                    for (int bj = 0; bj < 2; ++bj) { f32x4 o[2];
#pragma unroll
                        for (int n = 0; n < 2; ++n) { const f32x4 v = acc[ai][bj][m][n] + bv[bj][n];
#pragma unroll
                            for (int e = 0; e < 4; ++e) o[n][e] = sigmoid_f(v[e]); }
                        *(u32x4*)(rowp + bj * HALF) = pack8(o[0], o[1]); } }
        }
    }
};
struct EpiGate {
    static constexpr bool PERM = true, AFTER_DRAIN = false; static constexpr int NST = 16;
    const bf16_t* gate; const bf16_t* addend; bf16_t* O;
    __device__ __forceinline__ void operator()(const f32x4 (&acc)[2][2][4][2], const Unit& u, int wr, int wc, int fr, int fq) const {
        const int row0 = u.pm * BM + wr * 64 + fr, col0 = u.pn * BM + wc * 32 + 8 * fq;
#pragma unroll
        for (int ai = 0; ai < 2; ++ai) {
            u32x4 gw[4][2], tw[4][2];
#pragma unroll
            for (int m = 0; m < 4; ++m)
#pragma unroll
                for (int bj = 0; bj < 2; ++bj) { const size_t row = (size_t)(row0 + ai * HALF + m * 16);
                    gw[m][bj] = *(const u32x4*)(gate + row * 4096 + col0 + bj * HALF);
                    if (addend) tw[m][bj] = *(const u32x4*)(addend + row * 2048 + col0 + bj * HALF); }
#pragma unroll
            for (int m = 0; m < 4; ++m)
#pragma unroll
                for (int bj = 0; bj < 2; ++bj) { const size_t row = (size_t)(row0 + ai * HALF + m * 16); const u32x4 g = gw[m][bj];
                    f32x4 a = acc[ai][bj][m][0], b = acc[ai][bj][m][1];
                    a[0] *= bf_lo(g.x); a[1] *= bf_hi(g.x); a[2] *= bf_lo(g.y); a[3] *= bf_hi(g.y); b[0] *= bf_lo(g.z); b[1] *= bf_hi(g.z); b[2] *= bf_lo(g.w); b[3] *= bf_hi(g.w);
                    if (addend) { const u32x4 t = tw[m][bj];
                        a[0] += bf_lo(t.x); a[1] += bf_hi(t.x); a[2] += bf_lo(t.y); a[3] += bf_hi(t.y); b[0] += bf_lo(t.z); b[1] += bf_hi(t.z); b[2] += bf_lo(t.w); b[3] += bf_hi(t.w); }
                    *(u32x4*)(O + row * 2048 + col0 + bj * HALF) = pack8(a, b); }
        }
    }
};

template <class Epi, class Sched, bool ALIGN_EPI = false, bool SP2 = false>
__device__ __forceinline__ void gemm_phase(PG8_LAS unsigned char* lds, const Gemm g, const Sched& S, const Epi& E) {
    int tid = threadIdx.x; asm volatile("" : "+v"(tid));
    const int wid = __builtin_amdgcn_readfirstlane(tid >> 6), lane = tid & 63, wr = wid >> 2, wc = wid & 3, fr = lane & 15, fq = lane >> 4;
    const int K = g.K, nt = K / BK;
    unsigned voffA[2], voffB[2];
#pragma unroll
    for (int i = 0; i < 2; ++i) { int R, C; stage_rc(tid * 16 + i * 8192, R, C); const int Rb = Epi::PERM ? ((R & ~31) + perm32(R & 31)) : R;
        voffA[i] = (unsigned)(R * K + C) * 2u; voffB[i] = (unsigned)(Rb * K + C) * 2u; }
    const size_t kstep = (size_t)(BK * 2);
    const size_t hstep = (size_t)HALF * K * 2;
    const size_t tstep = 2 * hstep;
    const unsigned ldsw = (unsigned)wid * 1024u;
    const int aoff = lds_byte(wr * 64 + fr, fq * 8), boff = lds_byte(wc * 32 + fr, fq * 8);
#define PG8_SA(b, h) (((b) * 2 + (h)) * HTB)
#define PG8_SB(b, h) ((4 + (b) * 2 + (h)) * HTB)
#define PG8_STAGE(bufoff, gbase, voff) do { _Pragma("unroll") for (int _i = 0; _i < 2; ++_i) \
        __builtin_amdgcn_global_load_lds((const unsigned*)((const char*)(gbase) + (voff)[_i]), (PG8_LAS unsigned*)(lds + (bufoff) + ldsw + _i * 8192), 16, 0, 0); } while (0)
#define PG8_LDA(dst, b, h) do { _Pragma("unroll") for (int m = 0; m < 4; ++m) _Pragma("unroll") for (int k = 0; k < 2; ++k) dst[m][k] = *(const PG8_LAS bf16x8*)(lds + PG8_SA(b, h) + aoff + m * 2048 + k * 1024); } while (0)
#define PG8_LDB(dst, b, h) do { _Pragma("unroll") for (int n = 0; n < 2; ++n) _Pragma("unroll") for (int k = 0; k < 2; ++k) dst[n][k] = *(const PG8_LAS bf16x8*)(lds + PG8_SB(b, h) + boff + n * 2048 + k * 1024); } while (0)
#define PG8_MMA(ai, bj, At, Bt) do { __builtin_amdgcn_s_setprio(1); _Pragma("unroll") for (int m = 0; m < 4; ++m) _Pragma("unroll") for (int n = 0; n < 2; ++n) _Pragma("unroll") for (int k = 0; k < 2; ++k) \
        acc[ai][bj][m][n] = __builtin_amdgcn_mfma_f32_16x16x32_bf16(Bt[n][k], At[m][k], acc[ai][bj][m][n], 0, 0, 0); __builtin_amdgcn_s_setprio(0); } while (0)
#define PG8_WAIT_V(n) asm volatile("s_waitcnt vmcnt(" #n ")" ::: "memory")
#define PG8_WAIT_L(n) asm volatile("s_waitcnt lgkmcnt(" #n ")" ::: "memory")
#define PG8_BAR __builtin_amdgcn_s_barrier()
#define PG8_SCHED __builtin_amdgcn_sched_barrier(0)
    Unit cur, nxt; int ui = 0;
    if (!S.next(0, cur)) return;
    f32x4 acc[2][2][4][2];
#pragma unroll
    for (int a = 0; a < 2; ++a)
#pragma unroll
        for (int b = 0; b < 2; ++b)
#pragma unroll
            for (int m = 0; m < 4; ++m)
#pragma unroll
                for (int n = 0; n < 2; ++n) acc[a][b][m][n] = (f32x4){0.f, 0.f, 0.f, 0.f};
    bf16x8 At[4][2], B0[2][2], B1[2][2];
    const char* cA = (const char*)g.A + (size_t)cur.pm * tstep; const char* cB = (const char*)g.Bt + (size_t)cur.pn * tstep;
    S.a_ready(cur);
    if constexpr (SP2) {
        PG8_STAGE(PG8_SB(0, 0), cB, voffB); PG8_STAGE(PG8_SB(0, 1), cB + hstep, voffB); PG8_STAGE(PG8_SA(0, 0), cA, voffA); PG8_STAGE(PG8_SA(0, 1), cA + hstep, voffA);
        if (wr == 1) PG8_BAR;
        PG8_WAIT_V(2); PG8_BAR;
        PG8_STAGE(PG8_SB(1, 0), cB + kstep, voffB); PG8_STAGE(PG8_SA(1, 0), cA + kstep, voffA); PG8_STAGE(PG8_SB(1, 1), cB + hstep + kstep, voffB);
        PG8_WAIT_V(6); PG8_BAR;
    } else {
        PG8_STAGE(PG8_SB(0, 0), cB, voffB); PG8_STAGE(PG8_SA(0, 0), cA, voffA); PG8_STAGE(PG8_SB(0, 1), cB + hstep, voffB); PG8_STAGE(PG8_SA(0, 1), cA + hstep, voffA);
        if (wr == 1) PG8_BAR;
        PG8_WAIT_V(4); PG8_BAR;
        PG8_STAGE(PG8_SB(1, 0), cB + kstep, voffB); PG8_STAGE(PG8_SA(1, 0), cA + kstep, voffA); PG8_STAGE(PG8_SB(1, 1), cB + hstep + kstep, voffB);
        PG8_WAIT_V(6); PG8_BAR;
    }
    for (;;) {
        const bool has_next = S.next(ui + 1, nxt);
        const char* nA = has_next ? (const char*)g.A + (size_t)nxt.pm * tstep : cA; const char* nB = has_next ? (const char*)g.Bt + (size_t)nxt.pn * tstep : cB;
        for (int t = 0; t < nt; t += 2) {
            const bool last = (t == nt - 2);
            const char* a1 = cA + (size_t)(t + 1) * kstep;
            const char* a2 = last ? nA : cA + (size_t)(t + 2) * kstep; const char* b2 = last ? nB : cB + (size_t)(t + 2) * kstep;
            const char* a3 = a2 + kstep; const char* b3 = b2 + kstep;
            if (last && has_next) S.a_ready(nxt);
            if constexpr (SP2) {
            PG8_LDB(B0, 0, 0); PG8_LDB(B1, 0, 1); PG8_SCHED; PG8_LDA(At, 0, 0); PG8_STAGE(PG8_SA(1, 1), a1 + hstep, voffA);
            PG8_WAIT_V(8); PG8_WAIT_L(0); PG8_BAR; PG8_MMA(0, 0, At, B0); PG8_MMA(0, 1, At, B1); PG8_BAR; PG8_SCHED;
            PG8_LDA(At, 0, 1); PG8_STAGE(PG8_SB(0, 0), b2, voffB); PG8_STAGE(PG8_SB(0, 1), b2 + hstep, voffB); PG8_STAGE(PG8_SA(0, 0), a2, voffA);
            PG8_WAIT_V(8); PG8_WAIT_L(0); PG8_BAR; PG8_MMA(1, 0, At, B0); PG8_MMA(1, 1, At, B1); PG8_BAR; PG8_SCHED;
            PG8_LDB(B0, 1, 0); PG8_LDB(B1, 1, 1); PG8_SCHED; PG8_LDA(At, 1, 0); PG8_STAGE(PG8_SA(0, 1), a2 + hstep, voffA);
            PG8_WAIT_V(8); PG8_WAIT_L(0); PG8_BAR; PG8_MMA(0, 0, At, B0); PG8_MMA(0, 1, At, B1); PG8_BAR; PG8_SCHED;
            PG8_LDA(At, 1, 1); PG8_STAGE(PG8_SB(1, 0), b3, voffB); PG8_STAGE(PG8_SB(1, 1), b3 + hstep, voffB); PG8_STAGE(PG8_SA(1, 0), a3, voffA);
            PG8_WAIT_V(8); PG8_WAIT_L(0); PG8_BAR; PG8_MMA(1, 0, At, B0); PG8_MMA(1, 1, At, B1); PG8_BAR; PG8_SCHED;
            } else {
            PG8_LDB(B0, 0, 0); PG8_SCHED; PG8_LDA(At, 0, 0); PG8_STAGE(PG8_SA(1, 1), a1 + hstep, voffA);
            PG8_WAIT_L(8); PG8_BAR; PG8_WAIT_L(0); PG8_MMA(0, 0, At, B0); PG8_BAR; PG8_SCHED;
            PG8_LDB(B1, 0, 1); PG8_STAGE(PG8_SB(0, 0), b2, voffB);
            PG8_BAR; PG8_WAIT_L(0); PG8_MMA(0, 1, At, B1); PG8_BAR;
            PG8_LDA(At, 0, 1); PG8_STAGE(PG8_SA(0, 0), a2, voffA);
            PG8_BAR; PG8_WAIT_L(0); PG8_MMA(1, 0, At, B0); PG8_BAR; PG8_SCHED;
            PG8_STAGE(PG8_SB(0, 1), b2 + hstep, voffB);
            PG8_WAIT_V(6); PG8_BAR; PG8_MMA(1, 1, At, B1); PG8_BAR;
            PG8_LDB(B0, 1, 0); PG8_SCHED; PG8_LDA(At, 1, 0); PG8_STAGE(PG8_SA(0, 1), a2 + hstep, voffA);
            PG8_WAIT_L(8); PG8_BAR; PG8_WAIT_L(0); PG8_MMA(0, 0, At, B0); PG8_BAR; PG8_SCHED;
            PG8_LDB(B1, 1, 1); PG8_STAGE(PG8_SB(1, 0), b3, voffB);
            PG8_BAR; PG8_WAIT_L(0); PG8_MMA(0, 1, At, B1); PG8_BAR;
            PG8_LDA(At, 1, 1); PG8_STAGE(PG8_SA(1, 0), a3, voffA);
            PG8_BAR; PG8_WAIT_L(0); PG8_MMA(1, 0, At, B0); PG8_BAR; PG8_SCHED;
            PG8_STAGE(PG8_SB(1, 1), b3 + hstep, voffB);
            PG8_WAIT_V(6); PG8_BAR; PG8_MMA(1, 1, At, B1); PG8_BAR;
            }
        }
        if constexpr (ALIGN_EPI) { if (wr == 0) PG8_BAR; }
        if constexpr (!Epi::AFTER_DRAIN) { E(acc, cur, wr, wc, fr, fq); S.done(cur); }
        if (!has_next) break;
#pragma unroll
        for (int a = 0; a < 2; ++a)
#pragma unroll
            for (int b = 0; b < 2; ++b)
#pragma unroll
                for (int m = 0; m < 4; ++m)
#pragma unroll
                    for (int n = 0; n < 2; ++n) acc[a][b][m][n] = (f32x4){0.f, 0.f, 0.f, 0.f};
        cur = nxt; cA = nA; cB = nB; ++ui;
        if constexpr (ALIGN_EPI) { if (wr == 1) PG8_BAR; }
    }
    PG8_WAIT_V(0);
    if constexpr (!ALIGN_EPI) { if (wr == 0) PG8_BAR; }
    PG8_BAR;
    if constexpr (Epi::AFTER_DRAIN) { E.fused(acc, cur, wr, wc, fr, fq, lds, wid, lane); S.done(cur); }
#undef PG8_SA
#undef PG8_SB
#undef PG8_STAGE
#undef PG8_LDA
#undef PG8_LDB
#undef PG8_MMA
#undef PG8_WAIT_V
#undef PG8_WAIT_L
#undef PG8_BAR
#undef PG8_SCHED
}
}
namespace dattn {
#define DA_LAS __attribute__((address_space(3)))
typedef unsigned short bf16_t;
using bf16x8 = __attribute__((ext_vector_type(8))) short;
using s16x4  = __attribute__((ext_vector_type(4))) short;
using f32x16 = __attribute__((ext_vector_type(16))) float;
using u32x4  = __attribute__((ext_vector_type(4))) unsigned;
constexpr int NW = 8, QBLK = 32, KVBLK = 64, PITCH = 1024, LDO = 2048;
constexpr float SCALE = 0.125f;
constexpr float THR = 8.f;
constexpr int SHM_V = KVBLK * 128 * 2, SHM_K = KVBLK * 64 * 2;
constexpr int NSLOT = 3, OFF_V = 0, OFF_K = NSLOT * SHM_V, OFF_WS = NSLOT * (SHM_V + SHM_K), LDS_BYTES = OFF_WS + NW * 64 * 4;
#define DA_KSWZ(row, colB) ((row) * 128 + ((colB) ^ ((((row) >> 1) & 7) << 4)))
#define DA_SBAR() __builtin_amdgcn_sched_barrier(0)
__device__ __forceinline__ int crow(int r, int hi) { return (r & 3) + 8 * (r >> 2) + 4 * hi; }
typedef float cvt_f32x2 __attribute__((ext_vector_type(2))); typedef __bf16 cvt_bf16x2 __attribute__((ext_vector_type(2)));
__device__ __forceinline__ unsigned cvtpk(float lo, float hi) { const cvt_f32x2 v = {lo, hi}; return __builtin_bit_cast(unsigned, __builtin_convertvector(v, cvt_bf16x2)); }
#ifdef DA_THR2_TEST
constexpr float THR2 = DA_THR2_TEST;
#else
constexpr float THR2 = THR * 1.4426950408889634f;
#endif
__device__ __forceinline__ void glds16s(const void* sbase, unsigned voff, unsigned lds_dst) { unsigned keep;
  asm volatile("s_mov_b32 %0, m0\n\ts_mov_b32 m0, %3\n\ts_nop 0\n\tglobal_load_lds_dwordx4 %1, %2\n\ts_mov_b32 m0, %0" : "=&s"(keep) : "v"(voff), "s"(sbase), "s"(lds_dst) : "memory"); }
#define DA_WAIT_BAR(N) do { __builtin_amdgcn_sched_barrier(0); asm volatile("s_waitcnt vmcnt(" #N ") lgkmcnt(0)\n\ts_barrier" ::: "memory"); __builtin_amdgcn_sched_barrier(0); } while (0)
__device__ __forceinline__ int v_st(int k, int c) { const int kk = (k & ~0xC) | ((k & 4) << 1) | ((k & 8) >> 1); return ((kk >> 3) * 4 + (c >> 5)) * 512 + ((kk & 7) * 32 + (c & 31)) * 2; }
__device__ __forceinline__ int v_rd_base(int lane) { return ((lane & 3) << 3) | (((lane >> 2) & 3) << 6) | (((lane >> 4) & 1) << 5) | (((lane >> 5) & 1) << 8); }
constexpr int v_rd_off(int d0, int ks, int half) { return d0 * 512 + ks * 4096 + half * 2048; }
template <int OFF> __device__ __forceinline__ s16x4 tr_read(int vb) {
  s16x4 r; asm volatile("ds_read_b64_tr_b16 %0, %1 offset:%2" : "=&v"(r) : "v"(vb), "i"(OFF) : "memory"); return r;
}
#define DA_PK(L, H) (bf16x8){L[0], L[1], L[2], L[3], H[0], H[1], H[2], H[3]}
#define DA_LGKM(N) do { asm volatile("s_waitcnt lgkmcnt(" #N ")" ::: "memory"); DA_SBAR(); } while (0)
template <int OFF> __device__ __forceinline__ bf16x8 lds_rd128(int a) { bf16x8 r; asm volatile("ds_read_b128 %0, %1 offset:%2" : "=&v"(r) : "v"(a), "i"(OFF) : "memory"); return r; }
typedef float f32x4a __attribute__((ext_vector_type(4)));
typedef unsigned v2u16 __attribute__((ext_vector_type(2)));
struct KPre16 { bf16x8 k[4][2]; };
__device__ __forceinline__ void prefetch_k16(KPre16& P, int kbase, int fr, int fq) {
  const int sw = ((fr >> 1) & 7) << 4, a0 = kbase + fr * 128 + ((16 * fq) ^ sw), a1 = kbase + fr * 128 + ((64 + 16 * fq) ^ sw);
  P.k[0][0] = lds_rd128<0>(a0); P.k[1][0] = lds_rd128<2048>(a0); P.k[2][0] = lds_rd128<4096>(a0); P.k[3][0] = lds_rd128<6144>(a0);
  P.k[0][1] = lds_rd128<0>(a1); P.k[1][1] = lds_rd128<2048>(a1); P.k[2][1] = lds_rd128<4096>(a1); P.k[3][1] = lds_rd128<6144>(a1);
}
__device__ __forceinline__ float xfq_max(float v) {
  auto r = __builtin_amdgcn_permlane16_swap(__float_as_uint(v), __float_as_uint(v), false, false); v = fmaxf(__uint_as_float(r[0]), __uint_as_float(r[1]));
  auto q = __builtin_amdgcn_permlane32_swap(__float_as_uint(v), __float_as_uint(v), false, false); return fmaxf(__uint_as_float(q[0]), __uint_as_float(q[1]));
}
__device__ __forceinline__ float xfq_sum(float v) {
  auto r = __builtin_amdgcn_permlane16_swap(__float_as_uint(v), __float_as_uint(v), false, false); v = __uint_as_float(r[0]) + __uint_as_float(r[1]);
  auto q = __builtin_amdgcn_permlane32_swap(__float_as_uint(v), __float_as_uint(v), false, false); return __uint_as_float(q[0]) + __uint_as_float(q[1]);
}
template <bool SAFE>
__device__ __forceinline__ void softmax16(f32x4a (&s)[2][4], float (&mhat)[2], bool first, float (&alpha)[2], bf16x8 (&pa)[2][2]) {
  if (SAFE) {
    float lm[2];
#pragma unroll
    for (int qb = 0; qb < 2; ++qb) { float m = fmaxf(s[qb][0][0], s[qb][0][1]);
#pragma unroll
      for (int kb = 0; kb < 4; ++kb)
#pragma unroll
        for (int j = (kb == 0 ? 2 : 0); j < 4; ++j) m = fmaxf(m, s[qb][kb][j]);
      lm[qb] = m; alpha[qb] = 1.f; }
    if (__builtin_expect(first || __any(mhat[0] != 0.f || mhat[1] != 0.f || fmaxf(lm[0], lm[1]) > THR2), 0)) {
#pragma unroll
      for (int qb = 0; qb < 2; ++qb) { const float ex = xfq_max(lm[qb]) - mhat[qb]; float dl = 0.f;
        if (first) { if (ex > THR2 || ex < -THR2) dl = ex; } else if (ex > THR2) dl = ex;
        mhat[qb] += dl;
#pragma unroll
        for (int kb = 0; kb < 4; ++kb) s[qb][kb] -= mhat[qb];
        alpha[qb] = first ? 1.f : __builtin_amdgcn_exp2f(-dl); }
    }
  }
#pragma unroll
  for (int qb = 0; qb < 2; ++qb) {
#pragma unroll
    for (int kb = 0; kb < 4; ++kb)
#pragma unroll
      for (int j = 0; j < 4; ++j) s[qb][kb][j] = __builtin_amdgcn_exp2f(s[qb][kb][j]);
#pragma unroll
    for (int g = 0; g < 2; ++g) { const u32x4 w = {cvtpk(s[qb][2 * g][0], s[qb][2 * g][1]), cvtpk(s[qb][2 * g][2], s[qb][2 * g][3]), cvtpk(s[qb][2 * g + 1][0], s[qb][2 * g + 1][1]), cvtpk(s[qb][2 * g + 1][2], s[qb][2 * g + 1][3])};
      pa[qb][g] = __builtin_bit_cast(bf16x8, w); }
  }
}
#define DA_W16(N) do { asm volatile("s_waitcnt lgkmcnt(" #N ")" ::: "memory"); DA_SBAR(); } while (0)
#define DA_RF16(J) do { vl[(J) & 7] = tr_read<8192 * ((J) >> 3)>(va[(J) & 7]); vh[(J) & 7] = tr_read<8192 * ((J) >> 3) + 4096>(va[(J) & 7]); DA_SBAR(); } while (0)
#define DA_PV16(J) do { const bf16x8 vf_ = DA_PK(vl[(J) & 7], vh[(J) & 7]); \
    o[0][(J) & 7] = __builtin_amdgcn_mfma_f32_16x16x32_bf16(vf_, pa[0][(J) >> 3], o[0][(J) & 7], 0, 0, 0); o[1][(J) & 7] = __builtin_amdgcn_mfma_f32_16x16x32_bf16(vf_, pa[1][(J) >> 3], o[1][(J) & 7], 0, 0, 0); } while (0)
struct NoDma16 { __device__ __forceinline__ void operator()() const {} };
template <bool HAS_QK, bool HAS_PV, class DMA = NoDma16>
__device__ __forceinline__ void m_seg16(f32x4a (&s)[2][4], KPre16& P, const bf16x8 (&qf)[2][2], f32x4a (&o)[2][8], f32x4a (&lacc)[2], const bf16x8& ones, const int (&va)[8], const bf16x8 (&pa)[2][2], DMA dma = NoDma16()) {
  s16x4 vl[8], vh[8];
  __builtin_amdgcn_s_setprio(2);
  if (HAS_QK) {
    const f32x4a z = {0.f, 0.f, 0.f, 0.f};
#define DA_QK16(KB, KS) do { s[0][KB] = __builtin_amdgcn_mfma_f32_16x16x32_bf16(P.k[KB][KS], qf[0][KS], (KS) == 0 ? z : s[0][KB], 0, 0, 0); \
    s[1][KB] = __builtin_amdgcn_mfma_f32_16x16x32_bf16(P.k[KB][KS], qf[1][KS], (KS) == 0 ? z : s[1][KB], 0, 0, 0); } while (0)
    DA_QK16(0, 0); dma(); DA_SBAR(); if (HAS_PV) DA_RF16(0); DA_QK16(1, 0); if (HAS_PV) DA_RF16(1); DA_QK16(2, 0); if (HAS_PV) DA_RF16(2); DA_QK16(3, 0); if (HAS_PV) DA_RF16(3);
    DA_QK16(0, 1); if (HAS_PV) DA_RF16(4); DA_QK16(1, 1); if (HAS_PV) DA_RF16(5); DA_QK16(2, 1); if (HAS_PV) DA_RF16(6); DA_QK16(3, 1); DA_SBAR();
#undef DA_QK16
  } else if (HAS_PV) { DA_RF16(0); DA_RF16(1); DA_RF16(2); DA_RF16(3); DA_RF16(4); DA_RF16(5); DA_RF16(6); }
  if (HAS_PV) {
    lacc[0] = __builtin_amdgcn_mfma_f32_16x16x32_bf16(ones, pa[0][0], lacc[0], 0, 0, 0); lacc[1] = __builtin_amdgcn_mfma_f32_16x16x32_bf16(ones, pa[1][0], lacc[1], 0, 0, 0);
    lacc[0] = __builtin_amdgcn_mfma_f32_16x16x32_bf16(ones, pa[0][1], lacc[0], 0, 0, 0); lacc[1] = __builtin_amdgcn_mfma_f32_16x16x32_bf16(ones, pa[1][1], lacc[1], 0, 0, 0);
    DA_SBAR();
    DA_W16(12); DA_PV16(0); DA_RF16(7);   DA_W16(12); DA_PV16(1); DA_RF16(8);   DA_W16(12); DA_PV16(2); DA_RF16(9);   DA_W16(12); DA_PV16(3); DA_RF16(10);
    DA_W16(12); DA_PV16(4); DA_RF16(11);  DA_W16(12); DA_PV16(5); DA_RF16(12);  DA_W16(12); DA_PV16(6); DA_RF16(13);  DA_W16(12); DA_PV16(7); DA_RF16(14);
    DA_W16(12); DA_PV16(8); DA_RF16(15);  DA_W16(12); DA_PV16(9); DA_SBAR();    DA_W16(10); DA_PV16(10); DA_SBAR();   DA_W16(8); DA_PV16(11); DA_SBAR();
    DA_W16(6); DA_PV16(12); DA_SBAR();    DA_W16(4); DA_PV16(13); DA_SBAR();    DA_W16(2); DA_PV16(14); DA_SBAR();    DA_W16(0); DA_PV16(15);
    asm volatile("" : "+v"(o[0][0]), "+v"(o[0][1]), "+v"(o[0][2]), "+v"(o[0][3]), "+v"(o[0][4]), "+v"(o[0][5]), "+v"(o[0][6]), "+v"(o[0][7]));
    asm volatile("" : "+v"(o[1][0]), "+v"(o[1][1]), "+v"(o[1][2]), "+v"(o[1][3]), "+v"(o[1][4]), "+v"(o[1][5]), "+v"(o[1][6]), "+v"(o[1][7]));
    asm volatile("" : "+v"(lacc[0]), "+v"(lacc[1]));
  }
  __builtin_amdgcn_s_setprio(0);
}
#undef DA_W16
#undef DA_RF16
#undef DA_PV16
template <bool SAFE>
__device__ __forceinline__ bool attn_unit16_body(const bf16_t* __restrict__ Qb, const bf16_t* __restrict__ Kh, const bf16_t* __restrict__ Vh, float* Ob, int seq, DA_LAS char* lds,
                                            bool second, float lam, float oscale, const float* __restrict__ subg, bf16_t* __restrict__ AOb) {
  int tid = threadIdx.x; asm volatile("" : "+v"(tid));
  const int wid = __builtin_amdgcn_readfirstlane(tid >> 6), lane = tid & 63, fr = lane & 15, fq = lane >> 4;
  const bool grpA = wid < 4;
  const unsigned lds0 = (unsigned)(size_t)lds;
  const int krow = 8 * wid + (lane >> 3), kpiece = (lane & 7) ^ ((krow >> 1) & 7);
  const unsigned ksrc = (unsigned)(krow * PITCH + kpiece * 8) * 2u;
  const int vr0 = 8 * wid + (lane >> 4), vr1 = vr0 + 4;
  const unsigned vsrc0 = (unsigned)(vr0 * PITCH + (((lane & 15) ^ (((vr0 & 3) << 2) | ((vr0 >> 2) & 3))) * 8)) * 2u;
  const unsigned vsrc1 = (unsigned)(vr1 * PITCH + (((lane & 15) ^ (((vr1 & 3) << 2) | ((vr1 >> 2) & 3))) * 8)) * 2u;
  const unsigned kdst = lds0 + OFF_K + wid * 1024, vdst = lds0 + OFF_V + wid * 2048;
#define DA_DMA_K(t, slot) glds16s(Kh + (long)(t) * KVBLK * PITCH, ksrc, (unsigned)__builtin_amdgcn_readfirstlane(kdst + (slot) * SHM_K))
#define DA_DMA_V(t, slot) do { glds16s(Vh + (long)(t) * KVBLK * PITCH, vsrc0, (unsigned)__builtin_amdgcn_readfirstlane(vdst + (slot) * SHM_V)); \
    glds16s(Vh + (long)(t) * KVBLK * PITCH, vsrc1, (unsigned)__builtin_amdgcn_readfirstlane(vdst + (slot) * SHM_V + 1024)); } while (0)
  const int NT = seq / KVBLK;
  DA_DMA_K(0, 0); DA_DMA_K(1, 1); DA_DMA_V(0, 0);
  float mhat[2] = {0.f, 0.f}, alpha[2] = {1.f, 1.f};
  f32x4a o[2][8] = {}; f32x4a lacc[2] = {}; f32x4a s[2][4] = {}; bf16x8 qf[2][2]; bf16x8 pa[2][2]; KPre16 P;
  bf16x8 ones; { const u32x4 w1 = {0x3f803f80u, 0x3f803f80u, 0x3f803f80u, 0x3f803f80u}; ones = __builtin_bit_cast(bf16x8, w1); asm volatile("" : "+v"(ones)); }
#pragma unroll
  for (int qb = 0; qb < 2; ++qb)
#pragma unroll
    for (int ks = 0; ks < 2; ++ks) qf[qb][ks] = *(const bf16x8*)(Qb + (long)(wid * QBLK + 16 * qb + fr) * PITCH + 32 * ks + 8 * fq);
  int va[8], vcur = 0;
  { const int e = fr >> 2, pp = fr & 3, x = (e << 2) | fq;
#pragma unroll
    for (int db = 0; db < 8; ++db) va[db] = (int)(lds0 + OFF_V) + 256 * (4 * fq + e) + 16 * ((2 * db + (pp >> 1)) ^ x) + 8 * (pp & 1); }
  const int kb0 = (int)(lds0 + OFF_K);
#define DA_VA(slot) { const int so_ = __builtin_amdgcn_readfirstlane(((slot) - vcur) * SHM_V); vcur = (slot); _Pragma("unroll") for (int db = 0; db < 8; ++db) { va[db] += so_; asm volatile("" : "+v"(va[db])); } }
#define DA_PREF_K(slot) prefetch_k16(P, kb0 + (slot) * SHM_K, fr, fq)
#define DA_RESC16() do { if (__any(alpha[0] < 1.f || alpha[1] < 1.f)) { _Pragma("unroll") for (int qb = 0; qb < 2; ++qb) { lacc[qb] *= alpha[qb]; _Pragma("unroll") for (int db = 0; db < 8; ++db) o[qb][db] *= alpha[qb]; } } } while (0)
#define DA_SEG_V(first) do { softmax16<SAFE>(s, mhat, (first), alpha, pa); asm volatile("" : "+v"(pa[0][0]), "+v"(pa[0][1]), "+v"(pa[1][0]), "+v"(pa[1][1])); if (SAFE) DA_RESC16(); } while (0)
  asm volatile("s_waitcnt vmcnt(3)" ::: "memory");
  DA_WAIT_BAR(3);
  int m0 = 0, m1 = 1, m2 = 2;
  if (grpA) {
    DA_DMA_K(2, 2); DA_DMA_V(1, 1);
    DA_PREF_K(0); DA_LGKM(0);
    m_seg16<true, false>(s, P, qf, o, lacc, ones, va, pa);
    DA_WAIT_BAR(3);
    DA_PREF_K(1);
    DA_SEG_V(true);
    DA_WAIT_BAR(3);
    m_seg16<true, true>(s, P, qf, o, lacc, ones, va, pa, [&]() { DA_DMA_K(3, 0); });
    DA_WAIT_BAR(3);
    m0 = 1; m1 = 2; m2 = 0;
#pragma unroll 1
    for (int t = 1; t + 1 < NT; ++t) {
      DA_PREF_K(m1);
      DA_SEG_V(false);
      DA_VA(m0);
      DA_DMA_V(t + 1, m1);
      if (t + 2 < NT) DA_WAIT_BAR(3); else DA_WAIT_BAR(2);
      m_seg16<true, true>(s, P, qf, o, lacc, ones, va, pa, [&]() { if (t + 3 < NT) DA_DMA_K(t + 3, m0); });
      if (t + 3 < NT) DA_WAIT_BAR(3); else DA_WAIT_BAR(0);
      { const int mm = m0; m0 = m1; m1 = m2; m2 = mm; }
    }
    DA_SEG_V(false);
    DA_VA(m0);
    DA_WAIT_BAR(0);
  } else {
    DA_DMA_K(2, 2); DA_DMA_V(1, 1);
    DA_PREF_K(0);
    DA_WAIT_BAR(3);
    m_seg16<true, false>(s, P, qf, o, lacc, ones, va, pa);
    DA_WAIT_BAR(3);
    DA_PREF_K(1);
    __builtin_amdgcn_s_setprio(1); DA_SEG_V(true); __builtin_amdgcn_s_setprio(0);
    DA_DMA_V(2, 2);
    DA_WAIT_BAR(2);
    m0 = 1; m1 = 2; m2 = 0;
#pragma unroll 1
    for (int t = 1; t + 1 < NT; ++t) {
      m_seg16<true, true>(s, P, qf, o, lacc, ones, va, pa, [&]() { if (t + 2 < NT) DA_DMA_K(t + 2, m2); });
      DA_WAIT_BAR(3);
      DA_PREF_K(m1);
      __builtin_amdgcn_s_setprio(1); DA_SEG_V(false); DA_VA(m0); __builtin_amdgcn_s_setprio(0);
      if (t + 2 < NT) { DA_DMA_V(t + 2, m2); DA_WAIT_BAR(2); } else DA_WAIT_BAR(0);
      { const int mm = m0; m0 = m1; m1 = m2; m2 = mm; }
    }
    m_seg16<true, true>(s, P, qf, o, lacc, ones, va, pa);
    DA_WAIT_BAR(0);
    __builtin_amdgcn_s_setprio(1); DA_SEG_V(false); DA_VA(m0); __builtin_amdgcn_s_setprio(0);
  }
  m_seg16<false, true>(s, P, qf, o, lacc, ones, va, pa);
  const float lsum[2] = {lacc[0][0], lacc[1][0]};
  int te = threadIdx.x; asm volatile("" : "+v"(te));
  const int wid_e = __builtin_amdgcn_readfirstlane(te >> 6), lane_e = te & 63, fr_e = lane_e & 15, fq_e = lane_e >> 4;
  if (!SAFE) {
    float om = 0.f;
#pragma unroll
    for (int qb = 0; qb < 2; ++qb)
#pragma unroll
      for (int db = 0; db < 8; ++db) om = fmaxf(fmaxf(om, fmaxf(fabsf(o[qb][db][0]), fabsf(o[qb][db][1]))), fmaxf(fabsf(o[qb][db][2]), fabsf(o[qb][db][3])));
#ifdef DA_TEST_FALLBACK
    const bool good = false;
#else
    const bool good = lsum[0] > 0x1p-100f && lsum[0] < 0x1p100f && lsum[1] > 0x1p-100f && lsum[1] < 0x1p100f && om < 0x1p120f;
#endif
    DA_LAS int* fl = (DA_LAS int*)(lds + OFF_WS);
    if (lane_e == 0) fl[wid_e] = __any(!good) ? 1 : 0;
    DA_WAIT_BAR(0);
    int bad = 0;
#pragma unroll
    for (int w = 0; w < NW; ++w) bad |= fl[w];
    if (__builtin_amdgcn_readfirstlane(bad)) { DA_WAIT_BAR(0); return false; }
  }
#pragma unroll
  for (int qb = 0; qb < 2; ++qb) {
    const float rl = __builtin_amdgcn_rcpf(lsum[qb]);
    const long row = wid_e * QBLK + 16 * qb + fr_e;
    if (!second) {
#pragma unroll
      for (int db = 0; db < 8; ++db) *(f32x4a*)(Ob + row * LDO + 16 * db + 4 * fq_e) = o[qb][db] * rl;
    } else {
      f32x4a d[8]; float ss = 0.f;
#pragma unroll
      for (int db = 0; db < 8; ++db) d[db] = *(const f32x4a*)(Ob + row * LDO + 16 * db + 4 * fq_e);
#pragma unroll
      for (int db = 0; db < 8; ++db) { d[db] = d[db] - (o[qb][db] * rl) * lam; ss += (d[db][0] * d[db][0] + d[db][1] * d[db][1]) + (d[db][2] * d[db][2] + d[db][3] * d[db][3]); }
      const float rs = oscale / sqrtf(xfq_sum(ss) * (1.0f / 128.0f) + 1e-5f);
#pragma unroll
      for (int db = 0; db < 8; ++db) { const f32x4a g = *(const f32x4a*)(subg + 16 * db + 4 * fq_e); const f32x4a v = d[db] * g * rs;
        const v2u16 w = {cvtpk(v[0], v[1]), cvtpk(v[2], v[3])}; *(v2u16*)(AOb + row * 1024 + 16 * db + 4 * fq_e) = w; }
    }
  }
  DA_WAIT_BAR(0);
  return true;
#undef DA_DMA_K
#undef DA_DMA_V
#undef DA_VA
#undef DA_PREF_K
#undef DA_RESC16
#undef DA_SEG_V
}
__device__ __forceinline__ void attn_unit16(const bf16_t* __restrict__ Qb, const bf16_t* __restrict__ Kh, const bf16_t* __restrict__ Vh, float* Ob, int seq, DA_LAS char* lds,
                                            bool second, float lam, float oscale, const float* __restrict__ subg, bf16_t* __restrict__ AOb) {
#ifndef DA_FORCE_SAFE
  if (attn_unit16_body<false>(Qb, Kh, Vh, Ob, seq, lds, second, lam, oscale, subg, AOb)) return;
#endif
#ifndef DA_FORCE_FAST
  attn_unit16_body<true>(Qb, Kh, Vh, Ob, seq, lds, second, lam, oscale, subg, AOb);
#endif
}
}

constexpr int NWAVES = 8;
constexpr int SEQ = 16384, DM = 2048, FF = 5632, AW = 1024, NHEAD = 8, FW = 1024, NGRP = 8, GD = 128, DEPTH = 2;
constexpr int NMOD = 9 * DM;
constexpr int KSPLIT = 16;
constexpr float NORM_EPS = 1e-6f, SUBLN_EPS = 1e-5f;

constexpr size_t MiB = 1u << 20;
constexpr size_t WS_CTL = 0, CTL_ZERO_BYTES = 1 * MiB;
constexpr size_t WS_COS = 1 * MiB, WS_SIN = 3 * MiB;
constexpr size_t WS_DFTC = 5 * MiB, WS_DFTS = 5 * MiB + 32768, WS_TW = 5 * MiB + 65536;
constexpr size_t WS_MODP = 6 * MiB;
constexpr size_t WS_MODF = 9 * MiB;
constexpr size_t WS_LAM = WS_MODF + (size_t)DEPTH * 9 * DM * 4;
constexpr size_t WS_W = 10 * MiB, W_LAYER = 180 * MiB;
constexpr size_t W_1IN = 0, W_1OUT = 44 * MiB, W_MIX = 66 * MiB, W_AP = 98 * MiB, W_FP = 102 * MiB, W_MO = 106 * MiB, W_2IN = 114 * MiB, W_2OUT = 158 * MiB;
constexpr size_t WS_H = 370 * MiB, WS_Y = 434 * MiB, WS_ACT = 498 * MiB, WS_M1 = 674 * MiB, WS_O = 802 * MiB, WS_END = 930 * MiB;
constexpr size_t WS_TRE = WS_Y, WS_TIM = WS_Y + 32 * MiB;
constexpr size_t WS_GATE = WS_ACT;
constexpr size_t WS_Q = WS_M1, WS_K = WS_M1 + 32 * MiB, WS_V = WS_M1 + 64 * MiB, WS_U = WS_M1 + 96 * MiB;
constexpr size_t WS_AO = WS_M1, WS_YF = WS_M1 + 32 * MiB, WS_MG = WS_M1 + 64 * MiB;
constexpr size_t WS_TT = WS_O;
constexpr int CW_TMO = 0, CW_CODE = 1, CW_BAR = 4096, CW_CHK = 16384;

constexpr int RING_OFF = 0, PHASE_LDS = 143360;
constexpr int LDSCTL_OFF = PHASE_LDS, MISC_OFF = LDSCTL_OFF + 320;
constexpr int LDS_BYTES = 147456;
static_assert(MISC_OFF + 128 <= LDS_BYTES, "LDS map");

#define GAS __attribute__((address_space(1)))
#define LAS __attribute__((address_space(3)))
typedef unsigned short bf16;
typedef unsigned v4u __attribute__((ext_vector_type(4)));
typedef unsigned v2u __attribute__((ext_vector_type(2)));
typedef float f32x4 __attribute__((ext_vector_type(4)));
typedef float f32x16 __attribute__((ext_vector_type(16)));
typedef short bf16x8 __attribute__((ext_vector_type(8)));
typedef short s16x4 __attribute__((ext_vector_type(4)));
typedef GAS unsigned gu32;
#define RLX_AGENT __ATOMIC_RELAXED, __HIP_MEMORY_SCOPE_AGENT
#define LDS_WAIT() asm volatile("s_waitcnt lgkmcnt(0)" ::: "memory")
#define VM_WAIT() asm volatile("s_waitcnt vmcnt(0)" ::: "memory")
__device__ __forceinline__ unsigned f2bf(float f) { unsigned u = __builtin_bit_cast(unsigned, f); return (u + 0x7fffu + ((u >> 16) & 1u)) >> 16; }
__device__ __forceinline__ unsigned pk2(float lo, float hi) { return f2bf(lo) | (f2bf(hi) << 16); }
__device__ __forceinline__ float bfl(unsigned w) { return __builtin_bit_cast(float, w << 16); }
__device__ __forceinline__ float bfh(unsigned w) { return __builtin_bit_cast(float, w & 0xffff0000u); }
__device__ __forceinline__ float wave_sum(float v) {
#pragma unroll
    for (int o = 1; o < 64; o <<= 1) v += __shfl_xor(v, o);
    return v;
}
__device__ __forceinline__ void sincos_turns(double t, double& s, double& c) {
    t -= floor(t);
    const double q = floor(t * 4.0 + 0.5);
    const double x = (t - q * 0.25) * 6.283185307179586476925286766559;
    const double x2 = x * x;
    double sp = -1.0 / 1307674368000.0; sp = sp * x2 + 1.0 / 6227020800.0; sp = sp * x2 - 1.0 / 39916800.0; sp = sp * x2 + 1.0 / 362880.0; sp = sp * x2 - 1.0 / 5040.0; sp = sp * x2 + 1.0 / 120.0; sp = sp * x2 - 1.0 / 6.0; sp = sp * x2 + 1.0;
    const double sx = sp * x;
    double cp = 1.0 / 20922789888000.0; cp = cp * x2 - 1.0 / 87178291200.0; cp = cp * x2 + 1.0 / 479001600.0; cp = cp * x2 - 1.0 / 3628800.0; cp = cp * x2 + 1.0 / 40320.0; cp = cp * x2 - 1.0 / 720.0; cp = cp * x2 + 1.0 / 24.0; cp = cp * x2 - 0.5; cp = cp * x2 + 1.0;
    const int qi = ((int)q) & 3;
    s = (qi == 0) ? sx : (qi == 1) ? cp : (qi == 2) ? -sx : -cp;
    c = (qi == 0) ? cp : (qi == 1) ? -sx : (qi == 2) ? -cp : sx;
}
__constant__ float ROPE_INV_FREQ[32] = {1.f,0.749894261f,0.562341332f,0.421696514f,0.316227764f,0.237137377f,0.177827939f,0.133352131f,0.100000001f,0.0749894157f,0.0562341325f,0.0421696529f,0.0316227749f,0.0237137377f,0.0177827943f,0.0133352149f,0.00999999978f,0.00749894185f,0.00562341325f,0.00421696482f,0.00316227763f,0.00237137359f,0.00177827943f,0.00133352145f,0.00100000005f,0.000749894243f,0.000562341302f,0.000421696517f,0.000316227757f,0.00023713737f,0.00017782794f,0.00013335215f};

#define XB_TMO      128
#define XB_XCNT(j)  (256  + 64 * (j))
#define XB_XSUB(j)  (1280 + 64 * (j))
#define XB_XGEN(j)  (2304 + 64 * (j))
#define XB_TOP      3328
#define XB_TOPGEN   3392
#define XCD_BAR_WORDS 3456
#define XB_SPIN_CAP (1u << 21)

__device__ __forceinline__ unsigned xb_ld(unsigned* p)              { return __hip_atomic_load(p, __ATOMIC_RELAXED, __HIP_MEMORY_SCOPE_AGENT); }
__device__ __forceinline__ unsigned xb_add(unsigned* p, unsigned v) { return __hip_atomic_fetch_add(p, v, __ATOMIC_RELAXED, __HIP_MEMORY_SCOPE_AGENT); }
__device__ __forceinline__ unsigned xb_xcc_id() { return (unsigned)__builtin_amdgcn_s_getreg((3 << 11) | 20) & 0xFu; }
#define XB_SPIN(cond, bar) do { unsigned _sp = 0; while (cond) { __builtin_amdgcn_s_sleep(1); \
    if ((++_sp & 255u) == 0u) { if (xb_ld(&(bar)[XB_TMO])) break; if (_sp > XB_SPIN_CAP) { atomicAdd(&(bar)[XB_TMO], 1u); break; } } } } while (0)

struct XcdBarrier {
    unsigned* bar; unsigned x;
    volatile LAS unsigned* st;
};

__device__ __forceinline__ XcdBarrier xcd_barrier_post(unsigned* bar, volatile LAS unsigned* st) {
    XcdBarrier b; b.bar = bar; b.x = xb_xcc_id(); b.st = st;
    if (threadIdx.x == 0) (void)xb_add(&bar[XB_XCNT(b.x)], 1u);
    return b;
}
__device__ __forceinline__ void xcd_barrier_complete(unsigned* bar, unsigned x, unsigned& nloc, unsigned& nx) {
    const unsigned G = gridDim.x * gridDim.y * gridDim.z;
    unsigned sum, cnt, mine, sp = 0u;
    for (;;) {
        sum = 0u; cnt = 0u; mine = 0u;
#pragma unroll
        for (unsigned j = 0; j < 16; ++j) { const unsigned c = xb_ld(&bar[XB_XCNT(j)]); sum += c; cnt += (c > 0u) ? 1u : 0u; mine = (j == x) ? c : mine; }
        if (sum == G) break;
        __builtin_amdgcn_s_sleep(1);
        if ((++sp & 255u) == 0u) { if (xb_ld(&bar[XB_TMO])) break; if (sp > XB_SPIN_CAP) { atomicAdd(&bar[XB_TMO], 1u); break; } }
    }
    nloc = mine > 0u ? mine : 1u; nx = cnt > 0u ? cnt : 1u;
}

__device__ __forceinline__ void xcd_barrier(const XcdBarrier& b) {
    asm volatile("s_waitcnt vmcnt(0)" ::: "memory");
    __syncthreads();
    if (threadIdx.x == 0) {
        unsigned* bar = b.bar; unsigned bx = b.x; asm volatile("" : "+s"(bx));
        __builtin_amdgcn_s_waitcnt(0);
        unsigned nloc = b.st[0], nx = b.st[1];
        if (nloc == 0u) { xcd_barrier_complete(bar, bx, nloc, nx); b.st[0] = nloc; b.st[1] = nx; }
        const unsigned old = xb_add(&bar[XB_XSUB(bx)], 1u);
        const unsigned gen = old / nloc;
        if (old + 1u == (gen + 1u) * nloc) {
            __builtin_amdgcn_fence(__ATOMIC_RELEASE, "agent");
            asm volatile("s_waitcnt vmcnt(0)" ::: "memory");
            const unsigned og = xb_add(&bar[XB_TOP], 1u);
            const unsigned tg = og / nx;
            if (og + 1u == (tg + 1u) * nx) xb_add(&bar[XB_TOPGEN], 1u);
            else XB_SPIN(xb_ld(&bar[XB_TOPGEN]) == tg, bar);
            __builtin_amdgcn_fence(__ATOMIC_ACQUIRE, "agent");
            xb_add(&bar[XB_XGEN(bx)], 1u);
            asm volatile("s_waitcnt vmcnt(0)" ::: "memory");
        } else {
            XB_SPIN(xb_ld(&bar[XB_XGEN(bx)]) == gen, bar);
            __builtin_amdgcn_fence(__ATOMIC_ACQUIRE, "agent");
            asm volatile("s_waitcnt vmcnt(0)" ::: "memory");
        }
    }
    __syncthreads();
}
struct Frame {
    LAS unsigned char* lds;
    volatile LAS unsigned* MISC;
    gu32* ctl;
    int tid, lane, wave;
    int vcu, G;
    unsigned char* ws;
};

__device__ __forceinline__ int wt_row(int mode, int row_off, int n0) {
    if (mode == 1) { const int up = n0 >= FF ? 1 : 0, j = n0 - up * FF; return (j >> 7) * 256 + up * 128 + (j & 127); }
    if (mode == 2) { if (n0 < 2048) { const int ch = n0 >> 6, d = n0 & 63; return 256 * (ch >> 2) + 128 * (d >> 5) + 32 * (ch & 3) + (d & 31); } return n0; }
    return row_off + n0;
}
__device__ __forceinline__ void p0_transpose_item(const float* W, int K, int N, bf16* WT, int mode, int row_off, LAS float* scr, int item, int lane) {
    const int nblk = N / 32, kb = item / nblk, nb = item % nblk, k0 = 64 * kb, n0 = 32 * nb;
#pragma unroll 8
    for (int i = 0; i < 32; ++i) { const int kk = 2 * i + (lane >> 5); scr[kk * 33 + (lane & 31)] = W[(size_t)(k0 + kk) * N + n0 + (lane & 31)]; }
    LDS_WAIT(); asm volatile("" ::: "memory");
    const int c = lane & 7, rbase = wt_row(mode, row_off, n0);
#pragma unroll
    for (int j = 0; j < 4; ++j) { const int n = (lane >> 3) + 8 * j; const LAS float* s = scr + (8 * c) * 33 + n;
        v4u o; o.x = pk2(s[0 * 33], s[1 * 33]); o.y = pk2(s[2 * 33], s[3 * 33]); o.z = pk2(s[4 * 33], s[5 * 33]); o.w = pk2(s[6 * 33], s[7 * 33]);
        *(GAS v4u*)(WT + (size_t)(rbase + n) * K + k0 + 8 * c) = o; }
    LDS_WAIT(); asm volatile("" ::: "memory");
}
struct In18 { const float* p[18]; };
__device__ __forceinline__ void p0_prologue(Frame& F, const In18& in) {
    LAS float* scr = (LAS float*)(F.lds + RING_OFF + F.wave * 16384);
    const int gw = F.vcu * NWAVES + F.wave, NGW = F.G * NWAVES;
    constexpr int I0 = 32 * 352, I1 = 88 * 64, I2 = 32 * 128, I3 = 32 * 128, I4 = 16 * 64, I5 = 16 * 64, I6 = 32 * 64, IL = 2 * I0 + 2 * I1 + I2 + I3 + I4 + I5 + I6;
    for (int it = gw; it < DEPTH * IL; it += NGW) {
        const int l = it / IL; int r = it % IL;
        bf16* wl = (bf16*)(F.ws + WS_W + (size_t)l * W_LAYER);
        if (r < I0) { p0_transpose_item(in.p[6] + (size_t)l * DM * 2 * FF, DM, 2 * FF, (bf16*)((unsigned char*)wl + W_1IN), 1, 0, scr, r, F.lane); continue; } r -= I0;
        if (r < I1) { p0_transpose_item(in.p[7] + (size_t)l * FF * DM, FF, DM, (bf16*)((unsigned char*)wl + W_1OUT), 0, 0, scr, r, F.lane); continue; } r -= I1;
        if (r < I2) { p0_transpose_item(in.p[8] + (size_t)l * DM * 4096, DM, 4096, (bf16*)((unsigned char*)wl + W_MIX), 2, 0, scr, r, F.lane); continue; } r -= I2;
        if (r < I3) { p0_transpose_item(in.p[13] + (size_t)l * DM * 4096, DM, 4096, (bf16*)((unsigned char*)wl + W_MIX), 0, 4096, scr, r, F.lane); continue; } r -= I3;
        if (r < I4) { p0_transpose_item(in.p[11] + (size_t)l * AW * DM, AW, DM, (bf16*)((unsigned char*)wl + W_AP), 0, 0, scr, r, F.lane); continue; } r -= I4;
        if (r < I5) { p0_transpose_item(in.p[12] + (size_t)l * FW * DM, FW, DM, (bf16*)((unsigned char*)wl + W_FP), 0, 0, scr, r, F.lane); continue; } r -= I5;
        if (r < I6) { p0_transpose_item(in.p[15] + (size_t)l * DM * DM, DM, DM, (bf16*)((unsigned char*)wl + W_MO), 0, 0, scr, r, F.lane); continue; } r -= I6;
        if (r < I0) { p0_transpose_item(in.p[16] + (size_t)l * DM * 2 * FF, DM, 2 * FF, (bf16*)((unsigned char*)wl + W_2IN), 1, 0, scr, r, F.lane); continue; } r -= I0;
        p0_transpose_item(in.p[17] + (size_t)l * FF * DM, FF, DM, (bf16*)((unsigned char*)wl + W_2OUT), 0, 0, scr, r, F.lane);
    }
    {
        constexpr int NCB = NMOD / 256, KR = DM / KSPLIT;
        const float* cvec = in.p[1]; float* modp = (float*)(F.ws + WS_MODP);
        for (int it = gw; it < DEPTH * NCB * KSPLIT; it += NGW) {
            const int l = it / (NCB * KSPLIT), r = it % (NCB * KSPLIT), ks = r / NCB, cb = r % NCB, c0 = cb * 256 + 4 * F.lane, k0 = ks * KR;
            const float* W = in.p[2] + (size_t)l * DM * NMOD + (size_t)k0 * NMOD + c0;
            f32x4 acc = {0.f, 0.f, 0.f, 0.f};
#pragma unroll 8
            for (int k = 0; k < KR; ++k) { const float cv = cvec[k0 + k]; const float ca = cv * __builtin_amdgcn_rcpf(1.0f + __builtin_amdgcn_exp2f(cv * -1.4426950408889634f));
                const f32x4 w = *(const GAS f32x4*)(W + (size_t)k * NMOD); acc += w * ca; }
            *(GAS f32x4*)(modp + (size_t)(l * KSPLIT + ks) * NMOD + c0) = acc;
        }
    }
    {
        const int gt = F.vcu * (NWAVES * 64) + F.tid, NT = F.G * NWAVES * 64;
        float* cosT = (float*)(F.ws + WS_COS); float* sinT = (float*)(F.ws + WS_SIN);
        for (int idx = gt; idx < SEQ * 32; idx += NT) { const int pos = idx >> 5, i = idx & 31; const float ang = (float)pos * ROPE_INV_FREQ[i];
            double s, c; sincos_turns((double)ang * 0.15915494309189533576888376337251, s, c); cosT[idx] = (float)c; sinT[idx] = (float)s; }
        bf16* dC = (bf16*)(F.ws + WS_DFTC); bf16* dS = (bf16*)(F.ws + WS_DFTS); float* tw = (float*)(F.ws + WS_TW);
        for (int idx = gt; idx < 128 * 128; idx += NT) { const int a = idx >> 7, b = idx & 127; double s, c;
            sincos_turns((double)((a * b) & 127) * (1.0 / 128.0), s, c); dC[idx] = (bf16)f2bf((float)c); dS[idx] = (bf16)f2bf((float)s);
            sincos_turns((double)(a * b) * (1.0 / 16384.0), s, c); tw[2 * idx] = (float)c; tw[2 * idx + 1] = (float)s; }
    }
}
__device__ __forceinline__ void p1_modfin(Frame& F, const In18& in) {
    const int gt = F.vcu * (NWAVES * 64) + F.tid, NT = F.G * NWAVES * 64;
    const float* modp = (const float*)(F.ws + WS_MODP); float* modf = (float*)(F.ws + WS_MODF);
    for (int idx = gt; idx < DEPTH * 3 * DM; idx += NT) { const int l = idx / (3 * DM), s = (idx / DM) % 3, c = idx % DM, base = s * 3 * DM + c;
        float sh = in.p[3][l * NMOD + base], sc = in.p[3][l * NMOD + base + DM], gt_ = in.p[3][l * NMOD + base + 2 * DM];
        for (int ks = 0; ks < KSPLIT; ++ks) { const float* q = modp + (size_t)(l * KSPLIT + ks) * NMOD + base; sh += q[0]; sc += q[DM]; gt_ += q[2 * DM]; }
        const float gpre = in.p[4][(l * 3 + s) * DM + c], gpost = in.p[5][(l * 3 + s) * DM + c];
        float* o = modf + (size_t)((l * 3 + s) * 3) * DM + c;
        o[0] = gpre * (1.0f + sc); o[DM] = sh; o[2 * DM] = (s == 1 ? 1.0f : 0.5f) * gt_ * gpost; }
    if (blockIdx.x == 0 && F.wave < DEPTH) { const int l = F.wave; const float* lq = in.p[9] + l * 256;
        const float sa = wave_sum(lq[F.lane] * lq[64 + F.lane]), sb = wave_sum(lq[128 + F.lane] * lq[192 + F.lane]);
        const float linit = l == 0 ? 0.2f : 0.35550906758f;
        if (F.lane == 0) { float* lamv = (float*)(F.ws + WS_LAM); lamv[l] = __builtin_amdgcn_exp2f(sa * 1.4426950408889634f) - __builtin_amdgcn_exp2f(sb * 1.4426950408889634f) + linit; lamv[2 + l] = 1.0f - linit; } }
}
template <bool HAS_Y, bool HAS_H>
__device__ __forceinline__ void norm_phase(Frame& F, const float* xin, float* xout, const bf16* y, bf16* h, const float* Gv, const float* Av, const float* Bv) {
    int lane = F.lane; asm volatile("" : "+v"(lane));
    const int gw = F.vcu * NWAVES + F.wave, NGW = F.G * NWAVES;
    f32x4 g[8], a[8], b[8];
#pragma unroll
    for (int j = 0; j < 8; ++j) { if (HAS_Y) g[j] = *(const GAS f32x4*)(Gv + 4 * lane + 256 * j); if (HAS_H) { a[j] = *(const GAS f32x4*)(Av + 4 * lane + 256 * j); b[j] = *(const GAS f32x4*)(Bv + 4 * lane + 256 * j); } }
    for (int row = gw; row < SEQ; row += NGW) {
        f32x4 x[8];
#pragma unroll
        for (int j = 0; j < 8; ++j) x[j] = *(const GAS f32x4*)(xin + (size_t)row * DM + 4 * lane + 256 * j);
        if (HAS_Y) {
            f32x4 yv[8]; float ss = 0.f;
#pragma unroll
            for (int j = 0; j < 8; ++j) { const v2u w = *(const GAS v2u*)(y + (size_t)row * DM + 4 * lane + 256 * j); yv[j] = (f32x4){bfl(w.x), bfh(w.x), bfl(w.y), bfh(w.y)};
                ss += (yv[j].x * yv[j].x + yv[j].y * yv[j].y) + (yv[j].z * yv[j].z + yv[j].w * yv[j].w); }
            const float ry = 1.0f / sqrtf(wave_sum(ss) * (1.0f / DM) + NORM_EPS);
#pragma unroll
            for (int j = 0; j < 8; ++j) x[j] = x[j] + g[j] * yv[j] * ry;
        }
        if (HAS_Y) {
#pragma unroll
            for (int j = 0; j < 8; ++j) *(GAS f32x4*)(xout + (size_t)row * DM + 4 * lane + 256 * j) = x[j];
        }
        if (HAS_H) {
            float ss = 0.f;
#pragma unroll
            for (int j = 0; j < 8; ++j) ss += (x[j].x * x[j].x + x[j].y * x[j].y) + (x[j].z * x[j].z + x[j].w * x[j].w);
            const float rx = 1.0f / sqrtf(wave_sum(ss) * (1.0f / DM) + NORM_EPS);
#pragma unroll
            for (int j = 0; j < 8; ++j) { const f32x4 v = x[j] * rx * a[j] + b[j]; v2u w; w.x = pk2(v.x, v.y); w.y = pk2(v.z, v.w); *(GAS v2u*)(h + (size_t)row * DM + 4 * lane + 256 * j) = w; }
        }
    }
}
__device__ __forceinline__ void combine_phase(Frame& F, const float* O, bf16* AO, const float* subg, float lam, float oscale) {
    int lane = F.lane; asm volatile("" : "+v"(lane));
    const int gw = F.vcu * NWAVES + F.wave, NGW = F.G * NWAVES, hh = lane >> 3, e0 = (lane & 7) * 16;
    f32x4 g[4];
#pragma unroll
    for (int j = 0; j < 4; ++j) g[j] = *(const GAS f32x4*)(subg + e0 + 4 * j) * oscale;
    for (int row = gw; row < SEQ; row += NGW) {
        const float* p0 = O + (size_t)row * 2048 + hh * 256 + e0;
        f32x4 o[4]; float ss = 0.f;
#pragma unroll
        for (int j = 0; j < 4; ++j) { const f32x4 a = *(const GAS f32x4*)(p0 + 4 * j), b = *(const GAS f32x4*)(p0 + 128 + 4 * j); o[j] = a - b * lam; ss += (o[j].x * o[j].x + o[j].y * o[j].y) + (o[j].z * o[j].z + o[j].w * o[j].w); }
        ss += __shfl_xor(ss, 1); ss += __shfl_xor(ss, 2); ss += __shfl_xor(ss, 4);
        const float r = 1.0f / sqrtf(ss * (1.0f / 128.0f) + SUBLN_EPS);
        v4u w0, w1; { const f32x4 v0 = o[0] * r * g[0], v1 = o[1] * r * g[1], v2 = o[2] * r * g[2], v3 = o[3] * r * g[3];
            w0.x = pk2(v0.x, v0.y); w0.y = pk2(v0.z, v0.w); w0.z = pk2(v1.x, v1.y); w0.w = pk2(v1.z, v1.w); w1.x = pk2(v2.x, v2.y); w1.y = pk2(v2.z, v2.w); w1.z = pk2(v3.x, v3.y); w1.w = pk2(v3.z, v3.w); }
        bf16* op = AO + (size_t)row * 1024 + hh * 128 + e0;
        *(GAS v4u*)op = w0; *(GAS v4u*)(op + 8) = w1;
    }
}
template <int DD> __device__ __forceinline__ void fft_mm2(f32x16& aR, f32x16& aI, int vb, const bf16x8* Ca, const bf16x8* Sa) {
    using namespace dattn;
    const s16x4 l0 = tr_read<v_rd_off(DD, 0, 0)>(vb), h0 = tr_read<v_rd_off(DD, 0, 1)>(vb), l1 = tr_read<v_rd_off(DD, 1, 0)>(vb), h1 = tr_read<v_rd_off(DD, 1, 1)>(vb);
    const s16x4 l2 = tr_read<v_rd_off(DD, 2, 0)>(vb), h2 = tr_read<v_rd_off(DD, 2, 1)>(vb), l3 = tr_read<v_rd_off(DD, 3, 0)>(vb), h3 = tr_read<v_rd_off(DD, 3, 1)>(vb);
    asm volatile("s_waitcnt lgkmcnt(0)" ::: "memory"); __builtin_amdgcn_sched_barrier(0);
    const bf16x8 b0 = DA_PK(l0, h0), b1 = DA_PK(l1, h1), b2 = DA_PK(l2, h2), b3 = DA_PK(l3, h3);
    aR = __builtin_amdgcn_mfma_f32_32x32x16_bf16(Ca[0], b0, aR, 0, 0, 0); aI = __builtin_amdgcn_mfma_f32_32x32x16_bf16(Sa[0], b0, aI, 0, 0, 0);
    aR = __builtin_amdgcn_mfma_f32_32x32x16_bf16(Ca[1], b1, aR, 0, 0, 0); aI = __builtin_amdgcn_mfma_f32_32x32x16_bf16(Sa[1], b1, aI, 0, 0, 0);
    aR = __builtin_amdgcn_mfma_f32_32x32x16_bf16(Ca[2], b2, aR, 0, 0, 0); aI = __builtin_amdgcn_mfma_f32_32x32x16_bf16(Sa[2], b2, aI, 0, 0, 0);
    aR = __builtin_amdgcn_mfma_f32_32x32x16_bf16(Ca[3], b3, aR, 0, 0, 0); aI = __builtin_amdgcn_mfma_f32_32x32x16_bf16(Sa[3], b3, aI, 0, 0, 0);
}
__device__ __forceinline__ void fftA_phase(Frame& F, const bf16* U, bf16* TRE, bf16* TIM, const bf16* dftC, const bf16* dftS, const float* TW) {
    using namespace dattn;
    int tid = threadIdx.x; asm volatile("" : "+v"(tid));
    const int wid = __builtin_amdgcn_readfirstlane(tid >> 6), lane = tid & 63, r32 = lane & 31, hi = lane >> 5, kb = wid & 3, ch = wid >> 2;
    bf16x8 Cf[8], Sf[8];
#pragma unroll
    for (int i = 0; i < 8; ++i) { Cf[i] = *(const bf16x8*)(dftC + (32 * kb + r32) * 128 + 16 * i + 8 * hi); Sf[i] = *(const bf16x8*)(dftS + (32 * kb + r32) * 128 + 16 * i + 8 * hi); }
    const int sr = tid >> 4, sc = (tid & 15) * 8, vst0 = v_st(sr, sc), vst1 = v_st(32 + sr, sc);
    LAS unsigned char* L = F.lds + RING_OFF;
    const int vb = (int)(unsigned)(size_t)L + v_rd_base(lane) + ch * 1024;
    for (int unit = F.vcu; unit < 128 * NGRP; unit += F.G) {
        const int n2 = unit >> 3, g = unit & 7;
        const bf16* src = U + (size_t)n2 * 1024 + g * 128 + sc;
        const bf16x8 x0 = *(const bf16x8*)(src + (size_t)sr * 131072), x1 = *(const bf16x8*)(src + (size_t)(32 + sr) * 131072), x2 = *(const bf16x8*)(src + (size_t)(64 + sr) * 131072), x3 = *(const bf16x8*)(src + (size_t)(96 + sr) * 131072);
        *(LAS bf16x8*)(L + vst0) = x0; *(LAS bf16x8*)(L + vst1) = x1; *(LAS bf16x8*)(L + 16384 + vst0) = x2; *(LAS bf16x8*)(L + 16384 + vst1) = x3;
        LDS_WAIT(); __syncthreads();
        f32x16 PR[2] = {}, PI[2] = {};
        fft_mm2<0>(PR[0], PI[0], vb, Cf, Sf); fft_mm2<1>(PR[1], PI[1], vb, Cf, Sf);
        fft_mm2<0>(PR[0], PI[0], vb + 16384, Cf + 4, Sf + 4); fft_mm2<1>(PR[1], PI[1], vb + 16384, Cf + 4, Sf + 4);
        LDS_WAIT(); __syncthreads();
        const float* tw = TW + (size_t)(n2 * 128 + 32 * kb + 4 * hi) * 2;
#pragma unroll
        for (int rg = 0; rg < 4; ++rg) { const f32x4 t0 = *(const GAS f32x4*)(tw + 16 * rg), t1 = *(const GAS f32x4*)(tw + 16 * rg + 4);
            const float cc[4] = {t0.x, t0.z, t1.x, t1.z}, ss[4] = {t0.y, t0.w, t1.y, t1.w};
#pragma unroll
            for (int e = 0; e < 4; ++e) { const int r = 4 * rg + e, k1 = 32 * kb + 8 * rg + 4 * hi + e; const size_t rowo = (size_t)(k1 * 128 + n2) * 1024 + g * 128 + 64 * ch + r32;
#pragma unroll
                for (int dd = 0; dd < 2; ++dd) { const float pr = PR[dd][r], pi = PI[dd][r]; TRE[rowo + 32 * dd] = (bf16)f2bf(pr * cc[e] - pi * ss[e]); TIM[rowo + 32 * dd] = (bf16)f2bf(-(pr * ss[e] + pi * cc[e])); } } }
    }
}
__device__ __forceinline__ void fftB_phase(Frame& F, const bf16* TRE, const bf16* TIM, bf16* YF, const bf16* dftC, const bf16* dftS) {
    using namespace dattn;
    constexpr int WSTR = 272, OFF_WR = 65536, OFF_WI = 65536 + 128 * WSTR;
    constexpr float NORMF = 6.905339660024878e-4f;
    int tid = threadIdx.x; asm volatile("" : "+v"(tid));
    const int wid = __builtin_amdgcn_readfirstlane(tid >> 6), lane = tid & 63, r32 = lane & 31, hi = lane >> 5, kb = wid & 3, ch = wid >> 2;
    bf16x8 Cf[8], Sf[8];
#pragma unroll
    for (int i = 0; i < 8; ++i) { Cf[i] = *(const bf16x8*)(dftC + (32 * kb + r32) * 128 + 16 * i + 8 * hi); Sf[i] = *(const bf16x8*)(dftS + (32 * kb + r32) * 128 + 16 * i + 8 * hi); }
    const int sr = tid >> 4, sc = (tid & 15) * 8, vst0 = v_st(sr, sc), vst1 = v_st(32 + sr, sc);
    LAS unsigned char* L = F.lds + RING_OFF;
    const int vb = (int)(unsigned)(size_t)L + v_rd_base(lane) + ch * 1024;
    for (int unit = F.vcu; unit < 128 * NGRP; unit += F.G) {
        const int k1 = unit >> 3, g = unit & 7;
        const size_t so = (size_t)(k1 * 128) * 1024 + g * 128 + sc;
        bf16x8 zr[4], zi[4];
#pragma unroll
        for (int q = 0; q < 4; ++q) { zr[q] = *(const bf16x8*)(TRE + so + (size_t)(32 * q + sr) * 1024); zi[q] = *(const bf16x8*)(TIM + so + (size_t)(32 * q + sr) * 1024); }
        *(LAS bf16x8*)(L + vst0) = zr[0]; *(LAS bf16x8*)(L + vst1) = zr[1]; *(LAS bf16x8*)(L + 16384 + vst0) = zr[2]; *(LAS bf16x8*)(L + 16384 + vst1) = zr[3];
        *(LAS bf16x8*)(L + 32768 + vst0) = zi[0]; *(LAS bf16x8*)(L + 32768 + vst1) = zi[1]; *(LAS bf16x8*)(L + 49152 + vst0) = zi[2]; *(LAS bf16x8*)(L + 49152 + vst1) = zi[3];
        LDS_WAIT(); __syncthreads();
        f32x16 WR[2] = {}, WI[2] = {}, WX[2] = {};
        fft_mm2<0>(WR[0], WX[0], vb, Cf, Sf); fft_mm2<1>(WR[1], WX[1], vb, Cf, Sf);
        fft_mm2<0>(WR[0], WX[0], vb + 16384, Cf + 4, Sf + 4); fft_mm2<1>(WR[1], WX[1], vb + 16384, Cf + 4, Sf + 4);
        fft_mm2<0>(WI[0], WR[0], vb + 32768, Cf, Sf); fft_mm2<1>(WI[1], WR[1], vb + 32768, Cf, Sf);
        fft_mm2<0>(WI[0], WR[0], vb + 49152, Cf + 4, Sf + 4); fft_mm2<1>(WI[1], WR[1], vb + 49152, Cf + 4, Sf + 4);
        WI[0] -= WX[0]; WI[1] -= WX[1];
#pragma unroll
        for (int dd = 0; dd < 2; ++dd)
#pragma unroll
            for (int r = 0; r < 16; ++r) { const int k2 = 32 * kb + crow(r, hi), j = 64 * ch + 32 * dd + r32;
                *(LAS unsigned short*)(L + OFF_WR + k2 * WSTR + j * 2) = (unsigned short)f2bf(WR[dd][r]); *(LAS unsigned short*)(L + OFF_WI + k2 * WSTR + j * 2) = (unsigned short)f2bf(WI[dd][r]); }
        LDS_WAIT(); __syncthreads();
        f32x16 Y[2] = {};
#pragma unroll
        for (int kk = 0; kk < 2; ++kk) { const int rb = (64 * ch + 32 * kk + r32) * WSTR + 16 * hi;
#pragma unroll
            for (int jc = 0; jc < 8; ++jc) { const bf16x8 aR = *(const LAS bf16x8*)(L + OFF_WR + rb + 32 * jc), aI = *(const LAS bf16x8*)(L + OFF_WI + rb + 32 * jc);
                Y[kk] = __builtin_amdgcn_mfma_f32_32x32x16_bf16(aR, Cf[jc], Y[kk], 0, 0, 0); Y[kk] = __builtin_amdgcn_mfma_f32_32x32x16_bf16(aI, Sf[jc], Y[kk], 0, 0, 0); } }
#pragma unroll
        for (int kk = 0; kk < 2; ++kk)
#pragma unroll
            for (int r = 0; r < 16; ++r) { const int k2 = 64 * ch + 32 * kk + crow(r, hi); YF[(size_t)(k1 + 128 * k2) * 1024 + g * 128 + 32 * kb + r32] = (bf16)f2bf(Y[kk][r] * NORMF); }
    }
}
#ifndef PHMASK
#define PHMASK 0xffffffffu
#endif
#define PH(k) (((PHMASK) >> (k)) & 1u)
#ifndef PHREPM
#define PHREPM 0u
#endif
#define REP(k) _Pragma("unroll 1") for (int rep_ = 0; rep_ < (int)(1u + (((PHREPM) >> (k)) & 1u)); ++rep_)
struct Args { const float* in[18]; float* out; unsigned char* ws; };
__global__ void __launch_bounds__(NWAVES * 64, 2) enc_fwd(Args args) {
    extern __shared__ __attribute__((aligned(16))) unsigned char lds[];
    Frame F;
    F.lds = (LAS unsigned char*)lds;
    F.MISC = (volatile LAS unsigned*)(F.lds + MISC_OFF);
    F.tid = threadIdx.x; F.lane = F.tid & 63; F.wave = __builtin_amdgcn_readfirstlane(F.tid >> 6);
    F.G = gridDim.x; { const int bx = blockIdx.x; F.vcu = (F.G % 8 == 0) ? (bx % 8) * (F.G / 8) + bx / 8 : bx; }
    F.ws = args.ws;
    unsigned char* ws = args.ws;
    F.ctl = (gu32*)(ws + WS_CTL);
    In18 in;
#pragma unroll
    for (int i = 0; i < 18; ++i) in.p[i] = args.in[i];
    for (int u = F.tid; u < (LDS_BYTES - LDSCTL_OFF) / 4; u += NWAVES * 64) ((LAS unsigned*)(F.lds + LDSCTL_OFF))[u] = 0u;
    __syncthreads();
    XcdBarrier bar = xcd_barrier_post((unsigned*)(F.ctl + CW_BAR), F.MISC + 8);
#ifdef PROBE_BAR
    unsigned long long bar_ticks = 0ull;
#define GRID_BAR() do { const unsigned long long w0_ = wall_clock64(); xcd_barrier(bar); bar_ticks += wall_clock64() - w0_; } while (0)
#else
#define GRID_BAR() xcd_barrier(bar)
#endif

    float* const xres = args.out;
    bf16* const HB = (bf16*)(ws + WS_H); bf16* const YB = (bf16*)(ws + WS_Y); bf16* const ACT = (bf16*)(ws + WS_ACT);
    bf16* const QB = (bf16*)(ws + WS_Q); bf16* const KB = (bf16*)(ws + WS_K); bf16* const VB = (bf16*)(ws + WS_V); bf16* const UB = (bf16*)(ws + WS_U);
    bf16* const GB = (bf16*)(ws + WS_GATE); float* const OB = (float*)(ws + WS_O);
    bf16* const TRE = (bf16*)(ws + WS_TRE); bf16* const TIM = (bf16*)(ws + WS_TIM);
    bf16* const YF = (bf16*)(ws + WS_YF); bf16* const AO = (bf16*)(ws + WS_AO); bf16* const MG = (bf16*)(ws + WS_MG); bf16* const TT = (bf16*)(ws + WS_TT);
    const float* const modf = (const float*)(ws + WS_MODF); const float* const lamv = (const float*)(ws + WS_LAM);
    const float* const cosT = (const float*)(ws + WS_COS); const float* const sinT = (const float*)(ws + WS_SIN);
    const bf16* const dftC = (const bf16*)(ws + WS_DFTC); const bf16* const dftS = (const bf16*)(ws + WS_DFTS); const float* const TW = (const float*)(ws + WS_TW);
#define MODF(l, s, k) (modf + (size_t)(((l) * 3 + (s)) * 3 + (k)) * DM)

    REP(0) if (PH(0)) p0_prologue(F, in);
    GRID_BAR();
    REP(1) if (PH(1)) p1_modfin(F, in);
    GRID_BAR();
    REP(2) if (PH(2)) norm_phase<false, true>(F, in.p[0], nullptr, nullptr, HB, nullptr, MODF(0, 0, 0), MODF(0, 0, 1));
#ifdef PROBE_NORM2
    for (int q_ = 0; q_ < 4; ++q_) norm_phase<false, true>(F, in.p[0], xres, nullptr, HB, nullptr, MODF(0, 0, 0), MODF(0, 0, 1));
#endif
    GRID_BAR();

    for (int l = 0; l < DEPTH; ++l) {
        const unsigned char* wl = ws + WS_W + (size_t)l * W_LAYER;
        { pg8::Gemm g{HB, (const bf16*)(wl + W_1IN), SEQ, 2 * FF, DM}; pg8::StaticOrder S; S.init(SEQ, 2 * FF, F.G, (int)blockIdx.x);
          pg8::EpiSwiGLU E{ACT, FF};
          REP(3) if (PH(3)) pg8::gemm_phase<pg8::EpiSwiGLU, pg8::StaticOrder, false, true>(F.lds + RING_OFF, g, S, E);
#ifdef PROBE_G1X2
          __syncthreads(); pg8::gemm_phase<pg8::EpiSwiGLU, pg8::StaticOrder, false, true>(F.lds + RING_OFF, g, S, E);
#endif
          GRID_BAR(); }
        { pg8::Gemm g{ACT, (const bf16*)(wl + W_1OUT), SEQ, DM, FF}; pg8::StaticOrder S; S.init(SEQ, DM, F.G, (int)blockIdx.x);
          pg8::EpiPlain E{YB, DM};
          REP(4) if (PH(4)) pg8::gemm_phase<pg8::EpiPlain, pg8::StaticOrder, true, true>(F.lds + RING_OFF, g, S, E); GRID_BAR(); }
        if (PH(5)) norm_phase<true, true>(F, l == 0 ? in.p[0] : xres, xres, YB, HB, MODF(l, 0, 2), MODF(l, 1, 0), MODF(l, 1, 1)); GRID_BAR();
        { pg8::Gemm g{HB, (const bf16*)(wl + W_MIX), SEQ, 8192, DM}; pg8::StaticOrder S; S.init(SEQ, 8192, F.G, (int)blockIdx.x);
          pg8::EpiMix E{QB, KB, VB, UB, GB, cosT, sinT, in.p[14] + (size_t)l * 4096};
          REP(6) if (PH(6)) pg8::gemm_phase<pg8::EpiMix, pg8::StaticOrder, false, true>(F.lds + RING_OFF, g, S, E); GRID_BAR(); }
        {
            const int xcd = F.vcu >> 5, j = F.vcu & 31;
            REP(7) if (!PH(7)) {} else if (F.G == 256) {
#pragma unroll 1
                for (int i = 0; i < 4; ++i) { const int vh = 2 * xcd + (i >> 1), qb = (i & 1) * 32 + j;
                    dattn::attn_unit16(QB + (size_t)(qb * 256) * 1024 + vh * 64, KB + vh * 64, VB + (vh >> 1) * 128, OB + (size_t)(qb * 256) * 2048 + (2 * xcd) * 128, SEQ, (LAS char*)(F.lds + RING_OFF),
                                     i >= 2, lamv[l], lamv[2 + l], in.p[10] + (size_t)l * 128, AO + (size_t)(qb * 256) * 1024 + xcd * 128); }
            } else {
#pragma unroll 1
                for (int un = F.vcu; un < 1024; un += F.G) { const int vh = un >> 6, qb = un & 63;
                    dattn::attn_unit16(QB + (size_t)(qb * 256) * 1024 + vh * 64, KB + vh * 64, VB + (vh >> 1) * 128, OB + (size_t)(qb * 256) * 2048 + vh * 128, SEQ, (LAS char*)(F.lds + RING_OFF),
                                     false, 0.f, 0.f, nullptr, nullptr); }
            }
            REP(8) if (PH(8)) fftA_phase(F, UB, TRE, TIM, dftC, dftS, TW);
#ifdef PROBE_FFT2
            fftA_phase(F, UB, TRE, TIM, dftC, dftS, TW);
#endif
            GRID_BAR();
        }
        REP(9) if (PH(9)) fftB_phase(F, TRE, TIM, YF, dftC, dftS);
#ifdef PROBE_FFT2
        fftB_phase(F, TRE, TIM, YF, dftC, dftS);
#endif
        REP(10) if (PH(10) && F.G != 256) combine_phase(F, OB, AO, in.p[10] + (size_t)l * 128, lamv[l], lamv[2 + l]);
#ifdef PROBE_COMB2
        combine_phase(F, OB, AO, in.p[10] + (size_t)l * 128, lamv[l], lamv[2 + l]);
#endif
        GRID_BAR();
        { pg8::Gemm g{AO, (const bf16*)(wl + W_AP), SEQ, DM, AW}; pg8::StaticOrder S; S.init(SEQ, DM, F.G, (int)blockIdx.x);
          pg8::EpiGate E{GB, nullptr, TT};
          REP(11) if (PH(11)) pg8::gemm_phase<pg8::EpiGate, pg8::StaticOrder, true, true>(F.lds + RING_OFF, g, S, E);
          VM_WAIT(); __syncthreads(); }
        { pg8::Gemm g{YF, (const bf16*)(wl + W_FP), SEQ, DM, FW}; pg8::StaticOrder S; S.init(SEQ, DM, F.G, (int)blockIdx.x);
          pg8::EpiGate E{GB + 2048, TT, MG};
          REP(12) if (PH(12)) pg8::gemm_phase<pg8::EpiGate, pg8::StaticOrder, true, true>(F.lds + RING_OFF, g, S, E); GRID_BAR(); }
        { pg8::Gemm g{MG, (const bf16*)(wl + W_MO), SEQ, DM, DM}; pg8::StaticOrder S; S.init(SEQ, DM, F.G, (int)blockIdx.x);
          pg8::EpiPlain E{YB, DM};
          REP(13) if (PH(13)) pg8::gemm_phase<pg8::EpiPlain, pg8::StaticOrder, true, true>(F.lds + RING_OFF, g, S, E); GRID_BAR(); }
        if (PH(14)) norm_phase<true, true>(F, xres, xres, YB, HB, MODF(l, 1, 2), MODF(l, 2, 0), MODF(l, 2, 1)); GRID_BAR();
        { pg8::Gemm g{HB, (const bf16*)(wl + W_2IN), SEQ, 2 * FF, DM}; pg8::StaticOrder S; S.init(SEQ, 2 * FF, F.G, (int)blockIdx.x);
          pg8::EpiSwiGLU E{ACT, FF};
          REP(15) if (PH(15)) pg8::gemm_phase<pg8::EpiSwiGLU, pg8::StaticOrder, false, true>(F.lds + RING_OFF, g, S, E); GRID_BAR(); }
        { pg8::Gemm g{ACT, (const bf16*)(wl + W_2OUT), SEQ, DM, FF}; pg8::StaticOrder S; S.init(SEQ, DM, F.G, (int)blockIdx.x);
          pg8::EpiPlain E{YB, DM};
          REP(16) if (PH(16)) pg8::gemm_phase<pg8::EpiPlain, pg8::StaticOrder, true, true>(F.lds + RING_OFF, g, S, E); GRID_BAR(); }
        if (l + 1 < DEPTH) { if (PH(17)) norm_phase<true, true>(F, xres, xres, YB, HB, MODF(l, 2, 2), MODF(l + 1, 0, 0), MODF(l + 1, 0, 1)); GRID_BAR(); }
        else if (PH(17)) norm_phase<true, false>(F, xres, xres, YB, nullptr, MODF(l, 2, 2), nullptr, nullptr);
    }
#ifdef PROBE_BAR
    if (blockIdx.x == PROBE_BAR - 1 && F.tid == 0) { const unsigned long long w0 = wall_clock64(); while (wall_clock64() - w0 < bar_ticks) __builtin_amdgcn_s_sleep(8); }
#endif
#ifdef PROBE_GEMM
    if (blockIdx.x == 0 && F.tid == 0) { VM_WAIT(); const unsigned long long sm = __hip_atomic_load(&pg8::g_gp_sum, __ATOMIC_RELAXED, __HIP_MEMORY_SCOPE_AGENT); const unsigned cn = __hip_atomic_load(&pg8::g_gp_cnt, __ATOMIC_RELAXED, __HIP_MEMORY_SCOPE_AGENT);
        const unsigned long long avg = cn ? sm / cn : 0ull, ticks = avg * 20ull;
        const unsigned long long w0 = wall_clock64(); while (wall_clock64() - w0 < ticks) __builtin_amdgcn_s_sleep(8); }
#endif
    if (blockIdx.x == 0) { int t_ = threadIdx.x; asm volatile("" : "+v"(t_)); if (t_ < 64) { VM_WAIT(); if (__hip_atomic_load((gu32*)((unsigned*)(args.ws + WS_CTL) + CW_BAR + XB_TMO), RLX_AGENT) != 0u) { const float q = __builtin_nanf(""); for (int c = t_; c < DM; c += 64) args.out[c] = q; } } }
}

extern "C" void kernel_launch(void* const* d_in, const int* in_sizes, int n_in, void* d_out, int out_size, void* d_ws, size_t ws_size, hipStream_t stream) {
    static int grid = 0;
    if (grid == 0) {
        if (n_in != 18 || in_sizes[0] != SEQ * DM || out_size != SEQ * DM || ws_size < WS_END) { fprintf(stderr, "kernel_launch: unexpected shapes: n_in %d in0 %d out %d ws %zu (need %zu)\n", n_in, n_in > 0 ? in_sizes[0] : -1, out_size, ws_size, (size_t)WS_END); grid = -1; return; }
        int dev = 0, cus = 0, per_cu = 0;
        if (hipGetDevice(&dev) != hipSuccess || hipDeviceGetAttribute(&cus, hipDeviceAttributeMultiprocessorCount, dev) != hipSuccess) { grid = -1; return; }
        if (hipFuncSetAttribute((const void*)enc_fwd, hipFuncAttributeMaxDynamicSharedMemorySize, LDS_BYTES) != hipSuccess) { fprintf(stderr, "kernel_launch: hipFuncSetAttribute failed\n"); grid = -1; return; }
        if (hipOccupancyMaxActiveBlocksPerMultiprocessor(&per_cu, (const void*)enc_fwd, NWAVES * 64, LDS_BYTES) != hipSuccess || per_cu < 1) { fprintf(stderr, "kernel_launch: occupancy query reports %d blocks per CU\n", per_cu); }
        (void)hipGetLastError();
        grid = cus;
    }
    if (grid < 0) return;
#ifdef DBG_ZERO_WS
    if (hipMemsetAsync((char*)d_ws, 0, WS_END, stream) != hipSuccess) return;
#else
    if (hipMemsetAsync((char*)d_ws + WS_CTL, 0, CTL_ZERO_BYTES, stream) != hipSuccess) return;
#endif
    Args a{};
    for (int i = 0; i < 18; ++i) a.in[i] = (const float*)d_in[i];
    a.out = (float*)d_out; a.ws = (unsigned char*)d_ws;
    hipLaunchKernelGGL(enc_fwd, dim3(grid), dim3(NWAVES * 64), LDS_BYTES, stream, a);
    const hipError_t le = hipPeekAtLastError();
    if (le != hipSuccess) fprintf(stderr, "kernel_launch: launch failed: %s\n", hipGetErrorName(le));
}
```

```cpp
#include <hip/hip_runtime.h>
#include <hip/hip_bf16.h>
#include <cstdio>
#include <cstdint>
#include <cmath>
namespace pg8 {
#define PG8_LAS __attribute__((address_space(3)))
typedef unsigned short bf16_t;
typedef short bf16x8 __attribute__((ext_vector_type(8)));
typedef float f32x4 __attribute__((ext_vector_type(4)));
typedef unsigned u32x4 __attribute__((ext_vector_type(4)));
constexpr int BM = 256, BK = 64, HALF = 128, HTB = HALF * BK * 2  , STAGE_BYTES = 8 * HTB, NXCD = 8, WGM = 8;

__host__ __device__ __forceinline__ int lds_byte(int r, int c) { const int st = (r >> 4) * 2 + (c >> 5), rr = r & 15, cc = c & 31, ob = rr * 64 + cc * 2; return st * 1024 + (ob ^ (((ob >> 9) & 1) << 5)); }
__host__ __device__ __forceinline__ void stage_rc(int b, int& R, int& C) { const int st = b / 1024, sb = b % 1024, swz = sb ^ (((sb >> 9) & 1) << 5); R = (st >> 1) * 16 + swz / 64; C = (st & 1) * 32 + (swz % 64) / 2; }
__host__ __device__ __forceinline__ int perm32(int rho) { const int n = rho >> 4, i = rho & 15; return 8 * (i >> 2) + 4 * n + (i & 3); }

struct Unit { int pm, pn; };
struct Gemm { const bf16_t* A; const bf16_t* Bt; int M, N, K; };

struct StaticOrder {
    int nM, nN, nwg, G, c;
    __host__ __device__ void init(int M, int N, int G_, int c_) { nM = M / BM; nN = N / BM; nwg = nM * nN; G = G_; c = c_; }
    __host__ __device__ bool next(int i, Unit& u) const {
        const long L = (long)i * G + c; if (L >= nwg) return false;
        int wgid = (int)L; { const int q = nwg / NXCD, r = nwg % NXCD, xcd = wgid % NXCD, off = wgid / NXCD; wgid = (xcd < r ? xcd * (q + 1) : r * (q + 1) + (xcd - r) * q) + off; }
        const int nig = WGM * nN, gid = wgid / nig, fm = gid * WGM, gsz = (nM - fm) < WGM ? (nM - fm) : WGM;
        u.pm = fm + ((wgid % nig) % gsz); u.pn = (wgid % nig) / gsz; return true;
    }
    __device__ __forceinline__ void a_ready(const Unit&) const {}
    __device__ __forceinline__ void done(const Unit&) const {}
};

typedef float cvt_f32x2 __attribute__((ext_vector_type(2))); typedef __bf16 cvt_bf16x2 __attribute__((ext_vector_type(2)));
__device__ __forceinline__ unsigned cvt_pk_bf16(float lo, float hi) { const cvt_f32x2 v = {lo, hi}; return __builtin_bit_cast(unsigned, __builtin_convertvector(v, cvt_bf16x2)); }
typedef float f32x2 __attribute__((ext_vector_type(2)));
__device__ __forceinline__ float bf_lo(unsigned w) { return __builtin_bit_cast(float, w << 16); }
__device__ __forceinline__ float bf_hi(unsigned w) { return __builtin_bit_cast(float, w & 0xffff0000u); }
__device__ __forceinline__ float sigmoid_f(float v) { return __builtin_amdgcn_rcpf(1.0f + __builtin_amdgcn_exp2f(v * -1.4426950408889634f)); }
__device__ __forceinline__ u32x4 pack8(const f32x4 a, const f32x4 b) { u32x4 w; w.x = cvt_pk_bf16(a[0], a[1]); w.y = cvt_pk_bf16(a[2], a[3]); w.z = cvt_pk_bf16(b[0], b[1]); w.w = cvt_pk_bf16(b[2], b[3]); return w; }

struct EpiPlain {
    static constexpr bool PERM = true, AFTER_DRAIN = false; static constexpr int NST = 16;
    bf16_t* O; int ldc;
    __device__ __forceinline__ void operator()(const f32x4 (&acc)[2][2][4][2], const Unit& u, int wr, int wc, int fr, int fq) const {
        const int row0 = u.pm * BM + wr * 64 + fr, col0 = u.pn * BM + wc * 32 + 8 * fq;
#pragma unroll
        for (int ai = 0; ai < 2; ++ai)
#pragma unroll
            for (int m = 0; m < 4; ++m) { bf16_t* rowp = O + (size_t)(row0 + ai * HALF + m * 16) * ldc + col0;
#pragma unroll
                for (int bj = 0; bj < 2; ++bj) *(u32x4*)(rowp + bj * HALF) = pack8(acc[ai][bj][m][0], acc[ai][bj][m][1]); }
    }
};
struct EpiSwiGLU {
    static constexpr bool PERM = true, AFTER_DRAIN = false; static constexpr int NST = 8;
    bf16_t* O; int ldc;
    __device__ __forceinline__ void operator()(const f32x4 (&acc)[2][2][4][2], const Unit& u, int wr, int wc, int fr, int fq) const {
        const int row0 = u.pm * BM + wr * 64 + fr, col0 = u.pn * HALF + wc * 32 + 8 * fq;
#pragma unroll
        for (int ai = 0; ai < 2; ++ai)
#pragma unroll
            for (int m = 0; m < 4; ++m) { bf16_t* rowp = O + (size_t)(row0 + ai * HALF + m * 16) * ldc + col0;
                f32x4 o[2];
#pragma unroll
                for (int n = 0; n < 2; ++n) { const f32x4 g = acc[ai][0][m][n], up = acc[ai][1][m][n];
#pragma unroll
                    for (int e = 0; e < 4; ++e) o[n][e] = g[e] * sigmoid_f(g[e]) * up[e]; }
                *(u32x4*)rowp = pack8(o[0], o[1]); }
    }
};
struct EpiMix {
    static constexpr bool PERM = true, AFTER_DRAIN = false; static constexpr int NST = 16;
    bf16_t *Q, *K, *V, *U, *G; const float* cosT; const float* sinT; const float* gbias;
    __device__ __forceinline__ void operator()(const f32x4 (&acc)[2][2][4][2], const Unit& u, int wr, int wc, int fr, int fq) const {
        const int pn = u.pn, row0 = u.pm * BM + wr * 64 + fr;
        if (pn < 8) {
            bf16_t* base = (pn < 4 ? Q : K) + ((pn & 3) * 4 + wc) * 64 + 8 * fq;
            const float qs = pn < 4 ? 0.18033688011112042f : 1.0f;
#pragma unroll
            for (int ai = 0; ai < 2; ++ai) {
                f32x4 cc[4][2], ss[4][2];
#pragma unroll
                for (int m = 0; m < 4; ++m) { const int row = row0 + ai * HALF + m * 16;
                    cc[m][0] = *(const f32x4*)(cosT + (size_t)row * 32 + 8 * fq); cc[m][1] = *(const f32x4*)(cosT + (size_t)row * 32 + 8 * fq + 4);
                    ss[m][0] = *(const f32x4*)(sinT + (size_t)row * 32 + 8 * fq); ss[m][1] = *(const f32x4*)(sinT + (size_t)row * 32 + 8 * fq + 4); }
#pragma unroll
                for (int m = 0; m < 4; ++m) { const int row = row0 + ai * HALF + m * 16;
                    const f32x4 c0 = cc[m][0], c1 = cc[m][1], s0 = ss[m][0], s1 = ss[m][1];
                    const f32x4 x1a = acc[ai][0][m][0], x1b = acc[ai][0][m][1], x2a = acc[ai][1][m][0], x2b = acc[ai][1][m][1];
                    const f32x4 o1a = (x1a * c0 - x2a * s0) * qs, o1b = (x1b * c1 - x2b * s1) * qs, o2a = (x2a * c0 + x1a * s0) * qs, o2b = (x2b * c1 + x1b * s1) * qs;
                    bf16_t* rowp = base + (size_t)row * 1024;
                    *(u32x4*)rowp = pack8(o1a, o1b); *(u32x4*)(rowp + 32) = pack8(o2a, o2b); }
            }
        } else if (pn < 16) {
            bf16_t* base = (pn < 12 ? V : U) + (pn & 3) * BM + wc * 32 + 8 * fq;
#pragma unroll
            for (int ai = 0; ai < 2; ++ai)
#pragma unroll
                for (int m = 0; m < 4; ++m) { bf16_t* rowp = base + (size_t)(row0 + ai * HALF + m * 16) * 1024;
#pragma unroll
                    for (int bj = 0; bj < 2; ++bj) *(u32x4*)(rowp + bj * HALF) = pack8(acc[ai][bj][m][0], acc[ai][bj][m][1]); }
        } else {
            const int col0 = (pn - 16) * BM + wc * 32 + 8 * fq;
            f32x4 bv[2][2];
#pragma unroll
            for (int bj = 0; bj < 2; ++bj)
#pragma unroll
                for (int n = 0; n < 2; ++n) bv[bj][n] = *(const f32x4*)(gbias + col0 + bj * HALF + 4 * n);
#pragma unroll
            for (int ai = 0; ai < 2; ++ai)
#pragma unroll
                for (int m = 0; m < 4; ++m) { bf16_t* rowp = G + (size_t)(row0 + ai * HALF + m * 16) * 4096 + col0;
#pragma unroll
                    for (int bj = 0; bj < 2; ++bj) { f32x4 o[2];
#pragma unroll
                        for (int n = 0; n < 2; ++n) { const f32x4 v = acc[ai][bj][m][n] + bv[bj][n];
#pragma unroll
                            for (int e = 0; e < 4; ++e) o[n][e] = sigmoid_f(v[e]); }
                        *(u32x4*)(rowp + bj * HALF) = pack8(o[0], o[1]); } }
        }
    }
};
struct EpiGate {
    static constexpr bool PERM = true, AFTER_DRAIN = false; static constexpr int NST = 16;
    const bf16_t* gate; const bf16_t* addend; bf16_t* O;
    __device__ __forceinline__ void operator()(const f32x4 (&acc)[2][2][4][2], const Unit& u, int wr, int wc, int fr, int fq) const {
        const int row0 = u.pm * BM + wr * 64 + fr, col0 = u.pn * BM + wc * 32 + 8 * fq;
#pragma unroll
        for (int ai = 0; ai < 2; ++ai) {
            u32x4 gw[4][2], tw[4][2];
#pragma unroll
            for (int m = 0; m < 4; ++m)
#pragma unroll
                for (int bj = 0; bj < 2; ++bj) { const size_t row = (size_t)(row0 + ai * HALF + m * 16);
                    gw[m][bj] = *(const u32x4*)(gate + row * 4096 + col0 + bj * HALF);
                    if (addend) tw[m][bj] = *(const u32x4*)(addend + row * 2048 + col0 + bj * HALF); }
#pragma unroll
            for (int m = 0; m < 4; ++m)
#pragma unroll
                for (int bj = 0; bj < 2; ++bj) { const size_t row = (size_t)(row0 + ai * HALF + m * 16); const u32x4 g = gw[m][bj];
                    f32x4 a = acc[ai][bj][m][0], b = acc[ai][bj][m][1];
                    a[0] *= bf_lo(g.x); a[1] *= bf_hi(g.x); a[2] *= bf_lo(g.y); a[3] *= bf_hi(g.y); b[0] *= bf_lo(g.z); b[1] *= bf_hi(g.z); b[2] *= bf_lo(g.w); b[3] *= bf_hi(g.w);
                    if (addend) { const u32x4 t = tw[m][bj];
                        a[0] += bf_lo(t.x); a[1] += bf_hi(t.x); a[2] += bf_lo(t.y); a[3] += bf_hi(t.y); b[0] += bf_lo(t.z); b[1] += bf_hi(t.z); b[2] += bf_lo(t.w); b[3] += bf_hi(t.w); }
                    *(u32x4*)(O + row * 2048 + col0 + bj * HALF) = pack8(a, b); }
        }
    }
};

template <class Epi, class Sched, bool ALIGN_EPI = false, bool SP2 = false>
__device__ __forceinline__ void gemm_phase(PG8_LAS unsigned char* lds, const Gemm g, const Sched& S, const Epi& E) {
    int tid = threadIdx.x; asm volatile("" : "+v"(tid));
    const int wid = __builtin_amdgcn_readfirstlane(tid >> 6), lane = tid & 63, wr = wid >> 2, wc = wid & 3, fr = lane & 15, fq = lane >> 4;
    const int K = g.K, nt = K / BK;
    unsigned voffA[2], voffB[2];
#pragma unroll
    for (int i = 0; i < 2; ++i) { int R, C; stage_rc(tid * 16 + i * 8192, R, C); const int Rb = Epi::PERM ? ((R & ~31) + perm32(R & 31)) : R;
        voffA[i] = (unsigned)(R * K + C) * 2u; voffB[i] = (unsigned)(Rb * K + C) * 2u; }
    const size_t kstep = (size_t)(BK * 2);
    const size_t hstep = (size_t)HALF * K * 2;
    const size_t tstep = 2 * hstep;
    const unsigned ldsw = (unsigned)wid * 1024u;
    const int aoff = lds_byte(wr * 64 + fr, fq * 8), boff = lds_byte(wc * 32 + fr, fq * 8);
#define PG8_SA(b, h) (((b) * 2 + (h)) * HTB)
#define PG8_SB(b, h) ((4 + (b) * 2 + (h)) * HTB)
#define PG8_STAGE(bufoff, gbase, voff) do { _Pragma("unroll") for (int _i = 0; _i < 2; ++_i) \
        __builtin_amdgcn_global_load_lds((const unsigned*)((const char*)(gbase) + (voff)[_i]), (PG8_LAS unsigned*)(lds + (bufoff) + ldsw + _i * 8192), 16, 0, 0); } while (0)
#define PG8_LDA(dst, b, h) do { _Pragma("unroll") for (int m = 0; m < 4; ++m) _Pragma("unroll") for (int k = 0; k < 2; ++k) dst[m][k] = *(const PG8_LAS bf16x8*)(lds + PG8_SA(b, h) + aoff + m * 2048 + k * 1024); } while (0)
#define PG8_LDB(dst, b, h) do { _Pragma("unroll") for (int n = 0; n < 2; ++n) _Pragma("unroll") for (int k = 0; k < 2; ++k) dst[n][k] = *(const PG8_LAS bf16x8*)(lds + PG8_SB(b, h) + boff + n * 2048 + k * 1024); } while (0)
#define PG8_MMA(ai, bj, At, Bt) do { __builtin_amdgcn_s_setprio(1); _Pragma("unroll") for (int m = 0; m < 4; ++m) _Pragma("unroll") for (int n = 0; n < 2; ++n) _Pragma("unroll") for (int k = 0; k < 2; ++k) \
        acc[ai][bj][m][n] = __builtin_amdgcn_mfma_f32_16x16x32_bf16(Bt[n][k], At[m][k], acc[ai][bj][m][n], 0, 0, 0); __builtin_amdgcn_s_setprio(0); } while (0)
#define PG8_WAIT_V(n) asm volatile("s_waitcnt vmcnt(" #n ")" ::: "memory")
#define PG8_WAIT_L(n) asm volatile("s_waitcnt lgkmcnt(" #n ")" ::: "memory")
#define PG8_BAR __builtin_amdgcn_s_barrier()
#define PG8_SCHED __builtin_amdgcn_sched_barrier(0)
    Unit cur, nxt; int ui = 0;
    if (!S.next(0, cur)) return;
    f32x4 acc[2][2][4][2];
#pragma unroll
    for (int a = 0; a < 2; ++a)
#pragma unroll
        for (int b = 0; b < 2; ++b)
#pragma unroll
            for (int m = 0; m < 4; ++m)
#pragma unroll
                for (int n = 0; n < 2; ++n) acc[a][b][m][n] = (f32x4){0.f, 0.f, 0.f, 0.f};
    bf16x8 At[4][2], B0[2][2], B1[2][2];
    const char* cA = (const char*)g.A + (size_t)cur.pm * tstep; const char* cB = (const char*)g.Bt + (size_t)cur.pn * tstep;
    S.a_ready(cur);
    if constexpr (SP2) {
        PG8_STAGE(PG8_SB(0, 0), cB, voffB); PG8_STAGE(PG8_SB(0, 1), cB + hstep, voffB); PG8_STAGE(PG8_SA(0, 0), cA, voffA); PG8_STAGE(PG8_SA(0, 1), cA + hstep, voffA);
        if (wr == 1) PG8_BAR;
        PG8_WAIT_V(2); PG8_BAR;
        PG8_STAGE(PG8_SB(1, 0), cB + kstep, voffB); PG8_STAGE(PG8_SA(1, 0), cA + kstep, voffA); PG8_STAGE(PG8_SB(1, 1), cB + hstep + kstep, voffB);
        PG8_WAIT_V(6); PG8_BAR;
    } else {
        PG8_STAGE(PG8_SB(0, 0), cB, voffB); PG8_STAGE(PG8_SA(0, 0), cA, voffA); PG8_STAGE(PG8_SB(0, 1), cB + hstep, voffB); PG8_STAGE(PG8_SA(0, 1), cA + hstep, voffA);
        if (wr == 1) PG8_BAR;
        PG8_WAIT_V(4); PG8_BAR;
        PG8_STAGE(PG8_SB(1, 0), cB + kstep, voffB); PG8_STAGE(PG8_SA(1, 0), cA + kstep, voffA); PG8_STAGE(PG8_SB(1, 1), cB + hstep + kstep, voffB);
        PG8_WAIT_V(6); PG8_BAR;
    }
    for (;;) {
        const bool has_next = S.next(ui + 1, nxt);
        const char* nA = has_next ? (const char*)g.A + (size_t)nxt.pm * tstep : cA; const char* nB = has_next ? (const char*)g.Bt + (size_t)nxt.pn * tstep : cB;
        for (int t = 0; t < nt; t += 2) {
            const bool last = (t == nt - 2);
            const char* a1 = cA + (size_t)(t + 1) * kstep;
            const char* a2 = last ? nA : cA + (size_t)(t + 2) * kstep; const char* b2 = last ? nB : cB + (size_t)(t + 2) * kstep;
            const char* a3 = a2 + kstep; const char* b3 = b2 + kstep;
            if (last && has_next) S.a_ready(nxt);
            if constexpr (SP2) {
            PG8_LDB(B0, 0, 0); PG8_LDB(B1, 0, 1); PG8_SCHED; PG8_LDA(At, 0, 0); PG8_STAGE(PG8_SA(1, 1), a1 + hstep, voffA);
            PG8_WAIT_V(8); PG8_WAIT_L(0); PG8_BAR; PG8_MMA(0, 0, At, B0); PG8_MMA(0, 1, At, B1); PG8_BAR; PG8_SCHED;
            PG8_LDA(At, 0, 1); PG8_STAGE(PG8_SB(0, 0), b2, voffB); PG8_STAGE(PG8_SB(0, 1), b2 + hstep, voffB); PG8_STAGE(PG8_SA(0, 0), a2, voffA);
            PG8_WAIT_V(8); PG8_WAIT_L(0); PG8_BAR; PG8_MMA(1, 0, At, B0); PG8_MMA(1, 1, At, B1); PG8_BAR; PG8_SCHED;
            PG8_LDB(B0, 1, 0); PG8_LDB(B1, 1, 1); PG8_SCHED; PG8_LDA(At, 1, 0); PG8_STAGE(PG8_SA(0, 1), a2 + hstep, voffA);
            PG8_WAIT_V(8); PG8_WAIT_L(0); PG8_BAR; PG8_MMA(0, 0, At, B0); PG8_MMA(0, 1, At, B1); PG8_BAR; PG8_SCHED;
            PG8_LDA(At, 1, 1); PG8_STAGE(PG8_SB(1, 0), b3, voffB); PG8_STAGE(PG8_SB(1, 1), b3 + hstep, voffB); PG8_STAGE(PG8_SA(1, 0), a3, voffA);
            PG8_WAIT_V(8); PG8_WAIT_L(0); PG8_BAR; PG8_MMA(1, 0, At, B0); PG8_MMA(1, 1, At, B1); PG8_BAR; PG8_SCHED;
            } else {
            PG8_LDB(B0, 0, 0); PG8_SCHED; PG8_LDA(At, 0, 0); PG8_STAGE(PG8_SA(1, 1), a1 + hstep, voffA);
            PG8_WAIT_L(8); PG8_BAR; PG8_WAIT_L(0); PG8_MMA(0, 0, At, B0); PG8_BAR; PG8_SCHED;
            PG8_LDB(B1, 0, 1); PG8_STAGE(PG8_SB(0, 0), b2, voffB);
            PG8_BAR; PG8_WAIT_L(0); PG8_MMA(0, 1, At, B1); PG8_BAR;
            PG8_LDA(At, 0, 1); PG8_STAGE(PG8_SA(0, 0), a2, voffA);
            PG8_BAR; PG8_WAIT_L(0); PG8_MMA(1, 0, At, B0); PG8_BAR; PG8_SCHED;
            PG8_STAGE(PG8_SB(0, 1), b2 + hstep, voffB);
            PG8_WAIT_V(6); PG8_BAR; PG8_MMA(1, 1, At, B1); PG8_BAR;
            PG8_LDB(B0, 1, 0); PG8_SCHED; PG8_LDA(At, 1, 0); PG8_STAGE(PG8_SA(0, 1), a2 + hstep, voffA);
            PG8_WAIT_L(8); PG8_BAR; PG8_WAIT_L(0); PG8_MMA(0, 0, At, B0); PG8_BAR; PG8_SCHED;
            PG8_LDB(B1, 1, 1); PG8_STAGE(PG8_SB(1, 0), b3, voffB);
            PG8_BAR; PG8_WAIT_L(0); PG8_MMA(0, 1, At, B1); PG8_BAR;
            PG8_LDA(At, 1, 1); PG8_STAGE(PG8_SA(1, 0), a3, voffA);
            PG8_BAR; PG8_WAIT_L(0); PG8_MMA(1, 0, At, B0); PG8_BAR; PG8_SCHED;
            PG8_STAGE(PG8_SB(1, 1), b3 + hstep, voffB);
            PG8_WAIT_V(6); PG8_BAR; PG8_MMA(1, 1, At, B1); PG8_BAR;
            }
        }
        if constexpr (ALIGN_EPI) { if (wr == 0) PG8_BAR; }
        if constexpr (!Epi::AFTER_DRAIN) { E(acc, cur, wr, wc, fr, fq); S.done(cur); }
        if (!has_next) break;
#pragma unroll
        for (int a = 0; a < 2; ++a)
#pragma unroll
            for (int b = 0; b < 2; ++b)
#pragma unroll
                for (int m = 0; m < 4; ++m)
#pragma unroll
                    for (int n = 0; n < 2; ++n) acc[a][b][m][n] = (f32x4){0.f, 0.f, 0.f, 0.f};
        cur = nxt; cA = nA; cB = nB; ++ui;
        if constexpr (ALIGN_EPI) { if (wr == 1) PG8_BAR; }
    }
    PG8_WAIT_V(0);
    if constexpr (!ALIGN_EPI) { if (wr == 0) PG8_BAR; }
    PG8_BAR;
    if constexpr (Epi::AFTER_DRAIN) { E.fused(acc, cur, wr, wc, fr, fq, lds, wid, lane); S.done(cur); }
#undef PG8_SA
#undef PG8_SB
#undef PG8_STAGE
#undef PG8_LDA
#undef PG8_LDB
#undef PG8_MMA
#undef PG8_WAIT_V
#undef PG8_WAIT_L
#undef PG8_BAR
#undef PG8_SCHED
}
}
namespace dattn {
#define DA_LAS __attribute__((address_space(3)))
typedef unsigned short bf16_t;
using bf16x8 = __attribute__((ext_vector_type(8))) short;
using s16x4  = __attribute__((ext_vector_type(4))) short;
using f32x16 = __attribute__((ext_vector_type(16))) float;
using u32x4  = __attribute__((ext_vector_type(4))) unsigned;
constexpr int NW = 8, QBLK = 32, KVBLK = 64, PITCH = 1024, LDO = 2048;
constexpr float SCALE = 0.125f;
constexpr float THR = 8.f;
constexpr int SHM_V = KVBLK * 128 * 2, SHM_K = KVBLK * 64 * 2;
constexpr int NSLOT = 3, OFF_V = 0, OFF_K = NSLOT * SHM_V, OFF_WS = NSLOT * (SHM_V + SHM_K), LDS_BYTES = OFF_WS + NW * 64 * 4;
#define DA_KSWZ(row, colB) ((row) * 128 + ((colB) ^ ((((row) >> 1) & 7) << 4)))
#define DA_SBAR() __builtin_amdgcn_sched_barrier(0)
__device__ __forceinline__ int crow(int r, int hi) { return (r & 3) + 8 * (r >> 2) + 4 * hi; }
typedef float cvt_f32x2 __attribute__((ext_vector_type(2))); typedef __bf16 cvt_bf16x2 __attribute__((ext_vector_type(2)));
__device__ __forceinline__ unsigned cvtpk(float lo, float hi) { const cvt_f32x2 v = {lo, hi}; return __builtin_bit_cast(unsigned, __builtin_convertvector(v, cvt_bf16x2)); }
#ifdef DA_THR2_TEST
constexpr float THR2 = DA_THR2_TEST;
#else
constexpr float THR2 = THR * 1.4426950408889634f;
#endif
__device__ __forceinline__ void glds16s(const void* sbase, unsigned voff, unsigned lds_dst) { unsigned keep;
  asm volatile("s_mov_b32 %0, m0\n\ts_mov_b32 m0, %3\n\ts_nop 0\n\tglobal_load_lds_dwordx4 %1, %2\n\ts_mov_b32 m0, %0" : "=&s"(keep) : "v"(voff), "s"(sbase), "s"(lds_dst) : "memory"); }
#define DA_WAIT_BAR(N) do { __builtin_amdgcn_sched_barrier(0); asm volatile("s_waitcnt vmcnt(" #N ") lgkmcnt(0)\n\ts_barrier" ::: "memory"); __builtin_amdgcn_sched_barrier(0); } while (0)
__device__ __forceinline__ int v_st(int k, int c) { const int kk = (k & ~0xC) | ((k & 4) << 1) | ((k & 8) >> 1); return ((kk >> 3) * 4 + (c >> 5)) * 512 + ((kk & 7) * 32 + (c & 31)) * 2; }
__device__ __forceinline__ int v_rd_base(int lane) { return ((lane & 3) << 3) | (((lane >> 2) & 3) << 6) | (((lane >> 4) & 1) << 5) | (((lane >> 5) & 1) << 8); }
constexpr int v_rd_off(int d0, int ks, int half) { return d0 * 512 + ks * 4096 + half * 2048; }
template <int OFF> __device__ __forceinline__ s16x4 tr_read(int vb) {
  s16x4 r; asm volatile("ds_read_b64_tr_b16 %0, %1 offset:%2" : "=&v"(r) : "v"(vb), "i"(OFF) : "memory"); return r;
}
#define DA_PK(L, H) (bf16x8){L[0], L[1], L[2], L[3], H[0], H[1], H[2], H[3]}
#define DA_LGKM(N) do { asm volatile("s_waitcnt lgkmcnt(" #N ")" ::: "memory"); DA_SBAR(); } while (0)
template <int OFF> __device__ __forceinline__ bf16x8 lds_rd128(int a) { bf16x8 r; asm volatile("ds_read_b128 %0, %1 offset:%2" : "=&v"(r) : "v"(a), "i"(OFF) : "memory"); return r; }
typedef float f32x4a __attribute__((ext_vector_type(4)));
typedef unsigned v2u16 __attribute__((ext_vector_type(2)));
struct KPre16 { bf16x8 k[4][2]; };
__device__ __forceinline__ void prefetch_k16(KPre16& P, int kbase, int fr, int fq) {
  const int sw = ((fr >> 1) & 7) << 4, a0 = kbase + fr * 128 + ((16 * fq) ^ sw), a1 = kbase + fr * 128 + ((64 + 16 * fq) ^ sw);
  P.k[0][0] = lds_rd128<0>(a0); P.k[1][0] = lds_rd128<2048>(a0); P.k[2][0] = lds_rd128<4096>(a0); P.k[3][0] = lds_rd128<6144>(a0);
  P.k[0][1] = lds_rd128<0>(a1); P.k[1][1] = lds_rd128<2048>(a1); P.k[2][1] = lds_rd128<4096>(a1); P.k[3][1] = lds_rd128<6144>(a1);
}
__device__ __forceinline__ float xfq_max(float v) {
  auto r = __builtin_amdgcn_permlane16_swap(__float_as_uint(v), __float_as_uint(v), false, false); v = fmaxf(__uint_as_float(r[0]), __uint_as_float(r[1]));
  auto q = __builtin_amdgcn_permlane32_swap(__float_as_uint(v), __float_as_uint(v), false, false); return fmaxf(__uint_as_float(q[0]), __uint_as_float(q[1]));
}
__device__ __forceinline__ float xfq_sum(float v) {
  auto r = __builtin_amdgcn_permlane16_swap(__float_as_uint(v), __float_as_uint(v), false, false); v = __uint_as_float(r[0]) + __uint_as_float(r[1]);
  auto q = __builtin_amdgcn_permlane32_swap(__float_as_uint(v), __float_as_uint(v), false, false); return __uint_as_float(q[0]) + __uint_as_float(q[1]);
}
template <bool SAFE>
__device__ __forceinline__ void softmax16(f32x4a (&s)[2][4], float (&mhat)[2], bool first, float (&alpha)[2], bf16x8 (&pa)[2][2]) {
  if (SAFE) {
    float lm[2];
#pragma unroll
    for (int qb = 0; qb < 2; ++qb) { float m = fmaxf(s[qb][0][0], s[qb][0][1]);
#pragma unroll
      for (int kb = 0; kb < 4; ++kb)
#pragma unroll
        for (int j = (kb == 0 ? 2 : 0); j < 4; ++j) m = fmaxf(m, s[qb][kb][j]);
      lm[qb] = m; alpha[qb] = 1.f; }
    if (__builtin_expect(first || __any(mhat[0] != 0.f || mhat[1] != 0.f || fmaxf(lm[0], lm[1]) > THR2), 0)) {
#pragma unroll
      for (int qb = 0; qb < 2; ++qb) { const float ex = xfq_max(lm[qb]) - mhat[qb]; float dl = 0.f;
        if (first) { if (ex > THR2 || ex < -THR2) dl = ex; } else if (ex > THR2) dl = ex;
        mhat[qb] += dl;
#pragma unroll
        for (int kb = 0; kb < 4; ++kb) s[qb][kb] -= mhat[qb];
        alpha[qb] = first ? 1.f : __builtin_amdgcn_exp2f(-dl); }
    }
  }
#pragma unroll
  for (int qb = 0; qb < 2; ++qb) {
#pragma unroll
    for (int kb = 0; kb < 4; ++kb)
#pragma unroll
      for (int j = 0; j < 4; ++j) s[qb][kb][j] = __builtin_amdgcn_exp2f(s[qb][kb][j]);
#pragma unroll
    for (int g = 0; g < 2; ++g) { const u32x4 w = {cvtpk(s[qb][2 * g][0], s[qb][2 * g][1]), cvtpk(s[qb][2 * g][2], s[qb][2 * g][3]), cvtpk(s[qb][2 * g + 1][0], s[qb][2 * g + 1][1]), cvtpk(s[qb][2 * g + 1][2], s[qb][2 * g + 1][3])};
      pa[qb][g] = __builtin_bit_cast(bf16x8, w); }
  }
}
#define DA_W16(N) do { asm volatile("s_waitcnt lgkmcnt(" #N ")" ::: "memory"); DA_SBAR(); } while (0)
#define DA_RF16(J) do { vl[(J) & 7] = tr_read<8192 * ((J) >> 3)>(va[(J) & 7]); vh[(J) & 7] = tr_read<8192 * ((J) >> 3) + 4096>(va[(J) & 7]); DA_SBAR(); } while (0)
#define DA_PV16(J) do { const bf16x8 vf_ = DA_PK(vl[(J) & 7], vh[(J) & 7]); \
    o[0][(J) & 7] = __builtin_amdgcn_mfma_f32_16x16x32_bf16(vf_, pa[0][(J) >> 3], o[0][(J) & 7], 0, 0, 0); o[1][(J) & 7] = __builtin_amdgcn_mfma_f32_16x16x32_bf16(vf_, pa[1][(J) >> 3], o[1][(J) & 7], 0, 0, 0); } while (0)
struct NoDma16 { __device__ __forceinline__ void operator()() const {} };
template <bool HAS_QK, bool HAS_PV, class DMA = NoDma16>
__device__ __forceinline__ void m_seg16(f32x4a (&s)[2][4], KPre16& P, const bf16x8 (&qf)[2][2], f32x4a (&o)[2][8], f32x4a (&lacc)[2], const bf16x8& ones, const int (&va)[8], const bf16x8 (&pa)[2][2], DMA dma = NoDma16()) {
  s16x4 vl[8], vh[8];
  __builtin_amdgcn_s_setprio(2);
  if (HAS_QK) {
    const f32x4a z = {0.f, 0.f, 0.f, 0.f};
#define DA_QK16(KB, KS) do { s[0][KB] = __builtin_amdgcn_mfma_f32_16x16x32_bf16(P.k[KB][KS], qf[0][KS], (KS) == 0 ? z : s[0][KB], 0, 0, 0); \
    s[1][KB] = __builtin_amdgcn_mfma_f32_16x16x32_bf16(P.k[KB][KS], qf[1][KS], (KS) == 0 ? z : s[1][KB], 0, 0, 0); } while (0)
    DA_QK16(0, 0); dma(); DA_SBAR(); if (HAS_PV) DA_RF16(0); DA_QK16(1, 0); if (HAS_PV) DA_RF16(1); DA_QK16(2, 0); if (HAS_PV) DA_RF16(2); DA_QK16(3, 0); if (HAS_PV) DA_RF16(3);
    DA_QK16(0, 1); if (HAS_PV) DA_RF16(4); DA_QK16(1, 1); if (HAS_PV) DA_RF16(5); DA_QK16(2, 1); if (HAS_PV) DA_RF16(6); DA_QK16(3, 1); DA_SBAR();
#undef DA_QK16
  } else if (HAS_PV) { DA_RF16(0); DA_RF16(1); DA_RF16(2); DA_RF16(3); DA_RF16(4); DA_RF16(5); DA_RF16(6); }
  if (HAS_PV) {
    lacc[0] = __builtin_amdgcn_mfma_f32_16x16x32_bf16(ones, pa[0][0], lacc[0], 0, 0, 0); lacc[1] = __builtin_amdgcn_mfma_f32_16x16x32_bf16(ones, pa[1][0], lacc[1], 0, 0, 0);
    lacc[0] = __builtin_amdgcn_mfma_f32_16x16x32_bf16(ones, pa[0][1], lacc[0], 0, 0, 0); lacc[1] = __builtin_amdgcn_mfma_f32_16x16x32_bf16(ones, pa[1][1], lacc[1], 0, 0, 0);
    DA_SBAR();
    DA_W16(10); DA_PV16(0); DA_RF16(7);   DA_PV16(1); DA_RF16(8);   DA_W16(10); DA_PV16(2); DA_RF16(9);   DA_PV16(3); DA_RF16(10);
    DA_W16(10); DA_PV16(4); DA_RF16(11);  DA_PV16(5); DA_RF16(12);  DA_W16(10); DA_PV16(6); DA_RF16(13);  DA_PV16(7); DA_RF16(14);
    DA_W16(10); DA_PV16(8); DA_RF16(15);  DA_PV16(9); DA_SBAR();    DA_W16(8); DA_PV16(10); DA_SBAR();   DA_PV16(11); DA_SBAR();
    DA_W16(4); DA_PV16(12); DA_SBAR();    DA_PV16(13); DA_SBAR();    DA_W16(0); DA_PV16(14); DA_SBAR();    DA_PV16(15);
    asm volatile("" : "+v"(o[0][0]), "+v"(o[0][1]), "+v"(o[0][2]), "+v"(o[0][3]), "+v"(o[0][4]), "+v"(o[0][5]), "+v"(o[0][6]), "+v"(o[0][7]));
    asm volatile("" : "+v"(o[1][0]), "+v"(o[1][1]), "+v"(o[1][2]), "+v"(o[1][3]), "+v"(o[1][4]), "+v"(o[1][5]), "+v"(o[1][6]), "+v"(o[1][7]));
    asm volatile("" : "+v"(lacc[0]), "+v"(lacc[1]));
  }
  __builtin_amdgcn_s_setprio(0);
}
#undef DA_W16
#undef DA_RF16
#undef DA_PV16
template <bool SAFE>
__device__ __forceinline__ bool attn_unit16_body(const bf16_t* __restrict__ Qb, const bf16_t* __restrict__ Kh, const bf16_t* __restrict__ Vh, float* Ob, int seq, DA_LAS char* lds,
                                            bool second, float lam, float oscale, const float* __restrict__ subg, bf16_t* __restrict__ AOb) {
  int tid = threadIdx.x; asm volatile("" : "+v"(tid));
  const int wid = __builtin_amdgcn_readfirstlane(tid >> 6), lane = tid & 63, fr = lane & 15, fq = lane >> 4;
  const bool grpA = wid < 4;
  const unsigned lds0 = (unsigned)(size_t)lds;
  const int krow = 8 * wid + (lane >> 3), kpiece = (lane & 7) ^ ((krow >> 1) & 7);
  const unsigned ksrc = (unsigned)(krow * PITCH + kpiece * 8) * 2u;
  const int vr0 = 8 * wid + (lane >> 4), vr1 = vr0 + 4;
  const unsigned vsrc0 = (unsigned)(vr0 * PITCH + (((lane & 15) ^ (((vr0 & 3) << 2) | ((vr0 >> 2) & 3))) * 8)) * 2u;
  const unsigned vsrc1 = (unsigned)(vr1 * PITCH + (((lane & 15) ^ (((vr1 & 3) << 2) | ((vr1 >> 2) & 3))) * 8)) * 2u;
  const unsigned kdst = lds0 + OFF_K + wid * 1024, vdst = lds0 + OFF_V + wid * 2048;
#define DA_DMA_K(t, slot) glds16s(Kh + (long)(t) * KVBLK * PITCH, ksrc, (unsigned)__builtin_amdgcn_readfirstlane(kdst + (slot) * SHM_K))
#define DA_DMA_V(t, slot) do { glds16s(Vh + (long)(t) * KVBLK * PITCH, vsrc0, (unsigned)__builtin_amdgcn_readfirstlane(vdst + (slot) * SHM_V)); \
    glds16s(Vh + (long)(t) * KVBLK * PITCH, vsrc1, (unsigned)__builtin_amdgcn_readfirstlane(vdst + (slot) * SHM_V + 1024)); } while (0)
  const int NT = seq / KVBLK;
  DA_DMA_K(0, 0); DA_DMA_K(1, 1); DA_DMA_V(0, 0);
  float mhat[2] = {0.f, 0.f}, alpha[2] = {1.f, 1.f};
  f32x4a o[2][8] = {}; f32x4a lacc[2] = {}; f32x4a s[2][4] = {}; bf16x8 qf[2][2]; bf16x8 pa[2][2]; KPre16 P;
  bf16x8 ones; { const u32x4 w1 = {0x3f803f80u, 0x3f803f80u, 0x3f803f80u, 0x3f803f80u}; ones = __builtin_bit_cast(bf16x8, w1); asm volatile("" : "+v"(ones)); }
#pragma unroll
  for (int qb = 0; qb < 2; ++qb)
#pragma unroll
    for (int ks = 0; ks < 2; ++ks) qf[qb][ks] = *(const bf16x8*)(Qb + (long)(wid * QBLK + 16 * qb + fr) * PITCH + 32 * ks + 8 * fq);
  int va[8], vcur = 0;
  { const int e = fr >> 2, pp = fr & 3, x = (e << 2) | fq;
#pragma unroll
    for (int db = 0; db < 8; ++db) va[db] = (int)(lds0 + OFF_V) + 256 * (4 * fq + e) + 16 * ((2 * db + (pp >> 1)) ^ x) + 8 * (pp & 1); }
  const int kb0 = (int)(lds0 + OFF_K);
#define DA_VA(slot) { const int so_ = __builtin_amdgcn_readfirstlane(((slot) - vcur) * SHM_V); vcur = (slot); _Pragma("unroll") for (int db = 0; db < 8; ++db) { va[db] += so_; asm volatile("" : "+v"(va[db])); } }
#define DA_PREF_K(slot) prefetch_k16(P, kb0 + (slot) * SHM_K, fr, fq)
#define DA_RESC16() do { if (__any(alpha[0] < 1.f || alpha[1] < 1.f)) { _Pragma("unroll") for (int qb = 0; qb < 2; ++qb) { lacc[qb] *= alpha[qb]; _Pragma("unroll") for (int db = 0; db < 8; ++db) o[qb][db] *= alpha[qb]; } } } while (0)
#define DA_SEG_V(first) do { softmax16<SAFE>(s, mhat, (first), alpha, pa); asm volatile("" : "+v"(pa[0][0]), "+v"(pa[0][1]), "+v"(pa[1][0]), "+v"(pa[1][1])); if (SAFE) DA_RESC16(); } while (0)
  asm volatile("s_waitcnt vmcnt(3)" ::: "memory");
  DA_WAIT_BAR(3);
  int m0 = 0, m1 = 1, m2 = 2;
  if (grpA) {
    DA_DMA_K(2, 2); DA_DMA_V(1, 1);
    DA_PREF_K(0); DA_LGKM(0);
    m_seg16<true, false>(s, P, qf, o, lacc, ones, va, pa);
    DA_WAIT_BAR(3);
    DA_PREF_K(1);
    DA_SEG_V(true);
    DA_WAIT_BAR(3);
    m_seg16<true, true>(s, P, qf, o, lacc, ones, va, pa, [&]() { DA_DMA_K(3, 0); });
    DA_WAIT_BAR(3);
    m0 = 1; m1 = 2; m2 = 0;
#pragma unroll 1
    for (int t = 1; t + 1 < NT; ++t) {
      DA_PREF_K(m1);
      DA_SEG_V(false);
      DA_VA(m0);
      DA_DMA_V(t + 1, m1);
      if (t + 2 < NT) DA_WAIT_BAR(3); else DA_WAIT_BAR(2);
      m_seg16<true, true>(s, P, qf, o, lacc, ones, va, pa, [&]() { if (t + 3 < NT) DA_DMA_K(t + 3, m0); });
      if (t + 3 < NT) DA_WAIT_BAR(3); else DA_WAIT_BAR(0);
      { const int mm = m0; m0 = m1; m1 = m2; m2 = mm; }
    }
    DA_SEG_V(false);
    DA_VA(m0);
    DA_WAIT_BAR(0);
  } else {
    DA_DMA_K(2, 2); DA_DMA_V(1, 1);
    DA_PREF_K(0);
    DA_WAIT_BAR(3);
    m_seg16<true, false>(s, P, qf, o, lacc, ones, va, pa);
    DA_WAIT_BAR(3);
    DA_PREF_K(1);
    __builtin_amdgcn_s_setprio(1); DA_SEG_V(true); __builtin_amdgcn_s_setprio(0);
    DA_DMA_V(2, 2);
    DA_WAIT_BAR(2);
    m0 = 1; m1 = 2; m2 = 0;
#pragma unroll 1
    for (int t = 1; t + 1 < NT; ++t) {
      m_seg16<true, true>(s, P, qf, o, lacc, ones, va, pa, [&]() { if (t + 2 < NT) DA_DMA_K(t + 2, m2); });
      DA_WAIT_BAR(3);
      DA_PREF_K(m1);
      __builtin_amdgcn_s_setprio(1); DA_SEG_V(false); DA_VA(m0); __builtin_amdgcn_s_setprio(0);
      if (t + 2 < NT) { DA_DMA_V(t + 2, m2); DA_WAIT_BAR(2); } else DA_WAIT_BAR(0);
      { const int mm = m0; m0 = m1; m1 = m2; m2 = mm; }
    }
    m_seg16<true, true>(s, P, qf, o, lacc, ones, va, pa);
    DA_WAIT_BAR(0);
    __builtin_amdgcn_s_setprio(1); DA_SEG_V(false); DA_VA(m0); __builtin_amdgcn_s_setprio(0);
  }
  m_seg16<false, true>(s, P, qf, o, lacc, ones, va, pa);
  const float lsum[2] = {lacc[0][0], lacc[1][0]};
  int te = threadIdx.x; asm volatile("" : "+v"(te));
  const int wid_e = __builtin_amdgcn_readfirstlane(te >> 6), lane_e = te & 63, fr_e = lane_e & 15, fq_e = lane_e >> 4;
  if (!SAFE) {
    float om = 0.f;
#pragma unroll
    for (int qb = 0; qb < 2; ++qb)
#pragma unroll
      for (int db = 0; db < 8; ++db) om = fmaxf(fmaxf(om, fmaxf(fabsf(o[qb][db][0]), fabsf(o[qb][db][1]))), fmaxf(fabsf(o[qb][db][2]), fabsf(o[qb][db][3])));
#ifdef DA_TEST_FALLBACK
    const bool good = false;
#else
    const bool good = lsum[0] > 0x1p-100f && lsum[0] < 0x1p100f && lsum[1] > 0x1p-100f && lsum[1] < 0x1p100f && om < 0x1p120f;
#endif
    DA_LAS int* fl = (DA_LAS int*)(lds + OFF_WS);
    if (lane_e == 0) fl[wid_e] = __any(!good) ? 1 : 0;
    DA_WAIT_BAR(0);
    int bad = 0;
#pragma unroll
    for (int w = 0; w < NW; ++w) bad |= fl[w];
    if (__builtin_amdgcn_readfirstlane(bad)) { DA_WAIT_BAR(0); return false; }
  }
#pragma unroll
  for (int qb = 0; qb < 2; ++qb) {
    const float rl = __builtin_amdgcn_rcpf(lsum[qb]);
    const long row = wid_e * QBLK + 16 * qb + fr_e;
    if (!second) {
#pragma unroll
      for (int db = 0; db < 8; ++db) *(f32x4a*)(Ob + row * LDO + 16 * db + 4 * fq_e) = o[qb][db] * rl;
    } else {
      f32x4a d[8]; float ss = 0.f;
#pragma unroll
      for (int db = 0; db < 8; ++db) d[db] = *(const f32x4a*)(Ob + row * LDO + 16 * db + 4 * fq_e);
#pragma unroll
      for (int db = 0; db < 8; ++db) { d[db] = d[db] - (o[qb][db] * rl) * lam; ss += (d[db][0] * d[db][0] + d[db][1] * d[db][1]) + (d[db][2] * d[db][2] + d[db][3] * d[db][3]); }
      const float rs = oscale / sqrtf(xfq_sum(ss) * (1.0f / 128.0f) + 1e-5f);
#pragma unroll
      for (int db = 0; db < 8; ++db) { const f32x4a g = *(const f32x4a*)(subg + 16 * db + 4 * fq_e); const f32x4a v = d[db] * g * rs;
        const v2u16 w = {cvtpk(v[0], v[1]), cvtpk(v[2], v[3])}; *(v2u16*)(AOb + row * 1024 + 16 * db + 4 * fq_e) = w; }
    }
  }
  DA_WAIT_BAR(0);
  return true;
#undef DA_DMA_K
#undef DA_DMA_V
#undef DA_VA
#undef DA_PREF_K
#undef DA_RESC16
#undef DA_SEG_V
}
__device__ __forceinline__ void attn_unit16(const bf16_t* __restrict__ Qb, const bf16_t* __restrict__ Kh, const bf16_t* __restrict__ Vh, float* Ob, int seq, DA_LAS char* lds,
                                            bool second, float lam, float oscale, const float* __restrict__ subg, bf16_t* __restrict__ AOb) {
#ifndef DA_FORCE_SAFE
  if (attn_unit16_body<false>(Qb, Kh, Vh, Ob, seq, lds, second, lam, oscale, subg, AOb)) return;
#endif
#ifndef DA_FORCE_FAST
  attn_unit16_body<true>(Qb, Kh, Vh, Ob, seq, lds, second, lam, oscale, subg, AOb);
#endif
}
}

constexpr int NWAVES = 8;
constexpr int SEQ = 16384, DM = 2048, FF = 5632, AW = 1024, NHEAD = 8, FW = 1024, NGRP = 8, GD = 128, DEPTH = 2;
constexpr int NMOD = 9 * DM;
constexpr int KSPLIT = 16;
constexpr float NORM_EPS = 1e-6f, SUBLN_EPS = 1e-5f;

constexpr size_t MiB = 1u << 20;
constexpr size_t WS_CTL = 0, CTL_ZERO_BYTES = 1 * MiB;
constexpr size_t WS_COS = 1 * MiB, WS_SIN = 3 * MiB;
constexpr size_t WS_DFTC = 5 * MiB, WS_DFTS = 5 * MiB + 32768, WS_TW = 5 * MiB + 65536;
constexpr size_t WS_MODP = 6 * MiB;
constexpr size_t WS_MODF = 9 * MiB;
constexpr size_t WS_LAM = WS_MODF + (size_t)DEPTH * 9 * DM * 4;
constexpr size_t WS_W = 10 * MiB, W_LAYER = 180 * MiB;
constexpr size_t W_1IN = 0, W_1OUT = 44 * MiB, W_MIX = 66 * MiB, W_AP = 98 * MiB, W_FP = 102 * MiB, W_MO = 106 * MiB, W_2IN = 114 * MiB, W_2OUT = 158 * MiB;
constexpr size_t WS_H = 370 * MiB, WS_Y = 434 * MiB, WS_ACT = 498 * MiB, WS_M1 = 674 * MiB, WS_O = 802 * MiB, WS_END = 930 * MiB;
constexpr size_t WS_TRE = WS_Y, WS_TIM = WS_Y + 32 * MiB;
constexpr size_t WS_GATE = WS_ACT;
constexpr size_t WS_Q = WS_M1, WS_K = WS_M1 + 32 * MiB, WS_V = WS_M1 + 64 * MiB, WS_U = WS_M1 + 96 * MiB;
constexpr size_t WS_AO = WS_M1, WS_YF = WS_M1 + 32 * MiB, WS_MG = WS_M1 + 64 * MiB;
constexpr size_t WS_TT = WS_O;
constexpr int CW_TMO = 0, CW_CODE = 1, CW_BAR = 4096, CW_CHK = 16384;

constexpr int RING_OFF = 0, PHASE_LDS = 143360;
constexpr int LDSCTL_OFF = PHASE_LDS, MISC_OFF = LDSCTL_OFF + 320;
constexpr int LDS_BYTES = 147456;
static_assert(MISC_OFF + 128 <= LDS_BYTES, "LDS map");

#define GAS __attribute__((address_space(1)))
#define LAS __attribute__((address_space(3)))
typedef unsigned short bf16;
typedef unsigned v4u __attribute__((ext_vector_type(4)));
typedef unsigned v2u __attribute__((ext_vector_type(2)));
typedef float f32x4 __attribute__((ext_vector_type(4)));
typedef float f32x16 __attribute__((ext_vector_type(16)));
typedef short bf16x8 __attribute__((ext_vector_type(8)));
typedef short s16x4 __attribute__((ext_vector_type(4)));
typedef GAS unsigned gu32;
#define RLX_AGENT __ATOMIC_RELAXED, __HIP_MEMORY_SCOPE_AGENT
#define LDS_WAIT() asm volatile("s_waitcnt lgkmcnt(0)" ::: "memory")
#define VM_WAIT() asm volatile("s_waitcnt vmcnt(0)" ::: "memory")
__device__ __forceinline__ unsigned f2bf(float f) { unsigned u = __builtin_bit_cast(unsigned, f); return (u + 0x7fffu + ((u >> 16) & 1u)) >> 16; }
__device__ __forceinline__ unsigned pk2(float lo, float hi) { return f2bf(lo) | (f2bf(hi) << 16); }
__device__ __forceinline__ float bfl(unsigned w) { return __builtin_bit_cast(float, w << 16); }
__device__ __forceinline__ float bfh(unsigned w) { return __builtin_bit_cast(float, w & 0xffff0000u); }
__device__ __forceinline__ float wave_sum(float v) {
#pragma unroll
    for (int o = 1; o < 64; o <<= 1) v += __shfl_xor(v, o);
    return v;
}
__device__ __forceinline__ void sincos_turns(double t, double& s, double& c) {
    t -= floor(t);
    const double q = floor(t * 4.0 + 0.5);
    const double x = (t - q * 0.25) * 6.283185307179586476925286766559;
    const double x2 = x * x;
    double sp = -1.0 / 1307674368000.0; sp = sp * x2 + 1.0 / 6227020800.0; sp = sp * x2 - 1.0 / 39916800.0; sp = sp * x2 + 1.0 / 362880.0; sp = sp * x2 - 1.0 / 5040.0; sp = sp * x2 + 1.0 / 120.0; sp = sp * x2 - 1.0 / 6.0; sp = sp * x2 + 1.0;
    const double sx = sp * x;
    double cp = 1.0 / 20922789888000.0; cp = cp * x2 - 1.0 / 87178291200.0; cp = cp * x2 + 1.0 / 479001600.0; cp = cp * x2 - 1.0 / 3628800.0; cp = cp * x2 + 1.0 / 40320.0; cp = cp * x2 - 1.0 / 720.0; cp = cp * x2 + 1.0 / 24.0; cp = cp * x2 - 0.5; cp = cp * x2 + 1.0;
    const int qi = ((int)q) & 3;
    s = (qi == 0) ? sx : (qi == 1) ? cp : (qi == 2) ? -sx : -cp;
    c = (qi == 0) ? cp : (qi == 1) ? -sx : (qi == 2) ? -cp : sx;
}
__constant__ float ROPE_INV_FREQ[32] = {1.f,0.749894261f,0.562341332f,0.421696514f,0.316227764f,0.237137377f,0.177827939f,0.133352131f,0.100000001f,0.0749894157f,0.0562341325f,0.0421696529f,0.0316227749f,0.0237137377f,0.0177827943f,0.0133352149f,0.00999999978f,0.00749894185f,0.00562341325f,0.00421696482f,0.00316227763f,0.00237137359f,0.00177827943f,0.00133352145f,0.00100000005f,0.000749894243f,0.000562341302f,0.000421696517f,0.000316227757f,0.00023713737f,0.00017782794f,0.00013335215f};

#define XB_TMO      128
#define XB_XCNT(j)  (256  + 64 * (j))
#define XB_XSUB(j)  (1280 + 64 * (j))
#define XB_XGEN(j)  (2304 + 64 * (j))
#define XB_TOP      3328
#define XB_TOPGEN   3392
#define XCD_BAR_WORDS 3456
#define XB_SPIN_CAP (1u << 21)

__device__ __forceinline__ unsigned xb_ld(unsigned* p)              { return __hip_atomic_load(p, __ATOMIC_RELAXED, __HIP_MEMORY_SCOPE_AGENT); }
__device__ __forceinline__ unsigned xb_add(unsigned* p, unsigned v) { return __hip_atomic_fetch_add(p, v, __ATOMIC_RELAXED, __HIP_MEMORY_SCOPE_AGENT); }
__device__ __forceinline__ unsigned xb_xcc_id() { return (unsigned)__builtin_amdgcn_s_getreg((3 << 11) | 20) & 0xFu; }
#define XB_SPIN(cond, bar) do { unsigned _sp = 0; while (cond) { __builtin_amdgcn_s_sleep(1); \
    if ((++_sp & 255u) == 0u) { if (xb_ld(&(bar)[XB_TMO])) break; if (_sp > XB_SPIN_CAP) { atomicAdd(&(bar)[XB_TMO], 1u); break; } } } } while (0)

struct XcdBarrier {
    unsigned* bar; unsigned x;
    volatile LAS unsigned* st;
};

__device__ __forceinline__ XcdBarrier xcd_barrier_post(unsigned* bar, volatile LAS unsigned* st) {
    XcdBarrier b; b.bar = bar; b.x = xb_xcc_id(); b.st = st;
    if (threadIdx.x == 0) (void)xb_add(&bar[XB_XCNT(b.x)], 1u);
    return b;
}
__device__ __forceinline__ void xcd_barrier_complete(unsigned* bar, unsigned x, unsigned& nloc, unsigned& nx) {
    const unsigned G = gridDim.x * gridDim.y * gridDim.z;
    unsigned sum, cnt, mine, sp = 0u;
    for (;;) {
        sum = 0u; cnt = 0u; mine = 0u;
#pragma unroll
        for (unsigned j = 0; j < 16; ++j) { const unsigned c = xb_ld(&bar[XB_XCNT(j)]); sum += c; cnt += (c > 0u) ? 1u : 0u; mine = (j == x) ? c : mine; }
        if (sum == G) break;
        __builtin_amdgcn_s_sleep(1);
        if ((++sp & 255u) == 0u) { if (xb_ld(&bar[XB_TMO])) break; if (sp > XB_SPIN_CAP) { atomicAdd(&bar[XB_TMO], 1u); break; } }
    }
    nloc = mine > 0u ? mine : 1u; nx = cnt > 0u ? cnt : 1u;
}

__device__ __forceinline__ void xcd_barrier(const XcdBarrier& b) {
    asm volatile("s_waitcnt vmcnt(0)" ::: "memory");
    __syncthreads();
    if (threadIdx.x == 0) {
        unsigned* bar = b.bar; unsigned bx = b.x; asm volatile("" : "+s"(bx));
        __builtin_amdgcn_s_waitcnt(0);
        unsigned nloc = b.st[0], nx = b.st[1];
        if (nloc == 0u) { xcd_barrier_complete(bar, bx, nloc, nx); b.st[0] = nloc; b.st[1] = nx; }
        const unsigned old = xb_add(&bar[XB_XSUB(bx)], 1u);
        const unsigned gen = old / nloc;
        if (old + 1u == (gen + 1u) * nloc) {
            __builtin_amdgcn_fence(__ATOMIC_RELEASE, "agent");
            asm volatile("s_waitcnt vmcnt(0)" ::: "memory");
            const unsigned og = xb_add(&bar[XB_TOP], 1u);
            const unsigned tg = og / nx;
            if (og + 1u == (tg + 1u) * nx) xb_add(&bar[XB_TOPGEN], 1u);
            else XB_SPIN(xb_ld(&bar[XB_TOPGEN]) == tg, bar);
            __builtin_amdgcn_fence(__ATOMIC_ACQUIRE, "agent");
            xb_add(&bar[XB_XGEN(bx)], 1u);
            asm volatile("s_waitcnt vmcnt(0)" ::: "memory");
        } else {
            XB_SPIN(xb_ld(&bar[XB_XGEN(bx)]) == gen, bar);
            __builtin_amdgcn_fence(__ATOMIC_ACQUIRE, "agent");
            asm volatile("s_waitcnt vmcnt(0)" ::: "memory");
        }
    }
    __syncthreads();
}
struct Frame {
    LAS unsigned char* lds;
    volatile LAS unsigned* MISC;
    gu32* ctl;
    int tid, lane, wave;
    int vcu, G;
    unsigned char* ws;
};

__device__ __forceinline__ int wt_row(int mode, int row_off, int n0) {
    if (mode == 1) { const int up = n0 >= FF ? 1 : 0, j = n0 - up * FF; return (j >> 7) * 256 + up * 128 + (j & 127); }
    if (mode == 2) { if (n0 < 2048) { const int ch = n0 >> 6, d = n0 & 63; return 256 * (ch >> 2) + 128 * (d >> 5) + 32 * (ch & 3) + (d & 31); } return n0; }
    return row_off + n0;
}
__device__ __forceinline__ void p0_transpose_item(const float* W, int K, int N, bf16* WT, int mode, int row_off, LAS float* scr, int item, int lane) {
    const int nblk = N / 32, kb = item / nblk, nb = item % nblk, k0 = 64 * kb, n0 = 32 * nb;
#pragma unroll 8
    for (int i = 0; i < 32; ++i) { const int kk = 2 * i + (lane >> 5); scr[kk * 33 + (lane & 31)] = W[(size_t)(k0 + kk) * N + n0 + (lane & 31)]; }
    LDS_WAIT(); asm volatile("" ::: "memory");
    const int c = lane & 7, rbase = wt_row(mode, row_off, n0);
#pragma unroll
    for (int j = 0; j < 4; ++j) { const int n = (lane >> 3) + 8 * j; const LAS float* s = scr + (8 * c) * 33 + n;
        v4u o; o.x = pk2(s[0 * 33], s[1 * 33]); o.y = pk2(s[2 * 33], s[3 * 33]); o.z = pk2(s[4 * 33], s[5 * 33]); o.w = pk2(s[6 * 33], s[7 * 33]);
        *(GAS v4u*)(WT + (size_t)(rbase + n) * K + k0 + 8 * c) = o; }
    LDS_WAIT(); asm volatile("" ::: "memory");
}
struct In18 { const float* p[18]; };
__device__ __forceinline__ void p0_prologue(Frame& F, const In18& in) {
    LAS float* scr = (LAS float*)(F.lds + RING_OFF + F.wave * 16384);
    const int gw = F.vcu * NWAVES + F.wave, NGW = F.G * NWAVES;
    constexpr int I0 = 32 * 352, I1 = 88 * 64, I2 = 32 * 128, I3 = 32 * 128, I4 = 16 * 64, I5 = 16 * 64, I6 = 32 * 64, IL = 2 * I0 + 2 * I1 + I2 + I3 + I4 + I5 + I6;
    for (int it = gw; it < DEPTH * IL; it += NGW) {
        const int l = it / IL; int r = it % IL;
        bf16* wl = (bf16*)(F.ws + WS_W + (size_t)l * W_LAYER);
        if (r < I0) { p0_transpose_item(in.p[6] + (size_t)l * DM * 2 * FF, DM, 2 * FF, (bf16*)((unsigned char*)wl + W_1IN), 1, 0, scr, r, F.lane); continue; } r -= I0;
        if (r < I1) { p0_transpose_item(in.p[7] + (size_t)l * FF * DM, FF, DM, (bf16*)((unsigned char*)wl + W_1OUT), 0, 0, scr, r, F.lane); continue; } r -= I1;
        if (r < I2) { p0_transpose_item(in.p[8] + (size_t)l * DM * 4096, DM, 4096, (bf16*)((unsigned char*)wl + W_MIX), 2, 0, scr, r, F.lane); continue; } r -= I2;
        if (r < I3) { p0_transpose_item(in.p[13] + (size_t)l * DM * 4096, DM, 4096, (bf16*)((unsigned char*)wl + W_MIX), 0, 4096, scr, r, F.lane); continue; } r -= I3;
        if (r < I4) { p0_transpose_item(in.p[11] + (size_t)l * AW * DM, AW, DM, (bf16*)((unsigned char*)wl + W_AP), 0, 0, scr, r, F.lane); continue; } r -= I4;
        if (r < I5) { p0_transpose_item(in.p[12] + (size_t)l * FW * DM, FW, DM, (bf16*)((unsigned char*)wl + W_FP), 0, 0, scr, r, F.lane); continue; } r -= I5;
        if (r < I6) { p0_transpose_item(in.p[15] + (size_t)l * DM * DM, DM, DM, (bf16*)((unsigned char*)wl + W_MO), 0, 0, scr, r, F.lane); continue; } r -= I6;
        if (r < I0) { p0_transpose_item(in.p[16] + (size_t)l * DM * 2 * FF, DM, 2 * FF, (bf16*)((unsigned char*)wl + W_2IN), 1, 0, scr, r, F.lane); continue; } r -= I0;
        p0_transpose_item(in.p[17] + (size_t)l * FF * DM, FF, DM, (bf16*)((unsigned char*)wl + W_2OUT), 0, 0, scr, r, F.lane);
    }
    {
        constexpr int NCB = NMOD / 256, KR = DM / KSPLIT;
        const float* cvec = in.p[1]; float* modp = (float*)(F.ws + WS_MODP);
        for (int it = gw; it < DEPTH * NCB * KSPLIT; it += NGW) {
            const int l = it / (NCB * KSPLIT), r = it % (NCB * KSPLIT), ks = r / NCB, cb = r % NCB, c0 = cb * 256 + 4 * F.lane, k0 = ks * KR;
            const float* W = in.p[2] + (size_t)l * DM * NMOD + (size_t)k0 * NMOD + c0;
            f32x4 acc = {0.f, 0.f, 0.f, 0.f};
#pragma unroll 8
            for (int k = 0; k < KR; ++k) { const float cv = cvec[k0 + k]; const float ca = cv * __builtin_amdgcn_rcpf(1.0f + __builtin_amdgcn_exp2f(cv * -1.4426950408889634f));
                const f32x4 w = *(const GAS f32x4*)(W + (size_t)k * NMOD); acc += w * ca; }
            *(GAS f32x4*)(modp + (size_t)(l * KSPLIT + ks) * NMOD + c0) = acc;
        }
    }
    {
        const int gt = F.vcu * (NWAVES * 64) + F.tid, NT = F.G * NWAVES * 64;
        float* cosT = (float*)(F.ws + WS_COS); float* sinT = (float*)(F.ws + WS_SIN);
        for (int idx = gt; idx < SEQ * 32; idx += NT) { const int pos = idx >> 5, i = idx & 31; const float ang = (float)pos * ROPE_INV_FREQ[i];
            double s, c; sincos_turns((double)ang * 0.15915494309189533576888376337251, s, c); cosT[idx] = (float)c; sinT[idx] = (float)s; }
        bf16* dC = (bf16*)(F.ws + WS_DFTC); bf16* dS = (bf16*)(F.ws + WS_DFTS); float* tw = (float*)(F.ws + WS_TW);
        for (int idx = gt; idx < 128 * 128; idx += NT) { const int a = idx >> 7, b = idx & 127; double s, c;
            sincos_turns((double)((a * b) & 127) * (1.0 / 128.0), s, c); dC[idx] = (bf16)f2bf((float)c); dS[idx] = (bf16)f2bf((float)s);
            sincos_turns((double)(a * b) * (1.0 / 16384.0), s, c); tw[2 * idx] = (float)c; tw[2 * idx + 1] = (float)s; }
    }
}
__device__ __forceinline__ void p1_modfin(Frame& F, const In18& in) {
    const int gt = F.vcu * (NWAVES * 64) + F.tid, NT = F.G * NWAVES * 64;
    const float* modp = (const float*)(F.ws + WS_MODP); float* modf = (float*)(F.ws + WS_MODF);
    for (int idx = gt; idx < DEPTH * 3 * DM; idx += NT) { const int l = idx / (3 * DM), s = (idx / DM) % 3, c = idx % DM, base = s * 3 * DM + c;
        float sh = in.p[3][l * NMOD + base], sc = in.p[3][l * NMOD + base + DM], gt_ = in.p[3][l * NMOD + base + 2 * DM];
        for (int ks = 0; ks < KSPLIT; ++ks) { const float* q = modp + (size_t)(l * KSPLIT + ks) * NMOD + base; sh += q[0]; sc += q[DM]; gt_ += q[2 * DM]; }
        const float gpre = in.p[4][(l * 3 + s) * DM + c], gpost = in.p[5][(l * 3 + s) * DM + c];
        float* o = modf + (size_t)((l * 3 + s) * 3) * DM + c;
        o[0] = gpre * (1.0f + sc); o[DM] = sh; o[2 * DM] = (s == 1 ? 1.0f : 0.5f) * gt_ * gpost; }
    if (blockIdx.x == 0 && F.wave < DEPTH) { const int l = F.wave; const float* lq = in.p[9] + l * 256;
        const float sa = wave_sum(lq[F.lane] * lq[64 + F.lane]), sb = wave_sum(lq[128 + F.lane] * lq[192 + F.lane]);
        const float linit = l == 0 ? 0.2f : 0.35550906758f;
        if (F.lane == 0) { float* lamv = (float*)(F.ws + WS_LAM); lamv[l] = __builtin_amdgcn_exp2f(sa * 1.4426950408889634f) - __builtin_amdgcn_exp2f(sb * 1.4426950408889634f) + linit; lamv[2 + l] = 1.0f - linit; } }
}
template <bool HAS_Y, bool HAS_H>
__device__ __forceinline__ void norm_phase(Frame& F, const float* xin, float* xout, const bf16* y, bf16* h, const float* Gv, const float* Av, const float* Bv) {
    int lane = F.lane; asm volatile("" : "+v"(lane));
    const int gw = F.vcu * NWAVES + F.wave, NGW = F.G * NWAVES;
    f32x4 g[8], a[8], b[8];
#pragma unroll
    for (int j = 0; j < 8; ++j) { if (HAS_Y) g[j] = *(const GAS f32x4*)(Gv + 4 * lane + 256 * j); if (HAS_H) { a[j] = *(const GAS f32x4*)(Av + 4 * lane + 256 * j); b[j] = *(const GAS f32x4*)(Bv + 4 * lane + 256 * j); } }
    for (int row = gw; row < SEQ; row += NGW) {
        f32x4 x[8];
#pragma unroll
        for (int j = 0; j < 8; ++j) x[j] = *(const GAS f32x4*)(xin + (size_t)row * DM + 4 * lane + 256 * j);
        if (HAS_Y) {
            f32x4 yv[8]; float ss = 0.f;
#pragma unroll
            for (int j = 0; j < 8; ++j) { const v2u w = *(const GAS v2u*)(y + (size_t)row * DM + 4 * lane + 256 * j); yv[j] = (f32x4){bfl(w.x), bfh(w.x), bfl(w.y), bfh(w.y)};
                ss += (yv[j].x * yv[j].x + yv[j].y * yv[j].y) + (yv[j].z * yv[j].z + yv[j].w * yv[j].w); }
            const float ry = 1.0f / sqrtf(wave_sum(ss) * (1.0f / DM) + NORM_EPS);
#pragma unroll
            for (int j = 0; j < 8; ++j) x[j] = x[j] + g[j] * yv[j] * ry;
        }
        if (HAS_Y) {
#pragma unroll
            for (int j = 0; j < 8; ++j) *(GAS f32x4*)(xout + (size_t)row * DM + 4 * lane + 256 * j) = x[j];
        }
        if (HAS_H) {
            float ss = 0.f;
#pragma unroll
            for (int j = 0; j < 8; ++j) ss += (x[j].x * x[j].x + x[j].y * x[j].y) + (x[j].z * x[j].z + x[j].w * x[j].w);
            const float rx = 1.0f / sqrtf(wave_sum(ss) * (1.0f / DM) + NORM_EPS);
#pragma unroll
            for (int j = 0; j < 8; ++j) { const f32x4 v = x[j] * rx * a[j] + b[j]; v2u w; w.x = pk2(v.x, v.y); w.y = pk2(v.z, v.w); *(GAS v2u*)(h + (size_t)row * DM + 4 * lane + 256 * j) = w; }
        }
    }
}
__device__ __forceinline__ void combine_phase(Frame& F, const float* O, bf16* AO, const float* subg, float lam, float oscale) {
    int lane = F.lane; asm volatile("" : "+v"(lane));
    const int gw = F.vcu * NWAVES + F.wave, NGW = F.G * NWAVES, hh = lane >> 3, e0 = (lane & 7) * 16;
    f32x4 g[4];
#pragma unroll
    for (int j = 0; j < 4; ++j) g[j] = *(const GAS f32x4*)(subg + e0 + 4 * j) * oscale;
    for (int row = gw; row < SEQ; row += NGW) {
        const float* p0 = O + (size_t)row * 2048 + hh * 256 + e0;
        f32x4 o[4]; float ss = 0.f;
#pragma unroll
        for (int j = 0; j < 4; ++j) { const f32x4 a = *(const GAS f32x4*)(p0 + 4 * j), b = *(const GAS f32x4*)(p0 + 128 + 4 * j); o[j] = a - b * lam; ss += (o[j].x * o[j].x + o[j].y * o[j].y) + (o[j].z * o[j].z + o[j].w * o[j].w); }
        ss += __shfl_xor(ss, 1); ss += __shfl_xor(ss, 2); ss += __shfl_xor(ss, 4);
        const float r = 1.0f / sqrtf(ss * (1.0f / 128.0f) + SUBLN_EPS);
        v4u w0, w1; { const f32x4 v0 = o[0] * r * g[0], v1 = o[1] * r * g[1], v2 = o[2] * r * g[2], v3 = o[3] * r * g[3];
            w0.x = pk2(v0.x, v0.y); w0.y = pk2(v0.z, v0.w); w0.z = pk2(v1.x, v1.y); w0.w = pk2(v1.z, v1.w); w1.x = pk2(v2.x, v2.y); w1.y = pk2(v2.z, v2.w); w1.z = pk2(v3.x, v3.y); w1.w = pk2(v3.z, v3.w); }
        bf16* op = AO + (size_t)row * 1024 + hh * 128 + e0;
        *(GAS v4u*)op = w0; *(GAS v4u*)(op + 8) = w1;
    }
}
template <int DD> __device__ __forceinline__ void fft_mm2(f32x16& aR, f32x16& aI, int vb, const bf16x8* Ca, const bf16x8* Sa) {
    using namespace dattn;
    const s16x4 l0 = tr_read<v_rd_off(DD, 0, 0)>(vb), h0 = tr_read<v_rd_off(DD, 0, 1)>(vb), l1 = tr_read<v_rd_off(DD, 1, 0)>(vb), h1 = tr_read<v_rd_off(DD, 1, 1)>(vb);
    const s16x4 l2 = tr_read<v_rd_off(DD, 2, 0)>(vb), h2 = tr_read<v_rd_off(DD, 2, 1)>(vb), l3 = tr_read<v_rd_off(DD, 3, 0)>(vb), h3 = tr_read<v_rd_off(DD, 3, 1)>(vb);
    asm volatile("s_waitcnt lgkmcnt(0)" ::: "memory"); __builtin_amdgcn_sched_barrier(0);
    const bf16x8 b0 = DA_PK(l0, h0), b1 = DA_PK(l1, h1), b2 = DA_PK(l2, h2), b3 = DA_PK(l3, h3);
    aR = __builtin_amdgcn_mfma_f32_32x32x16_bf16(Ca[0], b0, aR, 0, 0, 0); aI = __builtin_amdgcn_mfma_f32_32x32x16_bf16(Sa[0], b0, aI, 0, 0, 0);
    aR = __builtin_amdgcn_mfma_f32_32x32x16_bf16(Ca[1], b1, aR, 0, 0, 0); aI = __builtin_amdgcn_mfma_f32_32x32x16_bf16(Sa[1], b1, aI, 0, 0, 0);
    aR = __builtin_amdgcn_mfma_f32_32x32x16_bf16(Ca[2], b2, aR, 0, 0, 0); aI = __builtin_amdgcn_mfma_f32_32x32x16_bf16(Sa[2], b2, aI, 0, 0, 0);
    aR = __builtin_amdgcn_mfma_f32_32x32x16_bf16(Ca[3], b3, aR, 0, 0, 0); aI = __builtin_amdgcn_mfma_f32_32x32x16_bf16(Sa[3], b3, aI, 0, 0, 0);
}
__device__ __forceinline__ void fftA_phase(Frame& F, const bf16* U, bf16* TRE, bf16* TIM, const bf16* dftC, const bf16* dftS, const float* TW) {
    using namespace dattn;
    int tid = threadIdx.x; asm volatile("" : "+v"(tid));
    const int wid = __builtin_amdgcn_readfirstlane(tid >> 6), lane = tid & 63, r32 = lane & 31, hi = lane >> 5, kb = wid & 3, ch = wid >> 2;
    bf16x8 Cf[8], Sf[8];
#pragma unroll
    for (int i = 0; i < 8; ++i) { Cf[i] = *(const bf16x8*)(dftC + (32 * kb + r32) * 128 + 16 * i + 8 * hi); Sf[i] = *(const bf16x8*)(dftS + (32 * kb + r32) * 128 + 16 * i + 8 * hi); }
    const int sr = tid >> 4, sc = (tid & 15) * 8, vst0 = v_st(sr, sc), vst1 = v_st(32 + sr, sc);
    LAS unsigned char* L = F.lds + RING_OFF;
    const int vb = (int)(unsigned)(size_t)L + v_rd_base(lane) + ch * 1024;
    for (int unit = F.vcu; unit < 128 * NGRP; unit += F.G) {
        const int n2 = unit >> 3, g = unit & 7;
        const bf16* src = U + (size_t)n2 * 1024 + g * 128 + sc;
        const bf16x8 x0 = *(const bf16x8*)(src + (size_t)sr * 131072), x1 = *(const bf16x8*)(src + (size_t)(32 + sr) * 131072), x2 = *(const bf16x8*)(src + (size_t)(64 + sr) * 131072), x3 = *(const bf16x8*)(src + (size_t)(96 + sr) * 131072);
        *(LAS bf16x8*)(L + vst0) = x0; *(LAS bf16x8*)(L + vst1) = x1; *(LAS bf16x8*)(L + 16384 + vst0) = x2; *(LAS bf16x8*)(L + 16384 + vst1) = x3;
        LDS_WAIT(); __syncthreads();
        f32x16 PR[2] = {}, PI[2] = {};
        fft_mm2<0>(PR[0], PI[0], vb, Cf, Sf); fft_mm2<1>(PR[1], PI[1], vb, Cf, Sf);
        fft_mm2<0>(PR[0], PI[0], vb + 16384, Cf + 4, Sf + 4); fft_mm2<1>(PR[1], PI[1], vb + 16384, Cf + 4, Sf + 4);
        LDS_WAIT(); __syncthreads();
        const float* tw = TW + (size_t)(n2 * 128 + 32 * kb + 4 * hi) * 2;
#pragma unroll
        for (int rg = 0; rg < 4; ++rg) { const f32x4 t0 = *(const GAS f32x4*)(tw + 16 * rg), t1 = *(const GAS f32x4*)(tw + 16 * rg + 4);
            const float cc[4] = {t0.x, t0.z, t1.x, t1.z}, ss[4] = {t0.y, t0.w, t1.y, t1.w};
#pragma unroll
            for (int e = 0; e < 4; ++e) { const int r = 4 * rg + e, k1 = 32 * kb + 8 * rg + 4 * hi + e; const size_t rowo = (size_t)(k1 * 128 + n2) * 1024 + g * 128 + 64 * ch + r32;
#pragma unroll
                for (int dd = 0; dd < 2; ++dd) { const float pr = PR[dd][r], pi = PI[dd][r]; TRE[rowo + 32 * dd] = (bf16)f2bf(pr * cc[e] - pi * ss[e]); TIM[rowo + 32 * dd] = (bf16)f2bf(-(pr * ss[e] + pi * cc[e])); } } }
    }
}
__device__ __forceinline__ void fftB_phase(Frame& F, const bf16* TRE, const bf16* TIM, bf16* YF, const bf16* dftC, const bf16* dftS) {
    using namespace dattn;
    constexpr int WSTR = 272, OFF_WR = 65536, OFF_WI = 65536 + 128 * WSTR;
    constexpr float NORMF = 6.905339660024878e-4f;
    int tid = threadIdx.x; asm volatile("" : "+v"(tid));
    const int wid = __builtin_amdgcn_readfirstlane(tid >> 6), lane = tid & 63, r32 = lane & 31, hi = lane >> 5, kb = wid & 3, ch = wid >> 2;
    bf16x8 Cf[8], Sf[8];
#pragma unroll
    for (int i = 0; i < 8; ++i) { Cf[i] = *(const bf16x8*)(dftC + (32 * kb + r32) * 128 + 16 * i + 8 * hi); Sf[i] = *(const bf16x8*)(dftS + (32 * kb + r32) * 128 + 16 * i + 8 * hi); }
    const int sr = tid >> 4, sc = (tid & 15) * 8, vst0 = v_st(sr, sc), vst1 = v_st(32 + sr, sc);
    LAS unsigned char* L = F.lds + RING_OFF;
    const int vb = (int)(unsigned)(size_t)L + v_rd_base(lane) + ch * 1024;
    for (int unit = F.vcu; unit < 128 * NGRP; unit += F.G) {
        const int k1 = unit >> 3, g = unit & 7;
        const size_t so = (size_t)(k1 * 128) * 1024 + g * 128 + sc;
        bf16x8 zr[4], zi[4];
#pragma unroll
        for (int q = 0; q < 4; ++q) { zr[q] = *(const bf16x8*)(TRE + so + (size_t)(32 * q + sr) * 1024); zi[q] = *(const bf16x8*)(TIM + so + (size_t)(32 * q + sr) * 1024); }
        *(LAS bf16x8*)(L + vst0) = zr[0]; *(LAS bf16x8*)(L + vst1) = zr[1]; *(LAS bf16x8*)(L + 16384 + vst0) = zr[2]; *(LAS bf16x8*)(L + 16384 + vst1) = zr[3];
        *(LAS bf16x8*)(L + 32768 + vst0) = zi[0]; *(LAS bf16x8*)(L + 32768 + vst1) = zi[1]; *(LAS bf16x8*)(L + 49152 + vst0) = zi[2]; *(LAS bf16x8*)(L + 49152 + vst1) = zi[3];
        LDS_WAIT(); __syncthreads();
        f32x16 WR[2] = {}, WI[2] = {}, WX[2] = {};
        fft_mm2<0>(WR[0], WX[0], vb, Cf, Sf); fft_mm2<1>(WR[1], WX[1], vb, Cf, Sf);
        fft_mm2<0>(WR[0], WX[0], vb + 16384, Cf + 4, Sf + 4); fft_mm2<1>(WR[1], WX[1], vb + 16384, Cf + 4, Sf + 4);
        fft_mm2<0>(WI[0], WR[0], vb + 32768, Cf, Sf); fft_mm2<1>(WI[1], WR[1], vb + 32768, Cf, Sf);
        fft_mm2<0>(WI[0], WR[0], vb + 49152, Cf + 4, Sf + 4); fft_mm2<1>(WI[1], WR[1], vb + 49152, Cf + 4, Sf + 4);
        WI[0] -= WX[0]; WI[1] -= WX[1];
#pragma unroll
        for (int dd = 0; dd < 2; ++dd)
#pragma unroll
            for (int r = 0; r < 16; ++r) { const int k2 = 32 * kb + crow(r, hi), j = 64 * ch + 32 * dd + r32;
                *(LAS unsigned short*)(L + OFF_WR + k2 * WSTR + j * 2) = (unsigned short)f2bf(WR[dd][r]); *(LAS unsigned short*)(L + OFF_WI + k2 * WSTR + j * 2) = (unsigned short)f2bf(WI[dd][r]); }
        LDS_WAIT(); __syncthreads();
        f32x16 Y[2] = {};
#pragma unroll
        for (int kk = 0; kk < 2; ++kk) { const int rb = (64 * ch + 32 * kk + r32) * WSTR + 16 * hi;
#pragma unroll
            for (int jc = 0; jc < 8; ++jc) { const bf16x8 aR = *(const LAS bf16x8*)(L + OFF_WR + rb + 32 * jc), aI = *(const LAS bf16x8*)(L + OFF_WI + rb + 32 * jc);
                Y[kk] = __builtin_amdgcn_mfma_f32_32x32x16_bf16(aR, Cf[jc], Y[kk], 0, 0, 0); Y[kk] = __builtin_amdgcn_mfma_f32_32x32x16_bf16(aI, Sf[jc], Y[kk], 0, 0, 0); } }
#pragma unroll
        for (int kk = 0; kk < 2; ++kk)
#pragma unroll
            for (int r = 0; r < 16; ++r) { const int k2 = 64 * ch + 32 * kk + crow(r, hi); YF[(size_t)(k1 + 128 * k2) * 1024 + g * 128 + 32 * kb + r32] = (bf16)f2bf(Y[kk][r] * NORMF); }
    }
}
#ifndef PHMASK
#define PHMASK 0xffffffffu
#endif
#define PH(k) (((PHMASK) >> (k)) & 1u)
#ifndef PHREPM
#define PHREPM 0u
#endif
#define REP(k) _Pragma("unroll 1") for (int rep_ = 0; rep_ < (int)(1u + (((PHREPM) >> (k)) & 1u)); ++rep_)
struct Args { const float* in[18]; float* out; unsigned char* ws; };
__global__ void __launch_bounds__(NWAVES * 64, 2) enc_fwd(Args args) {
    extern __shared__ __attribute__((aligned(16))) unsigned char lds[];
    Frame F;
    F.lds = (LAS unsigned char*)lds;
    F.MISC = (volatile LAS unsigned*)(F.lds + MISC_OFF);
    F.tid = threadIdx.x; F.lane = F.tid & 63; F.wave = __builtin_amdgcn_readfirstlane(F.tid >> 6);
    F.G = gridDim.x; { const int bx = blockIdx.x; F.vcu = (F.G % 8 == 0) ? (bx % 8) * (F.G / 8) + bx / 8 : bx; }
    F.ws = args.ws;
    unsigned char* ws = args.ws;
    F.ctl = (gu32*)(ws + WS_CTL);
    In18 in;
#pragma unroll
    for (int i = 0; i < 18; ++i) in.p[i] = args.in[i];
    for (int u = F.tid; u < (LDS_BYTES - LDSCTL_OFF) / 4; u += NWAVES * 64) ((LAS unsigned*)(F.lds + LDSCTL_OFF))[u] = 0u;
    __syncthreads();
    XcdBarrier bar = xcd_barrier_post((unsigned*)(F.ctl + CW_BAR), F.MISC + 8);
#ifdef PROBE_BAR
    unsigned long long bar_ticks = 0ull;
#define GRID_BAR() do { const unsigned long long w0_ = wall_clock64(); xcd_barrier(bar); bar_ticks += wall_clock64() - w0_; } while (0)
#else
#define GRID_BAR() xcd_barrier(bar)
#endif

    float* const xres = args.out;
    bf16* const HB = (bf16*)(ws + WS_H); bf16* const YB = (bf16*)(ws + WS_Y); bf16* const ACT = (bf16*)(ws + WS_ACT);
    bf16* const QB = (bf16*)(ws + WS_Q); bf16* const KB = (bf16*)(ws + WS_K); bf16* const VB = (bf16*)(ws + WS_V); bf16* const UB = (bf16*)(ws + WS_U);
    bf16* const GB = (bf16*)(ws + WS_GATE); float* const OB = (float*)(ws + WS_O);
    bf16* const TRE = (bf16*)(ws + WS_TRE); bf16* const TIM = (bf16*)(ws + WS_TIM);
    bf16* const YF = (bf16*)(ws + WS_YF); bf16* const AO = (bf16*)(ws + WS_AO); bf16* const MG = (bf16*)(ws + WS_MG); bf16* const TT = (bf16*)(ws + WS_TT);
    const float* const modf = (const float*)(ws + WS_MODF); const float* const lamv = (const float*)(ws + WS_LAM);
    const float* const cosT = (const float*)(ws + WS_COS); const float* const sinT = (const float*)(ws + WS_SIN);
    const bf16* const dftC = (const bf16*)(ws + WS_DFTC); const bf16* const dftS = (const bf16*)(ws + WS_DFTS); const float* const TW = (const float*)(ws + WS_TW);
#define MODF(l, s, k) (modf + (size_t)(((l) * 3 + (s)) * 3 + (k)) * DM)

    REP(0) if (PH(0)) p0_prologue(F, in);
    GRID_BAR();
    REP(1) if (PH(1)) p1_modfin(F, in);
    GRID_BAR();
    REP(2) if (PH(2)) norm_phase<false, true>(F, in.p[0], nullptr, nullptr, HB, nullptr, MODF(0, 0, 0), MODF(0, 0, 1));
#ifdef PROBE_NORM2
    for (int q_ = 0; q_ < 4; ++q_) norm_phase<false, true>(F, in.p[0], xres, nullptr, HB, nullptr, MODF(0, 0, 0), MODF(0, 0, 1));
#endif
    GRID_BAR();

    for (int l = 0; l < DEPTH; ++l) {
        const unsigned char* wl = ws + WS_W + (size_t)l * W_LAYER;
        { pg8::Gemm g{HB, (const bf16*)(wl + W_1IN), SEQ, 2 * FF, DM}; pg8::StaticOrder S; S.init(SEQ, 2 * FF, F.G, (int)blockIdx.x);
          pg8::EpiSwiGLU E{ACT, FF};
          REP(3) if (PH(3)) pg8::gemm_phase<pg8::EpiSwiGLU, pg8::StaticOrder, false, true>(F.lds + RING_OFF, g, S, E);
#ifdef PROBE_G1X2
          __syncthreads(); pg8::gemm_phase<pg8::EpiSwiGLU, pg8::StaticOrder, false, true>(F.lds + RING_OFF, g, S, E);
#endif
          GRID_BAR(); }
        { pg8::Gemm g{ACT, (const bf16*)(wl + W_1OUT), SEQ, DM, FF}; pg8::StaticOrder S; S.init(SEQ, DM, F.G, (int)blockIdx.x);
          pg8::EpiPlain E{YB, DM};
          REP(4) if (PH(4)) pg8::gemm_phase<pg8::EpiPlain, pg8::StaticOrder, true, true>(F.lds + RING_OFF, g, S, E); GRID_BAR(); }
        if (PH(5)) norm_phase<true, true>(F, l == 0 ? in.p[0] : xres, xres, YB, HB, MODF(l, 0, 2), MODF(l, 1, 0), MODF(l, 1, 1)); GRID_BAR();
        { pg8::Gemm g{HB, (const bf16*)(wl + W_MIX), SEQ, 8192, DM}; pg8::StaticOrder S; S.init(SEQ, 8192, F.G, (int)blockIdx.x);
          pg8::EpiMix E{QB, KB, VB, UB, GB, cosT, sinT, in.p[14] + (size_t)l * 4096};
          REP(6) if (PH(6)) pg8::gemm_phase<pg8::EpiMix, pg8::StaticOrder, false, true>(F.lds + RING_OFF, g, S, E); GRID_BAR(); }
        {
            const int xcd = F.vcu >> 5, j = F.vcu & 31;
            REP(7) if (!PH(7)) {} else if (F.G == 256) {
#pragma unroll 1
                for (int i = 0; i < 4; ++i) { const int vh = 2 * xcd + (i >> 1), qb = (i & 1) * 32 + j;
                    dattn::attn_unit16(QB + (size_t)(qb * 256) * 1024 + vh * 64, KB + vh * 64, VB + (vh >> 1) * 128, OB + (size_t)(qb * 256) * 2048 + (2 * xcd) * 128, SEQ, (LAS char*)(F.lds + RING_OFF),
                                     i >= 2, lamv[l], lamv[2 + l], in.p[10] + (size_t)l * 128, AO + (size_t)(qb * 256) * 1024 + xcd * 128); }
            } else {
#pragma unroll 1
                for (int un = F.vcu; un < 1024; un += F.G) { const int vh = un >> 6, qb = un & 63;
                    dattn::attn_unit16(QB + (size_t)(qb * 256) * 1024 + vh * 64, KB + vh * 64, VB + (vh >> 1) * 128, OB + (size_t)(qb * 256) * 2048 + vh * 128, SEQ, (LAS char*)(F.lds + RING_OFF),
                                     false, 0.f, 0.f, nullptr, nullptr); }
            }
            REP(8) if (PH(8)) fftA_phase(F, UB, TRE, TIM, dftC, dftS, TW);
#ifdef PROBE_FFT2
            fftA_phase(F, UB, TRE, TIM, dftC, dftS, TW);
#endif
            GRID_BAR();
        }
        REP(9) if (PH(9)) fftB_phase(F, TRE, TIM, YF, dftC, dftS);
#ifdef PROBE_FFT2
        fftB_phase(F, TRE, TIM, YF, dftC, dftS);
#endif
        REP(10) if (PH(10) && F.G != 256) combine_phase(F, OB, AO, in.p[10] + (size_t)l * 128, lamv[l], lamv[2 + l]);
#ifdef PROBE_COMB2
        combine_phase(F, OB, AO, in.p[10] + (size_t)l * 128, lamv[l], lamv[2 + l]);
#endif
        GRID_BAR();
        { pg8::Gemm g{AO, (const bf16*)(wl + W_AP), SEQ, DM, AW}; pg8::StaticOrder S; S.init(SEQ, DM, F.G, (int)blockIdx.x);
          pg8::EpiGate E{GB, nullptr, TT};
          REP(11) if (PH(11)) pg8::gemm_phase<pg8::EpiGate, pg8::StaticOrder, true, true>(F.lds + RING_OFF, g, S, E);
          VM_WAIT(); __syncthreads(); }
        { pg8::Gemm g{YF, (const bf16*)(wl + W_FP), SEQ, DM, FW}; pg8::StaticOrder S; S.init(SEQ, DM, F.G, (int)blockIdx.x);
          pg8::EpiGate E{GB + 2048, TT, MG};
          REP(12) if (PH(12)) pg8::gemm_phase<pg8::EpiGate, pg8::StaticOrder, true, true>(F.lds + RING_OFF, g, S, E); GRID_BAR(); }
        { pg8::Gemm g{MG, (const bf16*)(wl + W_MO), SEQ, DM, DM}; pg8::StaticOrder S; S.init(SEQ, DM, F.G, (int)blockIdx.x);
          pg8::EpiPlain E{YB, DM};
          REP(13) if (PH(13)) pg8::gemm_phase<pg8::EpiPlain, pg8::StaticOrder, true, true>(F.lds + RING_OFF, g, S, E); GRID_BAR(); }
        if (PH(14)) norm_phase<true, true>(F, xres, xres, YB, HB, MODF(l, 1, 2), MODF(l, 2, 0), MODF(l, 2, 1)); GRID_BAR();
        { pg8::Gemm g{HB, (const bf16*)(wl + W_2IN), SEQ, 2 * FF, DM}; pg8::StaticOrder S; S.init(SEQ, 2 * FF, F.G, (int)blockIdx.x);
          pg8::EpiSwiGLU E{ACT, FF};
          REP(15) if (PH(15)) pg8::gemm_phase<pg8::EpiSwiGLU, pg8::StaticOrder, false, true>(F.lds + RING_OFF, g, S, E); GRID_BAR(); }
        { pg8::Gemm g{ACT, (const bf16*)(wl + W_2OUT), SEQ, DM, FF}; pg8::StaticOrder S; S.init(SEQ, DM, F.G, (int)blockIdx.x);
          pg8::EpiPlain E{YB, DM};
          REP(16) if (PH(16)) pg8::gemm_phase<pg8::EpiPlain, pg8::StaticOrder, true, true>(F.lds + RING_OFF, g, S, E); GRID_BAR(); }
        if (l + 1 < DEPTH) { if (PH(17)) norm_phase<true, true>(F, xres, xres, YB, HB, MODF(l, 2, 2), MODF(l + 1, 0, 0), MODF(l + 1, 0, 1)); GRID_BAR(); }
        else if (PH(17)) norm_phase<true, false>(F, xres, xres, YB, nullptr, MODF(l, 2, 2), nullptr, nullptr);
    }
#ifdef PROBE_BAR
    if (blockIdx.x == PROBE_BAR - 1 && F.tid == 0) { const unsigned long long w0 = wall_clock64(); while (wall_clock64() - w0 < bar_ticks) __builtin_amdgcn_s_sleep(8); }
#endif
#ifdef PROBE_GEMM
    if (blockIdx.x == 0 && F.tid == 0) { VM_WAIT(); const unsigned long long sm = __hip_atomic_load(&pg8::g_gp_sum, __ATOMIC_RELAXED, __HIP_MEMORY_SCOPE_AGENT); const unsigned cn = __hip_atomic_load(&pg8::g_gp_cnt, __ATOMIC_RELAXED, __HIP_MEMORY_SCOPE_AGENT);
        const unsigned long long avg = cn ? sm / cn : 0ull, ticks = avg * 20ull;
        const unsigned long long w0 = wall_clock64(); while (wall_clock64() - w0 < ticks) __builtin_amdgcn_s_sleep(8); }
#endif
    if (blockIdx.x == 0) { int t_ = threadIdx.x; asm volatile("" : "+v"(t_)); if (t_ < 64) { VM_WAIT(); if (__hip_atomic_load((gu32*)((unsigned*)(args.ws + WS_CTL) + CW_BAR + XB_TMO), RLX_AGENT) != 0u) { const float q = __builtin_nanf(""); for (int c = t_; c < DM; c += 64) args.out[c] = q; } } }
}

extern "C" void kernel_launch(void* const* d_in, const int* in_sizes, int n_in, void* d_out, int out_size, void* d_ws, size_t ws_size, hipStream_t stream) {
    static int grid = 0;
    if (grid == 0) {
        if (n_in != 18 || in_sizes[0] != SEQ * DM || out_size != SEQ * DM || ws_size < WS_END) { fprintf(stderr, "kernel_launch: unexpected shapes: n_in %d in0 %d out %d ws %zu (need %zu)\n", n_in, n_in > 0 ? in_sizes[0] : -1, out_size, ws_size, (size_t)WS_END); grid = -1; return; }
        int dev = 0, cus = 0, per_cu = 0;
        if (hipGetDevice(&dev) != hipSuccess || hipDeviceGetAttribute(&cus, hipDeviceAttributeMultiprocessorCount, dev) != hipSuccess) { grid = -1; return; }
        if (hipFuncSetAttribute((const void*)enc_fwd, hipFuncAttributeMaxDynamicSharedMemorySize, LDS_BYTES) != hipSuccess) { fprintf(stderr, "kernel_launch: hipFuncSetAttribute failed\n"); grid = -1; return; }
        if (hipOccupancyMaxActiveBlocksPerMultiprocessor(&per_cu, (const void*)enc_fwd, NWAVES * 64, LDS_BYTES) != hipSuccess || per_cu < 1) { fprintf(stderr, "kernel_launch: occupancy query reports %d blocks per CU\n", per_cu); }
        (void)hipGetLastError();
        grid = cus;
    }
    if (grid < 0) return;
#ifdef DBG_ZERO_WS
    if (hipMemsetAsync((char*)d_ws, 0, WS_END, stream) != hipSuccess) return;
#else
    if (hipMemsetAsync((char*)d_ws + WS_CTL, 0, CTL_ZERO_BYTES, stream) != hipSuccess) return;
#endif
    Args a{};
    for (int i = 0; i < 18; ++i) a.in[i] = (const float*)d_in[i];
    a.out = (float*)d_out; a.ws = (unsigned char*)d_ws;
    hipLaunchKernelGGL(enc_fwd, dim3(grid), dim3(NWAVES * 64), LDS_BYTES, stream, a);
    const hipError_t le = hipPeekAtLastError();
    if (le != hipSuccess) fprintf(stderr, "kernel_launch: launch failed: %s\n", hipGetErrorName(le));
}
```

```cpp
#include <hip/hip_runtime.h>
#include <hip/hip_bf16.h>
#include <cstdio>
#include <cstdint>
#include <cmath>
namespace pg8 {
#define PG8_LAS __attribute__((address_space(3)))
typedef unsigned short bf16_t;
typedef short bf16x8 __attribute__((ext_vector_type(8)));
typedef float f32x4 __attribute__((ext_vector_type(4)));
typedef unsigned u32x4 __attribute__((ext_vector_type(4)));
constexpr int BM = 256, BK = 64, HALF = 128, HTB = HALF * BK * 2  , STAGE_BYTES = 8 * HTB, NXCD = 8, WGM = 8;

__host__ __device__ __forceinline__ int lds_byte(int r, int c) { const int st = (r >> 4) * 2 + (c >> 5), rr = r & 15, cc = c & 31, ob = rr * 64 + cc * 2; return st * 1024 + (ob ^ (((ob >> 9) & 1) << 5)); }
__host__ __device__ __forceinline__ void stage_rc(int b, int& R, int& C) { const int st = b / 1024, sb = b % 1024, swz = sb ^ (((sb >> 9) & 1) << 5); R = (st >> 1) * 16 + swz / 64; C = (st & 1) * 32 + (swz % 64) / 2; }
__host__ __device__ __forceinline__ int perm32(int rho) { const int n = rho >> 4, i = rho & 15; return 8 * (i >> 2) + 4 * n + (i & 3); }

struct Unit { int pm, pn; };
struct Gemm { const bf16_t* A; const bf16_t* Bt; int M, N, K; };

struct StaticOrder {
    int nM, nN, nwg, G, c;
    __host__ __device__ void init(int M, int N, int G_, int c_) { nM = M / BM; nN = N / BM; nwg = nM * nN; G = G_; c = c_; }
    __host__ __device__ bool next(int i, Unit& u) const {
        const long L = (long)i * G + c; if (L >= nwg) return false;
        int wgid = (int)L; { const int q = nwg / NXCD, r = nwg % NXCD, xcd = wgid % NXCD, off = wgid / NXCD; wgid = (xcd < r ? xcd * (q + 1) : r * (q + 1) + (xcd - r) * q) + off; }
        const int nig = WGM * nN, gid = wgid / nig, fm = gid * WGM, gsz = (nM - fm) < WGM ? (nM - fm) : WGM;
        u.pm = fm + ((wgid % nig) % gsz); u.pn = (wgid % nig) / gsz; return true;
    }
    __device__ __forceinline__ void a_ready(const Unit&) const {}
    __device__ __forceinline__ void done(const Unit&) const {}
};

typedef float cvt_f32x2 __attribute__((ext_vector_type(2))); typedef __bf16 cvt_bf16x2 __attribute__((ext_vector_type(2)));
__device__ __forceinline__ unsigned cvt_pk_bf16(float lo, float hi) { const cvt_f32x2 v = {lo, hi}; return __builtin_bit_cast(unsigned, __builtin_convertvector(v, cvt_bf16x2)); }
typedef float f32x2 __attribute__((ext_vector_type(2)));
__device__ __forceinline__ float bf_lo(unsigned w) { return __builtin_bit_cast(float, w << 16); }
__device__ __forceinline__ float bf_hi(unsigned w) { return __builtin_bit_cast(float, w & 0xffff0000u); }
__device__ __forceinline__ float sigmoid_f(float v) { return __builtin_amdgcn_rcpf(1.0f + __builtin_amdgcn_exp2f(v * -1.4426950408889634f)); }
__device__ __forceinline__ u32x4 pack8(const f32x4 a, const f32x4 b) { u32x4 w; w.x = cvt_pk_bf16(a[0], a[1]); w.y = cvt_pk_bf16(a[2], a[3]); w.z = cvt_pk_bf16(b[0], b[1]); w.w = cvt_pk_bf16(b[2], b[3]); return w; }

struct EpiPlain {
    static constexpr bool PERM = true, AFTER_DRAIN = false; static constexpr int NST = 16;
    bf16_t* O; int ldc;
    __device__ __forceinline__ void operator()(const f32x4 (&acc)[2][2][4][2], const Unit& u, int wr, int wc, int fr, int fq) const {
        const int row0 = u.pm * BM + wr * 64 + fr, col0 = u.pn * BM + wc * 32 + 8 * fq;
#pragma unroll
        for (int ai = 0; ai < 2; ++ai)
#pragma unroll
            for (int m = 0; m < 4; ++m) { bf16_t* rowp = O + (size_t)(row0 + ai * HALF + m * 16) * ldc + col0;
#pragma unroll
                for (int bj = 0; bj < 2; ++bj) *(u32x4*)(rowp + bj * HALF) = pack8(acc[ai][bj][m][0], acc[ai][bj][m][1]); }
    }
};
struct EpiSwiGLU {
    static constexpr bool PERM = true, AFTER_DRAIN = false; static constexpr int NST = 8;
    bf16_t* O; int ldc;
    __device__ __forceinline__ void operator()(const f32x4 (&acc)[2][2][4][2], const Unit& u, int wr, int wc, int fr, int fq) const {
        const int row0 = u.pm * BM + wr * 64 + fr, col0 = u.pn * HALF + wc * 32 + 8 * fq;
#pragma unroll
        for (int ai = 0; ai < 2; ++ai)
#pragma unroll
            for (int m = 0; m < 4; ++m) { bf16_t* rowp = O + (size_t)(row0 + ai * HALF + m * 16) * ldc + col0;
                f32x4 o[2];
#pragma unroll
                for (int n = 0; n < 2; ++n) { const f32x4 g = acc[ai][0][m][n], up = acc[ai][1][m][n];
#pragma unroll
                    for (int e = 0; e < 4; ++e) o[n][e] = g[e] * sigmoid_f(g[e]) * up[e]; }
                *(u32x4*)rowp = pack8(o[0], o[1]); }
    }
};
struct EpiMix {
    static constexpr bool PERM = true, AFTER_DRAIN = false; static constexpr int NST = 16;
    bf16_t *Q, *K, *V, *U, *G; const float* cosT; const float* sinT; const float* gbias;
    __device__ __forceinline__ void operator()(const f32x4 (&acc)[2][2][4][2], const Unit& u, int wr, int wc, int fr, int fq) const {
        const int pn = u.pn, row0 = u.pm * BM + wr * 64 + fr;
        if (pn < 8) {
            bf16_t* base = (pn < 4 ? Q : K) + ((pn & 3) * 4 + wc) * 64 + 8 * fq;
            const float qs = pn < 4 ? 0.18033688011112042f : 1.0f;
#pragma unroll
            for (int ai = 0; ai < 2; ++ai) {
                f32x4 cc[4][2], ss[4][2];
#pragma unroll
                for (int m = 0; m < 4; ++m) { const int row = row0 + ai * HALF + m * 16;
                    cc[m][0] = *(const f32x4*)(cosT + (size_t)row * 32 + 8 * fq); cc[m][1] = *(const f32x4*)(cosT + (size_t)row * 32 + 8 * fq + 4);
                    ss[m][0] = *(const f32x4*)(sinT + (size_t)row * 32 + 8 * fq); ss[m][1] = *(const f32x4*)(sinT + (size_t)row * 32 + 8 * fq + 4); }
#pragma unroll
                for (int m = 0; m < 4; ++m) { const int row = row0 + ai * HALF + m * 16;
                    const f32x4 c0 = cc[m][0], c1 = cc[m][1], s0 = ss[m][0], s1 = ss[m][1];
                    const f32x4 x1a = acc[ai][0][m][0], x1b = acc[ai][0][m][1], x2a = acc[ai][1][m][0], x2b = acc[ai][1][m][1];
                    const f32x4 o1a = (x1a * c0 - x2a * s0) * qs, o1b = (x1b * c1 - x2b * s1) * qs, o2a = (x2a * c0 + x1a * s0) * qs, o2b = (x2b * c1 + x1b * s1) * qs;
                    bf16_t* rowp = base + (size_t)row * 1024;
                    *(u32x4*)rowp = pack8(o1a, o1b); *(u32x4*)(rowp + 32) = pack8(o2a, o2b); }
            }
        } else if (pn < 16) {
            bf16_t* base = (pn < 12 ? V : U) + (pn & 3) * BM + wc * 32 + 8 * fq;
#pragma unroll
            for (int ai = 0; ai < 2; ++ai)
#pragma unroll
                for (int m = 0; m < 4; ++m) { bf16_t* rowp = base + (size_t)(row0 + ai * HALF + m * 16) * 1024;
#pragma unroll
                    for (int bj = 0; bj < 2; ++bj) *(u32x4*)(rowp + bj * HALF) = pack8(acc[ai][bj][m][0], acc[ai][bj][m][1]); }
        } else {
            const int col0 = (pn - 16) * BM + wc * 32 + 8 * fq;
            f32x4 bv[2][2];
#pragma unroll
            for (int bj = 0; bj < 2; ++bj)
#pragma unroll
                for (int n = 0; n < 2; ++n) bv[bj][n] = *(const f32x4*)(gbias + col0 + bj * HALF + 4 * n);
#pragma unroll
            for (int ai = 0; ai < 2; ++ai)
#pragma unroll
                for (int m = 0; m < 4; ++m) { bf16_t* rowp = G + (size_t)(row0 + ai * HALF + m * 16) * 4096 + col0;
#pragma unroll
                    for (int bj = 0; bj < 2; ++bj) { f32x4 o[2];
#pragma unroll
                        for (int n = 0; n < 2; ++n) { const f32x4 v = acc[ai][bj][m][n] + bv[bj][n];
#pragma unroll
                            for (int e = 0; e < 4; ++e) o[n][e] = sigmoid_f(v[e]); }
                        *(u32x4*)(rowp + bj * HALF) = pack8(o[0], o[1]); } }
        }
    }
};
struct EpiGate {
    static constexpr bool PERM = true, AFTER_DRAIN = false; static constexpr int NST = 16;
    const bf16_t* gate; const bf16_t* addend; bf16_t* O;
    __device__ __forceinline__ void operator()(const f32x4 (&acc)[2][2][4][2], const Unit& u, int wr, int wc, int fr, int fq) const {
        const int row0 = u.pm * BM + wr * 64 + fr, col0 = u.pn * BM + wc * 32 + 8 * fq;
#pragma unroll
        for (int ai = 0; ai < 2; ++ai) {
            u32x4 gw[4][2], tw[4][2];
#pragma unroll
            for (int m = 0; m < 4; ++m)
#pragma unroll
                for (int bj = 0; bj < 2; ++bj) { const size_t row = (size_t)(row0 + ai * HALF + m * 16);
                    gw[m][bj] = *(const u32x4*)(gate + row * 4096 + col0 + bj * HALF);
                    if (addend) tw[m][bj] = *(const u32x4*)(addend + row * 2048 + col0 + bj * HALF); }
#pragma unroll
            for (int m = 0; m < 4; ++m)
#pragma unroll
                for (int bj = 0; bj < 2; ++bj) { const size_t row = (size_t)(row0 + ai * HALF + m * 16); const u32x4 g = gw[m][bj];
                    f32x4 a = acc[ai][bj][m][0], b = acc[ai][bj][m][1];
                    a[0] *= bf_lo(g.x); a[1] *= bf_hi(g.x); a[2] *= bf_lo(g.y); a[3] *= bf_hi(g.y); b[0] *= bf_lo(g.z); b[1] *= bf_hi(g.z); b[2] *= bf_lo(g.w); b[3] *= bf_hi(g.w);
                    if (addend) { const u32x4 t = tw[m][bj];
                        a[0] += bf_lo(t.x); a[1] += bf_hi(t.x); a[2] += bf_lo(t.y); a[3] += bf_hi(t.y); b[0] += bf_lo(t.z); b[1] += bf_hi(t.z); b[2] += bf_lo(t.w); b[3] += bf_hi(t.w); }
                    *(u32x4*)(O + row * 2048 + col0 + bj * HALF) = pack8(a, b); }
        }
    }
};

template <class Epi, class Sched, bool ALIGN_EPI = false, bool SP2 = false>
__device__ __forceinline__ void gemm_phase(PG8_LAS unsigned char* lds, const Gemm g, const Sched& S, const Epi& E) {
    int tid = threadIdx.x; asm volatile("" : "+v"(tid));
    const int wid = __builtin_amdgcn_readfirstlane(tid >> 6), lane = tid & 63, wr = wid >> 2, wc = wid & 3, fr = lane & 15, fq = lane >> 4;
    const int K = g.K, nt = K / BK;
    unsigned voffA[2], voffB[2];
#pragma unroll
    for (int i = 0; i < 2; ++i) { int R, C; stage_rc(tid * 16 + i * 8192, R, C); const int Rb = Epi::PERM ? ((R & ~31) + perm32(R & 31)) : R;
        voffA[i] = (unsigned)(R * K + C) * 2u; voffB[i] = (unsigned)(Rb * K + C) * 2u; }
    const size_t kstep = (size_t)(BK * 2);
    const size_t hstep = (size_t)HALF * K * 2;
    const size_t tstep = 2 * hstep;
    const unsigned ldsw = (unsigned)wid * 1024u;
    const int aoff = lds_byte(wr * 64 + fr, fq * 8), boff = lds_byte(wc * 32 + fr, fq * 8);
#define PG8_SA(b, h) (((b) * 2 + (h)) * HTB)
#define PG8_SB(b, h) ((4 + (b) * 2 + (h)) * HTB)
#define PG8_STAGE(bufoff, gbase, voff) do { _Pragma("unroll") for (int _i = 0; _i < 2; ++_i) \
        __builtin_amdgcn_global_load_lds((const unsigned*)((const char*)(gbase) + (voff)[_i]), (PG8_LAS unsigned*)(lds + (bufoff) + ldsw + _i * 8192), 16, 0, 0); } while (0)
#define PG8_LDA(dst, b, h) do { _Pragma("unroll") for (int m = 0; m < 4; ++m) _Pragma("unroll") for (int k = 0; k < 2; ++k) dst[m][k] = *(const PG8_LAS bf16x8*)(lds + PG8_SA(b, h) + aoff + m * 2048 + k * 1024); } while (0)
#define PG8_LDB(dst, b, h) do { _Pragma("unroll") for (int n = 0; n < 2; ++n) _Pragma("unroll") for (int k = 0; k < 2; ++k) dst[n][k] = *(const PG8_LAS bf16x8*)(lds + PG8_SB(b, h) + boff + n * 2048 + k * 1024); } while (0)
#define PG8_MMA(ai, bj, At, Bt) do { __builtin_amdgcn_s_setprio(1); _Pragma("unroll") for (int m = 0; m < 4; ++m) _Pragma("unroll") for (int n = 0; n < 2; ++n) _Pragma("unroll") for (int k = 0; k < 2; ++k) \
        acc[ai][bj][m][n] = __builtin_amdgcn_mfma_f32_16x16x32_bf16(Bt[n][k], At[m][k], acc[ai][bj][m][n], 0, 0, 0); __builtin_amdgcn_s_setprio(0); } while (0)
#define PG8_WAIT_V(n) asm volatile("s_waitcnt vmcnt(" #n ")" ::: "memory")
#define PG8_WAIT_L(n) asm volatile("s_waitcnt lgkmcnt(" #n ")" ::: "memory")
#define PG8_BAR __builtin_amdgcn_s_barrier()
#define PG8_SCHED __builtin_amdgcn_sched_barrier(0)
    Unit cur, nxt; int ui = 0;
    if (!S.next(0, cur)) return;
    f32x4 acc[2][2][4][2];
#pragma unroll
    for (int a = 0; a < 2; ++a)
#pragma unroll
        for (int b = 0; b < 2; ++b)
#pragma unroll
            for (int m = 0; m < 4; ++m)
#pragma unroll
                for (int n = 0; n < 2; ++n) acc[a][b][m][n] = (f32x4){0.f, 0.f, 0.f, 0.f};
    bf16x8 At[4][2], B0[2][2], B1[2][2];
    const char* cA = (const char*)g.A + (size_t)cur.pm * tstep; const char* cB = (const char*)g.Bt + (size_t)cur.pn * tstep;
    S.a_ready(cur);
    if constexpr (SP2) {
        PG8_STAGE(PG8_SB(0, 0), cB, voffB); PG8_STAGE(PG8_SB(0, 1), cB + hstep, voffB); PG8_STAGE(PG8_SA(0, 0), cA, voffA); PG8_STAGE(PG8_SA(0, 1), cA + hstep, voffA);
        if (wr == 1) PG8_BAR;
        PG8_WAIT_V(2); PG8_BAR;
        PG8_STAGE(PG8_SB(1, 0), cB + kstep, voffB); PG8_STAGE(PG8_SA(1, 0), cA + kstep, voffA); PG8_STAGE(PG8_SB(1, 1), cB + hstep + kstep, voffB);
        PG8_WAIT_V(6); PG8_BAR;
    } else {
        PG8_STAGE(PG8_SB(0, 0), cB, voffB); PG8_STAGE(PG8_SA(0, 0), cA, voffA); PG8_STAGE(PG8_SB(0, 1), cB + hstep, voffB); PG8_STAGE(PG8_SA(0, 1), cA + hstep, voffA);
        if (wr == 1) PG8_BAR;
        PG8_WAIT_V(4); PG8_BAR;
        PG8_STAGE(PG8_SB(1, 0), cB + kstep, voffB); PG8_STAGE(PG8_SA(1, 0), cA + kstep, voffA); PG8_STAGE(PG8_SB(1, 1), cB + hstep + kstep, voffB);
        PG8_WAIT_V(6); PG8_BAR;
    }
    for (;;) {
        const bool has_next = S.next(ui + 1, nxt);
        const char* nA = has_next ? (const char*)g.A + (size_t)nxt.pm * tstep : cA; const char* nB = has_next ? (const char*)g.Bt + (size_t)nxt.pn * tstep : cB;
        for (int t = 0; t < nt; t += 2) {
            const bool last = (t == nt - 2);
            const char* a1 = cA + (size_t)(t + 1) * kstep;
            const char* a2 = last ? nA : cA + (size_t)(t + 2) * kstep; const char* b2 = last ? nB : cB + (size_t)(t + 2) * kstep;
            const char* a3 = a2 + kstep; const char* b3 = b2 + kstep;
            if (last && has_next) S.a_ready(nxt);
            if constexpr (SP2) {
            PG8_LDB(B0, 0, 0); PG8_LDB(B1, 0, 1); PG8_SCHED; PG8_LDA(At, 0, 0); PG8_STAGE(PG8_SA(1, 1), a1 + hstep, voffA);
            PG8_WAIT_V(8); PG8_WAIT_L(0); PG8_BAR; PG8_MMA(0, 0, At, B0); PG8_MMA(0, 1, At, B1); PG8_BAR; PG8_SCHED;
            PG8_LDA(At, 0, 1); PG8_STAGE(PG8_SB(0, 0), b2, voffB); PG8_STAGE(PG8_SB(0, 1), b2 + hstep, voffB); PG8_STAGE(PG8_SA(0, 0), a2, voffA);
            PG8_WAIT_V(8); PG8_WAIT_L(0); PG8_BAR; PG8_MMA(1, 0, At, B0); PG8_MMA(1, 1, At, B1); PG8_BAR; PG8_SCHED;
            PG8_LDB(B0, 1, 0); PG8_LDB(B1, 1, 1); PG8_SCHED; PG8_LDA(At, 1, 0); PG8_STAGE(PG8_SA(0, 1), a2 + hstep, voffA);
            PG8_WAIT_V(8); PG8_WAIT_L(0); PG8_BAR; PG8_MMA(0, 0, At, B0); PG8_MMA(0, 1, At, B1); PG8_BAR; PG8_SCHED;
            PG8_LDA(At, 1, 1); PG8_STAGE(PG8_SB(1, 0), b3, voffB); PG8_STAGE(PG8_SB(1, 1), b3 + hstep, voffB); PG8_STAGE(PG8_SA(1, 0), a3, voffA);
            PG8_WAIT_V(8); PG8_WAIT_L(0); PG8_BAR; PG8_MMA(1, 0, At, B0); PG8_MMA(1, 1, At, B1); PG8_BAR; PG8_SCHED;
            } else {
            PG8_LDB(B0, 0, 0); PG8_SCHED; PG8_LDA(At, 0, 0); PG8_STAGE(PG8_SA(1, 1), a1 + hstep, voffA);
            PG8_WAIT_L(8); PG8_BAR; PG8_WAIT_L(0); PG8_MMA(0, 0, At, B0); PG8_BAR; PG8_SCHED;
            PG8_LDB(B1, 0, 1); PG8_STAGE(PG8_SB(0, 0), b2, voffB);
            PG8_BAR; PG8_WAIT_L(0); PG8_MMA(0, 1, At, B1); PG8_BAR;
            PG8_LDA(At, 0, 1); PG8_STAGE(PG8_SA(0, 0), a2, voffA);
            PG8_BAR; PG8_WAIT_L(0); PG8_MMA(1, 0, At, B0); PG8_BAR; PG8_SCHED;
            PG8_STAGE(PG8_SB(0, 1), b2 + hstep, voffB);
            PG8_WAIT_V(6); PG8_BAR; PG8_MMA(1, 1, At, B1); PG8_BAR;
            PG8_LDB(B0, 1, 0); PG8_SCHED; PG8_LDA(At, 1, 0); PG8_STAGE(PG8_SA(0, 1), a2 + hstep, voffA);
            PG8_WAIT_L(8); PG8_BAR; PG8_WAIT_L(0); PG8_MMA(0, 0, At, B0); PG8_BAR; PG8_SCHED;
            PG8_LDB(B1, 1, 1); PG8_STAGE(PG8_SB(1, 0), b3, voffB);
            PG8_BAR; PG8_WAIT_L(0); PG8_MMA(0, 1, At, B1); PG8_BAR;
            PG8_LDA(At, 1, 1); PG8_STAGE(PG8_SA(1, 0), a3, voffA);
            PG8_BAR; PG8_WAIT_L(0); PG8_MMA(1, 0, At, B0); PG8_BAR; PG8_SCHED;
            PG8_STAGE(PG8_SB(1, 1), b3 + hstep, voffB);
            PG8_WAIT_V(6); PG8_BAR; PG8_MMA(1, 1, At, B1); PG8_BAR;
            }
        }
        if constexpr (ALIGN_EPI) { if (wr == 0) PG8_BAR; }
        if constexpr (!Epi::AFTER_DRAIN) { E(acc, cur, wr, wc, fr, fq); S.done(cur); }
        if (!has_next) break;
#pragma unroll
        for (int a = 0; a < 2; ++a)
#pragma unroll
            for (int b = 0; b < 2; ++b)
#pragma unroll
                for (int m = 0; m < 4; ++m)
#pragma unroll
                    for (int n = 0; n < 2; ++n) acc[a][b][m][n] = (f32x4){0.f, 0.f, 0.f, 0.f};
        cur = nxt; cA = nA; cB = nB; ++ui;
        if constexpr (ALIGN_EPI) { if (wr == 1) PG8_BAR; }
    }
    PG8_WAIT_V(0);
    if constexpr (!ALIGN_EPI) { if (wr == 0) PG8_BAR; }
    PG8_BAR;
    if constexpr (Epi::AFTER_DRAIN) { E.fused(acc, cur, wr, wc, fr, fq, lds, wid, lane); S.done(cur); }
#undef PG8_SA
#undef PG8_SB
#undef PG8_STAGE
#undef PG8_LDA
#undef PG8_LDB
#undef PG8_MMA
#undef PG8_WAIT_V
#undef PG8_WAIT_L
#undef PG8_BAR
#undef PG8_SCHED
}
}
namespace dattn {
#define DA_LAS __attribute__((address_space(3)))
typedef unsigned short bf16_t;
using bf16x8 = __attribute__((ext_vector_type(8))) short;
using s16x4  = __attribute__((ext_vector_type(4))) short;
using f32x16 = __attribute__((ext_vector_type(16))) float;
using u32x4  = __attribute__((ext_vector_type(4))) unsigned;
constexpr int NW = 8, QBLK = 32, KVBLK = 64, PITCH = 1024, LDO = 2048;
constexpr float SCALE = 0.125f;
constexpr float THR = 8.f;
constexpr int SHM_V = KVBLK * 128 * 2, SHM_K = KVBLK * 64 * 2;
constexpr int NSLOT = 3, OFF_V = 0, OFF_K = NSLOT * SHM_V, OFF_WS = NSLOT * (SHM_V + SHM_K), LDS_BYTES = OFF_WS + NW * 64 * 4;
#define DA_KSWZ(row, colB) ((row) * 128 + ((colB) ^ ((((row) >> 1) & 7) << 4)))
#define DA_SBAR() __builtin_amdgcn_sched_barrier(0)
__device__ __forceinline__ int crow(int r, int hi) { return (r & 3) + 8 * (r >> 2) + 4 * hi; }
typedef float cvt_f32x2 __attribute__((ext_vector_type(2))); typedef __bf16 cvt_bf16x2 __attribute__((ext_vector_type(2)));
__device__ __forceinline__ unsigned cvtpk(float lo, float hi) { const cvt_f32x2 v = {lo, hi}; return __builtin_bit_cast(unsigned, __builtin_convertvector(v, cvt_bf16x2)); }
#ifdef DA_THR2_TEST
constexpr float THR2 = DA_THR2_TEST;
#else
constexpr float THR2 = THR * 1.4426950408889634f;
#endif
__device__ __forceinline__ void glds16s(const void* sbase, unsigned voff, unsigned lds_dst) { unsigned keep;
  asm volatile("s_mov_b32 %0, m0\n\ts_mov_b32 m0, %3\n\ts_nop 0\n\tglobal_load_lds_dwordx4 %1, %2\n\ts_mov_b32 m0, %0" : "=&s"(keep) : "v"(voff), "s"(sbase), "s"(lds_dst) : "memory"); }
#define DA_WAIT_BAR(N) do { __builtin_amdgcn_sched_barrier(0); asm volatile("s_waitcnt vmcnt(" #N ") lgkmcnt(0)\n\ts_barrier" ::: "memory"); __builtin_amdgcn_sched_barrier(0); } while (0)
__device__ __forceinline__ int v_st(int k, int c) { const int kk = (k & ~0xC) | ((k & 4) << 1) | ((k & 8) >> 1); return ((kk >> 3) * 4 + (c >> 5)) * 512 + ((kk & 7) * 32 + (c & 31)) * 2; }
__device__ __forceinline__ int v_rd_base(int lane) { return ((lane & 3) << 3) | (((lane >> 2) & 3) << 6) | (((lane >> 4) & 1) << 5) | (((lane >> 5) & 1) << 8); }
constexpr int v_rd_off(int d0, int ks, int half) { return d0 * 512 + ks * 4096 + half * 2048; }
template <int OFF> __device__ __forceinline__ s16x4 tr_read(int vb) {
  s16x4 r; asm volatile("ds_read_b64_tr_b16 %0, %1 offset:%2" : "=&v"(r) : "v"(vb), "i"(OFF) : "memory"); return r;
}
#define DA_PK(L, H) (bf16x8){L[0], L[1], L[2], L[3], H[0], H[1], H[2], H[3]}
#define DA_LGKM(N) do { asm volatile("s_waitcnt lgkmcnt(" #N ")" ::: "memory"); DA_SBAR(); } while (0)
template <int OFF> __device__ __forceinline__ bf16x8 lds_rd128(int a) { bf16x8 r; asm volatile("ds_read_b128 %0, %1 offset:%2" : "=&v"(r) : "v"(a), "i"(OFF) : "memory"); return r; }
typedef float f32x4a __attribute__((ext_vector_type(4)));
typedef unsigned v2u16 __attribute__((ext_vector_type(2)));
struct KPre16 { bf16x8 k[4][2]; };
__device__ __forceinline__ void prefetch_k16(KPre16& P, int kbase, int fr, int fq) {
  const int sw = ((fr >> 1) & 7) << 4, a0 = kbase + fr * 128 + ((16 * fq) ^ sw), a1 = kbase + fr * 128 + ((64 + 16 * fq) ^ sw);
  P.k[0][0] = lds_rd128<0>(a0); P.k[1][0] = lds_rd128<2048>(a0); P.k[2][0] = lds_rd128<4096>(a0); P.k[3][0] = lds_rd128<6144>(a0);
  P.k[0][1] = lds_rd128<0>(a1); P.k[1][1] = lds_rd128<2048>(a1); P.k[2][1] = lds_rd128<4096>(a1); P.k[3][1] = lds_rd128<6144>(a1);
}
template <int S> __device__ __forceinline__ void prefetch_k16s(KPre16& P, int a0, int a1) {
  P.k[0][0] = lds_rd128<S * SHM_K + 0>(a0); P.k[1][0] = lds_rd128<S * SHM_K + 2048>(a0); P.k[2][0] = lds_rd128<S * SHM_K + 4096>(a0); P.k[3][0] = lds_rd128<S * SHM_K + 6144>(a0);
  P.k[0][1] = lds_rd128<S * SHM_K + 0>(a1); P.k[1][1] = lds_rd128<S * SHM_K + 2048>(a1); P.k[2][1] = lds_rd128<S * SHM_K + 4096>(a1); P.k[3][1] = lds_rd128<S * SHM_K + 6144>(a1);
}
__device__ __forceinline__ float xfq_max(float v) {
  auto r = __builtin_amdgcn_permlane16_swap(__float_as_uint(v), __float_as_uint(v), false, false); v = fmaxf(__uint_as_float(r[0]), __uint_as_float(r[1]));
  auto q = __builtin_amdgcn_permlane32_swap(__float_as_uint(v), __float_as_uint(v), false, false); return fmaxf(__uint_as_float(q[0]), __uint_as_float(q[1]));
}
__device__ __forceinline__ float xfq_sum(float v) {
  auto r = __builtin_amdgcn_permlane16_swap(__float_as_uint(v), __float_as_uint(v), false, false); v = __uint_as_float(r[0]) + __uint_as_float(r[1]);
  auto q = __builtin_amdgcn_permlane32_swap(__float_as_uint(v), __float_as_uint(v), false, false); return __uint_as_float(q[0]) + __uint_as_float(q[1]);
}
template <bool SAFE>
__device__ __forceinline__ void softmax16(f32x4a (&s)[2][4], float (&mhat)[2], bool first, float (&alpha)[2], bf16x8 (&pa)[2][2]) {
  if (SAFE) {
    float lm[2];
#pragma unroll
    for (int qb = 0; qb < 2; ++qb) { float m = fmaxf(s[qb][0][0], s[qb][0][1]);
#pragma unroll
      for (int kb = 0; kb < 4; ++kb)
#pragma unroll
        for (int j = (kb == 0 ? 2 : 0); j < 4; ++j) m = fmaxf(m, s[qb][kb][j]);
      lm[qb] = m; alpha[qb] = 1.f; }
    if (__builtin_expect(first || __any(mhat[0] != 0.f || mhat[1] != 0.f || fmaxf(lm[0], lm[1]) > THR2), 0)) {
#pragma unroll
      for (int qb = 0; qb < 2; ++qb) { const float ex = xfq_max(lm[qb]) - mhat[qb]; float dl = 0.f;
        if (first) { if (ex > THR2 || ex < -THR2) dl = ex; } else if (ex > THR2) dl = ex;
        mhat[qb] += dl;
#pragma unroll
        for (int kb = 0; kb < 4; ++kb) s[qb][kb] -= mhat[qb];
        alpha[qb] = first ? 1.f : __builtin_amdgcn_exp2f(-dl); }
    }
  }
#pragma unroll
  for (int qb = 0; qb < 2; ++qb) {
#pragma unroll
    for (int kb = 0; kb < 4; ++kb)
#pragma unroll
      for (int j = 0; j < 4; ++j) s[qb][kb][j] = __builtin_amdgcn_exp2f(s[qb][kb][j]);
#pragma unroll
    for (int g = 0; g < 2; ++g) { const u32x4 w = {cvtpk(s[qb][2 * g][0], s[qb][2 * g][1]), cvtpk(s[qb][2 * g][2], s[qb][2 * g][3]), cvtpk(s[qb][2 * g + 1][0], s[qb][2 * g + 1][1]), cvtpk(s[qb][2 * g + 1][2], s[qb][2 * g + 1][3])};
      pa[qb][g] = __builtin_bit_cast(bf16x8, w); }
  }
}
#define DA_W16(N) do { asm volatile("s_waitcnt lgkmcnt(" #N ")" ::: "memory"); DA_SBAR(); } while (0)
#define DA_RF16(J) do { vl[(J) & 7] = tr_read<VS * SHM_V + 8192 * ((J) >> 3)>(va[(J) & 7]); vh[(J) & 7] = tr_read<VS * SHM_V + 8192 * ((J) >> 3) + 4096>(va[(J) & 7]); DA_SBAR(); } while (0)
#define DA_PV16(J) do { const bf16x8 vf_ = DA_PK(vl[(J) & 7], vh[(J) & 7]); \
    o[0][(J) & 7] = __builtin_amdgcn_mfma_f32_16x16x32_bf16(vf_, pa[0][(J) >> 3], o[0][(J) & 7], 0, 0, 0); o[1][(J) & 7] = __builtin_amdgcn_mfma_f32_16x16x32_bf16(vf_, pa[1][(J) >> 3], o[1][(J) & 7], 0, 0, 0); } while (0)
struct NoDma16 { __device__ __forceinline__ void operator()() const {} };
template <bool HAS_QK, bool HAS_PV, int VS, class DMA = NoDma16>
__device__ __forceinline__ void m_seg16(f32x4a (&s)[2][4], KPre16& P, const bf16x8 (&qf)[2][2], f32x4a (&o)[2][8], f32x4a (&lacc)[2], const bf16x8& ones, const int (&va)[8], const bf16x8 (&pa)[2][2], DMA dma = NoDma16()) {
  s16x4 vl[8], vh[8];
  __builtin_amdgcn_s_setprio(2);
  if (HAS_QK) {
    const f32x4a z = {0.f, 0.f, 0.f, 0.f};
#define DA_QK16(KB, KS) do { s[0][KB] = __builtin_amdgcn_mfma_f32_16x16x32_bf16(P.k[KB][KS], qf[0][KS], (KS) == 0 ? z : s[0][KB], 0, 0, 0); \
    s[1][KB] = __builtin_amdgcn_mfma_f32_16x16x32_bf16(P.k[KB][KS], qf[1][KS], (KS) == 0 ? z : s[1][KB], 0, 0, 0); } while (0)
    DA_QK16(0, 0); dma(); DA_SBAR(); if (HAS_PV) DA_RF16(0); DA_QK16(1, 0); if (HAS_PV) DA_RF16(1); DA_QK16(2, 0); if (HAS_PV) DA_RF16(2); DA_QK16(3, 0); if (HAS_PV) DA_RF16(3);
    DA_QK16(0, 1); if (HAS_PV) DA_RF16(4); DA_QK16(1, 1); if (HAS_PV) DA_RF16(5); DA_QK16(2, 1); if (HAS_PV) DA_RF16(6); DA_QK16(3, 1); DA_SBAR();
#undef DA_QK16
  } else if (HAS_PV) { DA_RF16(0); DA_RF16(1); DA_RF16(2); DA_RF16(3); DA_RF16(4); DA_RF16(5); DA_RF16(6); }
  if (HAS_PV) {
    lacc[0] = __builtin_amdgcn_mfma_f32_16x16x32_bf16(ones, pa[0][0], lacc[0], 0, 0, 0); lacc[1] = __builtin_amdgcn_mfma_f32_16x16x32_bf16(ones, pa[1][0], lacc[1], 0, 0, 0);
    lacc[0] = __builtin_amdgcn_mfma_f32_16x16x32_bf16(ones, pa[0][1], lacc[0], 0, 0, 0); lacc[1] = __builtin_amdgcn_mfma_f32_16x16x32_bf16(ones, pa[1][1], lacc[1], 0, 0, 0);
    DA_SBAR();
    DA_W16(10); DA_PV16(0); DA_RF16(7);   DA_PV16(1); DA_RF16(8);   DA_W16(10); DA_PV16(2); DA_RF16(9);   DA_PV16(3); DA_RF16(10);
    DA_W16(10); DA_PV16(4); DA_RF16(11);  DA_PV16(5); DA_RF16(12);  DA_W16(10); DA_PV16(6); DA_RF16(13);  DA_PV16(7); DA_RF16(14);
    DA_W16(10); DA_PV16(8); DA_RF16(15);  DA_PV16(9); DA_SBAR();    DA_W16(8); DA_PV16(10); DA_SBAR();   DA_PV16(11); DA_SBAR();
    DA_W16(4); DA_PV16(12); DA_SBAR();    DA_PV16(13); DA_SBAR();    DA_W16(0); DA_PV16(14); DA_SBAR();    DA_PV16(15);
    asm volatile("" : "+v"(o[0][0]), "+v"(o[0][1]), "+v"(o[0][2]), "+v"(o[0][3]), "+v"(o[0][4]), "+v"(o[0][5]), "+v"(o[0][6]), "+v"(o[0][7]));
    asm volatile("" : "+v"(o[1][0]), "+v"(o[1][1]), "+v"(o[1][2]), "+v"(o[1][3]), "+v"(o[1][4]), "+v"(o[1][5]), "+v"(o[1][6]), "+v"(o[1][7]));
    asm volatile("" : "+v"(lacc[0]), "+v"(lacc[1]));
  }
  __builtin_amdgcn_s_setprio(0);
}
#undef DA_W16
#undef DA_RF16
#undef DA_PV16
template <bool SAFE>
__device__ __forceinline__ bool attn_unit16_body(const bf16_t* __restrict__ Qb, const bf16_t* __restrict__ Kh, const bf16_t* __restrict__ Vh, float* Ob, int seq, DA_LAS char* lds,
                                            bool second, float lam, float oscale, const float* __restrict__ subg, bf16_t* __restrict__ AOb) {
  int tid = threadIdx.x; asm volatile("" : "+v"(tid));
  const int wid = __builtin_amdgcn_readfirstlane(tid >> 6), lane = tid & 63, fr = lane & 15, fq = lane >> 4;
  const bool grpA = wid < 4;
  const unsigned lds0 = (unsigned)(size_t)lds;
  const int krow = 8 * wid + (lane >> 3), kpiece = (lane & 7) ^ ((krow >> 1) & 7);
  const unsigned ksrc = (unsigned)(krow * PITCH + kpiece * 8) * 2u;
  const int vr0 = 8 * wid + (lane >> 4), vr1 = vr0 + 4;
  const unsigned vsrc0 = (unsigned)(vr0 * PITCH + (((lane & 15) ^ (((vr0 & 3) << 2) | ((vr0 >> 2) & 3))) * 8)) * 2u;
  const unsigned vsrc1 = (unsigned)(vr1 * PITCH + (((lane & 15) ^ (((vr1 & 3) << 2) | ((vr1 >> 2) & 3))) * 8)) * 2u;
  const unsigned kdst = lds0 + OFF_K + wid * 1024, vdst = lds0 + OFF_V + wid * 2048;
#define DA_DMA_K(t, slot) glds16s(Kh + (long)(t) * KVBLK * PITCH, ksrc, (unsigned)__builtin_amdgcn_readfirstlane(kdst + (slot) * SHM_K))
#define DA_DMA_V(t, slot) do { glds16s(Vh + (long)(t) * KVBLK * PITCH, vsrc0, (unsigned)__builtin_amdgcn_readfirstlane(vdst + (slot) * SHM_V)); \
    glds16s(Vh + (long)(t) * KVBLK * PITCH, vsrc1, (unsigned)__builtin_amdgcn_readfirstlane(vdst + (slot) * SHM_V + 1024)); } while (0)
  const int NT = seq / KVBLK;
  DA_DMA_K(0, 0); DA_DMA_K(1, 1); DA_DMA_V(0, 0);
  float mhat[2] = {0.f, 0.f}, alpha[2] = {1.f, 1.f};
  f32x4a o[2][8] = {}; f32x4a lacc[2] = {}; f32x4a s[2][4] = {}; bf16x8 qf[2][2]; bf16x8 pa[2][2]; KPre16 P;
  bf16x8 ones; { const u32x4 w1 = {0x3f803f80u, 0x3f803f80u, 0x3f803f80u, 0x3f803f80u}; ones = __builtin_bit_cast(bf16x8, w1); asm volatile("" : "+v"(ones)); }
#pragma unroll
  for (int qb = 0; qb < 2; ++qb)
#pragma unroll
    for (int ks = 0; ks < 2; ++ks) qf[qb][ks] = *(const bf16x8*)(Qb + (long)(wid * QBLK + 16 * qb + fr) * PITCH + 32 * ks + 8 * fq);
  int va[8];
  { const int e = fr >> 2, pp = fr & 3, x = (e << 2) | fq;
#pragma unroll
    for (int db = 0; db < 8; ++db) va[db] = (int)(lds0 + OFF_V) + 256 * (4 * fq + e) + 16 * ((2 * db + (pp >> 1)) ^ x) + 8 * (pp & 1); }
  const int ksw = ((fr >> 1) & 7) << 4, ka0 = (int)(lds0 + OFF_K) + fr * 128 + ((16 * fq) ^ ksw), ka1 = (int)(lds0 + OFF_K) + fr * 128 + ((64 + 16 * fq) ^ ksw);
#define DA_PREF_K(slot) prefetch_k16s<slot>(P, ka0, ka1)
#define DA_RESC16() do { if (__any(alpha[0] < 1.f || alpha[1] < 1.f)) { _Pragma("unroll") for (int qb = 0; qb < 2; ++qb) { lacc[qb] *= alpha[qb]; _Pragma("unroll") for (int db = 0; db < 8; ++db) o[qb][db] *= alpha[qb]; } } } while (0)
#define DA_SEG_V(first) do { softmax16<SAFE>(s, mhat, (first), alpha, pa); asm volatile("" : "+v"(pa[0][0]), "+v"(pa[0][1]), "+v"(pa[1][0]), "+v"(pa[1][1])); if (SAFE) DA_RESC16(); } while (0)
  asm volatile("s_waitcnt vmcnt(3)" ::: "memory");
  DA_WAIT_BAR(3);
  int t = 1;
  if (grpA) {
    DA_DMA_K(2, 2); DA_DMA_V(1, 1);
    DA_PREF_K(0); DA_LGKM(0);
    m_seg16<true, false, 0>(s, P, qf, o, lacc, ones, va, pa);
    DA_WAIT_BAR(3);
    DA_PREF_K(1);
    DA_SEG_V(true);
    DA_WAIT_BAR(3);
    m_seg16<true, true, 0>(s, P, qf, o, lacc, ones, va, pa, [&]() { DA_DMA_K(3, 0); });
    DA_WAIT_BAR(3);
#define DA_BODY_A(T, M0, M1, M2) do { \
      DA_PREF_K(M1); \
      DA_SEG_V(false); \
      DA_DMA_V((T) + 1, M1); \
      if ((T) + 2 < NT) DA_WAIT_BAR(3); else DA_WAIT_BAR(2); \
      m_seg16<true, true, M0>(s, P, qf, o, lacc, ones, va, pa, [&]() { if ((T) + 3 < NT) DA_DMA_K((T) + 3, M0); }); \
      if ((T) + 3 < NT) DA_WAIT_BAR(3); else DA_WAIT_BAR(0); } while (0)
#pragma unroll 1
    for (; t + 3 < NT; t += 3) { DA_BODY_A(t, 1, 2, 0); DA_BODY_A(t + 1, 2, 0, 1); DA_BODY_A(t + 2, 0, 1, 2); }
    if (t + 1 < NT) { DA_BODY_A(t, 1, 2, 0); ++t; }
    if (t + 1 < NT) { DA_BODY_A(t, 2, 0, 1); ++t; }
#undef DA_BODY_A
    DA_SEG_V(false);
    DA_WAIT_BAR(0);
  } else {
    DA_DMA_K(2, 2); DA_DMA_V(1, 1);
    DA_PREF_K(0);
    DA_WAIT_BAR(3);
    m_seg16<true, false, 0>(s, P, qf, o, lacc, ones, va, pa);
    DA_WAIT_BAR(3);
    DA_PREF_K(1);
    __builtin_amdgcn_s_setprio(1); DA_SEG_V(true); __builtin_amdgcn_s_setprio(0);
    DA_DMA_V(2, 2);
    DA_WAIT_BAR(2);
#define DA_BODY_B(T, M0, M1, M2) do { \
      m_seg16<true, true, M2>(s, P, qf, o, lacc, ones, va, pa, [&]() { if ((T) + 2 < NT) DA_DMA_K((T) + 2, M2); }); \
      DA_WAIT_BAR(3); \
      DA_PREF_K(M1); \
      __builtin_amdgcn_s_setprio(1); DA_SEG_V(false); __builtin_amdgcn_s_setprio(0); \
      if ((T) + 2 < NT) { DA_DMA_V((T) + 2, M2); DA_WAIT_BAR(2); } else DA_WAIT_BAR(0); } while (0)
#pragma unroll 1
    for (; t + 3 < NT; t += 3) { DA_BODY_B(t, 1, 2, 0); DA_BODY_B(t + 1, 2, 0, 1); DA_BODY_B(t + 2, 0, 1, 2); }
    if (t + 1 < NT) { DA_BODY_B(t, 1, 2, 0); ++t; }
    if (t + 1 < NT) { DA_BODY_B(t, 2, 0, 1); ++t; }
#undef DA_BODY_B
    if ((NT - 2) % 3 == 0) m_seg16<true, true, 0>(s, P, qf, o, lacc, ones, va, pa); else if ((NT - 2) % 3 == 1) m_seg16<true, true, 1>(s, P, qf, o, lacc, ones, va, pa); else m_seg16<true, true, 2>(s, P, qf, o, lacc, ones, va, pa);
    DA_WAIT_BAR(0);
    __builtin_amdgcn_s_setprio(1); DA_SEG_V(false); __builtin_amdgcn_s_setprio(0);
  }
  if ((NT - 1) % 3 == 0) m_seg16<false, true, 0>(s, P, qf, o, lacc, ones, va, pa); else if ((NT - 1) % 3 == 1) m_seg16<false, true, 1>(s, P, qf, o, lacc, ones, va, pa); else m_seg16<false, true, 2>(s, P, qf, o, lacc, ones, va, pa);
  const float lsum[2] = {lacc[0][0], lacc[1][0]};
  int te = threadIdx.x; asm volatile("" : "+v"(te));
  const int wid_e = __builtin_amdgcn_readfirstlane(te >> 6), lane_e = te & 63, fr_e = lane_e & 15, fq_e = lane_e >> 4;
  if (!SAFE) {
    float om = 0.f;
#pragma unroll
    for (int qb = 0; qb < 2; ++qb)
#pragma unroll
      for (int db = 0; db < 8; ++db) om = fmaxf(fmaxf(om, fmaxf(fabsf(o[qb][db][0]), fabsf(o[qb][db][1]))), fmaxf(fabsf(o[qb][db][2]), fabsf(o[qb][db][3])));
#ifdef DA_TEST_FALLBACK
    const bool good = false;
#else
    const bool good = lsum[0] > 0x1p-100f && lsum[0] < 0x1p100f && lsum[1] > 0x1p-100f && lsum[1] < 0x1p100f && om < 0x1p120f;
#endif
    DA_LAS int* fl = (DA_LAS int*)(lds + OFF_WS);
    if (lane_e == 0) fl[wid_e] = __any(!good) ? 1 : 0;
    DA_WAIT_BAR(0);
    int bad = 0;
#pragma unroll
    for (int w = 0; w < NW; ++w) bad |= fl[w];
    if (__builtin_amdgcn_readfirstlane(bad)) { DA_WAIT_BAR(0); return false; }
  }
#pragma unroll
  for (int qb = 0; qb < 2; ++qb) {
    const float rl = __builtin_amdgcn_rcpf(lsum[qb]);
    const long row = wid_e * QBLK + 16 * qb + fr_e;
    if (!second) {
#pragma unroll
      for (int db = 0; db < 8; ++db) *(f32x4a*)(Ob + row * LDO + 16 * db + 4 * fq_e) = o[qb][db] * rl;
    } else {
      f32x4a d[8]; float ss = 0.f;
#pragma unroll
      for (int db = 0; db < 8; ++db) d[db] = *(const f32x4a*)(Ob + row * LDO + 16 * db + 4 * fq_e);
#pragma unroll
      for (int db = 0; db < 8; ++db) { d[db] = d[db] - (o[qb][db] * rl) * lam; ss += (d[db][0] * d[db][0] + d[db][1] * d[db][1]) + (d[db][2] * d[db][2] + d[db][3] * d[db][3]); }
      const float rs = oscale / sqrtf(xfq_sum(ss) * (1.0f / 128.0f) + 1e-5f);
#pragma unroll
      for (int db = 0; db < 8; ++db) { const f32x4a g = *(const f32x4a*)(subg + 16 * db + 4 * fq_e); const f32x4a v = d[db] * g * rs;
        const v2u16 w = {cvtpk(v[0], v[1]), cvtpk(v[2], v[3])}; *(v2u16*)(AOb + row * 1024 + 16 * db + 4 * fq_e) = w; }
    }
  }
  DA_WAIT_BAR(0);
  return true;
#undef DA_DMA_K
#undef DA_DMA_V
#undef DA_PREF_K
#undef DA_RESC16
#undef DA_SEG_V
}
__device__ __forceinline__ void attn_unit16(const bf16_t* __restrict__ Qb, const bf16_t* __restrict__ Kh, const bf16_t* __restrict__ Vh, float* Ob, int seq, DA_LAS char* lds,
                                            bool second, float lam, float oscale, const float* __restrict__ subg, bf16_t* __restrict__ AOb) {
#ifndef DA_FORCE_SAFE
  if (attn_unit16_body<false>(Qb, Kh, Vh, Ob, seq, lds, second, lam, oscale, subg, AOb)) return;
#endif
#ifndef DA_FORCE_FAST
  attn_unit16_body<true>(Qb, Kh, Vh, Ob, seq, lds, second, lam, oscale, subg, AOb);
#endif
}
}

constexpr int NWAVES = 8;
constexpr int SEQ = 16384, DM = 2048, FF = 5632, AW = 1024, NHEAD = 8, FW = 1024, NGRP = 8, GD = 128, DEPTH = 2;
constexpr int NMOD = 9 * DM;
constexpr int KSPLIT = 16;
constexpr float NORM_EPS = 1e-6f, SUBLN_EPS = 1e-5f;

constexpr size_t MiB = 1u << 20;
constexpr size_t WS_CTL = 0, CTL_ZERO_BYTES = 1 * MiB;
constexpr size_t WS_COS = 1 * MiB, WS_SIN = 3 * MiB;
constexpr size_t WS_DFTC = 5 * MiB, WS_DFTS = 5 * MiB + 32768, WS_TW = 5 * MiB + 65536;
constexpr size_t WS_MODP = 6 * MiB;
constexpr size_t WS_MODF = 9 * MiB;
constexpr size_t WS_LAM = WS_MODF + (size_t)DEPTH * 9 * DM * 4;
constexpr size_t WS_W = 10 * MiB, W_LAYER = 180 * MiB;
constexpr size_t W_1IN = 0, W_1OUT = 44 * MiB, W_MIX = 66 * MiB, W_AP = 98 * MiB, W_FP = 102 * MiB, W_MO = 106 * MiB, W_2IN = 114 * MiB, W_2OUT = 158 * MiB;
constexpr size_t WS_H = 370 * MiB, WS_Y = 434 * MiB, WS_ACT = 498 * MiB, WS_M1 = 674 * MiB, WS_O = 802 * MiB, WS_END = 930 * MiB;
constexpr size_t WS_TRE = WS_Y, WS_TIM = WS_Y + 32 * MiB;
constexpr size_t WS_GATE = WS_ACT;
constexpr size_t WS_Q = WS_M1, WS_K = WS_M1 + 32 * MiB, WS_V = WS_M1 + 64 * MiB, WS_U = WS_M1 + 96 * MiB;
constexpr size_t WS_AO = WS_M1, WS_YF = WS_M1 + 32 * MiB, WS_MG = WS_M1 + 64 * MiB;
constexpr size_t WS_TT = WS_O;
constexpr int CW_TMO = 0, CW_CODE = 1, CW_BAR = 4096, CW_CHK = 16384;

constexpr int RING_OFF = 0, PHASE_LDS = 143360;
constexpr int LDSCTL_OFF = PHASE_LDS, MISC_OFF = LDSCTL_OFF + 320;
constexpr int LDS_BYTES = 147456;
static_assert(MISC_OFF + 128 <= LDS_BYTES, "LDS map");

#define GAS __attribute__((address_space(1)))
#define LAS __attribute__((address_space(3)))
typedef unsigned short bf16;
typedef unsigned v4u __attribute__((ext_vector_type(4)));
typedef unsigned v2u __attribute__((ext_vector_type(2)));
typedef float f32x4 __attribute__((ext_vector_type(4)));
typedef float f32x16 __attribute__((ext_vector_type(16)));
typedef short bf16x8 __attribute__((ext_vector_type(8)));
typedef short s16x4 __attribute__((ext_vector_type(4)));
typedef GAS unsigned gu32;
#define RLX_AGENT __ATOMIC_RELAXED, __HIP_MEMORY_SCOPE_AGENT
#define LDS_WAIT() asm volatile("s_waitcnt lgkmcnt(0)" ::: "memory")
#define VM_WAIT() asm volatile("s_waitcnt vmcnt(0)" ::: "memory")
__device__ __forceinline__ unsigned f2bf(float f) { unsigned u = __builtin_bit_cast(unsigned, f); return (u + 0x7fffu + ((u >> 16) & 1u)) >> 16; }
__device__ __forceinline__ unsigned pk2(float lo, float hi) { return f2bf(lo) | (f2bf(hi) << 16); }
__device__ __forceinline__ float bfl(unsigned w) { return __builtin_bit_cast(float, w << 16); }
__device__ __forceinline__ float bfh(unsigned w) { return __builtin_bit_cast(float, w & 0xffff0000u); }
__device__ __forceinline__ float wave_sum(float v) {
#pragma unroll
    for (int o = 1; o < 64; o <<= 1) v += __shfl_xor(v, o);
    return v;
}
__device__ __forceinline__ void sincos_turns(double t, double& s, double& c) {
    t -= floor(t);
    const double q = floor(t * 4.0 + 0.5);
    const double x = (t - q * 0.25) * 6.283185307179586476925286766559;
    const double x2 = x * x;
    double sp = -1.0 / 1307674368000.0; sp = sp * x2 + 1.0 / 6227020800.0; sp = sp * x2 - 1.0 / 39916800.0; sp = sp * x2 + 1.0 / 362880.0; sp = sp * x2 - 1.0 / 5040.0; sp = sp * x2 + 1.0 / 120.0; sp = sp * x2 - 1.0 / 6.0; sp = sp * x2 + 1.0;
    const double sx = sp * x;
    double cp = 1.0 / 20922789888000.0; cp = cp * x2 - 1.0 / 87178291200.0; cp = cp * x2 + 1.0 / 479001600.0; cp = cp * x2 - 1.0 / 3628800.0; cp = cp * x2 + 1.0 / 40320.0; cp = cp * x2 - 1.0 / 720.0; cp = cp * x2 + 1.0 / 24.0; cp = cp * x2 - 0.5; cp = cp * x2 + 1.0;
    const int qi = ((int)q) & 3;
    s = (qi == 0) ? sx : (qi == 1) ? cp : (qi == 2) ? -sx : -cp;
    c = (qi == 0) ? cp : (qi == 1) ? -sx : (qi == 2) ? -cp : sx;
}
__constant__ float ROPE_INV_FREQ[32] = {1.f,0.749894261f,0.562341332f,0.421696514f,0.316227764f,0.237137377f,0.177827939f,0.133352131f,0.100000001f,0.0749894157f,0.0562341325f,0.0421696529f,0.0316227749f,0.0237137377f,0.0177827943f,0.0133352149f,0.00999999978f,0.00749894185f,0.00562341325f,0.00421696482f,0.00316227763f,0.00237137359f,0.00177827943f,0.00133352145f,0.00100000005f,0.000749894243f,0.000562341302f,0.000421696517f,0.000316227757f,0.00023713737f,0.00017782794f,0.00013335215f};

#define XB_TMO      128
#define XB_XCNT(j)  (256  + 64 * (j))
#define XB_XSUB(j)  (1280 + 64 * (j))
#define XB_XGEN(j)  (2304 + 64 * (j))
#define XB_TOP      3328
#define XB_TOPGEN   3392
#define XCD_BAR_WORDS 3456
#define XB_SPIN_CAP (1u << 21)

__device__ __forceinline__ unsigned xb_ld(unsigned* p)              { return __hip_atomic_load(p, __ATOMIC_RELAXED, __HIP_MEMORY_SCOPE_AGENT); }
__device__ __forceinline__ unsigned xb_add(unsigned* p, unsigned v) { return __hip_atomic_fetch_add(p, v, __ATOMIC_RELAXED, __HIP_MEMORY_SCOPE_AGENT); }
__device__ __forceinline__ unsigned xb_xcc_id() { return (unsigned)__builtin_amdgcn_s_getreg((3 << 11) | 20) & 0xFu; }
#define XB_SPIN(cond, bar) do { unsigned _sp = 0; while (cond) { __builtin_amdgcn_s_sleep(1); \
    if ((++_sp & 255u) == 0u) { if (xb_ld(&(bar)[XB_TMO])) break; if (_sp > XB_SPIN_CAP) { atomicAdd(&(bar)[XB_TMO], 1u); break; } } } } while (0)

struct XcdBarrier {
    unsigned* bar; unsigned x;
    volatile LAS unsigned* st;
};

__device__ __forceinline__ XcdBarrier xcd_barrier_post(unsigned* bar, volatile LAS unsigned* st) {
    XcdBarrier b; b.bar = bar; b.x = xb_xcc_id(); b.st = st;
    if (threadIdx.x == 0) (void)xb_add(&bar[XB_XCNT(b.x)], 1u);
    return b;
}
__device__ __forceinline__ void xcd_barrier_complete(unsigned* bar, unsigned x, unsigned& nloc, unsigned& nx) {
    const unsigned G = gridDim.x * gridDim.y * gridDim.z;
    unsigned sum, cnt, mine, sp = 0u;
    for (;;) {
        sum = 0u; cnt = 0u; mine = 0u;
#pragma unroll
        for (unsigned j = 0; j < 16; ++j) { const unsigned c = xb_ld(&bar[XB_XCNT(j)]); sum += c; cnt += (c > 0u) ? 1u : 0u; mine = (j == x) ? c : mine; }
        if (sum == G) break;
        __builtin_amdgcn_s_sleep(1);
        if ((++sp & 255u) == 0u) { if (xb_ld(&bar[XB_TMO])) break; if (sp > XB_SPIN_CAP) { atomicAdd(&bar[XB_TMO], 1u); break; } }
    }
    nloc = mine > 0u ? mine : 1u; nx = cnt > 0u ? cnt : 1u;
}

__device__ __forceinline__ void xcd_barrier(const XcdBarrier& b) {
    asm volatile("s_waitcnt vmcnt(0)" ::: "memory");
    __syncthreads();
    if (threadIdx.x == 0) {
        unsigned* bar = b.bar; unsigned bx = b.x; asm volatile("" : "+s"(bx));
        __builtin_amdgcn_s_waitcnt(0);
        unsigned nloc = b.st[0], nx = b.st[1];
        if (nloc == 0u) { xcd_barrier_complete(bar, bx, nloc, nx); b.st[0] = nloc; b.st[1] = nx; }
        const unsigned old = xb_add(&bar[XB_XSUB(bx)], 1u);
        const unsigned gen = old / nloc;
        if (old + 1u == (gen + 1u) * nloc) {
            __builtin_amdgcn_fence(__ATOMIC_RELEASE, "agent");
            asm volatile("s_waitcnt vmcnt(0)" ::: "memory");
            const unsigned og = xb_add(&bar[XB_TOP], 1u);
            const unsigned tg = og / nx;
            if (og + 1u == (tg + 1u) * nx) xb_add(&bar[XB_TOPGEN], 1u);
            else XB_SPIN(xb_ld(&bar[XB_TOPGEN]) == tg, bar);
            __builtin_amdgcn_fence(__ATOMIC_ACQUIRE, "agent");
            xb_add(&bar[XB_XGEN(bx)], 1u);
            asm volatile("s_waitcnt vmcnt(0)" ::: "memory");
        } else {
            XB_SPIN(xb_ld(&bar[XB_XGEN(bx)]) == gen, bar);
            __builtin_amdgcn_fence(__ATOMIC_ACQUIRE, "agent");
            asm volatile("s_waitcnt vmcnt(0)" ::: "memory");
        }
    }
    __syncthreads();
}
struct Frame {
    LAS unsigned char* lds;
    volatile LAS unsigned* MISC;
    gu32* ctl;
    int tid, lane, wave;
    int vcu, G;
    unsigned char* ws;
};

__device__ __forceinline__ int wt_row(int mode, int row_off, int n0) {
    if (mode == 1) { const int up = n0 >= FF ? 1 : 0, j = n0 - up * FF; return (j >> 7) * 256 + up * 128 + (j & 127); }
    if (mode == 2) { if (n0 < 2048) { const int ch = n0 >> 6, d = n0 & 63; return 256 * (ch >> 2) + 128 * (d >> 5) + 32 * (ch & 3) + (d & 31); } return n0; }
    return row_off + n0;
}
__device__ __forceinline__ void p0_transpose_item(const float* W, int K, int N, bf16* WT, int mode, int row_off, LAS float* scr, int item, int lane) {
    const int nblk = N / 32, kb = item / nblk, nb = item % nblk, k0 = 64 * kb, n0 = 32 * nb;
#pragma unroll 8
    for (int i = 0; i < 32; ++i) { const int kk = 2 * i + (lane >> 5); scr[kk * 33 + (lane & 31)] = W[(size_t)(k0 + kk) * N + n0 + (lane & 31)]; }
    LDS_WAIT(); asm volatile("" ::: "memory");
    const int c = lane & 7, rbase = wt_row(mode, row_off, n0);
#pragma unroll
    for (int j = 0; j < 4; ++j) { const int n = (lane >> 3) + 8 * j; const LAS float* s = scr + (8 * c) * 33 + n;
        v4u o; o.x = pk2(s[0 * 33], s[1 * 33]); o.y = pk2(s[2 * 33], s[3 * 33]); o.z = pk2(s[4 * 33], s[5 * 33]); o.w = pk2(s[6 * 33], s[7 * 33]);
        *(GAS v4u*)(WT + (size_t)(rbase + n) * K + k0 + 8 * c) = o; }
    LDS_WAIT(); asm volatile("" ::: "memory");
}
struct In18 { const float* p[18]; };
__device__ __forceinline__ void p0_prologue(Frame& F, const In18& in) {
    LAS float* scr = (LAS float*)(F.lds + RING_OFF + F.wave * 16384);
    const int gw = F.vcu * NWAVES + F.wave, NGW = F.G * NWAVES;
    constexpr int I0 = 32 * 352, I1 = 88 * 64, I2 = 32 * 128, I3 = 32 * 128, I4 = 16 * 64, I5 = 16 * 64, I6 = 32 * 64, IL = 2 * I0 + 2 * I1 + I2 + I3 + I4 + I5 + I6;
    for (int it = gw; it < DEPTH * IL; it += NGW) {
        const int l = it / IL; int r = it % IL;
        bf16* wl = (bf16*)(F.ws + WS_W + (size_t)l * W_LAYER);
        if (r < I0) { p0_transpose_item(in.p[6] + (size_t)l * DM * 2 * FF, DM, 2 * FF, (bf16*)((unsigned char*)wl + W_1IN), 1, 0, scr, r, F.lane); continue; } r -= I0;
        if (r < I1) { p0_transpose_item(in.p[7] + (size_t)l * FF * DM, FF, DM, (bf16*)((unsigned char*)wl + W_1OUT), 0, 0, scr, r, F.lane); continue; } r -= I1;
        if (r < I2) { p0_transpose_item(in.p[8] + (size_t)l * DM * 4096, DM, 4096, (bf16*)((unsigned char*)wl + W_MIX), 2, 0, scr, r, F.lane); continue; } r -= I2;
        if (r < I3) { p0_transpose_item(in.p[13] + (size_t)l * DM * 4096, DM, 4096, (bf16*)((unsigned char*)wl + W_MIX), 0, 4096, scr, r, F.lane); continue; } r -= I3;
        if (r < I4) { p0_transpose_item(in.p[11] + (size_t)l * AW * DM, AW, DM, (bf16*)((unsigned char*)wl + W_AP), 0, 0, scr, r, F.lane); continue; } r -= I4;
        if (r < I5) { p0_transpose_item(in.p[12] + (size_t)l * FW * DM, FW, DM, (bf16*)((unsigned char*)wl + W_FP), 0, 0, scr, r, F.lane); continue; } r -= I5;
        if (r < I6) { p0_transpose_item(in.p[15] + (size_t)l * DM * DM, DM, DM, (bf16*)((unsigned char*)wl + W_MO), 0, 0, scr, r, F.lane); continue; } r -= I6;
        if (r < I0) { p0_transpose_item(in.p[16] + (size_t)l * DM * 2 * FF, DM, 2 * FF, (bf16*)((unsigned char*)wl + W_2IN), 1, 0, scr, r, F.lane); continue; } r -= I0;
        p0_transpose_item(in.p[17] + (size_t)l * FF * DM, FF, DM, (bf16*)((unsigned char*)wl + W_2OUT), 0, 0, scr, r, F.lane);
    }
    {
        constexpr int NCB = NMOD / 256, KR = DM / KSPLIT;
        const float* cvec = in.p[1]; float* modp = (float*)(F.ws + WS_MODP);
        for (int it = gw; it < DEPTH * NCB * KSPLIT; it += NGW) {
            const int l = it / (NCB * KSPLIT), r = it % (NCB * KSPLIT), ks = r / NCB, cb = r % NCB, c0 = cb * 256 + 4 * F.lane, k0 = ks * KR;
            const float* W = in.p[2] + (size_t)l * DM * NMOD + (size_t)k0 * NMOD + c0;
            f32x4 acc = {0.f, 0.f, 0.f, 0.f};
#pragma unroll 8
            for (int k = 0; k < KR; ++k) { const float cv = cvec[k0 + k]; const float ca = cv * __builtin_amdgcn_rcpf(1.0f + __builtin_amdgcn_exp2f(cv * -1.4426950408889634f));
                const f32x4 w = *(const GAS f32x4*)(W + (size_t)k * NMOD); acc += w * ca; }
            *(GAS f32x4*)(modp + (size_t)(l * KSPLIT + ks) * NMOD + c0) = acc;
        }
    }
    {
        const int gt = F.vcu * (NWAVES * 64) + F.tid, NT = F.G * NWAVES * 64;
        float* cosT = (float*)(F.ws + WS_COS); float* sinT = (float*)(F.ws + WS_SIN);
        for (int idx = gt; idx < SEQ * 32; idx += NT) { const int pos = idx >> 5, i = idx & 31; const float ang = (float)pos * ROPE_INV_FREQ[i];
            double s, c; sincos_turns((double)ang * 0.15915494309189533576888376337251, s, c); cosT[idx] = (float)c; sinT[idx] = (float)s; }
        bf16* dC = (bf16*)(F.ws + WS_DFTC); bf16* dS = (bf16*)(F.ws + WS_DFTS); float* tw = (float*)(F.ws + WS_TW);
        for (int idx = gt; idx < 128 * 128; idx += NT) { const int a = idx >> 7, b = idx & 127; double s, c;
            sincos_turns((double)((a * b) & 127) * (1.0 / 128.0), s, c); dC[idx] = (bf16)f2bf((float)c); dS[idx] = (bf16)f2bf((float)s);
            sincos_turns((double)(a * b) * (1.0 / 16384.0), s, c); tw[2 * idx] = (float)c; tw[2 * idx + 1] = (float)s; }
    }
}
__device__ __forceinline__ void p1_modfin(Frame& F, const In18& in) {
    const int gt = F.vcu * (NWAVES * 64) + F.tid, NT = F.G * NWAVES * 64;
    const float* modp = (const float*)(F.ws + WS_MODP); float* modf = (float*)(F.ws + WS_MODF);
    for (int idx = gt; idx < DEPTH * 3 * DM; idx += NT) { const int l = idx / (3 * DM), s = (idx / DM) % 3, c = idx % DM, base = s * 3 * DM + c;
        float sh = in.p[3][l * NMOD + base], sc = in.p[3][l * NMOD + base + DM], gt_ = in.p[3][l * NMOD + base + 2 * DM];
        for (int ks = 0; ks < KSPLIT; ++ks) { const float* q = modp + (size_t)(l * KSPLIT + ks) * NMOD + base; sh += q[0]; sc += q[DM]; gt_ += q[2 * DM]; }
        const float gpre = in.p[4][(l * 3 + s) * DM + c], gpost = in.p[5][(l * 3 + s) * DM + c];
        float* o = modf + (size_t)((l * 3 + s) * 3) * DM + c;
        o[0] = gpre * (1.0f + sc); o[DM] = sh; o[2 * DM] = (s == 1 ? 1.0f : 0.5f) * gt_ * gpost; }
    if (blockIdx.x == 0 && F.wave < DEPTH) { const int l = F.wave; const float* lq = in.p[9] + l * 256;
        const float sa = wave_sum(lq[F.lane] * lq[64 + F.lane]), sb = wave_sum(lq[128 + F.lane] * lq[192 + F.lane]);
        const float linit = l == 0 ? 0.2f : 0.35550906758f;
        if (F.lane == 0) { float* lamv = (float*)(F.ws + WS_LAM); lamv[l] = __builtin_amdgcn_exp2f(sa * 1.4426950408889634f) - __builtin_amdgcn_exp2f(sb * 1.4426950408889634f) + linit; lamv[2 + l] = 1.0f - linit; } }
}
template <bool HAS_Y, bool HAS_H>
__device__ __forceinline__ void norm_phase(Frame& F, const float* xin, float* xout, const bf16* y, bf16* h, const float* Gv, const float* Av, const float* Bv) {
    int lane = F.lane; asm volatile("" : "+v"(lane));
    const int gw = F.vcu * NWAVES + F.wave, NGW = F.G * NWAVES;
    f32x4 g[8], a[8], b[8];
#pragma unroll
    for (int j = 0; j < 8; ++j) { if (HAS_Y) g[j] = *(const GAS f32x4*)(Gv + 4 * lane + 256 * j); if (HAS_H) { a[j] = *(const GAS f32x4*)(Av + 4 * lane + 256 * j); b[j] = *(const GAS f32x4*)(Bv + 4 * lane + 256 * j); } }
    for (int row = gw; row < SEQ; row += NGW) {
        f32x4 x[8];
#pragma unroll
        for (int j = 0; j < 8; ++j) x[j] = *(const GAS f32x4*)(xin + (size_t)row * DM + 4 * lane + 256 * j);
        if (HAS_Y) {
            f32x4 yv[8]; float ss = 0.f;
#pragma unroll
            for (int j = 0; j < 8; ++j) { const v2u w = *(const GAS v2u*)(y + (size_t)row * DM + 4 * lane + 256 * j); yv[j] = (f32x4){bfl(w.x), bfh(w.x), bfl(w.y), bfh(w.y)};
                ss += (yv[j].x * yv[j].x + yv[j].y * yv[j].y) + (yv[j].z * yv[j].z + yv[j].w * yv[j].w); }
            const float ry = 1.0f / sqrtf(wave_sum(ss) * (1.0f / DM) + NORM_EPS);
#pragma unroll
            for (int j = 0; j < 8; ++j) x[j] = x[j] + g[j] * yv[j] * ry;
        }
        if (HAS_Y) {
#pragma unroll
            for (int j = 0; j < 8; ++j) *(GAS f32x4*)(xout + (size_t)row * DM + 4 * lane + 256 * j) = x[j];
        }
        if (HAS_H) {
            float ss = 0.f;
#pragma unroll
            for (int j = 0; j < 8; ++j) ss += (x[j].x * x[j].x + x[j].y * x[j].y) + (x[j].z * x[j].z + x[j].w * x[j].w);
            const float rx = 1.0f / sqrtf(wave_sum(ss) * (1.0f / DM) + NORM_EPS);
#pragma unroll
            for (int j = 0; j < 8; ++j) { const f32x4 v = x[j] * rx * a[j] + b[j]; v2u w; w.x = pk2(v.x, v.y); w.y = pk2(v.z, v.w); *(GAS v2u*)(h + (size_t)row * DM + 4 * lane + 256 * j) = w; }
        }
    }
}
__device__ __forceinline__ void combine_phase(Frame& F, const float* O, bf16* AO, const float* subg, float lam, float oscale) {
    int lane = F.lane; asm volatile("" : "+v"(lane));
    const int gw = F.vcu * NWAVES + F.wave, NGW = F.G * NWAVES, hh = lane >> 3, e0 = (lane & 7) * 16;
    f32x4 g[4];
#pragma unroll
    for (int j = 0; j < 4; ++j) g[j] = *(const GAS f32x4*)(subg + e0 + 4 * j) * oscale;
    for (int row = gw; row < SEQ; row += NGW) {
        const float* p0 = O + (size_t)row * 2048 + hh * 256 + e0;
        f32x4 o[4]; float ss = 0.f;
#pragma unroll
        for (int j = 0; j < 4; ++j) { const f32x4 a = *(const GAS f32x4*)(p0 + 4 * j), b = *(const GAS f32x4*)(p0 + 128 + 4 * j); o[j] = a - b * lam; ss += (o[j].x * o[j].x + o[j].y * o[j].y) + (o[j].z * o[j].z + o[j].w * o[j].w); }
        ss += __shfl_xor(ss, 1); ss += __shfl_xor(ss, 2); ss += __shfl_xor(ss, 4);
        const float r = 1.0f / sqrtf(ss * (1.0f / 128.0f) + SUBLN_EPS);
        v4u w0, w1; { const f32x4 v0 = o[0] * r * g[0], v1 = o[1] * r * g[1], v2 = o[2] * r * g[2], v3 = o[3] * r * g[3];
            w0.x = pk2(v0.x, v0.y); w0.y = pk2(v0.z, v0.w); w0.z = pk2(v1.x, v1.y); w0.w = pk2(v1.z, v1.w); w1.x = pk2(v2.x, v2.y); w1.y = pk2(v2.z, v2.w); w1.z = pk2(v3.x, v3.y); w1.w = pk2(v3.z, v3.w); }
        bf16* op = AO + (size_t)row * 1024 + hh * 128 + e0;
        *(GAS v4u*)op = w0; *(GAS v4u*)(op + 8) = w1;
    }
}
template <int DD> __device__ __forceinline__ void fft_mm2(f32x16& aR, f32x16& aI, int vb, const bf16x8* Ca, const bf16x8* Sa) {
    using namespace dattn;
    const s16x4 l0 = tr_read<v_rd_off(DD, 0, 0)>(vb), h0 = tr_read<v_rd_off(DD, 0, 1)>(vb), l1 = tr_read<v_rd_off(DD, 1, 0)>(vb), h1 = tr_read<v_rd_off(DD, 1, 1)>(vb);
    const s16x4 l2 = tr_read<v_rd_off(DD, 2, 0)>(vb), h2 = tr_read<v_rd_off(DD, 2, 1)>(vb), l3 = tr_read<v_rd_off(DD, 3, 0)>(vb), h3 = tr_read<v_rd_off(DD, 3, 1)>(vb);
    asm volatile("s_waitcnt lgkmcnt(0)" ::: "memory"); __builtin_amdgcn_sched_barrier(0);
    const bf16x8 b0 = DA_PK(l0, h0), b1 = DA_PK(l1, h1), b2 = DA_PK(l2, h2), b3 = DA_PK(l3, h3);
    aR = __builtin_amdgcn_mfma_f32_32x32x16_bf16(Ca[0], b0, aR, 0, 0, 0); aI = __builtin_amdgcn_mfma_f32_32x32x16_bf16(Sa[0], b0, aI, 0, 0, 0);
    aR = __builtin_amdgcn_mfma_f32_32x32x16_bf16(Ca[1], b1, aR, 0, 0, 0); aI = __builtin_amdgcn_mfma_f32_32x32x16_bf16(Sa[1], b1, aI, 0, 0, 0);
    aR = __builtin_amdgcn_mfma_f32_32x32x16_bf16(Ca[2], b2, aR, 0, 0, 0); aI = __builtin_amdgcn_mfma_f32_32x32x16_bf16(Sa[2], b2, aI, 0, 0, 0);
    aR = __builtin_amdgcn_mfma_f32_32x32x16_bf16(Ca[3], b3, aR, 0, 0, 0); aI = __builtin_amdgcn_mfma_f32_32x32x16_bf16(Sa[3], b3, aI, 0, 0, 0);
}
__device__ __forceinline__ void fftA_phase(Frame& F, const bf16* U, bf16* TRE, bf16* TIM, const bf16* dftC, const bf16* dftS, const float* TW) {
    using namespace dattn;
    int tid = threadIdx.x; asm volatile("" : "+v"(tid));
    const int wid = __builtin_amdgcn_readfirstlane(tid >> 6), lane = tid & 63, r32 = lane & 31, hi = lane >> 5, kb = wid & 3, ch = wid >> 2;
    bf16x8 Cf[8], Sf[8];
#pragma unroll
    for (int i = 0; i < 8; ++i) { Cf[i] = *(const bf16x8*)(dftC + (32 * kb + r32) * 128 + 16 * i + 8 * hi); Sf[i] = *(const bf16x8*)(dftS + (32 * kb + r32) * 128 + 16 * i + 8 * hi); }
    const int sr = tid >> 4, sc = (tid & 15) * 8, vst0 = v_st(sr, sc), vst1 = v_st(32 + sr, sc);
    LAS unsigned char* L = F.lds + RING_OFF;
    const int vb = (int)(unsigned)(size_t)L + v_rd_base(lane) + ch * 1024;
    for (int unit = F.vcu; unit < 128 * NGRP; unit += F.G) {
        const int n2 = unit >> 3, g = unit & 7;
        const bf16* src = U + (size_t)n2 * 1024 + g * 128 + sc;
        const bf16x8 x0 = *(const bf16x8*)(src + (size_t)sr * 131072), x1 = *(const bf16x8*)(src + (size_t)(32 + sr) * 131072), x2 = *(const bf16x8*)(src + (size_t)(64 + sr) * 131072), x3 = *(const bf16x8*)(src + (size_t)(96 + sr) * 131072);
        *(LAS bf16x8*)(L + vst0) = x0; *(LAS bf16x8*)(L + vst1) = x1; *(LAS bf16x8*)(L + 16384 + vst0) = x2; *(LAS bf16x8*)(L + 16384 + vst1) = x3;
        LDS_WAIT(); __syncthreads();
        f32x16 PR[2] = {}, PI[2] = {};
        fft_mm2<0>(PR[0], PI[0], vb, Cf, Sf); fft_mm2<1>(PR[1], PI[1], vb, Cf, Sf);
        fft_mm2<0>(PR[0], PI[0], vb + 16384, Cf + 4, Sf + 4); fft_mm2<1>(PR[1], PI[1], vb + 16384, Cf + 4, Sf + 4);
        LDS_WAIT(); __syncthreads();
        const float* tw = TW + (size_t)(n2 * 128 + 32 * kb + 4 * hi) * 2;
#pragma unroll
        for (int rg = 0; rg < 4; ++rg) { const f32x4 t0 = *(const GAS f32x4*)(tw + 16 * rg), t1 = *(const GAS f32x4*)(tw + 16 * rg + 4);
            const float cc[4] = {t0.x, t0.z, t1.x, t1.z}, ss[4] = {t0.y, t0.w, t1.y, t1.w};
#pragma unroll
            for (int e = 0; e < 4; ++e) { const int r = 4 * rg + e, k1 = 32 * kb + 8 * rg + 4 * hi + e; const size_t rowo = (size_t)(k1 * 128 + n2) * 1024 + g * 128 + 64 * ch + r32;
#pragma unroll
                for (int dd = 0; dd < 2; ++dd) { const float pr = PR[dd][r], pi = PI[dd][r]; TRE[rowo + 32 * dd] = (bf16)f2bf(pr * cc[e] - pi * ss[e]); TIM[rowo + 32 * dd] = (bf16)f2bf(-(pr * ss[e] + pi * cc[e])); } } }
    }
}
__device__ __forceinline__ void fftB_phase(Frame& F, const bf16* TRE, const bf16* TIM, bf16* YF, const bf16* dftC, const bf16* dftS) {
    using namespace dattn;
    constexpr int WSTR = 272, OFF_WR = 65536, OFF_WI = 65536 + 128 * WSTR;
    constexpr float NORMF = 6.905339660024878e-4f;
    int tid = threadIdx.x; asm volatile("" : "+v"(tid));
    const int wid = __builtin_amdgcn_readfirstlane(tid >> 6), lane = tid & 63, r32 = lane & 31, hi = lane >> 5, kb = wid & 3, ch = wid >> 2;
    bf16x8 Cf[8], Sf[8];
#pragma unroll
    for (int i = 0; i < 8; ++i) { Cf[i] = *(const bf16x8*)(dftC + (32 * kb + r32) * 128 + 16 * i + 8 * hi); Sf[i] = *(const bf16x8*)(dftS + (32 * kb + r32) * 128 + 16 * i + 8 * hi); }
    const int sr = tid >> 4, sc = (tid & 15) * 8, vst0 = v_st(sr, sc), vst1 = v_st(32 + sr, sc);
    LAS unsigned char* L = F.lds + RING_OFF;
    const int vb = (int)(unsigned)(size_t)L + v_rd_base(lane) + ch * 1024;
    for (int unit = F.vcu; unit < 128 * NGRP; unit += F.G) {
        const int k1 = unit >> 3, g = unit & 7;
        const size_t so = (size_t)(k1 * 128) * 1024 + g * 128 + sc;
        bf16x8 zr[4], zi[4];
#pragma unroll
        for (int q = 0; q < 4; ++q) { zr[q] = *(const bf16x8*)(TRE + so + (size_t)(32 * q + sr) * 1024); zi[q] = *(const bf16x8*)(TIM + so + (size_t)(32 * q + sr) * 1024); }
        *(LAS bf16x8*)(L + vst0) = zr[0]; *(LAS bf16x8*)(L + vst1) = zr[1]; *(LAS bf16x8*)(L + 16384 + vst0) = zr[2]; *(LAS bf16x8*)(L + 16384 + vst1) = zr[3];
        *(LAS bf16x8*)(L + 32768 + vst0) = zi[0]; *(LAS bf16x8*)(L + 32768 + vst1) = zi[1]; *(LAS bf16x8*)(L + 49152 + vst0) = zi[2]; *(LAS bf16x8*)(L + 49152 + vst1) = zi[3];
        LDS_WAIT(); __syncthreads();
        f32x16 WR[2] = {}, WI[2] = {}, WX[2] = {};
        fft_mm2<0>(WR[0], WX[0], vb, Cf, Sf); fft_mm2<1>(WR[1], WX[1], vb, Cf, Sf);
        fft_mm2<0>(WR[0], WX[0], vb + 16384, Cf + 4, Sf + 4); fft_mm2<1>(WR[1], WX[1], vb + 16384, Cf + 4, Sf + 4);
        fft_mm2<0>(WI[0], WR[0], vb + 32768, Cf, Sf); fft_mm2<1>(WI[1], WR[1], vb + 32768, Cf, Sf);
        fft_mm2<0>(WI[0], WR[0], vb + 49152, Cf + 4, Sf + 4); fft_mm2<1>(WI[1], WR[1], vb + 49152, Cf + 4, Sf + 4);
        WI[0] -= WX[0]; WI[1] -= WX[1];
#pragma unroll
        for (int dd = 0; dd < 2; ++dd)
#pragma unroll
            for (int r = 0; r < 16; ++r) { const int k2 = 32 * kb + crow(r, hi), j = 64 * ch + 32 * dd + r32;
                *(LAS unsigned short*)(L + OFF_WR + k2 * WSTR + j * 2) = (unsigned short)f2bf(WR[dd][r]); *(LAS unsigned short*)(L + OFF_WI + k2 * WSTR + j * 2) = (unsigned short)f2bf(WI[dd][r]); }
        LDS_WAIT(); __syncthreads();
        f32x16 Y[2] = {};
#pragma unroll
        for (int kk = 0; kk < 2; ++kk) { const int rb = (64 * ch + 32 * kk + r32) * WSTR + 16 * hi;
#pragma unroll
            for (int jc = 0; jc < 8; ++jc) { const bf16x8 aR = *(const LAS bf16x8*)(L + OFF_WR + rb + 32 * jc), aI = *(const LAS bf16x8*)(L + OFF_WI + rb + 32 * jc);
                Y[kk] = __builtin_amdgcn_mfma_f32_32x32x16_bf16(aR, Cf[jc], Y[kk], 0, 0, 0); Y[kk] = __builtin_amdgcn_mfma_f32_32x32x16_bf16(aI, Sf[jc], Y[kk], 0, 0, 0); } }
#pragma unroll
        for (int kk = 0; kk < 2; ++kk)
#pragma unroll
            for (int r = 0; r < 16; ++r) { const int k2 = 64 * ch + 32 * kk + crow(r, hi); YF[(size_t)(k1 + 128 * k2) * 1024 + g * 128 + 32 * kb + r32] = (bf16)f2bf(Y[kk][r] * NORMF); }
    }
}
#ifndef PHMASK
#define PHMASK 0xffffffffu
#endif
#define PH(k) (((PHMASK) >> (k)) & 1u)
#ifndef PHREPM
#define PHREPM 0u
#endif
#define REP(k) _Pragma("unroll 1") for (int rep_ = 0; rep_ < (int)(1u + (((PHREPM) >> (k)) & 1u)); ++rep_)
struct Args { const float* in[18]; float* out; unsigned char* ws; };
__global__ void __launch_bounds__(NWAVES * 64, 2) enc_fwd(Args args) {
    extern __shared__ __attribute__((aligned(16))) unsigned char lds[];
    Frame F;
    F.lds = (LAS unsigned char*)lds;
    F.MISC = (volatile LAS unsigned*)(F.lds + MISC_OFF);
    F.tid = threadIdx.x; F.lane = F.tid & 63; F.wave = __builtin_amdgcn_readfirstlane(F.tid >> 6);
    F.G = gridDim.x; { const int bx = blockIdx.x; F.vcu = (F.G % 8 == 0) ? (bx % 8) * (F.G / 8) + bx / 8 : bx; }
    F.ws = args.ws;
    unsigned char* ws = args.ws;
    F.ctl = (gu32*)(ws + WS_CTL);
    In18 in;
#pragma unroll
    for (int i = 0; i < 18; ++i) in.p[i] = args.in[i];
    for (int u = F.tid; u < (LDS_BYTES - LDSCTL_OFF) / 4; u += NWAVES * 64) ((LAS unsigned*)(F.lds + LDSCTL_OFF))[u] = 0u;
    __syncthreads();
    XcdBarrier bar = xcd_barrier_post((unsigned*)(F.ctl + CW_BAR), F.MISC + 8);
#ifdef PROBE_BAR
    unsigned long long bar_ticks = 0ull;
#ifndef PROBE_BARSEL
#define PROBE_BARSEL 0xffffffffu
#endif
    int bar_ord = 0;
#define GRID_BAR() do { const unsigned long long w0_ = wall_clock64(); xcd_barrier(bar); if (((PROBE_BARSEL) >> bar_ord) & 1u) bar_ticks += wall_clock64() - w0_; ++bar_ord; } while (0)
#else
#define GRID_BAR() xcd_barrier(bar)
#endif

    float* const xres = args.out;
    bf16* const HB = (bf16*)(ws + WS_H); bf16* const YB = (bf16*)(ws + WS_Y); bf16* const ACT = (bf16*)(ws + WS_ACT);
    bf16* const QB = (bf16*)(ws + WS_Q); bf16* const KB = (bf16*)(ws + WS_K); bf16* const VB = (bf16*)(ws + WS_V); bf16* const UB = (bf16*)(ws + WS_U);
    bf16* const GB = (bf16*)(ws + WS_GATE); float* const OB = (float*)(ws + WS_O);
    bf16* const TRE = (bf16*)(ws + WS_TRE); bf16* const TIM = (bf16*)(ws + WS_TIM);
    bf16* const YF = (bf16*)(ws + WS_YF); bf16* const AO = (bf16*)(ws + WS_AO); bf16* const MG = (bf16*)(ws + WS_MG); bf16* const TT = (bf16*)(ws + WS_TT);
    const float* const modf = (const float*)(ws + WS_MODF); const float* const lamv = (const float*)(ws + WS_LAM);
    const float* const cosT = (const float*)(ws + WS_COS); const float* const sinT = (const float*)(ws + WS_SIN);
    const bf16* const dftC = (const bf16*)(ws + WS_DFTC); const bf16* const dftS = (const bf16*)(ws + WS_DFTS); const float* const TW = (const float*)(ws + WS_TW);
#define MODF(l, s, k) (modf + (size_t)(((l) * 3 + (s)) * 3 + (k)) * DM)

    REP(0) if (PH(0)) p0_prologue(F, in);
    GRID_BAR();
    REP(1) if (PH(1)) p1_modfin(F, in);
    GRID_BAR();
    REP(2) if (PH(2)) norm_phase<false, true>(F, in.p[0], nullptr, nullptr, HB, nullptr, MODF(0, 0, 0), MODF(0, 0, 1));
#ifdef PROBE_NORM2
    for (int q_ = 0; q_ < 4; ++q_) norm_phase<false, true>(F, in.p[0], xres, nullptr, HB, nullptr, MODF(0, 0, 0), MODF(0, 0, 1));
#endif
    GRID_BAR();

    for (int l = 0; l < DEPTH; ++l) {
        const unsigned char* wl = ws + WS_W + (size_t)l * W_LAYER;
        { pg8::Gemm g{HB, (const bf16*)(wl + W_1IN), SEQ, 2 * FF, DM}; pg8::StaticOrder S; S.init(SEQ, 2 * FF, F.G, (int)blockIdx.x);
          pg8::EpiSwiGLU E{ACT, FF};
          REP(3) if (PH(3)) pg8::gemm_phase<pg8::EpiSwiGLU, pg8::StaticOrder, false, true>(F.lds + RING_OFF, g, S, E);
#ifdef PROBE_G1X2
          __syncthreads(); pg8::gemm_phase<pg8::EpiSwiGLU, pg8::StaticOrder, false, true>(F.lds + RING_OFF, g, S, E);
#endif
          GRID_BAR(); }
        { pg8::Gemm g{ACT, (const bf16*)(wl + W_1OUT), SEQ, DM, FF}; pg8::StaticOrder S; S.init(SEQ, DM, F.G, (int)blockIdx.x);
          pg8::EpiPlain E{YB, DM};
          REP(4) if (PH(4)) pg8::gemm_phase<pg8::EpiPlain, pg8::StaticOrder, true, true>(F.lds + RING_OFF, g, S, E); GRID_BAR(); }
        if (PH(5)) norm_phase<true, true>(F, l == 0 ? in.p[0] : xres, xres, YB, HB, MODF(l, 0, 2), MODF(l, 1, 0), MODF(l, 1, 1)); GRID_BAR();
        { pg8::Gemm g{HB, (const bf16*)(wl + W_MIX), SEQ, 8192, DM}; pg8::StaticOrder S; S.init(SEQ, 8192, F.G, (int)blockIdx.x);
          pg8::EpiMix E{QB, KB, VB, UB, GB, cosT, sinT, in.p[14] + (size_t)l * 4096};
          REP(6) if (PH(6)) pg8::gemm_phase<pg8::EpiMix, pg8::StaticOrder, false, true>(F.lds + RING_OFF, g, S, E); GRID_BAR(); }
        {
            const int xcd = F.vcu >> 5, j = F.vcu & 31;
            REP(7) if (!PH(7)) {} else if (F.G == 256) {
#pragma unroll 1
                for (int i = 0; i < 4; ++i) { const int vh = 2 * xcd + (i >> 1), qb = (i & 1) * 32 + j;
                    dattn::attn_unit16(QB + (size_t)(qb * 256) * 1024 + vh * 64, KB + vh * 64, VB + (vh >> 1) * 128, OB + (size_t)(qb * 256) * 2048 + (2 * xcd) * 128, SEQ, (LAS char*)(F.lds + RING_OFF),
                                     i >= 2, lamv[l], lamv[2 + l], in.p[10] + (size_t)l * 128, AO + (size_t)(qb * 256) * 1024 + xcd * 128); }
            } else {
#pragma unroll 1
                for (int un = F.vcu; un < 1024; un += F.G) { const int vh = un >> 6, qb = un & 63;
                    dattn::attn_unit16(QB + (size_t)(qb * 256) * 1024 + vh * 64, KB + vh * 64, VB + (vh >> 1) * 128, OB + (size_t)(qb * 256) * 2048 + vh * 128, SEQ, (LAS char*)(F.lds + RING_OFF),
                                     false, 0.f, 0.f, nullptr, nullptr); }
            }
            REP(8) if (PH(8)) fftA_phase(F, UB, TRE, TIM, dftC, dftS, TW);
#ifdef PROBE_FFT2
            fftA_phase(F, UB, TRE, TIM, dftC, dftS, TW);
#endif
            GRID_BAR();
        }
        REP(9) if (PH(9)) fftB_phase(F, TRE, TIM, YF, dftC, dftS);
#ifdef PROBE_FFT2
        fftB_phase(F, TRE, TIM, YF, dftC, dftS);
#endif
        REP(10) if (PH(10) && F.G != 256) combine_phase(F, OB, AO, in.p[10] + (size_t)l * 128, lamv[l], lamv[2 + l]);
#ifdef PROBE_COMB2
        combine_phase(F, OB, AO, in.p[10] + (size_t)l * 128, lamv[l], lamv[2 + l]);
#endif
        GRID_BAR();
        { pg8::Gemm g{AO, (const bf16*)(wl + W_AP), SEQ, DM, AW}; pg8::StaticOrder S; S.init(SEQ, DM, F.G, (int)blockIdx.x);
          pg8::EpiGate E{GB, nullptr, TT};
          REP(11) if (PH(11)) pg8::gemm_phase<pg8::EpiGate, pg8::StaticOrder, true, true>(F.lds + RING_OFF, g, S, E);
          VM_WAIT(); __syncthreads(); }
        { pg8::Gemm g{YF, (const bf16*)(wl + W_FP), SEQ, DM, FW}; pg8::StaticOrder S; S.init(SEQ, DM, F.G, (int)blockIdx.x);
          pg8::EpiGate E{GB + 2048, TT, MG};
          REP(12) if (PH(12)) pg8::gemm_phase<pg8::EpiGate, pg8::StaticOrder, true, true>(F.lds + RING_OFF, g, S, E); GRID_BAR(); }
        { pg8::Gemm g{MG, (const bf16*)(wl + W_MO), SEQ, DM, DM}; pg8::StaticOrder S; S.init(SEQ, DM, F.G, (int)blockIdx.x);
          pg8::EpiPlain E{YB, DM};
          REP(13) if (PH(13)) pg8::gemm_phase<pg8::EpiPlain, pg8::StaticOrder, true, true>(F.lds + RING_OFF, g, S, E); GRID_BAR(); }
        if (PH(14)) norm_phase<true, true>(F, xres, xres, YB, HB, MODF(l, 1, 2), MODF(l, 2, 0), MODF(l, 2, 1)); GRID_BAR();
        { pg8::Gemm g{HB, (const bf16*)(wl + W_2IN), SEQ, 2 * FF, DM}; pg8::StaticOrder S; S.init(SEQ, 2 * FF, F.G, (int)blockIdx.x);
          pg8::EpiSwiGLU E{ACT, FF};
          REP(15) if (PH(15)) pg8::gemm_phase<pg8::EpiSwiGLU, pg8::StaticOrder, false, true>(F.lds + RING_OFF, g, S, E); GRID_BAR(); }
        { pg8::Gemm g{ACT, (const bf16*)(wl + W_2OUT), SEQ, DM, FF}; pg8::StaticOrder S; S.init(SEQ, DM, F.G, (int)blockIdx.x);
          pg8::EpiPlain E{YB, DM};
          REP(16) if (PH(16)) pg8::gemm_phase<pg8::EpiPlain, pg8::StaticOrder, true, true>(F.lds + RING_OFF, g, S, E); GRID_BAR(); }
        if (l + 1 < DEPTH) { if (PH(17)) norm_phase<true, true>(F, xres, xres, YB, HB, MODF(l, 2, 2), MODF(l + 1, 0, 0), MODF(l + 1, 0, 1)); GRID_BAR(); }
        else if (PH(17)) norm_phase<true, false>(F, xres, xres, YB, nullptr, MODF(l, 2, 2), nullptr, nullptr);
    }
#ifdef PROBE_BAR
    if (blockIdx.x == PROBE_BAR - 1 && F.tid == 0) { const unsigned long long w0 = wall_clock64(); while (wall_clock64() - w0 < bar_ticks) __builtin_amdgcn_s_sleep(8); }
#endif
#ifdef PROBE_GEMM
    if (blockIdx.x == 0 && F.tid == 0) { VM_WAIT(); const unsigned long long sm = __hip_atomic_load(&pg8::g_gp_sum, __ATOMIC_RELAXED, __HIP_MEMORY_SCOPE_AGENT); const unsigned cn = __hip_atomic_load(&pg8::g_gp_cnt, __ATOMIC_RELAXED, __HIP_MEMORY_SCOPE_AGENT);
        const unsigned long long avg = cn ? sm / cn : 0ull, ticks = avg * 20ull;
        const unsigned long long w0 = wall_clock64(); while (wall_clock64() - w0 < ticks) __builtin_amdgcn_s_sleep(8); }
#endif
    if (blockIdx.x == 0) { int t_ = threadIdx.x; asm volatile("" : "+v"(t_)); if (t_ < 64) { VM_WAIT(); if (__hip_atomic_load((gu32*)((unsigned*)(args.ws + WS_CTL) + CW_BAR + XB_TMO), RLX_AGENT) != 0u) { const float q = __builtin_nanf(""); for (int c = t_; c < DM; c += 64) args.out[c] = q; } } }
}

extern "C" void kernel_launch(void* const* d_in, const int* in_sizes, int n_in, void* d_out, int out_size, void* d_ws, size_t ws_size, hipStream_t stream) {
    static int grid = 0;
    if (grid == 0) {
        if (n_in != 18 || in_sizes[0] != SEQ * DM || out_size != SEQ * DM || ws_size < WS_END) { fprintf(stderr, "kernel_launch: unexpected shapes: n_in %d in0 %d out %d ws %zu (need %zu)\n", n_in, n_in > 0 ? in_sizes[0] : -1, out_size, ws_size, (size_t)WS_END); grid = -1; return; }
        int dev = 0, cus = 0, per_cu = 0;
        if (hipGetDevice(&dev) != hipSuccess || hipDeviceGetAttribute(&cus, hipDeviceAttributeMultiprocessorCount, dev) != hipSuccess) { grid = -1; return; }
        if (hipFuncSetAttribute((const void*)enc_fwd, hipFuncAttributeMaxDynamicSharedMemorySize, LDS_BYTES) != hipSuccess) { fprintf(stderr, "kernel_launch: hipFuncSetAttribute failed\n"); grid = -1; return; }
        if (hipOccupancyMaxActiveBlocksPerMultiprocessor(&per_cu, (const void*)enc_fwd, NWAVES * 64, LDS_BYTES) != hipSuccess || per_cu < 1) { fprintf(stderr, "kernel_launch: occupancy query reports %d blocks per CU\n", per_cu); }
        (void)hipGetLastError();
        grid = cus;
    }
    if (grid < 0) return;
#ifdef DBG_ZERO_WS
    if (hipMemsetAsync((char*)d_ws, 0, WS_END, stream) != hipSuccess) return;
#else
    if (hipMemsetAsync((char*)d_ws + WS_CTL, 0, CTL_ZERO_BYTES, stream) != hipSuccess) return;
#endif
    Args a{};
    for (int i = 0; i < 18; ++i) a.in[i] = (const float*)d_in[i];
    a.out = (float*)d_out; a.ws = (unsigned char*)d_ws;
    hipLaunchKernelGGL(enc_fwd, dim3(grid), dim3(NWAVES * 64), LDS_BYTES, stream, a);
    const hipError_t le = hipPeekAtLastError();
    if (le != hipSuccess) fprintf(stderr, "kernel_launch: launch failed: %s\n", hipGetErrorName(le));
}
```

```cpp
#include <hip/hip_runtime.h>
#include <hip/hip_bf16.h>
#include <cstdio>
#include <cstdint>
#include <cmath>
namespace pg8 {
#define PG8_LAS __attribute__((address_space(3)))
typedef unsigned short bf16_t;
typedef short bf16x8 __attribute__((ext_vector_type(8)));
typedef float f32x4 __attribute__((ext_vector_type(4)));
typedef unsigned u32x4 __attribute__((ext_vector_type(4)));
constexpr int BM = 256, BK = 64, HALF = 128, HTB = HALF * BK * 2  , STAGE_BYTES = 8 * HTB, NXCD = 8, WGM = 8;

__host__ __device__ __forceinline__ int lds_byte(int r, int c) { const int st = (r >> 4) * 2 + (c >> 5), rr = r & 15, cc = c & 31, ob = rr * 64 + cc * 2; return st * 1024 + (ob ^ (((ob >> 9) & 1) << 5)); }
__host__ __device__ __forceinline__ void stage_rc(int b, int& R, int& C) { const int st = b / 1024, sb = b % 1024, swz = sb ^ (((sb >> 9) & 1) << 5); R = (st >> 1) * 16 + swz / 64; C = (st & 1) * 32 + (swz % 64) / 2; }
__host__ __device__ __forceinline__ int perm32(int rho) { const int n = rho >> 4, i = rho & 15; return 8 * (i >> 2) + 4 * n + (i & 3); }

struct Unit { int pm, pn; };
struct Gemm { const bf16_t* A; const bf16_t* Bt; int M, N, K; };

struct StaticOrder {
    int nM, nN, nwg, G, c;
    __host__ __device__ void init(int M, int N, int G_, int c_) { nM = M / BM; nN = N / BM; nwg = nM * nN; G = G_; c = c_; }
    __host__ __device__ bool next(int i, Unit& u) const {
        const long L = (long)i * G + c; if (L >= nwg) return false;
        int wgid = (int)L; { const int q = nwg / NXCD, r = nwg % NXCD, xcd = wgid % NXCD, off = wgid / NXCD; wgid = (xcd < r ? xcd * (q + 1) : r * (q + 1) + (xcd - r) * q) + off; }
        const int nig = WGM * nN, gid = wgid / nig, fm = gid * WGM, gsz = (nM - fm) < WGM ? (nM - fm) : WGM;
        u.pm = fm + ((wgid % nig) % gsz); u.pn = (wgid % nig) / gsz; return true;
    }
    __device__ __forceinline__ void a_ready(const Unit&) const {}
    __device__ __forceinline__ void done(const Unit&) const {}
};

typedef float cvt_f32x2 __attribute__((ext_vector_type(2))); typedef __bf16 cvt_bf16x2 __attribute__((ext_vector_type(2)));
__device__ __forceinline__ unsigned cvt_pk_bf16(float lo, float hi) { const cvt_f32x2 v = {lo, hi}; return __builtin_bit_cast(unsigned, __builtin_convertvector(v, cvt_bf16x2)); }
typedef float f32x2 __attribute__((ext_vector_type(2)));
__device__ __forceinline__ float bf_lo(unsigned w) { return __builtin_bit_cast(float, w << 16); }
__device__ __forceinline__ float bf_hi(unsigned w) { return __builtin_bit_cast(float, w & 0xffff0000u); }
__device__ __forceinline__ float sigmoid_f(float v) { return __builtin_amdgcn_rcpf(1.0f + __builtin_amdgcn_exp2f(v * -1.4426950408889634f)); }
__device__ __forceinline__ u32x4 pack8(const f32x4 a, const f32x4 b) { u32x4 w; w.x = cvt_pk_bf16(a[0], a[1]); w.y = cvt_pk_bf16(a[2], a[3]); w.z = cvt_pk_bf16(b[0], b[1]); w.w = cvt_pk_bf16(b[2], b[3]); return w; }

struct EpiPlain {
    static constexpr bool PERM = true, AFTER_DRAIN = false; static constexpr int NST = 16;
    bf16_t* O; int ldc;
    __device__ __forceinline__ void operator()(const f32x4 (&acc)[2][2][4][2], const Unit& u, int wr, int wc, int fr, int fq) const {
        const int row0 = u.pm * BM + wr * 64 + fr, col0 = u.pn * BM + wc * 32 + 8 * fq;
#pragma unroll
        for (int ai = 0; ai < 2; ++ai)
#pragma unroll
            for (int m = 0; m < 4; ++m) { bf16_t* rowp = O + (size_t)(row0 + ai * HALF + m * 16) * ldc + col0;
#pragma unroll
                for (int bj = 0; bj < 2; ++bj) *(u32x4*)(rowp + bj * HALF) = pack8(acc[ai][bj][m][0], acc[ai][bj][m][1]); }
    }
};
struct EpiSwiGLU {
    static constexpr bool PERM = true, AFTER_DRAIN = false; static constexpr int NST = 8;
    bf16_t* O; int ldc;
    __device__ __forceinline__ void operator()(const f32x4 (&acc)[2][2][4][2], const Unit& u, int wr, int wc, int fr, int fq) const {
        const int row0 = u.pm * BM + wr * 64 + fr, col0 = u.pn * HALF + wc * 32 + 8 * fq;
#pragma unroll
        for (int ai = 0; ai < 2; ++ai)
#pragma unroll
            for (int m = 0; m < 4; ++m) { bf16_t* rowp = O + (size_t)(row0 + ai * HALF + m * 16) * ldc + col0;
                f32x4 o[2];
#pragma unroll
                for (int n = 0; n < 2; ++n) { const f32x4 g = acc[ai][0][m][n], up = acc[ai][1][m][n];
#pragma unroll
                    for (int e = 0; e < 4; ++e) o[n][e] = g[e] * sigmoid_f(g[e]) * up[e]; }
                *(u32x4*)rowp = pack8(o[0], o[1]); }
    }
};
struct EpiMix {
    static constexpr bool PERM = true, AFTER_DRAIN = false; static constexpr int NST = 16;
    bf16_t *Q, *K, *V, *U, *G; const float* cosT; const float* sinT; const float* gbias;
    __device__ __forceinline__ void operator()(const f32x4 (&acc)[2][2][4][2], const Unit& u, int wr, int wc, int fr, int fq) const {
        const int pn = u.pn, row0 = u.pm * BM + wr * 64 + fr;
        if (pn < 8) {
            bf16_t* base = (pn < 4 ? Q : K) + ((pn & 3) * 4 + wc) * 64 + 8 * fq;
            const float qs = pn < 4 ? 0.18033688011112042f : 1.0f;
#pragma unroll
            for (int ai = 0; ai < 2; ++ai) {
                f32x4 cc[4][2], ss[4][2];
#pragma unroll
                for (int m = 0; m < 4; ++m) { const int row = row0 + ai * HALF + m * 16;
                    cc[m][0] = *(const f32x4*)(cosT + (size_t)row * 32 + 8 * fq); cc[m][1] = *(const f32x4*)(cosT + (size_t)row * 32 + 8 * fq + 4);
                    ss[m][0] = *(const f32x4*)(sinT + (size_t)row * 32 + 8 * fq); ss[m][1] = *(const f32x4*)(sinT + (size_t)row * 32 + 8 * fq + 4); }
#pragma unroll
                for (int m = 0; m < 4; ++m) { const int row = row0 + ai * HALF + m * 16;
                    const f32x4 c0 = cc[m][0], c1 = cc[m][1], s0 = ss[m][0], s1 = ss[m][1];
                    const f32x4 x1a = acc[ai][0][m][0], x1b = acc[ai][0][m][1], x2a = acc[ai][1][m][0], x2b = acc[ai][1][m][1];
                    const f32x4 o1a = (x1a * c0 - x2a * s0) * qs, o1b = (x1b * c1 - x2b * s1) * qs, o2a = (x2a * c0 + x1a * s0) * qs, o2b = (x2b * c1 + x1b * s1) * qs;
                    bf16_t* rowp = base + (size_t)row * 1024;
                    *(u32x4*)rowp = pack8(o1a, o1b); *(u32x4*)(rowp + 32) = pack8(o2a, o2b); }
            }
        } else if (pn < 16) {
            bf16_t* base = (pn < 12 ? V : U) + (pn & 3) * BM + wc * 32 + 8 * fq;
#pragma unroll
            for (int ai = 0; ai < 2; ++ai)
#pragma unroll
                for (int m = 0; m < 4; ++m) { bf16_t* rowp = base + (size_t)(row0 + ai * HALF + m * 16) * 1024;
#pragma unroll
                    for (int bj = 0; bj < 2; ++bj) *(u32x4*)(rowp + bj * HALF) = pack8(acc[ai][bj][m][0], acc[ai][bj][m][1]); }
        } else {
            const int col0 = (pn - 16) * BM + wc * 32 + 8 * fq;
            f32x4 bv[2][2];
#pragma unroll
            for (int bj = 0; bj < 2; ++bj)
#pragma unroll
                for (int n = 0; n < 2; ++n) bv[bj][n] = *(const f32x4*)(gbias + col0 + bj * HALF + 4 * n);
#pragma unroll
            for (int ai = 0; ai < 2; ++ai)
#pragma unroll
                for (int m = 0; m < 4; ++m) { bf16_t* rowp = G + (size_t)(row0 + ai * HALF + m * 16) * 4096 + col0;
#pragma unroll
                    for (int bj = 0; bj < 2; ++bj) { f32x4 o[2];
#pragma unroll
                        for (int n = 0; n < 2; ++n) { const f32x4 v = acc[ai][bj][m][n] + bv[bj][n];
#pragma unroll
                            for (int e = 0; e < 4; ++e) o[n][e] = sigmoid_f(v[e]); }
                        *(u32x4*)(rowp + bj * HALF) = pack8(o[0], o[1]); } }
        }
    }
};
struct EpiGate {
    static constexpr bool PERM = true, AFTER_DRAIN = false; static constexpr int NST = 16;
    const bf16_t* gate; const bf16_t* addend; bf16_t* O;
    __device__ __forceinline__ void operator()(const f32x4 (&acc)[2][2][4][2], const Unit& u, int wr, int wc, int fr, int fq) const {
        const int row0 = u.pm * BM + wr * 64 + fr, col0 = u.pn * BM + wc * 32 + 8 * fq;
#pragma unroll
        for (int ai = 0; ai < 2; ++ai) {
            u32x4 gw[4][2], tw[4][2];
#pragma unroll
            for (int m = 0; m < 4; ++m)
#pragma unroll
                for (int bj = 0; bj < 2; ++bj) { const size_t row = (size_t)(row0 + ai * HALF + m * 16);
                    gw[m][bj] = *(const u32x4*)(gate + row * 4096 + col0 + bj * HALF);
                    if (addend) tw[m][bj] = *(const u32x4*)(addend + row * 2048 + col0 + bj * HALF); }
#pragma unroll
            for (int m = 0; m < 4; ++m)
#pragma unroll
                for (int bj = 0; bj < 2; ++bj) { const size_t row = (size_t)(row0 + ai * HALF + m * 16); const u32x4 g = gw[m][bj];
                    f32x4 a = acc[ai][bj][m][0], b = acc[ai][bj][m][1];
                    a[0] *= bf_lo(g.x); a[1] *= bf_hi(g.x); a[2] *= bf_lo(g.y); a[3] *= bf_hi(g.y); b[0] *= bf_lo(g.z); b[1] *= bf_hi(g.z); b[2] *= bf_lo(g.w); b[3] *= bf_hi(g.w);
                    if (addend) { const u32x4 t = tw[m][bj];
                        a[0] += bf_lo(t.x); a[1] += bf_hi(t.x); a[2] += bf_lo(t.y); a[3] += bf_hi(t.y); b[0] += bf_lo(t.z); b[1] += bf_hi(t.z); b[2] += bf_lo(t.w); b[3] += bf_hi(t.w); }
                    *(u32x4*)(O + row * 2048 + col0 + bj * HALF) = pack8(a, b); }
        }
    }
};

template <class Epi, class Sched, bool ALIGN_EPI = false, bool SP2 = false>
__device__ __forceinline__ void gemm_phase(PG8_LAS unsigned char* lds, const Gemm g, const Sched& S, const Epi& E) {
    int tid = threadIdx.x; asm volatile("" : "+v"(tid));
    const int wid = __builtin_amdgcn_readfirstlane(tid >> 6), lane = tid & 63, wr = wid >> 2, wc = wid & 3, fr = lane & 15, fq = lane >> 4;
    const int K = g.K, nt = K / BK;
    unsigned voffA[2], voffB[2];
#pragma unroll
    for (int i = 0; i < 2; ++i) { int R, C; stage_rc(tid * 16 + i * 8192, R, C); const int Rb = Epi::PERM ? ((R & ~31) + perm32(R & 31)) : R;
        voffA[i] = (unsigned)(R * K + C) * 2u; voffB[i] = (unsigned)(Rb * K + C) * 2u; }
    const size_t kstep = (size_t)(BK * 2);
    const size_t hstep = (size_t)HALF * K * 2;
    const size_t tstep = 2 * hstep;
    const unsigned ldsw = (unsigned)wid * 1024u;
    const unsigned ldsbase = (unsigned)(size_t)lds + ldsw;
    const int aoff = lds_byte(wr * 64 + fr, fq * 8), boff = lds_byte(wc * 32 + fr, fq * 8);
#define PG8_SA(b, h) (((b) * 2 + (h)) * HTB)
#define PG8_SB(b, h) ((4 + (b) * 2 + (h)) * HTB)
#define PG8_STAGE(bufoff, gbase, voff) do { _Pragma("unroll") for (int _i = 0; _i < 2; ++_i) \
        asm volatile("s_mov_b32 m0, %2\n\ts_nop 0\n\tglobal_load_lds_dwordx4 %0, %1" : : "v"((voff)[_i]), "s"((const char*)(gbase)), \
                     "s"((unsigned)__builtin_amdgcn_readfirstlane((int)(ldsbase + (unsigned)((bufoff) + _i * 8192)))) : "memory", "m0"); } while (0)
#define PG8_LDA(dst, b, h) do { _Pragma("unroll") for (int m = 0; m < 4; ++m) _Pragma("unroll") for (int k = 0; k < 2; ++k) dst[m][k] = *(const PG8_LAS bf16x8*)(lds + PG8_SA(b, h) + aoff + m * 2048 + k * 1024); } while (0)
#define PG8_LDB(dst, b, h) do { _Pragma("unroll") for (int n = 0; n < 2; ++n) _Pragma("unroll") for (int k = 0; k < 2; ++k) dst[n][k] = *(const PG8_LAS bf16x8*)(lds + PG8_SB(b, h) + boff + n * 2048 + k * 1024); } while (0)
#define PG8_MMA(ai, bj, At, Bt) do { __builtin_amdgcn_s_setprio(1); _Pragma("unroll") for (int m = 0; m < 4; ++m) _Pragma("unroll") for (int n = 0; n < 2; ++n) _Pragma("unroll") for (int k = 0; k < 2; ++k) \
        acc[ai][bj][m][n] = __builtin_amdgcn_mfma_f32_16x16x32_bf16(Bt[n][k], At[m][k], acc[ai][bj][m][n], 0, 0, 0); __builtin_amdgcn_s_setprio(0); } while (0)
#define PG8_WAIT_V(n) asm volatile("s_waitcnt vmcnt(" #n ")" ::: "memory")
#define PG8_WAIT_L(n) asm volatile("s_waitcnt lgkmcnt(" #n ")" ::: "memory")
#define PG8_BAR __builtin_amdgcn_s_barrier()
#define PG8_SCHED __builtin_amdgcn_sched_barrier(0)
    Unit cur, nxt; int ui = 0;
    if (!S.next(0, cur)) return;
    f32x4 acc[2][2][4][2];
#pragma unroll
    for (int a = 0; a < 2; ++a)
#pragma unroll
        for (int b = 0; b < 2; ++b)
#pragma unroll
            for (int m = 0; m < 4; ++m)
#pragma unroll
                for (int n = 0; n < 2; ++n) acc[a][b][m][n] = (f32x4){0.f, 0.f, 0.f, 0.f};
    bf16x8 At[4][2], B0[2][2], B1[2][2];
    const char* cA = (const char*)g.A + (size_t)cur.pm * tstep; const char* cB = (const char*)g.Bt + (size_t)cur.pn * tstep;
    S.a_ready(cur);
    if constexpr (SP2) {
        PG8_STAGE(PG8_SB(0, 0), cB, voffB); PG8_STAGE(PG8_SB(0, 1), cB + hstep, voffB); PG8_STAGE(PG8_SA(0, 0), cA, voffA); PG8_STAGE(PG8_SA(0, 1), cA + hstep, voffA);
        if (wr == 1) PG8_BAR;
        PG8_WAIT_V(2); PG8_BAR;
        PG8_STAGE(PG8_SB(1, 0), cB + kstep, voffB); PG8_STAGE(PG8_SA(1, 0), cA + kstep, voffA); PG8_STAGE(PG8_SB(1, 1), cB + hstep + kstep, voffB);
        PG8_WAIT_V(6); PG8_BAR;
    } else {
        PG8_STAGE(PG8_SB(0, 0), cB, voffB); PG8_STAGE(PG8_SA(0, 0), cA, voffA); PG8_STAGE(PG8_SB(0, 1), cB + hstep, voffB); PG8_STAGE(PG8_SA(0, 1), cA + hstep, voffA);
        if (wr == 1) PG8_BAR;
        PG8_WAIT_V(4); PG8_BAR;
        PG8_STAGE(PG8_SB(1, 0), cB + kstep, voffB); PG8_STAGE(PG8_SA(1, 0), cA + kstep, voffA); PG8_STAGE(PG8_SB(1, 1), cB + hstep + kstep, voffB);
        PG8_WAIT_V(6); PG8_BAR;
    }
    for (;;) {
        const bool has_next = S.next(ui + 1, nxt);
        const char* nA = has_next ? (const char*)g.A + (size_t)nxt.pm * tstep : cA; const char* nB = has_next ? (const char*)g.Bt + (size_t)nxt.pn * tstep : cB;
        for (int t = 0; t < nt; t += 2) {
            const bool last = (t == nt - 2);
            const char* a1 = cA + (size_t)(t + 1) * kstep;
            const char* a2 = last ? nA : cA + (size_t)(t + 2) * kstep; const char* b2 = last ? nB : cB + (size_t)(t + 2) * kstep;
            const char* a3 = a2 + kstep; const char* b3 = b2 + kstep;
            if (last && has_next) S.a_ready(nxt);
            if constexpr (SP2) {
            PG8_LDB(B0, 0, 0); PG8_LDB(B1, 0, 1); PG8_SCHED; PG8_LDA(At, 0, 0); PG8_STAGE(PG8_SA(1, 1), a1 + hstep, voffA);
            PG8_WAIT_V(8); PG8_WAIT_L(0); PG8_BAR; PG8_MMA(0, 0, At, B0); PG8_MMA(0, 1, At, B1); PG8_BAR; PG8_SCHED;
            PG8_LDA(At, 0, 1); PG8_STAGE(PG8_SB(0, 0), b2, voffB); PG8_STAGE(PG8_SB(0, 1), b2 + hstep, voffB); PG8_STAGE(PG8_SA(0, 0), a2, voffA);
            PG8_WAIT_V(8); PG8_WAIT_L(0); PG8_BAR; PG8_MMA(1, 0, At, B0); PG8_MMA(1, 1, At, B1); PG8_BAR; PG8_SCHED;
            PG8_LDB(B0, 1, 0); PG8_LDB(B1, 1, 1); PG8_SCHED; PG8_LDA(At, 1, 0); PG8_STAGE(PG8_SA(0, 1), a2 + hstep, voffA);
            PG8_WAIT_V(8); PG8_WAIT_L(0); PG8_BAR; PG8_MMA(0, 0, At, B0); PG8_MMA(0, 1, At, B1); PG8_BAR; PG8_SCHED;
            PG8_LDA(At, 1, 1); PG8_STAGE(PG8_SB(1, 0), b3, voffB); PG8_STAGE(PG8_SB(1, 1), b3 + hstep, voffB); PG8_STAGE(PG8_SA(1, 0), a3, voffA);
            PG8_WAIT_V(8); PG8_WAIT_L(0); PG8_BAR; PG8_MMA(1, 0, At, B0); PG8_MMA(1, 1, At, B1); PG8_BAR; PG8_SCHED;
            } else {
            PG8_LDB(B0, 0, 0); PG8_SCHED; PG8_LDA(At, 0, 0); PG8_STAGE(PG8_SA(1, 1), a1 + hstep, voffA);
            PG8_WAIT_L(8); PG8_BAR; PG8_WAIT_L(0); PG8_MMA(0, 0, At, B0); PG8_BAR; PG8_SCHED;
            PG8_LDB(B1, 0, 1); PG8_STAGE(PG8_SB(0, 0), b2, voffB);
            PG8_BAR; PG8_WAIT_L(0); PG8_MMA(0, 1, At, B1); PG8_BAR;
            PG8_LDA(At, 0, 1); PG8_STAGE(PG8_SA(0, 0), a2, voffA);
            PG8_BAR; PG8_WAIT_L(0); PG8_MMA(1, 0, At, B0); PG8_BAR; PG8_SCHED;
            PG8_STAGE(PG8_SB(0, 1), b2 + hstep, voffB);
            PG8_WAIT_V(6); PG8_BAR; PG8_MMA(1, 1, At, B1); PG8_BAR;
            PG8_LDB(B0, 1, 0); PG8_SCHED; PG8_LDA(At, 1, 0); PG8_STAGE(PG8_SA(0, 1), a2 + hstep, voffA);
            PG8_WAIT_L(8); PG8_BAR; PG8_WAIT_L(0); PG8_MMA(0, 0, At, B0); PG8_BAR; PG8_SCHED;
            PG8_LDB(B1, 1, 1); PG8_STAGE(PG8_SB(1, 0), b3, voffB);
            PG8_BAR; PG8_WAIT_L(0); PG8_MMA(0, 1, At, B1); PG8_BAR;
            PG8_LDA(At, 1, 1); PG8_STAGE(PG8_SA(1, 0), a3, voffA);
            PG8_BAR; PG8_WAIT_L(0); PG8_MMA(1, 0, At, B0); PG8_BAR; PG8_SCHED;
            PG8_STAGE(PG8_SB(1, 1), b3 + hstep, voffB);
            PG8_WAIT_V(6); PG8_BAR; PG8_MMA(1, 1, At, B1); PG8_BAR;
            }
        }
        if constexpr (ALIGN_EPI) { if (wr == 0) PG8_BAR; }
        if constexpr (!Epi::AFTER_DRAIN) { E(acc, cur, wr, wc, fr, fq); S.done(cur); }
        if (!has_next) break;
#pragma unroll
        for (int a = 0; a < 2; ++a)
#pragma unroll
            for (int b = 0; b < 2; ++b)
#pragma unroll
                for (int m = 0; m < 4; ++m)
#pragma unroll
                    for (int n = 0; n < 2; ++n) acc[a][b][m][n] = (f32x4){0.f, 0.f, 0.f, 0.f};
        cur = nxt; cA = nA; cB = nB; ++ui;
        if constexpr (ALIGN_EPI) { if (wr == 1) PG8_BAR; }
    }
    PG8_WAIT_V(0);
    if constexpr (!ALIGN_EPI) { if (wr == 0) PG8_BAR; }
    PG8_BAR;
    if constexpr (Epi::AFTER_DRAIN) { E.fused(acc, cur, wr, wc, fr, fq, lds, wid, lane); S.done(cur); }
#undef PG8_SA
#undef PG8_SB
#undef PG8_STAGE
#undef PG8_LDA
#undef PG8_LDB
#undef PG8_MMA
#undef PG8_WAIT_V
#undef PG8_WAIT_L
#undef PG8_BAR
#undef PG8_SCHED
}
}
namespace dattn {
#define DA_LAS __attribute__((address_space(3)))
typedef unsigned short bf16_t;
using bf16x8 = __attribute__((ext_vector_type(8))) short;
using s16x4  = __attribute__((ext_vector_type(4))) short;
using f32x16 = __attribute__((ext_vector_type(16))) float;
using u32x4  = __attribute__((ext_vector_type(4))) unsigned;
constexpr int NW = 8, QBLK = 32, KVBLK = 64, PITCH = 1024, LDO = 2048;
constexpr float SCALE = 0.125f;
constexpr float THR = 8.f;
constexpr int SHM_V = KVBLK * 128 * 2, SHM_K = KVBLK * 64 * 2;
constexpr int NSLOT = 3, OFF_V = 0, OFF_K = NSLOT * SHM_V, OFF_WS = NSLOT * (SHM_V + SHM_K), LDS_BYTES = OFF_WS + NW * 64 * 4;
#define DA_KSWZ(row, colB) ((row) * 128 + ((colB) ^ ((((row) >> 1) & 7) << 4)))
#define DA_SBAR() __builtin_amdgcn_sched_barrier(0)
__device__ __forceinline__ int crow(int r, int hi) { return (r & 3) + 8 * (r >> 2) + 4 * hi; }
typedef float cvt_f32x2 __attribute__((ext_vector_type(2))); typedef __bf16 cvt_bf16x2 __attribute__((ext_vector_type(2)));
__device__ __forceinline__ unsigned cvtpk(float lo, float hi) { const cvt_f32x2 v = {lo, hi}; return __builtin_bit_cast(unsigned, __builtin_convertvector(v, cvt_bf16x2)); }
#ifdef DA_THR2_TEST
constexpr float THR2 = DA_THR2_TEST;
#else
constexpr float THR2 = THR * 1.4426950408889634f;
#endif
__device__ __forceinline__ void glds16s(const void* sbase, unsigned voff, unsigned lds_dst) { unsigned keep;
  asm volatile("s_mov_b32 %0, m0\n\ts_mov_b32 m0, %3\n\ts_nop 0\n\tglobal_load_lds_dwordx4 %1, %2\n\ts_mov_b32 m0, %0" : "=&s"(keep) : "v"(voff), "s"(sbase), "s"(lds_dst) : "memory"); }
#define DA_WAIT_BAR(N) do { __builtin_amdgcn_sched_barrier(0); asm volatile("s_waitcnt vmcnt(" #N ") lgkmcnt(0)\n\ts_barrier" ::: "memory"); __builtin_amdgcn_sched_barrier(0); } while (0)
__device__ __forceinline__ int v_st(int k, int c) { const int kk = (k & ~0xC) | ((k & 4) << 1) | ((k & 8) >> 1); return ((kk >> 3) * 4 + (c >> 5)) * 512 + ((kk & 7) * 32 + (c & 31)) * 2; }
__device__ __forceinline__ int v_rd_base(int lane) { return ((lane & 3) << 3) | (((lane >> 2) & 3) << 6) | (((lane >> 4) & 1) << 5) | (((lane >> 5) & 1) << 8); }
constexpr int v_rd_off(int d0, int ks, int half) { return d0 * 512 + ks * 4096 + half * 2048; }
template <int OFF> __device__ __forceinline__ s16x4 tr_read(int vb) {
  s16x4 r; asm volatile("ds_read_b64_tr_b16 %0, %1 offset:%2" : "=&v"(r) : "v"(vb), "i"(OFF) : "memory"); return r;
}
#define DA_PK(L, H) (bf16x8){L[0], L[1], L[2], L[3], H[0], H[1], H[2], H[3]}
#define DA_LGKM(N) do { asm volatile("s_waitcnt lgkmcnt(" #N ")" ::: "memory"); DA_SBAR(); } while (0)
template <int OFF> __device__ __forceinline__ bf16x8 lds_rd128(int a) { bf16x8 r; asm volatile("ds_read_b128 %0, %1 offset:%2" : "=&v"(r) : "v"(a), "i"(OFF) : "memory"); return r; }
typedef float f32x4a __attribute__((ext_vector_type(4)));
typedef unsigned v2u16 __attribute__((ext_vector_type(2)));
struct KPre16 { bf16x8 k[4][2]; };
__device__ __forceinline__ void prefetch_k16(KPre16& P, int kbase, int fr, int fq) {
  const int sw = ((fr >> 1) & 7) << 4, a0 = kbase + fr * 128 + ((16 * fq) ^ sw), a1 = kbase + fr * 128 + ((64 + 16 * fq) ^ sw);
  P.k[0][0] = lds_rd128<0>(a0); P.k[1][0] = lds_rd128<2048>(a0); P.k[2][0] = lds_rd128<4096>(a0); P.k[3][0] = lds_rd128<6144>(a0);
  P.k[0][1] = lds_rd128<0>(a1); P.k[1][1] = lds_rd128<2048>(a1); P.k[2][1] = lds_rd128<4096>(a1); P.k[3][1] = lds_rd128<6144>(a1);
}
template <int S> __device__ __forceinline__ void prefetch_k16s(KPre16& P, int a0, int a1) {
  P.k[0][0] = lds_rd128<S * SHM_K + 0>(a0); P.k[1][0] = lds_rd128<S * SHM_K + 2048>(a0); P.k[2][0] = lds_rd128<S * SHM_K + 4096>(a0); P.k[3][0] = lds_rd128<S * SHM_K + 6144>(a0);
  P.k[0][1] = lds_rd128<S * SHM_K + 0>(a1); P.k[1][1] = lds_rd128<S * SHM_K + 2048>(a1); P.k[2][1] = lds_rd128<S * SHM_K + 4096>(a1); P.k[3][1] = lds_rd128<S * SHM_K + 6144>(a1);
}
__device__ __forceinline__ float xfq_max(float v) {
  auto r = __builtin_amdgcn_permlane16_swap(__float_as_uint(v), __float_as_uint(v), false, false); v = fmaxf(__uint_as_float(r[0]), __uint_as_float(r[1]));
  auto q = __builtin_amdgcn_permlane32_swap(__float_as_uint(v), __float_as_uint(v), false, false); return fmaxf(__uint_as_float(q[0]), __uint_as_float(q[1]));
}
__device__ __forceinline__ float xfq_sum(float v) {
  auto r = __builtin_amdgcn_permlane16_swap(__float_as_uint(v), __float_as_uint(v), false, false); v = __uint_as_float(r[0]) + __uint_as_float(r[1]);
  auto q = __builtin_amdgcn_permlane32_swap(__float_as_uint(v), __float_as_uint(v), false, false); return __uint_as_float(q[0]) + __uint_as_float(q[1]);
}
template <bool SAFE>
__device__ __forceinline__ void softmax16(f32x4a (&s)[2][4], float (&mhat)[2], bool first, float (&alpha)[2], bf16x8 (&pa)[2][2]) {
  if (SAFE) {
    float lm[2];
#pragma unroll
    for (int qb = 0; qb < 2; ++qb) { float m = fmaxf(s[qb][0][0], s[qb][0][1]);
#pragma unroll
      for (int kb = 0; kb < 4; ++kb)
#pragma unroll
        for (int j = (kb == 0 ? 2 : 0); j < 4; ++j) m = fmaxf(m, s[qb][kb][j]);
      lm[qb] = m; alpha[qb] = 1.f; }
    if (__builtin_expect(first || __any(mhat[0] != 0.f || mhat[1] != 0.f || fmaxf(lm[0], lm[1]) > THR2), 0)) {
#pragma unroll
      for (int qb = 0; qb < 2; ++qb) { const float ex = xfq_max(lm[qb]) - mhat[qb]; float dl = 0.f;
        if (first) { if (ex > THR2 || ex < -THR2) dl = ex; } else if (ex > THR2) dl = ex;
        mhat[qb] += dl;
#pragma unroll
        for (int kb = 0; kb < 4; ++kb) s[qb][kb] -= mhat[qb];
        alpha[qb] = first ? 1.f : __builtin_amdgcn_exp2f(-dl); }
    }
  }
#pragma unroll
  for (int qb = 0; qb < 2; ++qb) {
#pragma unroll
    for (int kb = 0; kb < 4; ++kb)
#pragma unroll
      for (int j = 0; j < 4; ++j) s[qb][kb][j] = __builtin_amdgcn_exp2f(s[qb][kb][j]);
#pragma unroll
    for (int g = 0; g < 2; ++g) { const u32x4 w = {cvtpk(s[qb][2 * g][0], s[qb][2 * g][1]), cvtpk(s[qb][2 * g][2], s[qb][2 * g][3]), cvtpk(s[qb][2 * g + 1][0], s[qb][2 * g + 1][1]), cvtpk(s[qb][2 * g + 1][2], s[qb][2 * g + 1][3])};
      pa[qb][g] = __builtin_bit_cast(bf16x8, w); }
  }
}
#define DA_W16(N) do { asm volatile("s_waitcnt lgkmcnt(" #N ")" ::: "memory"); DA_SBAR(); } while (0)
#define DA_RF16(J) do { vl[(J) & 7] = tr_read<VS * SHM_V + 8192 * ((J) >> 3)>(va[(J) & 7]); vh[(J) & 7] = tr_read<VS * SHM_V + 8192 * ((J) >> 3) + 4096>(va[(J) & 7]); DA_SBAR(); } while (0)
#define DA_PV16(J) do { const bf16x8 vf_ = DA_PK(vl[(J) & 7], vh[(J) & 7]); \
    o[0][(J) & 7] = __builtin_amdgcn_mfma_f32_16x16x32_bf16(vf_, pa[0][(J) >> 3], o[0][(J) & 7], 0, 0, 0); o[1][(J) & 7] = __builtin_amdgcn_mfma_f32_16x16x32_bf16(vf_, pa[1][(J) >> 3], o[1][(J) & 7], 0, 0, 0); } while (0)
struct NoDma16 { __device__ __forceinline__ void operator()() const {} };
template <bool HAS_QK, bool HAS_PV, int VS, class DMA = NoDma16>
__device__ __forceinline__ void m_seg16(f32x4a (&s)[2][4], KPre16& P, const bf16x8 (&qf)[2][2], f32x4a (&o)[2][8], f32x4a (&lacc)[2], const bf16x8& ones, const int (&va)[8], const bf16x8 (&pa)[2][2], DMA dma = NoDma16()) {
  s16x4 vl[8], vh[8];
  __builtin_amdgcn_s_setprio(2);
  if (HAS_QK) {
    const f32x4a z = {0.f, 0.f, 0.f, 0.f};
#define DA_QK16(KB, KS) do { s[0][KB] = __builtin_amdgcn_mfma_f32_16x16x32_bf16(P.k[KB][KS], qf[0][KS], (KS) == 0 ? z : s[0][KB], 0, 0, 0); \
    s[1][KB] = __builtin_amdgcn_mfma_f32_16x16x32_bf16(P.k[KB][KS], qf[1][KS], (KS) == 0 ? z : s[1][KB], 0, 0, 0); } while (0)
    DA_QK16(0, 0); dma(); DA_SBAR(); if (HAS_PV) DA_RF16(0); DA_QK16(1, 0); if (HAS_PV) DA_RF16(1); DA_QK16(2, 0); if (HAS_PV) DA_RF16(2); DA_QK16(3, 0); if (HAS_PV) DA_RF16(3);
    DA_QK16(0, 1); if (HAS_PV) DA_RF16(4); DA_QK16(1, 1); if (HAS_PV) DA_RF16(5); DA_QK16(2, 1); if (HAS_PV) DA_RF16(6); DA_QK16(3, 1); DA_SBAR();
#undef DA_QK16
  } else if (HAS_PV) { DA_RF16(0); DA_RF16(1); DA_RF16(2); DA_RF16(3); DA_RF16(4); DA_RF16(5); DA_RF16(6); }
  if (HAS_PV) {
    lacc[0] = __builtin_amdgcn_mfma_f32_16x16x32_bf16(ones, pa[0][0], lacc[0], 0, 0, 0); lacc[1] = __builtin_amdgcn_mfma_f32_16x16x32_bf16(ones, pa[1][0], lacc[1], 0, 0, 0);
    lacc[0] = __builtin_amdgcn_mfma_f32_16x16x32_bf16(ones, pa[0][1], lacc[0], 0, 0, 0); lacc[1] = __builtin_amdgcn_mfma_f32_16x16x32_bf16(ones, pa[1][1], lacc[1], 0, 0, 0);
    DA_SBAR();
    DA_W16(10); DA_PV16(0); DA_RF16(7);   DA_PV16(1); DA_RF16(8);   DA_W16(10); DA_PV16(2); DA_RF16(9);   DA_PV16(3); DA_RF16(10);
    DA_W16(10); DA_PV16(4); DA_RF16(11);  DA_PV16(5); DA_RF16(12);  DA_W16(10); DA_PV16(6); DA_RF16(13);  DA_PV16(7); DA_RF16(14);
    DA_W16(10); DA_PV16(8); DA_RF16(15);  DA_PV16(9); DA_SBAR();    DA_W16(8); DA_PV16(10); DA_SBAR();   DA_PV16(11); DA_SBAR();
    DA_W16(4); DA_PV16(12); DA_SBAR();    DA_PV16(13); DA_SBAR();    DA_W16(0); DA_PV16(14); DA_SBAR();    DA_PV16(15);
    asm volatile("" : "+v"(o[0][0]), "+v"(o[0][1]), "+v"(o[0][2]), "+v"(o[0][3]), "+v"(o[0][4]), "+v"(o[0][5]), "+v"(o[0][6]), "+v"(o[0][7]));
    asm volatile("" : "+v"(o[1][0]), "+v"(o[1][1]), "+v"(o[1][2]), "+v"(o[1][3]), "+v"(o[1][4]), "+v"(o[1][5]), "+v"(o[1][6]), "+v"(o[1][7]));
    asm volatile("" : "+v"(lacc[0]), "+v"(lacc[1]));
  }
  __builtin_amdgcn_s_setprio(0);
}
#undef DA_W16
#undef DA_RF16
#undef DA_PV16
template <bool SAFE>
__device__ __forceinline__ bool attn_unit16_body(const bf16_t* __restrict__ Qb, const bf16_t* __restrict__ Kh, const bf16_t* __restrict__ Vh, float* Ob, int seq, DA_LAS char* lds,
                                            bool second, float lam, float oscale, const float* __restrict__ subg, bf16_t* __restrict__ AOb) {
  int tid = threadIdx.x; asm volatile("" : "+v"(tid));
  const int wid = __builtin_amdgcn_readfirstlane(tid >> 6), lane = tid & 63, fr = lane & 15, fq = lane >> 4;
  const bool grpA = wid < 4;
  const unsigned lds0 = (unsigned)(size_t)lds;
  const int krow = 8 * wid + (lane >> 3), kpiece = (lane & 7) ^ ((krow >> 1) & 7);
  const unsigned ksrc = (unsigned)(krow * PITCH + kpiece * 8) * 2u;
  const int vr0 = 8 * wid + (lane >> 4), vr1 = vr0 + 4;
  const unsigned vsrc0 = (unsigned)(vr0 * PITCH + (((lane & 15) ^ (((vr0 & 3) << 2) | ((vr0 >> 2) & 3))) * 8)) * 2u;
  const unsigned vsrc1 = (unsigned)(vr1 * PITCH + (((lane & 15) ^ (((vr1 & 3) << 2) | ((vr1 >> 2) & 3))) * 8)) * 2u;
  const unsigned kdst = lds0 + OFF_K + wid * 1024, vdst = lds0 + OFF_V + wid * 2048;
#define DA_DMA_K(t, slot) glds16s(Kh + (long)(t) * KVBLK * PITCH, ksrc, (unsigned)__builtin_amdgcn_readfirstlane(kdst + (slot) * SHM_K))
#define DA_DMA_V(t, slot) do { glds16s(Vh + (long)(t) * KVBLK * PITCH, vsrc0, (unsigned)__builtin_amdgcn_readfirstlane(vdst + (slot) * SHM_V)); \
    glds16s(Vh + (long)(t) * KVBLK * PITCH, vsrc1, (unsigned)__builtin_amdgcn_readfirstlane(vdst + (slot) * SHM_V + 1024)); } while (0)
  const int NT = seq / KVBLK;
  DA_DMA_K(0, 0); DA_DMA_K(1, 1); DA_DMA_V(0, 0);
  float mhat[2] = {0.f, 0.f}, alpha[2] = {1.f, 1.f};
  f32x4a o[2][8] = {}; f32x4a lacc[2] = {}; f32x4a s[2][4] = {}; bf16x8 qf[2][2]; bf16x8 pa[2][2]; KPre16 P;
  bf16x8 ones; { const u32x4 w1 = {0x3f803f80u, 0x3f803f80u, 0x3f803f80u, 0x3f803f80u}; ones = __builtin_bit_cast(bf16x8, w1); asm volatile("" : "+v"(ones)); }
#pragma unroll
  for (int qb = 0; qb < 2; ++qb)
#pragma unroll
    for (int ks = 0; ks < 2; ++ks) qf[qb][ks] = *(const bf16x8*)(Qb + (long)(wid * QBLK + 16 * qb + fr) * PITCH + 32 * ks + 8 * fq);
  int va[8];
  { const int e = fr >> 2, pp = fr & 3, x = (e << 2) | fq;
#pragma unroll
    for (int db = 0; db < 8; ++db) va[db] = (int)(lds0 + OFF_V) + 256 * (4 * fq + e) + 16 * ((2 * db + (pp >> 1)) ^ x) + 8 * (pp & 1); }
  const int ksw = ((fr >> 1) & 7) << 4, ka0 = (int)(lds0 + OFF_K) + fr * 128 + ((16 * fq) ^ ksw), ka1 = (int)(lds0 + OFF_K) + fr * 128 + ((64 + 16 * fq) ^ ksw);
#define DA_PREF_K(slot) prefetch_k16s<slot>(P, ka0, ka1)
#define DA_RESC16() do { if (__any(alpha[0] < 1.f || alpha[1] < 1.f)) { _Pragma("unroll") for (int qb = 0; qb < 2; ++qb) { lacc[qb] *= alpha[qb]; _Pragma("unroll") for (int db = 0; db < 8; ++db) o[qb][db] *= alpha[qb]; } } } while (0)
#define DA_SEG_V(first) do { softmax16<SAFE>(s, mhat, (first), alpha, pa); asm volatile("" : "+v"(pa[0][0]), "+v"(pa[0][1]), "+v"(pa[1][0]), "+v"(pa[1][1])); if (SAFE) DA_RESC16(); } while (0)
  asm volatile("s_waitcnt vmcnt(3)" ::: "memory");
  DA_WAIT_BAR(3);
  int t = 1;
  if (grpA) {
    DA_DMA_K(2, 2); DA_DMA_V(1, 1);
    DA_PREF_K(0); DA_LGKM(0);
    m_seg16<true, false, 0>(s, P, qf, o, lacc, ones, va, pa);
    DA_WAIT_BAR(3);
    DA_PREF_K(1);
    DA_SEG_V(true);
    DA_WAIT_BAR(3);
    m_seg16<true, true, 0>(s, P, qf, o, lacc, ones, va, pa, [&]() { DA_DMA_K(3, 0); });
    DA_WAIT_BAR(3);
#define DA_BODY_A(T, M0, M1, M2) do { \
      DA_PREF_K(M1); \
      DA_SEG_V(false); \
      DA_DMA_V((T) + 1, M1); \
      if ((T) + 2 < NT) DA_WAIT_BAR(3); else DA_WAIT_BAR(2); \
      m_seg16<true, true, M0>(s, P, qf, o, lacc, ones, va, pa, [&]() { if ((T) + 3 < NT) DA_DMA_K((T) + 3, M0); }); \
      if ((T) + 3 < NT) DA_WAIT_BAR(3); else DA_WAIT_BAR(0); } while (0)
#pragma unroll 1
    for (; t + 3 < NT; t += 3) { DA_BODY_A(t, 1, 2, 0); DA_BODY_A(t + 1, 2, 0, 1); DA_BODY_A(t + 2, 0, 1, 2); }
    if (t + 1 < NT) { DA_BODY_A(t, 1, 2, 0); ++t; }
    if (t + 1 < NT) { DA_BODY_A(t, 2, 0, 1); ++t; }
#undef DA_BODY_A
    DA_SEG_V(false);
    DA_WAIT_BAR(0);
  } else {
    DA_DMA_K(2, 2); DA_DMA_V(1, 1);
    DA_PREF_K(0);
    DA_WAIT_BAR(3);
    m_seg16<true, false, 0>(s, P, qf, o, lacc, ones, va, pa);
    DA_WAIT_BAR(3);
    DA_PREF_K(1);
    __builtin_amdgcn_s_setprio(1); DA_SEG_V(true); __builtin_amdgcn_s_setprio(0);
    DA_DMA_V(2, 2);
    DA_WAIT_BAR(2);
#define DA_BODY_B(T, M0, M1, M2) do { \
      m_seg16<true, true, M2>(s, P, qf, o, lacc, ones, va, pa, [&]() { if ((T) + 2 < NT) DA_DMA_K((T) + 2, M2); }); \
      DA_WAIT_BAR(3); \
      DA_PREF_K(M1); \
      __builtin_amdgcn_s_setprio(1); DA_SEG_V(false); __builtin_amdgcn_s_setprio(0); \
      if ((T) + 2 < NT) { DA_DMA_V((T) + 2, M2); DA_WAIT_BAR(2); } else DA_WAIT_BAR(0); } while (0)
#pragma unroll 1
    for (; t + 3 < NT; t += 3) { DA_BODY_B(t, 1, 2, 0); DA_BODY_B(t + 1, 2, 0, 1); DA_BODY_B(t + 2, 0, 1, 2); }
    if (t + 1 < NT) { DA_BODY_B(t, 1, 2, 0); ++t; }
    if (t + 1 < NT) { DA_BODY_B(t, 2, 0, 1); ++t; }
#undef DA_BODY_B
    if ((NT - 2) % 3 == 0) m_seg16<true, true, 0>(s, P, qf, o, lacc, ones, va, pa); else if ((NT - 2) % 3 == 1) m_seg16<true, true, 1>(s, P, qf, o, lacc, ones, va, pa); else m_seg16<true, true, 2>(s, P, qf, o, lacc, ones, va, pa);
    DA_WAIT_BAR(0);
    __builtin_amdgcn_s_setprio(1); DA_SEG_V(false); __builtin_amdgcn_s_setprio(0);
  }
  if ((NT - 1) % 3 == 0) m_seg16<false, true, 0>(s, P, qf, o, lacc, ones, va, pa); else if ((NT - 1) % 3 == 1) m_seg16<false, true, 1>(s, P, qf, o, lacc, ones, va, pa); else m_seg16<false, true, 2>(s, P, qf, o, lacc, ones, va, pa);
  const float lsum[2] = {lacc[0][0], lacc[1][0]};
  int te = threadIdx.x; asm volatile("" : "+v"(te));
  const int wid_e = __builtin_amdgcn_readfirstlane(te >> 6), lane_e = te & 63, fr_e = lane_e & 15, fq_e = lane_e >> 4;
  if (!SAFE) {
    float om = 0.f;
#pragma unroll
    for (int qb = 0; qb < 2; ++qb)
#pragma unroll
      for (int db = 0; db < 8; ++db) om = fmaxf(fmaxf(om, fmaxf(fabsf(o[qb][db][0]), fabsf(o[qb][db][1]))), fmaxf(fabsf(o[qb][db][2]), fabsf(o[qb][db][3])));
#ifdef DA_TEST_FALLBACK
    const bool good = false;
#else
    const bool good = lsum[0] > 0x1p-100f && lsum[0] < 0x1p100f && lsum[1] > 0x1p-100f && lsum[1] < 0x1p100f && om < 0x1p120f;
#endif
    DA_LAS int* fl = (DA_LAS int*)(lds + OFF_WS);
    if (lane_e == 0) fl[wid_e] = __any(!good) ? 1 : 0;
    DA_WAIT_BAR(0);
    int bad = 0;
#pragma unroll
    for (int w = 0; w < NW; ++w) bad |= fl[w];
    if (__builtin_amdgcn_readfirstlane(bad)) { DA_WAIT_BAR(0); return false; }
  }
#pragma unroll
  for (int qb = 0; qb < 2; ++qb) {
    const float rl = __builtin_amdgcn_rcpf(lsum[qb]);
    const long row = wid_e * QBLK + 16 * qb + fr_e;
    if (!second) {
#pragma unroll
      for (int db = 0; db < 8; ++db) *(f32x4a*)(Ob + row * LDO + 16 * db + 4 * fq_e) = o[qb][db] * rl;
    } else {
      f32x4a d[8]; float ss = 0.f;
#pragma unroll
      for (int db = 0; db < 8; ++db) d[db] = *(const f32x4a*)(Ob + row * LDO + 16 * db + 4 * fq_e);
#pragma unroll
      for (int db = 0; db < 8; ++db) { d[db] = d[db] - (o[qb][db] * rl) * lam; ss += (d[db][0] * d[db][0] + d[db][1] * d[db][1]) + (d[db][2] * d[db][2] + d[db][3] * d[db][3]); }
      const float rs = oscale / sqrtf(xfq_sum(ss) * (1.0f / 128.0f) + 1e-5f);
#pragma unroll
      for (int db = 0; db < 8; ++db) { const f32x4a g = *(const f32x4a*)(subg + 16 * db + 4 * fq_e); const f32x4a v = d[db] * g * rs;
        const v2u16 w = {cvtpk(v[0], v[1]), cvtpk(v[2], v[3])}; *(v2u16*)(AOb + row * 1024 + 16 * db + 4 * fq_e) = w; }
    }
  }
  DA_WAIT_BAR(0);
  return true;
#undef DA_DMA_K
#undef DA_DMA_V
#undef DA_PREF_K
#undef DA_RESC16
#undef DA_SEG_V
}
__device__ __forceinline__ void attn_unit16(const bf16_t* __restrict__ Qb, const bf16_t* __restrict__ Kh, const bf16_t* __restrict__ Vh, float* Ob, int seq, DA_LAS char* lds,
                                            bool second, float lam, float oscale, const float* __restrict__ subg, bf16_t* __restrict__ AOb) {
#ifndef DA_FORCE_SAFE
  if (attn_unit16_body<false>(Qb, Kh, Vh, Ob, seq, lds, second, lam, oscale, subg, AOb)) return;
#endif
#ifndef DA_FORCE_FAST
  attn_unit16_body<true>(Qb, Kh, Vh, Ob, seq, lds, second, lam, oscale, subg, AOb);
#endif
}
}

constexpr int NWAVES = 8;
constexpr int SEQ = 16384, DM = 2048, FF = 5632, AW = 1024, NHEAD = 8, FW = 1024, NGRP = 8, GD = 128, DEPTH = 2;
constexpr int NMOD = 9 * DM;
constexpr int KSPLIT = 16;
constexpr float NORM_EPS = 1e-6f, SUBLN_EPS = 1e-5f;

constexpr size_t MiB = 1u << 20;
constexpr size_t WS_CTL = 0, CTL_ZERO_BYTES = 1 * MiB;
constexpr size_t WS_COS = 1 * MiB, WS_SIN = 3 * MiB;
constexpr size_t WS_DFTC = 5 * MiB, WS_DFTS = 5 * MiB + 32768, WS_TW = 5 * MiB + 65536;
constexpr size_t WS_MODP = 6 * MiB;
constexpr size_t WS_MODF = 9 * MiB;
constexpr size_t WS_LAM = WS_MODF + (size_t)DEPTH * 9 * DM * 4;
constexpr size_t WS_W = 10 * MiB, W_LAYER = 180 * MiB;
constexpr size_t W_1IN = 0, W_1OUT = 44 * MiB, W_MIX = 66 * MiB, W_AP = 98 * MiB, W_FP = 102 * MiB, W_MO = 106 * MiB, W_2IN = 114 * MiB, W_2OUT = 158 * MiB;
constexpr size_t WS_H = 370 * MiB, WS_Y = 434 * MiB, WS_ACT = 498 * MiB, WS_M1 = 674 * MiB, WS_O = 802 * MiB, WS_END = 930 * MiB;
constexpr size_t WS_TRE = WS_Y, WS_TIM = WS_Y + 32 * MiB;
constexpr size_t WS_GATE = WS_ACT;
constexpr size_t WS_Q = WS_M1, WS_K = WS_M1 + 32 * MiB, WS_V = WS_M1 + 64 * MiB, WS_U = WS_M1 + 96 * MiB;
constexpr size_t WS_AO = WS_M1, WS_YF = WS_M1 + 32 * MiB, WS_MG = WS_M1 + 64 * MiB;
constexpr size_t WS_TT = WS_O;
constexpr int CW_TMO = 0, CW_CODE = 1, CW_BAR = 4096, CW_CHK = 16384;

constexpr int RING_OFF = 0, PHASE_LDS = 143360;
constexpr int LDSCTL_OFF = PHASE_LDS, MISC_OFF = LDSCTL_OFF + 320;
constexpr int LDS_BYTES = 147456;
static_assert(MISC_OFF + 128 <= LDS_BYTES, "LDS map");

#define GAS __attribute__((address_space(1)))
#define LAS __attribute__((address_space(3)))
typedef unsigned short bf16;
typedef unsigned v4u __attribute__((ext_vector_type(4)));
typedef unsigned v2u __attribute__((ext_vector_type(2)));
typedef float f32x4 __attribute__((ext_vector_type(4)));
typedef float f32x16 __attribute__((ext_vector_type(16)));
typedef short bf16x8 __attribute__((ext_vector_type(8)));
typedef short s16x4 __attribute__((ext_vector_type(4)));
typedef GAS unsigned gu32;
#define RLX_AGENT __ATOMIC_RELAXED, __HIP_MEMORY_SCOPE_AGENT
#define LDS_WAIT() asm volatile("s_waitcnt lgkmcnt(0)" ::: "memory")
#define VM_WAIT() asm volatile("s_waitcnt vmcnt(0)" ::: "memory")
__device__ __forceinline__ unsigned f2bf(float f) { unsigned u = __builtin_bit_cast(unsigned, f); return (u + 0x7fffu + ((u >> 16) & 1u)) >> 16; }
__device__ __forceinline__ unsigned pk2(float lo, float hi) { return f2bf(lo) | (f2bf(hi) << 16); }
__device__ __forceinline__ float bfl(unsigned w) { return __builtin_bit_cast(float, w << 16); }
__device__ __forceinline__ float bfh(unsigned w) { return __builtin_bit_cast(float, w & 0xffff0000u); }
__device__ __forceinline__ float wave_sum(float v) {
#pragma unroll
    for (int o = 1; o < 64; o <<= 1) v += __shfl_xor(v, o);
    return v;
}
__device__ __forceinline__ void sincos_turns(double t, double& s, double& c) {
    t -= floor(t);
    const double q = floor(t * 4.0 + 0.5);
    const double x = (t - q * 0.25) * 6.283185307179586476925286766559;
    const double x2 = x * x;
    double sp = -1.0 / 1307674368000.0; sp = sp * x2 + 1.0 / 6227020800.0; sp = sp * x2 - 1.0 / 39916800.0; sp = sp * x2 + 1.0 / 362880.0; sp = sp * x2 - 1.0 / 5040.0; sp = sp * x2 + 1.0 / 120.0; sp = sp * x2 - 1.0 / 6.0; sp = sp * x2 + 1.0;
    const double sx = sp * x;
    double cp = 1.0 / 20922789888000.0; cp = cp * x2 - 1.0 / 87178291200.0; cp = cp * x2 + 1.0 / 479001600.0; cp = cp * x2 - 1.0 / 3628800.0; cp = cp * x2 + 1.0 / 40320.0; cp = cp * x2 - 1.0 / 720.0; cp = cp * x2 + 1.0 / 24.0; cp = cp * x2 - 0.5; cp = cp * x2 + 1.0;
    const int qi = ((int)q) & 3;
    s = (qi == 0) ? sx : (qi == 1) ? cp : (qi == 2) ? -sx : -cp;
    c = (qi == 0) ? cp : (qi == 1) ? -sx : (qi == 2) ? -cp : sx;
}
__constant__ float ROPE_INV_FREQ[32] = {1.f,0.749894261f,0.562341332f,0.421696514f,0.316227764f,0.237137377f,0.177827939f,0.133352131f,0.100000001f,0.0749894157f,0.0562341325f,0.0421696529f,0.0316227749f,0.0237137377f,0.0177827943f,0.0133352149f,0.00999999978f,0.00749894185f,0.00562341325f,0.00421696482f,0.00316227763f,0.00237137359f,0.00177827943f,0.00133352145f,0.00100000005f,0.000749894243f,0.000562341302f,0.000421696517f,0.000316227757f,0.00023713737f,0.00017782794f,0.00013335215f};

#define XB_TMO      128
#define XB_XCNT(j)  (256  + 64 * (j))
#define XB_XSUB(j)  (1280 + 64 * (j))
#define XB_XGEN(j)  (2304 + 64 * (j))
#define XB_TOP      3328
#define XB_TOPGEN   3392
#define XCD_BAR_WORDS 3456
#define XB_SPIN_CAP (1u << 21)

__device__ __forceinline__ unsigned xb_ld(unsigned* p)              { return __hip_atomic_load(p, __ATOMIC_RELAXED, __HIP_MEMORY_SCOPE_AGENT); }
__device__ __forceinline__ unsigned xb_add(unsigned* p, unsigned v) { return __hip_atomic_fetch_add(p, v, __ATOMIC_RELAXED, __HIP_MEMORY_SCOPE_AGENT); }
__device__ __forceinline__ unsigned xb_xcc_id() { return (unsigned)__builtin_amdgcn_s_getreg((3 << 11) | 20) & 0xFu; }
#define XB_SPIN(cond, bar) do { unsigned _sp = 0; while (cond) { __builtin_amdgcn_s_sleep(1); \
    if ((++_sp & 255u) == 0u) { if (xb_ld(&(bar)[XB_TMO])) break; if (_sp > XB_SPIN_CAP) { atomicAdd(&(bar)[XB_TMO], 1u); break; } } } } while (0)

struct XcdBarrier {
    unsigned* bar; unsigned x;
    volatile LAS unsigned* st;
};

__device__ __forceinline__ XcdBarrier xcd_barrier_post(unsigned* bar, volatile LAS unsigned* st) {
    XcdBarrier b; b.bar = bar; b.x = xb_xcc_id(); b.st = st;
    if (threadIdx.x == 0) (void)xb_add(&bar[XB_XCNT(b.x)], 1u);
    return b;
}
__device__ __forceinline__ void xcd_barrier_complete(unsigned* bar, unsigned x, unsigned& nloc, unsigned& nx) {
    const unsigned G = gridDim.x * gridDim.y * gridDim.z;
    unsigned sum, cnt, mine, sp = 0u;
    for (;;) {
        sum = 0u; cnt = 0u; mine = 0u;
#pragma unroll
        for (unsigned j = 0; j < 16; ++j) { const unsigned c = xb_ld(&bar[XB_XCNT(j)]); sum += c; cnt += (c > 0u) ? 1u : 0u; mine = (j == x) ? c : mine; }
        if (sum == G) break;
        __builtin_amdgcn_s_sleep(1);
        if ((++sp & 255u) == 0u) { if (xb_ld(&bar[XB_TMO])) break; if (sp > XB_SPIN_CAP) { atomicAdd(&bar[XB_TMO], 1u); break; } }
    }
    nloc = mine > 0u ? mine : 1u; nx = cnt > 0u ? cnt : 1u;
}

__device__ __forceinline__ void xcd_barrier(const XcdBarrier& b) {
    asm volatile("s_waitcnt vmcnt(0)" ::: "memory");
    __syncthreads();
    if (threadIdx.x == 0) {
        unsigned* bar = b.bar; unsigned bx = b.x; asm volatile("" : "+s"(bx));
        __builtin_amdgcn_s_waitcnt(0);
        unsigned nloc = b.st[0], nx = b.st[1];
        if (nloc == 0u) { xcd_barrier_complete(bar, bx, nloc, nx); b.st[0] = nloc; b.st[1] = nx; }
        const unsigned old = xb_add(&bar[XB_XSUB(bx)], 1u);
        const unsigned gen = old / nloc;
        if (old + 1u == (gen + 1u) * nloc) {
            __builtin_amdgcn_fence(__ATOMIC_RELEASE, "agent");
            asm volatile("s_waitcnt vmcnt(0)" ::: "memory");
            const unsigned og = xb_add(&bar[XB_TOP], 1u);
            const unsigned tg = og / nx;
            if (og + 1u == (tg + 1u) * nx) xb_add(&bar[XB_TOPGEN], 1u);
            else XB_SPIN(xb_ld(&bar[XB_TOPGEN]) == tg, bar);
            __builtin_amdgcn_fence(__ATOMIC_ACQUIRE, "agent");
            xb_add(&bar[XB_XGEN(bx)], 1u);
            asm volatile("s_waitcnt vmcnt(0)" ::: "memory");
        } else {
            XB_SPIN(xb_ld(&bar[XB_XGEN(bx)]) == gen, bar);
            __builtin_amdgcn_fence(__ATOMIC_ACQUIRE, "agent");
            asm volatile("s_waitcnt vmcnt(0)" ::: "memory");
        }
    }
    __syncthreads();
}
struct Frame {
    LAS unsigned char* lds;
    volatile LAS unsigned* MISC;
    gu32* ctl;
    int tid, lane, wave;
    int vcu, G;
    unsigned char* ws;
};

__device__ __forceinline__ int wt_row(int mode, int row_off, int n0) {
    if (mode == 1) { const int up = n0 >= FF ? 1 : 0, j = n0 - up * FF; return (j >> 7) * 256 + up * 128 + (j & 127); }
    if (mode == 2) { if (n0 < 2048) { const int ch = n0 >> 6, d = n0 & 63; return 256 * (ch >> 2) + 128 * (d >> 5) + 32 * (ch & 3) + (d & 31); } return n0; }
    return row_off + n0;
}
__device__ __forceinline__ void p0_transpose_item(const float* W, int K, int N, bf16* WT, int mode, int row_off, LAS float* scr, int item, int lane) {
    const int nblk = N / 32, kb = item / nblk, nb = item % nblk, k0 = 64 * kb, n0 = 32 * nb;
#pragma unroll 8
    for (int i = 0; i < 32; ++i) { const int kk = 2 * i + (lane >> 5); scr[kk * 33 + (lane & 31)] = W[(size_t)(k0 + kk) * N + n0 + (lane & 31)]; }
    LDS_WAIT(); asm volatile("" ::: "memory");
    const int c = lane & 7, rbase = wt_row(mode, row_off, n0);
#pragma unroll
    for (int j = 0; j < 4; ++j) { const int n = (lane >> 3) + 8 * j; const LAS float* s = scr + (8 * c) * 33 + n;
        v4u o; o.x = pk2(s[0 * 33], s[1 * 33]); o.y = pk2(s[2 * 33], s[3 * 33]); o.z = pk2(s[4 * 33], s[5 * 33]); o.w = pk2(s[6 * 33], s[7 * 33]);
        *(GAS v4u*)(WT + (size_t)(rbase + n) * K + k0 + 8 * c) = o; }
    LDS_WAIT(); asm volatile("" ::: "memory");
}
struct In18 { const float* p[18]; };
__device__ __forceinline__ void p0_prologue(Frame& F, const In18& in) {
    LAS float* scr = (LAS float*)(F.lds + RING_OFF + F.wave * 16384);
    const int gw = F.vcu * NWAVES + F.wave, NGW = F.G * NWAVES;
    constexpr int I0 = 32 * 352, I1 = 88 * 64, I2 = 32 * 128, I3 = 32 * 128, I4 = 16 * 64, I5 = 16 * 64, I6 = 32 * 64, IL = 2 * I0 + 2 * I1 + I2 + I3 + I4 + I5 + I6;
    for (int it = gw; it < DEPTH * IL; it += NGW) {
        const int l = it / IL; int r = it % IL;
        bf16* wl = (bf16*)(F.ws + WS_W + (size_t)l * W_LAYER);
        if (r < I0) { p0_transpose_item(in.p[6] + (size_t)l * DM * 2 * FF, DM, 2 * FF, (bf16*)((unsigned char*)wl + W_1IN), 1, 0, scr, r, F.lane); continue; } r -= I0;
        if (r < I1) { p0_transpose_item(in.p[7] + (size_t)l * FF * DM, FF, DM, (bf16*)((unsigned char*)wl + W_1OUT), 0, 0, scr, r, F.lane); continue; } r -= I1;
        if (r < I2) { p0_transpose_item(in.p[8] + (size_t)l * DM * 4096, DM, 4096, (bf16*)((unsigned char*)wl + W_MIX), 2, 0, scr, r, F.lane); continue; } r -= I2;
        if (r < I3) { p0_transpose_item(in.p[13] + (size_t)l * DM * 4096, DM, 4096, (bf16*)((unsigned char*)wl + W_MIX), 0, 4096, scr, r, F.lane); continue; } r -= I3;
        if (r < I4) { p0_transpose_item(in.p[11] + (size_t)l * AW * DM, AW, DM, (bf16*)((unsigned char*)wl + W_AP), 0, 0, scr, r, F.lane); continue; } r -= I4;
        if (r < I5) { p0_transpose_item(in.p[12] + (size_t)l * FW * DM, FW, DM, (bf16*)((unsigned char*)wl + W_FP), 0, 0, scr, r, F.lane); continue; } r -= I5;
        if (r < I6) { p0_transpose_item(in.p[15] + (size_t)l * DM * DM, DM, DM, (bf16*)((unsigned char*)wl + W_MO), 0, 0, scr, r, F.lane); continue; } r -= I6;
        if (r < I0) { p0_transpose_item(in.p[16] + (size_t)l * DM * 2 * FF, DM, 2 * FF, (bf16*)((unsigned char*)wl + W_2IN), 1, 0, scr, r, F.lane); continue; } r -= I0;
        p0_transpose_item(in.p[17] + (size_t)l * FF * DM, FF, DM, (bf16*)((unsigned char*)wl + W_2OUT), 0, 0, scr, r, F.lane);
    }
    {
        constexpr int NCB = NMOD / 256, KR = DM / KSPLIT;
        const float* cvec = in.p[1]; float* modp = (float*)(F.ws + WS_MODP);
        for (int it = gw; it < DEPTH * NCB * KSPLIT; it += NGW) {
            const int l = it / (NCB * KSPLIT), r = it % (NCB * KSPLIT), ks = r / NCB, cb = r % NCB, c0 = cb * 256 + 4 * F.lane, k0 = ks * KR;
            const float* W = in.p[2] + (size_t)l * DM * NMOD + (size_t)k0 * NMOD + c0;
            f32x4 acc = {0.f, 0.f, 0.f, 0.f};
#pragma unroll 8
            for (int k = 0; k < KR; ++k) { const float cv = cvec[k0 + k]; const float ca = cv * __builtin_amdgcn_rcpf(1.0f + __builtin_amdgcn_exp2f(cv * -1.4426950408889634f));
                const f32x4 w = *(const GAS f32x4*)(W + (size_t)k * NMOD); acc += w * ca; }
            *(GAS f32x4*)(modp + (size_t)(l * KSPLIT + ks) * NMOD + c0) = acc;
        }
    }
    {
        const int gt = F.vcu * (NWAVES * 64) + F.tid, NT = F.G * NWAVES * 64;
        float* cosT = (float*)(F.ws + WS_COS); float* sinT = (float*)(F.ws + WS_SIN);
        for (int idx = gt; idx < SEQ * 32; idx += NT) { const int pos = idx >> 5, i = idx & 31; const float ang = (float)pos * ROPE_INV_FREQ[i];
            double s, c; sincos_turns((double)ang * 0.15915494309189533576888376337251, s, c); cosT[idx] = (float)c; sinT[idx] = (float)s; }
        bf16* dC = (bf16*)(F.ws + WS_DFTC); bf16* dS = (bf16*)(F.ws + WS_DFTS); float* tw = (float*)(F.ws + WS_TW);
        for (int idx = gt; idx < 128 * 128; idx += NT) { const int a = idx >> 7, b = idx & 127; double s, c;
            sincos_turns((double)((a * b) & 127) * (1.0 / 128.0), s, c); dC[idx] = (bf16)f2bf((float)c); dS[idx] = (bf16)f2bf((float)s);
            sincos_turns((double)(a * b) * (1.0 / 16384.0), s, c); tw[2 * idx] = (float)c; tw[2 * idx + 1] = (float)s; }
    }
}
__device__ __forceinline__ void p1_modfin(Frame& F, const In18& in) {
    const int gt = F.vcu * (NWAVES * 64) + F.tid, NT = F.G * NWAVES * 64;
    const float* modp = (const float*)(F.ws + WS_MODP); float* modf = (float*)(F.ws + WS_MODF);
    for (int idx = gt; idx < DEPTH * 3 * DM; idx += NT) { const int l = idx / (3 * DM), s = (idx / DM) % 3, c = idx % DM, base = s * 3 * DM + c;
        float sh = in.p[3][l * NMOD + base], sc = in.p[3][l * NMOD + base + DM], gt_ = in.p[3][l * NMOD + base + 2 * DM];
        for (int ks = 0; ks < KSPLIT; ++ks) { const float* q = modp + (size_t)(l * KSPLIT + ks) * NMOD + base; sh += q[0]; sc += q[DM]; gt_ += q[2 * DM]; }
        const float gpre = in.p[4][(l * 3 + s) * DM + c], gpost = in.p[5][(l * 3 + s) * DM + c];
        float* o = modf + (size_t)((l * 3 + s) * 3) * DM + c;
        o[0] = gpre * (1.0f + sc); o[DM] = sh; o[2 * DM] = (s == 1 ? 1.0f : 0.5f) * gt_ * gpost; }
    if (blockIdx.x == 0 && F.wave < DEPTH) { const int l = F.wave; const float* lq = in.p[9] + l * 256;
        const float sa = wave_sum(lq[F.lane] * lq[64 + F.lane]), sb = wave_sum(lq[128 + F.lane] * lq[192 + F.lane]);
        const float linit = l == 0 ? 0.2f : 0.35550906758f;
        if (F.lane == 0) { float* lamv = (float*)(F.ws + WS_LAM); lamv[l] = __builtin_amdgcn_exp2f(sa * 1.4426950408889634f) - __builtin_amdgcn_exp2f(sb * 1.4426950408889634f) + linit; lamv[2 + l] = 1.0f - linit; } }
}
template <bool HAS_Y, bool HAS_H>
__device__ __forceinline__ void norm_phase(Frame& F, const float* xin, float* xout, const bf16* y, bf16* h, const float* Gv, const float* Av, const float* Bv) {
    int lane = F.lane; asm volatile("" : "+v"(lane));
    const int gw = F.vcu * NWAVES + F.wave, NGW = F.G * NWAVES;
    f32x4 g[8], a[8], b[8];
#pragma unroll
    for (int j = 0; j < 8; ++j) { if (HAS_Y) g[j] = *(const GAS f32x4*)(Gv + 4 * lane + 256 * j); if (HAS_H) { a[j] = *(const GAS f32x4*)(Av + 4 * lane + 256 * j); b[j] = *(const GAS f32x4*)(Bv + 4 * lane + 256 * j); } }
    for (int row = gw; row < SEQ; row += NGW) {
        f32x4 x[8];
#pragma unroll
        for (int j = 0; j < 8; ++j) x[j] = *(const GAS f32x4*)(xin + (size_t)row * DM + 4 * lane + 256 * j);
        if (HAS_Y) {
            f32x4 yv[8]; float ss = 0.f;
#pragma unroll
            for (int j = 0; j < 8; ++j) { const v2u w = *(const GAS v2u*)(y + (size_t)row * DM + 4 * lane + 256 * j); yv[j] = (f32x4){bfl(w.x), bfh(w.x), bfl(w.y), bfh(w.y)};
                ss += (yv[j].x * yv[j].x + yv[j].y * yv[j].y) + (yv[j].z * yv[j].z + yv[j].w * yv[j].w); }
            const float ry = 1.0f / sqrtf(wave_sum(ss) * (1.0f / DM) + NORM_EPS);
#pragma unroll
            for (int j = 0; j < 8; ++j) x[j] = x[j] + g[j] * yv[j] * ry;
        }
        if (HAS_Y) {
#pragma unroll
            for (int j = 0; j < 8; ++j) *(GAS f32x4*)(xout + (size_t)row * DM + 4 * lane + 256 * j) = x[j];
        }
        if (HAS_H) {
            float ss = 0.f;
#pragma unroll
            for (int j = 0; j < 8; ++j) ss += (x[j].x * x[j].x + x[j].y * x[j].y) + (x[j].z * x[j].z + x[j].w * x[j].w);
            const float rx = 1.0f / sqrtf(wave_sum(ss) * (1.0f / DM) + NORM_EPS);
#pragma unroll
            for (int j = 0; j < 8; ++j) { const f32x4 v = x[j] * rx * a[j] + b[j]; v2u w; w.x = pk2(v.x, v.y); w.y = pk2(v.z, v.w); *(GAS v2u*)(h + (size_t)row * DM + 4 * lane + 256 * j) = w; }
        }
    }
}
__device__ __forceinline__ void combine_phase(Frame& F, const float* O, bf16* AO, const float* subg, float lam, float oscale) {
    int lane = F.lane; asm volatile("" : "+v"(lane));
    const int gw = F.vcu * NWAVES + F.wave, NGW = F.G * NWAVES, hh = lane >> 3, e0 = (lane & 7) * 16;
    f32x4 g[4];
#pragma unroll
    for (int j = 0; j < 4; ++j) g[j] = *(const GAS f32x4*)(subg + e0 + 4 * j) * oscale;
    for (int row = gw; row < SEQ; row += NGW) {
        const float* p0 = O + (size_t)row * 2048 + hh * 256 + e0;
        f32x4 o[4]; float ss = 0.f;
#pragma unroll
        for (int j = 0; j < 4; ++j) { const f32x4 a = *(const GAS f32x4*)(p0 + 4 * j), b = *(const GAS f32x4*)(p0 + 128 + 4 * j); o[j] = a - b * lam; ss += (o[j].x * o[j].x + o[j].y * o[j].y) + (o[j].z * o[j].z + o[j].w * o[j].w); }
        ss += __shfl_xor(ss, 1); ss += __shfl_xor(ss, 2); ss += __shfl_xor(ss, 4);
        const float r = 1.0f / sqrtf(ss * (1.0f / 128.0f) + SUBLN_EPS);
        v4u w0, w1; { const f32x4 v0 = o[0] * r * g[0], v1 = o[1] * r * g[1], v2 = o[2] * r * g[2], v3 = o[3] * r * g[3];
            w0.x = pk2(v0.x, v0.y); w0.y = pk2(v0.z, v0.w); w0.z = pk2(v1.x, v1.y); w0.w = pk2(v1.z, v1.w); w1.x = pk2(v2.x, v2.y); w1.y = pk2(v2.z, v2.w); w1.z = pk2(v3.x, v3.y); w1.w = pk2(v3.z, v3.w); }
        bf16* op = AO + (size_t)row * 1024 + hh * 128 + e0;
        *(GAS v4u*)op = w0; *(GAS v4u*)(op + 8) = w1;
    }
}
template <int DD> __device__ __forceinline__ void fft_mm2(f32x16& aR, f32x16& aI, int vb, const bf16x8* Ca, const bf16x8* Sa) {
    using namespace dattn;
    const s16x4 l0 = tr_read<v_rd_off(DD, 0, 0)>(vb), h0 = tr_read<v_rd_off(DD, 0, 1)>(vb), l1 = tr_read<v_rd_off(DD, 1, 0)>(vb), h1 = tr_read<v_rd_off(DD, 1, 1)>(vb);
    const s16x4 l2 = tr_read<v_rd_off(DD, 2, 0)>(vb), h2 = tr_read<v_rd_off(DD, 2, 1)>(vb), l3 = tr_read<v_rd_off(DD, 3, 0)>(vb), h3 = tr_read<v_rd_off(DD, 3, 1)>(vb);
    asm volatile("s_waitcnt lgkmcnt(0)" ::: "memory"); __builtin_amdgcn_sched_barrier(0);
    const bf16x8 b0 = DA_PK(l0, h0), b1 = DA_PK(l1, h1), b2 = DA_PK(l2, h2), b3 = DA_PK(l3, h3);
    aR = __builtin_amdgcn_mfma_f32_32x32x16_bf16(Ca[0], b0, aR, 0, 0, 0); aI = __builtin_amdgcn_mfma_f32_32x32x16_bf16(Sa[0], b0, aI, 0, 0, 0);
    aR = __builtin_amdgcn_mfma_f32_32x32x16_bf16(Ca[1], b1, aR, 0, 0, 0); aI = __builtin_amdgcn_mfma_f32_32x32x16_bf16(Sa[1], b1, aI, 0, 0, 0);
    aR = __builtin_amdgcn_mfma_f32_32x32x16_bf16(Ca[2], b2, aR, 0, 0, 0); aI = __builtin_amdgcn_mfma_f32_32x32x16_bf16(Sa[2], b2, aI, 0, 0, 0);
    aR = __builtin_amdgcn_mfma_f32_32x32x16_bf16(Ca[3], b3, aR, 0, 0, 0); aI = __builtin_amdgcn_mfma_f32_32x32x16_bf16(Sa[3], b3, aI, 0, 0, 0);
}
__device__ __forceinline__ void fftA_phase(Frame& F, const bf16* U, bf16* TRE, bf16* TIM, const bf16* dftC, const bf16* dftS, const float* TW) {
    using namespace dattn;
    int tid = threadIdx.x; asm volatile("" : "+v"(tid));
    const int wid = __builtin_amdgcn_readfirstlane(tid >> 6), lane = tid & 63, r32 = lane & 31, hi = lane >> 5, kb = wid & 3, ch = wid >> 2;
    bf16x8 Cf[8], Sf[8];
#pragma unroll
    for (int i = 0; i < 8; ++i) { Cf[i] = *(const bf16x8*)(dftC + (32 * kb + r32) * 128 + 16 * i + 8 * hi); Sf[i] = *(const bf16x8*)(dftS + (32 * kb + r32) * 128 + 16 * i + 8 * hi); }
    const int sr = tid >> 4, sc = (tid & 15) * 8, vst0 = v_st(sr, sc), vst1 = v_st(32 + sr, sc);
    LAS unsigned char* L = F.lds + RING_OFF;
    const int vb = (int)(unsigned)(size_t)L + v_rd_base(lane) + ch * 1024;
    for (int unit = F.vcu; unit < 128 * NGRP; unit += F.G) {
        const int n2 = unit >> 3, g = unit & 7;
        const bf16* src = U + (size_t)n2 * 1024 + g * 128 + sc;
        const bf16x8 x0 = *(const bf16x8*)(src + (size_t)sr * 131072), x1 = *(const bf16x8*)(src + (size_t)(32 + sr) * 131072), x2 = *(const bf16x8*)(src + (size_t)(64 + sr) * 131072), x3 = *(const bf16x8*)(src + (size_t)(96 + sr) * 131072);
        *(LAS bf16x8*)(L + vst0) = x0; *(LAS bf16x8*)(L + vst1) = x1; *(LAS bf16x8*)(L + 16384 + vst0) = x2; *(LAS bf16x8*)(L + 16384 + vst1) = x3;
        LDS_WAIT(); __syncthreads();
        f32x16 PR[2] = {}, PI[2] = {};
        fft_mm2<0>(PR[0], PI[0], vb, Cf, Sf); fft_mm2<1>(PR[1], PI[1], vb, Cf, Sf);
        fft_mm2<0>(PR[0], PI[0], vb + 16384, Cf + 4, Sf + 4); fft_mm2<1>(PR[1], PI[1], vb + 16384, Cf + 4, Sf + 4);
        LDS_WAIT(); __syncthreads();
        const float* tw = TW + (size_t)(n2 * 128 + 32 * kb + 4 * hi) * 2;
#pragma unroll
        for (int rg = 0; rg < 4; ++rg) { const f32x4 t0 = *(const GAS f32x4*)(tw + 16 * rg), t1 = *(const GAS f32x4*)(tw + 16 * rg + 4);
            const float cc[4] = {t0.x, t0.z, t1.x, t1.z}, ss[4] = {t0.y, t0.w, t1.y, t1.w};
#pragma unroll
            for (int e = 0; e < 4; ++e) { const int r = 4 * rg + e, k1 = 32 * kb + 8 * rg + 4 * hi + e; const size_t rowo = (size_t)(k1 * 128 + n2) * 1024 + g * 128 + 64 * ch + r32;
#pragma unroll
                for (int dd = 0; dd < 2; ++dd) { const float pr = PR[dd][r], pi = PI[dd][r]; TRE[rowo + 32 * dd] = (bf16)f2bf(pr * cc[e] - pi * ss[e]); TIM[rowo + 32 * dd] = (bf16)f2bf(-(pr * ss[e] + pi * cc[e])); } } }
    }
}
__device__ __forceinline__ void fftB_phase(Frame& F, const bf16* TRE, const bf16* TIM, bf16* YF, const bf16* dftC, const bf16* dftS) {
    using namespace dattn;
    constexpr int WSTR = 272, OFF_WR = 65536, OFF_WI = 65536 + 128 * WSTR;
    constexpr float NORMF = 6.905339660024878e-4f;
    int tid = threadIdx.x; asm volatile("" : "+v"(tid));
    const int wid = __builtin_amdgcn_readfirstlane(tid >> 6), lane = tid & 63, r32 = lane & 31, hi = lane >> 5, kb = wid & 3, ch = wid >> 2;
    bf16x8 Cf[8], Sf[8];
#pragma unroll
    for (int i = 0; i < 8; ++i) { Cf[i] = *(const bf16x8*)(dftC + (32 * kb + r32) * 128 + 16 * i + 8 * hi); Sf[i] = *(const bf16x8*)(dftS + (32 * kb + r32) * 128 + 16 * i + 8 * hi); }
    const int sr = tid >> 4, sc = (tid & 15) * 8, vst0 = v_st(sr, sc), vst1 = v_st(32 + sr, sc);
    LAS unsigned char* L = F.lds + RING_OFF;
    const int vb = (int)(unsigned)(size_t)L + v_rd_base(lane) + ch * 1024;
    for (int unit = F.vcu; unit < 128 * NGRP; unit += F.G) {
        const int k1 = unit >> 3, g = unit & 7;
        const size_t so = (size_t)(k1 * 128) * 1024 + g * 128 + sc;
        bf16x8 zr[4], zi[4];
#pragma unroll
        for (int q = 0; q < 4; ++q) { zr[q] = *(const bf16x8*)(TRE + so + (size_t)(32 * q + sr) * 1024); zi[q] = *(const bf16x8*)(TIM + so + (size_t)(32 * q + sr) * 1024); }
        *(LAS bf16x8*)(L + vst0) = zr[0]; *(LAS bf16x8*)(L + vst1) = zr[1]; *(LAS bf16x8*)(L + 16384 + vst0) = zr[2]; *(LAS bf16x8*)(L + 16384 + vst1) = zr[3];
        *(LAS bf16x8*)(L + 32768 + vst0) = zi[0]; *(LAS bf16x8*)(L + 32768 + vst1) = zi[1]; *(LAS bf16x8*)(L + 49152 + vst0) = zi[2]; *(LAS bf16x8*)(L + 49152 + vst1) = zi[3];
        LDS_WAIT(); __syncthreads();
        f32x16 WR[2] = {}, WI[2] = {}, WX[2] = {};
        fft_mm2<0>(WR[0], WX[0], vb, Cf, Sf); fft_mm2<1>(WR[1], WX[1], vb, Cf, Sf);
        fft_mm2<0>(WR[0], WX[0], vb + 16384, Cf + 4, Sf + 4); fft_mm2<1>(WR[1], WX[1], vb + 16384, Cf + 4, Sf + 4);
        fft_mm2<0>(WI[0], WR[0], vb + 32768, Cf, Sf); fft_mm2<1>(WI[1], WR[1], vb + 32768, Cf, Sf);
        fft_mm2<0>(WI[0], WR[0], vb + 49152, Cf + 4, Sf + 4); fft_mm2<1>(WI[1], WR[1], vb + 49152, Cf + 4, Sf + 4);
        WI[0] -= WX[0]; WI[1] -= WX[1];
#pragma unroll
        for (int dd = 0; dd < 2; ++dd)
#pragma unroll
            for (int r = 0; r < 16; ++r) { const int k2 = 32 * kb + crow(r, hi), j = 64 * ch + 32 * dd + r32;
                *(LAS unsigned short*)(L + OFF_WR + k2 * WSTR + j * 2) = (unsigned short)f2bf(WR[dd][r]); *(LAS unsigned short*)(L + OFF_WI + k2 * WSTR + j * 2) = (unsigned short)f2bf(WI[dd][r]); }
        LDS_WAIT(); __syncthreads();
        f32x16 Y[2] = {};
#pragma unroll
        for (int kk = 0; kk < 2; ++kk) { const int rb = (64 * ch + 32 * kk + r32) * WSTR + 16 * hi;
#pragma unroll
            for (int jc = 0; jc < 8; ++jc) { const bf16x8 aR = *(const LAS bf16x8*)(L + OFF_WR + rb + 32 * jc), aI = *(const LAS bf16x8*)(L + OFF_WI + rb + 32 * jc);
                Y[kk] = __builtin_amdgcn_mfma_f32_32x32x16_bf16(aR, Cf[jc], Y[kk], 0, 0, 0); Y[kk] = __builtin_amdgcn_mfma_f32_32x32x16_bf16(aI, Sf[jc], Y[kk], 0, 0, 0); } }
#pragma unroll
        for (int kk = 0; kk < 2; ++kk)
#pragma unroll
            for (int r = 0; r < 16; ++r) { const int k2 = 64 * ch + 32 * kk + crow(r, hi); YF[(size_t)(k1 + 128 * k2) * 1024 + g * 128 + 32 * kb + r32] = (bf16)f2bf(Y[kk][r] * NORMF); }
    }
}
#ifndef PHMASK
#define PHMASK 0xffffffffu
#endif
#define PH(k) (((PHMASK) >> (k)) & 1u)
#ifndef PHREPM
#define PHREPM 0u
#endif
#define REP(k) _Pragma("unroll 1") for (int rep_ = 0; rep_ < (int)(1u + (((PHREPM) >> (k)) & 1u)); ++rep_)
struct Args { const float* in[18]; float* out; unsigned char* ws; };
__global__ void __launch_bounds__(NWAVES * 64, 2) enc_fwd(Args args) {
    extern __shared__ __attribute__((aligned(16))) unsigned char lds[];
    Frame F;
    F.lds = (LAS unsigned char*)lds;
    F.MISC = (volatile LAS unsigned*)(F.lds + MISC_OFF);
    F.tid = threadIdx.x; F.lane = F.tid & 63; F.wave = __builtin_amdgcn_readfirstlane(F.tid >> 6);
    F.G = gridDim.x; { const int bx = blockIdx.x; F.vcu = (F.G % 8 == 0) ? (bx % 8) * (F.G / 8) + bx / 8 : bx; }
    F.ws = args.ws;
    unsigned char* ws = args.ws;
    F.ctl = (gu32*)(ws + WS_CTL);
    In18 in;
#pragma unroll
    for (int i = 0; i < 18; ++i) in.p[i] = args.in[i];
    for (int u = F.tid; u < (LDS_BYTES - LDSCTL_OFF) / 4; u += NWAVES * 64) ((LAS unsigned*)(F.lds + LDSCTL_OFF))[u] = 0u;
    __syncthreads();
    XcdBarrier bar = xcd_barrier_post((unsigned*)(F.ctl + CW_BAR), F.MISC + 8);
#ifdef PROBE_BAR
    unsigned long long bar_ticks = 0ull;
#ifndef PROBE_BARSEL
#define PROBE_BARSEL 0xffffffffu
#endif
    int bar_ord = 0;
#define GRID_BAR() do { const unsigned long long w0_ = wall_clock64(); xcd_barrier(bar); if (((PROBE_BARSEL) >> bar_ord) & 1u) bar_ticks += wall_clock64() - w0_; ++bar_ord; } while (0)
#else
#define GRID_BAR() xcd_barrier(bar)
#endif

    float* const xres = args.out;
    bf16* const HB = (bf16*)(ws + WS_H); bf16* const YB = (bf16*)(ws + WS_Y); bf16* const ACT = (bf16*)(ws + WS_ACT);
    bf16* const QB = (bf16*)(ws + WS_Q); bf16* const KB = (bf16*)(ws + WS_K); bf16* const VB = (bf16*)(ws + WS_V); bf16* const UB = (bf16*)(ws + WS_U);
    bf16* const GB = (bf16*)(ws + WS_GATE); float* const OB = (float*)(ws + WS_O);
    bf16* const TRE = (bf16*)(ws + WS_TRE); bf16* const TIM = (bf16*)(ws + WS_TIM);
    bf16* const YF = (bf16*)(ws + WS_YF); bf16* const AO = (bf16*)(ws + WS_AO); bf16* const MG = (bf16*)(ws + WS_MG); bf16* const TT = (bf16*)(ws + WS_TT);
    const float* const modf = (const float*)(ws + WS_MODF); const float* const lamv = (const float*)(ws + WS_LAM);
    const float* const cosT = (const float*)(ws + WS_COS); const float* const sinT = (const float*)(ws + WS_SIN);
    const bf16* const dftC = (const bf16*)(ws + WS_DFTC); const bf16* const dftS = (const bf16*)(ws + WS_DFTS); const float* const TW = (const float*)(ws + WS_TW);
#define MODF(l, s, k) (modf + (size_t)(((l) * 3 + (s)) * 3 + (k)) * DM)

    REP(0) if (PH(0)) p0_prologue(F, in);
    GRID_BAR();
    REP(1) if (PH(1)) p1_modfin(F, in);
    GRID_BAR();
    REP(2) if (PH(2)) norm_phase<false, true>(F, in.p[0], nullptr, nullptr, HB, nullptr, MODF(0, 0, 0), MODF(0, 0, 1));
#ifdef PROBE_NORM2
    for (int q_ = 0; q_ < 4; ++q_) norm_phase<false, true>(F, in.p[0], xres, nullptr, HB, nullptr, MODF(0, 0, 0), MODF(0, 0, 1));
#endif
    GRID_BAR();

    for (int l = 0; l < DEPTH; ++l) {
        const unsigned char* wl = ws + WS_W + (size_t)l * W_LAYER;
        { pg8::Gemm g{HB, (const bf16*)(wl + W_1IN), SEQ, 2 * FF, DM}; pg8::StaticOrder S; S.init(SEQ, 2 * FF, F.G, (int)blockIdx.x);
          pg8::EpiSwiGLU E{ACT, FF};
          REP(3) if (PH(3)) pg8::gemm_phase<pg8::EpiSwiGLU, pg8::StaticOrder, false, true>(F.lds + RING_OFF, g, S, E);
#ifdef PROBE_G1X2
          __syncthreads(); pg8::gemm_phase<pg8::EpiSwiGLU, pg8::StaticOrder, false, true>(F.lds + RING_OFF, g, S, E);
#endif
          GRID_BAR(); }
        { pg8::Gemm g{ACT, (const bf16*)(wl + W_1OUT), SEQ, DM, FF}; pg8::StaticOrder S; S.init(SEQ, DM, F.G, (int)blockIdx.x);
          pg8::EpiPlain E{YB, DM};
          REP(4) if (PH(4)) pg8::gemm_phase<pg8::EpiPlain, pg8::StaticOrder, true, true>(F.lds + RING_OFF, g, S, E); GRID_BAR(); }
        if (PH(5)) norm_phase<true, true>(F, l == 0 ? in.p[0] : xres, xres, YB, HB, MODF(l, 0, 2), MODF(l, 1, 0), MODF(l, 1, 1)); GRID_BAR();
        { pg8::Gemm g{HB, (const bf16*)(wl + W_MIX), SEQ, 8192, DM}; pg8::StaticOrder S; S.init(SEQ, 8192, F.G, (int)blockIdx.x);
          pg8::EpiMix E{QB, KB, VB, UB, GB, cosT, sinT, in.p[14] + (size_t)l * 4096};
          REP(6) if (PH(6)) pg8::gemm_phase<pg8::EpiMix, pg8::StaticOrder, false, true>(F.lds + RING_OFF, g, S, E); GRID_BAR(); }
        {
            const int xcd = F.vcu >> 5, j = F.vcu & 31;
            REP(7) if (!PH(7)) {} else if (F.G == 256) {
#pragma unroll 1
                for (int i = 0; i < 4; ++i) { const int vh = 2 * xcd + (i >> 1), qb = (i & 1) * 32 + j;
                    dattn::attn_unit16(QB + (size_t)(qb * 256) * 1024 + vh * 64, KB + vh * 64, VB + (vh >> 1) * 128, OB + (size_t)(qb * 256) * 2048 + (2 * xcd) * 128, SEQ, (LAS char*)(F.lds + RING_OFF),
                                     i >= 2, lamv[l], lamv[2 + l], in.p[10] + (size_t)l * 128, AO + (size_t)(qb * 256) * 1024 + xcd * 128); }
            } else {
#pragma unroll 1
                for (int un = F.vcu; un < 1024; un += F.G) { const int vh = un >> 6, qb = un & 63;
                    dattn::attn_unit16(QB + (size_t)(qb * 256) * 1024 + vh * 64, KB + vh * 64, VB + (vh >> 1) * 128, OB + (size_t)(qb * 256) * 2048 + vh * 128, SEQ, (LAS char*)(F.lds + RING_OFF),
                                     false, 0.f, 0.f, nullptr, nullptr); }
            }
            REP(8) if (PH(8)) fftA_phase(F, UB, TRE, TIM, dftC, dftS, TW);
#ifdef PROBE_FFT2
            fftA_phase(F, UB, TRE, TIM, dftC, dftS, TW);
#endif
            GRID_BAR();
        }
        REP(9) if (PH(9)) fftB_phase(F, TRE, TIM, YF, dftC, dftS);
#ifdef PROBE_FFT2
        fftB_phase(F, TRE, TIM, YF, dftC, dftS);
#endif
        REP(10) if (PH(10) && F.G != 256) combine_phase(F, OB, AO, in.p[10] + (size_t)l * 128, lamv[l], lamv[2 + l]);
#ifdef PROBE_COMB2
        combine_phase(F, OB, AO, in.p[10] + (size_t)l * 128, lamv[l], lamv[2 + l]);
#endif
        GRID_BAR();
        { pg8::Gemm g{AO, (const bf16*)(wl + W_AP), SEQ, DM, AW}; pg8::StaticOrder S; S.init(SEQ, DM, F.G, (int)blockIdx.x);
          pg8::EpiGate E{GB, nullptr, TT};
          REP(11) if (PH(11)) pg8::gemm_phase<pg8::EpiGate, pg8::StaticOrder, true, true>(F.lds + RING_OFF, g, S, E);
          VM_WAIT(); __syncthreads(); }
        { pg8::Gemm g{YF, (const bf16*)(wl + W_FP), SEQ, DM, FW}; pg8::StaticOrder S; S.init(SEQ, DM, F.G, (int)blockIdx.x);
          pg8::EpiGate E{GB + 2048, TT, MG};
          REP(12) if (PH(12)) pg8::gemm_phase<pg8::EpiGate, pg8::StaticOrder, true, true>(F.lds + RING_OFF, g, S, E); GRID_BAR(); }
        { pg8::Gemm g{MG, (const bf16*)(wl + W_MO), SEQ, DM, DM}; pg8::StaticOrder S; S.init(SEQ, DM, F.G, (int)blockIdx.x);
          pg8::EpiPlain E{YB, DM};
          REP(13) if (PH(13)) pg8::gemm_phase<pg8::EpiPlain, pg8::StaticOrder, true, true>(F.lds + RING_OFF, g, S, E); GRID_BAR(); }
        if (PH(14)) norm_phase<true, true>(F, xres, xres, YB, HB, MODF(l, 1, 2), MODF(l, 2, 0), MODF(l, 2, 1)); GRID_BAR();
        { pg8::Gemm g{HB, (const bf16*)(wl + W_2IN), SEQ, 2 * FF, DM}; pg8::StaticOrder S; S.init(SEQ, 2 * FF, F.G, (int)blockIdx.x);
          pg8::EpiSwiGLU E{ACT, FF};
          REP(15) if (PH(15)) pg8::gemm_phase<pg8::EpiSwiGLU, pg8::StaticOrder, false, true>(F.lds + RING_OFF, g, S, E); GRID_BAR(); }
        { pg8::Gemm g{ACT, (const bf16*)(wl + W_2OUT), SEQ, DM, FF}; pg8::StaticOrder S; S.init(SEQ, DM, F.G, (int)blockIdx.x);
          pg8::EpiPlain E{YB, DM};
          REP(16) if (PH(16)) pg8::gemm_phase<pg8::EpiPlain, pg8::StaticOrder, true, true>(F.lds + RING_OFF, g, S, E); GRID_BAR(); }
        if (l + 1 < DEPTH) { if (PH(17)) norm_phase<true, true>(F, xres, xres, YB, HB, MODF(l, 2, 2), MODF(l + 1, 0, 0), MODF(l + 1, 0, 1)); GRID_BAR(); }
        else if (PH(17)) norm_phase<true, false>(F, xres, xres, YB, nullptr, MODF(l, 2, 2), nullptr, nullptr);
    }
#ifdef PROBE_BAR
    if (blockIdx.x == PROBE_BAR - 1 && F.tid == 0) { const unsigned long long w0 = wall_clock64(); while (wall_clock64() - w0 < bar_ticks) __builtin_amdgcn_s_sleep(8); }
#endif
#ifdef PROBE_GEMM
    if (blockIdx.x == 0 && F.tid == 0) { VM_WAIT(); const unsigned long long sm = __hip_atomic_load(&pg8::g_gp_sum, __ATOMIC_RELAXED, __HIP_MEMORY_SCOPE_AGENT); const unsigned cn = __hip_atomic_load(&pg8::g_gp_cnt, __ATOMIC_RELAXED, __HIP_MEMORY_SCOPE_AGENT);
        const unsigned long long avg = cn ? sm / cn : 0ull, ticks = avg * 20ull;
        const unsigned long long w0 = wall_clock64(); while (wall_clock64() - w0 < ticks) __builtin_amdgcn_s_sleep(8); }
#endif
    if (blockIdx.x == 0) { int t_ = threadIdx.x; asm volatile("" : "+v"(t_)); if (t_ < 64) { VM_WAIT(); if (__hip_atomic_load((gu32*)((unsigned*)(args.ws + WS_CTL) + CW_BAR + XB_TMO), RLX_AGENT) != 0u) { const float q = __builtin_nanf(""); for (int c = t_; c < DM; c += 64) args.out[c] = q; } } }
}

extern "C" void kernel_launch(void* const* d_in, const int* in_sizes, int n_in, void* d_out, int out_size, void* d_ws, size_t ws_size, hipStream_t stream) {
    static int grid = 0;
    if (grid == 0) {
        if (n_in != 18 || in_sizes[0] != SEQ * DM || out_size != SEQ * DM || ws_size < WS_END) { fprintf(stderr, "kernel_launch: unexpected shapes: n_in %d in0 %d out %d ws %zu (need %zu)\n", n_in, n_in > 0 ? in_sizes[0] : -1, out_size, ws_size, (size_t)WS_END); grid = -1; return; }
        int dev = 0, cus = 0, per_cu = 0;
        if (hipGetDevice(&dev) != hipSuccess || hipDeviceGetAttribute(&cus, hipDeviceAttributeMultiprocessorCount, dev) != hipSuccess) { grid = -1; return; }
        if (hipFuncSetAttribute((const void*)enc_fwd, hipFuncAttributeMaxDynamicSharedMemorySize, LDS_BYTES) != hipSuccess) { fprintf(stderr, "kernel_launch: hipFuncSetAttribute failed\n"); grid = -1; return; }
        if (hipOccupancyMaxActiveBlocksPerMultiprocessor(&per_cu, (const void*)enc_fwd, NWAVES * 64, LDS_BYTES) != hipSuccess || per_cu < 1) { fprintf(stderr, "kernel_launch: occupancy query reports %d blocks per CU\n", per_cu); }
        (void)hipGetLastError();
        grid = cus;
    }
    if (grid < 0) return;
#ifdef DBG_ZERO_WS
    if (hipMemsetAsync((char*)d_ws, 0, WS_END, stream) != hipSuccess) return;
#else
    if (hipMemsetAsync((char*)d_ws + WS_CTL, 0, CTL_ZERO_BYTES, stream) != hipSuccess) return;
#endif
    Args a{};
    for (int i = 0; i < 18; ++i) a.in[i] = (const float*)d_in[i];
    a.out = (float*)d_out; a.ws = (unsigned char*)d_ws;
    hipLaunchKernelGGL(enc_fwd, dim3(grid), dim3(NWAVES * 64), LDS_BYTES, stream, a);
    const hipError_t le = hipPeekAtLastError();
    if (le != hipSuccess) fprintf(stderr, "kernel_launch: launch failed: %s\n", hipGetErrorName(le));
}
```

```cpp
#include <hip/hip_runtime.h>
#include <hip/hip_bf16.h>
#include <cstdio>
#include <cstdint>
#include <cmath>
namespace pg8 {
#define PG8_LAS __attribute__((address_space(3)))
typedef unsigned short bf16_t;
typedef short bf16x8 __attribute__((ext_vector_type(8)));
typedef float f32x4 __attribute__((ext_vector_type(4)));
typedef unsigned u32x4 __attribute__((ext_vector_type(4)));
constexpr int BM = 256, BK = 64, HALF = 128, HTB = HALF * BK * 2  , STAGE_BYTES = 8 * HTB, NXCD = 8, WGM = 8;

__host__ __device__ __forceinline__ int lds_byte(int r, int c) { const int st = (r >> 4) * 2 + (c >> 5), rr = r & 15, cc = c & 31, ob = rr * 64 + cc * 2; return st * 1024 + (ob ^ (((ob >> 9) & 1) << 5)); }
__host__ __device__ __forceinline__ void stage_rc(int b, int& R, int& C) { const int st = b / 1024, sb = b % 1024, swz = sb ^ (((sb >> 9) & 1) << 5); R = (st >> 1) * 16 + swz / 64; C = (st & 1) * 32 + (swz % 64) / 2; }
__host__ __device__ __forceinline__ int perm32(int rho) { const int n = rho >> 4, i = rho & 15; return 8 * (i >> 2) + 4 * n + (i & 3); }

struct Unit { int pm, pn; };
struct Gemm { const bf16_t* A; const bf16_t* Bt; int M, N, K; };

struct StaticOrder {
    int nM, nN, nwg, G, c;
    __host__ __device__ void init(int M, int N, int G_, int c_) { nM = M / BM; nN = N / BM; nwg = nM * nN; G = G_; c = c_; }
    __host__ __device__ bool next(int i, Unit& u) const {
        const long L = (long)i * G + c; if (L >= nwg) return false;
        int wgid = (int)L; { const int q = nwg / NXCD, r = nwg % NXCD, xcd = wgid % NXCD, off = wgid / NXCD; wgid = (xcd < r ? xcd * (q + 1) : r * (q + 1) + (xcd - r) * q) + off; }
        const int nig = WGM * nN, gid = wgid / nig, fm = gid * WGM, gsz = (nM - fm) < WGM ? (nM - fm) : WGM;
        u.pm = fm + ((wgid % nig) % gsz); u.pn = (wgid % nig) / gsz; return true;
    }
    __device__ __forceinline__ void a_ready(const Unit&) const {}
    __device__ __forceinline__ void done(const Unit&) const {}
};

typedef float cvt_f32x2 __attribute__((ext_vector_type(2))); typedef __bf16 cvt_bf16x2 __attribute__((ext_vector_type(2)));
__device__ __forceinline__ unsigned cvt_pk_bf16(float lo, float hi) { const cvt_f32x2 v = {lo, hi}; return __builtin_bit_cast(unsigned, __builtin_convertvector(v, cvt_bf16x2)); }
typedef float f32x2 __attribute__((ext_vector_type(2)));
__device__ __forceinline__ float bf_lo(unsigned w) { return __builtin_bit_cast(float, w << 16); }
__device__ __forceinline__ float bf_hi(unsigned w) { return __builtin_bit_cast(float, w & 0xffff0000u); }
__device__ __forceinline__ float sigmoid_f(float v) { return __builtin_amdgcn_rcpf(1.0f + __builtin_amdgcn_exp2f(v * -1.4426950408889634f)); }
__device__ __forceinline__ u32x4 pack8(const f32x4 a, const f32x4 b) { u32x4 w; w.x = cvt_pk_bf16(a[0], a[1]); w.y = cvt_pk_bf16(a[2], a[3]); w.z = cvt_pk_bf16(b[0], b[1]); w.w = cvt_pk_bf16(b[2], b[3]); return w; }

struct EpiPlain {
    static constexpr bool PERM = true, AFTER_DRAIN = false; static constexpr int NST = 16;
    bf16_t* O; int ldc;
    __device__ __forceinline__ void operator()(const f32x4 (&acc)[2][2][4][2], const Unit& u, int wr, int wc, int fr, int fq) const {
        const int row0 = u.pm * BM + wr * 64 + fr, col0 = u.pn * BM + wc * 32 + 8 * fq;
#pragma unroll
        for (int ai = 0; ai < 2; ++ai)
#pragma unroll
            for (int m = 0; m < 4; ++m) { bf16_t* rowp = O + (size_t)(row0 + ai * HALF + m * 16) * ldc + col0;
#pragma unroll
                for (int bj = 0; bj < 2; ++bj) *(u32x4*)(rowp + bj * HALF) = pack8(acc[ai][bj][m][0], acc[ai][bj][m][1]); }
    }
};
struct EpiSwiGLU {
    static constexpr bool PERM = true, AFTER_DRAIN = false; static constexpr int NST = 8;
    bf16_t* O; int ldc;
    __device__ __forceinline__ void operator()(const f32x4 (&acc)[2][2][4][2], const Unit& u, int wr, int wc, int fr, int fq) const {
        const int row0 = u.pm * BM + wr * 64 + fr, col0 = u.pn * HALF + wc * 32 + 8 * fq;
#pragma unroll
        for (int ai = 0; ai < 2; ++ai)
#pragma unroll
            for (int m = 0; m < 4; ++m) { bf16_t* rowp = O + (size_t)(row0 + ai * HALF + m * 16) * ldc + col0;
                f32x4 o[2];
#pragma unroll
                for (int n = 0; n < 2; ++n) { const f32x4 g = acc[ai][0][m][n], up = acc[ai][1][m][n];
#pragma unroll
                    for (int e = 0; e < 4; ++e) o[n][e] = g[e] * sigmoid_f(g[e]) * up[e]; }
                *(u32x4*)rowp = pack8(o[0], o[1]); }
    }
};
struct EpiMix {
    static constexpr bool PERM = true, AFTER_DRAIN = false; static constexpr int NST = 16;
    bf16_t *Q, *K, *V, *U, *G; const float* cosT; const float* sinT; const float* gbias;
    __device__ __forceinline__ void operator()(const f32x4 (&acc)[2][2][4][2], const Unit& u, int wr, int wc, int fr, int fq) const {
        const int pn = u.pn, row0 = u.pm * BM + wr * 64 + fr;
        if (pn < 8) {
            bf16_t* base = (pn < 4 ? Q : K) + ((pn & 3) * 4 + wc) * 64 + 8 * fq;
            const float qs = pn < 4 ? 0.18033688011112042f : 1.0f;
#pragma unroll
            for (int ai = 0; ai < 2; ++ai) {
                f32x4 cc[4][2], ss[4][2];
#pragma unroll
                for (int m = 0; m < 4; ++m) { const int row = row0 + ai * HALF + m * 16;
                    cc[m][0] = *(const f32x4*)(cosT + (size_t)row * 32 + 8 * fq); cc[m][1] = *(const f32x4*)(cosT + (size_t)row * 32 + 8 * fq + 4);
                    ss[m][0] = *(const f32x4*)(sinT + (size_t)row * 32 + 8 * fq); ss[m][1] = *(const f32x4*)(sinT + (size_t)row * 32 + 8 * fq + 4); }
#pragma unroll
                for (int m = 0; m < 4; ++m) { const int row = row0 + ai * HALF + m * 16;
                    const f32x4 c0 = cc[m][0], c1 = cc[m][1], s0 = ss[m][0], s1 = ss[m][1];
                    const f32x4 x1a = acc[ai][0][m][0], x1b = acc[ai][0][m][1], x2a = acc[ai][1][m][0], x2b = acc[ai][1][m][1];
                    const f32x4 o1a = (x1a * c0 - x2a * s0) * qs, o1b = (x1b * c1 - x2b * s1) * qs, o2a = (x2a * c0 + x1a * s0) * qs, o2b = (x2b * c1 + x1b * s1) * qs;
                    bf16_t* rowp = base + (size_t)row * 1024;
                    *(u32x4*)rowp = pack8(o1a, o1b); *(u32x4*)(rowp + 32) = pack8(o2a, o2b); }
            }
        } else if (pn < 16) {
            bf16_t* base = (pn < 12 ? V : U) + (pn & 3) * BM + wc * 32 + 8 * fq;
#pragma unroll
            for (int ai = 0; ai < 2; ++ai)
#pragma unroll
                for (int m = 0; m < 4; ++m) { bf16_t* rowp = base + (size_t)(row0 + ai * HALF + m * 16) * 1024;
#pragma unroll
                    for (int bj = 0; bj < 2; ++bj) *(u32x4*)(rowp + bj * HALF) = pack8(acc[ai][bj][m][0], acc[ai][bj][m][1]); }
        } else {
            const int col0 = (pn - 16) * BM + wc * 32 + 8 * fq;
            f32x4 bv[2][2];
#pragma unroll
            for (int bj = 0; bj < 2; ++bj)
#pragma unroll
                for (int n = 0; n < 2; ++n) bv[bj][n] = *(const f32x4*)(gbias + col0 + bj * HALF + 4 * n);
#pragma unroll
            for (int ai = 0; ai < 2; ++ai)
#pragma unroll
                for (int m = 0; m < 4; ++m) { bf16_t* rowp = G + (size_t)(row0 + ai * HALF + m * 16) * 4096 + col0;
#pragma unroll
                    for (int bj = 0; bj < 2; ++bj) { f32x4 o[2];
#pragma unroll
                        for (int n = 0; n < 2; ++n) { const f32x4 v = acc[ai][bj][m][n] + bv[bj][n];
#pragma unroll
                            for (int e = 0; e < 4; ++e) o[n][e] = sigmoid_f(v[e]); }
                        *(u32x4*)(rowp + bj * HALF) = pack8(o[0], o[1]); } }
        }
    }
};
struct EpiGate {
    static constexpr bool PERM = true, AFTER_DRAIN = false; static constexpr int NST = 16;
    const bf16_t* gate; const bf16_t* addend; bf16_t* O;
    __device__ __forceinline__ void operator()(const f32x4 (&acc)[2][2][4][2], const Unit& u, int wr, int wc, int fr, int fq) const {
        const int row0 = u.pm * BM + wr * 64 + fr, col0 = u.pn * BM + wc * 32 + 8 * fq;
#pragma unroll
        for (int ai = 0; ai < 2; ++ai) {
            u32x4 gw[4][2], tw[4][2];
#pragma unroll
            for (int m = 0; m < 4; ++m)
#pragma unroll
                for (int bj = 0; bj < 2; ++bj) { const size_t row = (size_t)(row0 + ai * HALF + m * 16);
                    gw[m][bj] = *(const u32x4*)(gate + row * 4096 + col0 + bj * HALF);
                    if (addend) tw[m][bj] = *(const u32x4*)(addend + row * 2048 + col0 + bj * HALF); }
#pragma unroll
            for (int m = 0; m < 4; ++m)
#pragma unroll
                for (int bj = 0; bj < 2; ++bj) { const size_t row = (size_t)(row0 + ai * HALF + m * 16); const u32x4 g = gw[m][bj];
                    f32x4 a = acc[ai][bj][m][0], b = acc[ai][bj][m][1];
                    a[0] *= bf_lo(g.x); a[1] *= bf_hi(g.x); a[2] *= bf_lo(g.y); a[3] *= bf_hi(g.y); b[0] *= bf_lo(g.z); b[1] *= bf_hi(g.z); b[2] *= bf_lo(g.w); b[3] *= bf_hi(g.w);
                    if (addend) { const u32x4 t = tw[m][bj];
                        a[0] += bf_lo(t.x); a[1] += bf_hi(t.x); a[2] += bf_lo(t.y); a[3] += bf_hi(t.y); b[0] += bf_lo(t.z); b[1] += bf_hi(t.z); b[2] += bf_lo(t.w); b[3] += bf_hi(t.w); }
                    *(u32x4*)(O + row * 2048 + col0 + bj * HALF) = pack8(a, b); }
        }
    }
};

template <class Epi, class Sched, bool ALIGN_EPI = false, bool SP2 = false>
__device__ __forceinline__ void gemm_phase(PG8_LAS unsigned char* lds, const Gemm g, const Sched& S, const Epi& E) {
    int tid = threadIdx.x; asm volatile("" : "+v"(tid));
    const int wid = __builtin_amdgcn_readfirstlane(tid >> 6), lane = tid & 63, wr = wid >> 2, wc = wid & 3, fr = lane & 15, fq = lane >> 4;
    const int K = g.K, nt = K / BK;
    unsigned voffA[2], voffB[2];
#pragma unroll
    for (int i = 0; i < 2; ++i) { int R, C; stage_rc(tid * 16 + i * 8192, R, C); const int Rb = Epi::PERM ? ((R & ~31) + perm32(R & 31)) : R;
        voffA[i] = (unsigned)(R * K + C) * 2u; voffB[i] = (unsigned)(Rb * K + C) * 2u; }
    const size_t kstep = (size_t)(BK * 2);
    const size_t hstep = (size_t)HALF * K * 2;
    const size_t tstep = 2 * hstep;
    const unsigned ldsw = (unsigned)wid * 1024u;
    const unsigned ldsbase = (unsigned)(size_t)lds + ldsw;
    const int aoff = lds_byte(wr * 64 + fr, fq * 8), boff = lds_byte(wc * 32 + fr, fq * 8);
#define PG8_SA(b, h) (((b) * 2 + (h)) * HTB)
#define PG8_SB(b, h) ((4 + (b) * 2 + (h)) * HTB)
#define PG8_STAGE(bufoff, gbase, voff) do { _Pragma("unroll") for (int _i = 0; _i < 2; ++_i) \
        asm volatile("s_mov_b32 m0, %2\n\ts_nop 0\n\tglobal_load_lds_dwordx4 %0, %1" : : "v"((voff)[_i]), "s"((const char*)(gbase)), \
                     "s"((unsigned)__builtin_amdgcn_readfirstlane((int)(ldsbase + (unsigned)((bufoff) + _i * 8192)))) : "memory", "m0"); } while (0)
#define PG8_LDA(dst, b, h) do { _Pragma("unroll") for (int m = 0; m < 4; ++m) _Pragma("unroll") for (int k = 0; k < 2; ++k) dst[m][k] = *(const PG8_LAS bf16x8*)(lds + PG8_SA(b, h) + aoff + m * 2048 + k * 1024); } while (0)
#define PG8_LDB(dst, b, h) do { _Pragma("unroll") for (int n = 0; n < 2; ++n) _Pragma("unroll") for (int k = 0; k < 2; ++k) dst[n][k] = *(const PG8_LAS bf16x8*)(lds + PG8_SB(b, h) + boff + n * 2048 + k * 1024); } while (0)
#define PG8_MMA(ai, bj, At, Bt) do { __builtin_amdgcn_s_setprio(1); _Pragma("unroll") for (int m = 0; m < 4; ++m) _Pragma("unroll") for (int n = 0; n < 2; ++n) _Pragma("unroll") for (int k = 0; k < 2; ++k) \
        acc[ai][bj][m][n] = __builtin_amdgcn_mfma_f32_16x16x32_bf16(Bt[n][k], At[m][k], acc[ai][bj][m][n], 0, 0, 0); __builtin_amdgcn_s_setprio(0); } while (0)
#define PG8_WAIT_V(n) asm volatile("s_waitcnt vmcnt(" #n ")" ::: "memory")
#define PG8_WAIT_L(n) asm volatile("s_waitcnt lgkmcnt(" #n ")" ::: "memory")
#define PG8_BAR __builtin_amdgcn_s_barrier()
#define PG8_SCHED __builtin_amdgcn_sched_barrier(0)
    Unit cur, nxt; int ui = 0;
    if (!S.next(0, cur)) return;
    f32x4 acc[2][2][4][2];
#pragma unroll
    for (int a = 0; a < 2; ++a)
#pragma unroll
        for (int b = 0; b < 2; ++b)
#pragma unroll
            for (int m = 0; m < 4; ++m)
#pragma unroll
                for (int n = 0; n < 2; ++n) acc[a][b][m][n] = (f32x4){0.f, 0.f, 0.f, 0.f};
    bf16x8 At[4][2], B0[2][2], B1[2][2];
    const char* cA = (const char*)g.A + (size_t)cur.pm * tstep; const char* cB = (const char*)g.Bt + (size_t)cur.pn * tstep;
    S.a_ready(cur);
    if constexpr (SP2) {
        PG8_STAGE(PG8_SB(0, 0), cB, voffB); PG8_STAGE(PG8_SB(0, 1), cB + hstep, voffB); PG8_STAGE(PG8_SA(0, 0), cA, voffA); PG8_STAGE(PG8_SA(0, 1), cA + hstep, voffA);
        if (wr == 1) PG8_BAR;
        PG8_WAIT_V(2); PG8_BAR;
        PG8_STAGE(PG8_SB(1, 0), cB + kstep, voffB); PG8_STAGE(PG8_SA(1, 0), cA + kstep, voffA); PG8_STAGE(PG8_SB(1, 1), cB + hstep + kstep, voffB);
        PG8_WAIT_V(6); PG8_BAR;
    } else {
        PG8_STAGE(PG8_SB(0, 0), cB, voffB); PG8_STAGE(PG8_SA(0, 0), cA, voffA); PG8_STAGE(PG8_SB(0, 1), cB + hstep, voffB); PG8_STAGE(PG8_SA(0, 1), cA + hstep, voffA);
        if (wr == 1) PG8_BAR;
        PG8_WAIT_V(4); PG8_BAR;
        PG8_STAGE(PG8_SB(1, 0), cB + kstep, voffB); PG8_STAGE(PG8_SA(1, 0), cA + kstep, voffA); PG8_STAGE(PG8_SB(1, 1), cB + hstep + kstep, voffB);
        PG8_WAIT_V(6); PG8_BAR;
    }
    for (;;) {
        const bool has_next = S.next(ui + 1, nxt);
        const char* nA = has_next ? (const char*)g.A + (size_t)nxt.pm * tstep : cA; const char* nB = has_next ? (const char*)g.Bt + (size_t)nxt.pn * tstep : cB;
        for (int t = 0; t < nt; t += 2) {
            const bool last = (t == nt - 2);
            const char* a1 = cA + (size_t)(t + 1) * kstep;
            const char* a2 = last ? nA : cA + (size_t)(t + 2) * kstep; const char* b2 = last ? nB : cB + (size_t)(t + 2) * kstep;
            const char* a3 = a2 + kstep; const char* b3 = b2 + kstep;
            if (last && has_next) S.a_ready(nxt);
            if constexpr (SP2) {
            PG8_LDB(B0, 0, 0); PG8_LDB(B1, 0, 1); PG8_SCHED; PG8_LDA(At, 0, 0); PG8_STAGE(PG8_SA(1, 1), a1 + hstep, voffA);
            PG8_WAIT_V(8); PG8_WAIT_L(0); PG8_BAR; PG8_MMA(0, 0, At, B0); PG8_MMA(0, 1, At, B1); PG8_BAR; PG8_SCHED;
            PG8_LDA(At, 0, 1); PG8_STAGE(PG8_SB(0, 0), b2, voffB); PG8_STAGE(PG8_SB(0, 1), b2 + hstep, voffB); PG8_STAGE(PG8_SA(0, 0), a2, voffA);
            PG8_WAIT_V(8); PG8_WAIT_L(0); PG8_BAR; PG8_MMA(1, 0, At, B0); PG8_MMA(1, 1, At, B1); PG8_BAR; PG8_SCHED;
            PG8_LDB(B0, 1, 0); PG8_LDB(B1, 1, 1); PG8_SCHED; PG8_LDA(At, 1, 0); PG8_STAGE(PG8_SA(0, 1), a2 + hstep, voffA);
            PG8_WAIT_V(8); PG8_WAIT_L(0); PG8_BAR; PG8_MMA(0, 0, At, B0); PG8_MMA(0, 1, At, B1); PG8_BAR; PG8_SCHED;
            PG8_LDA(At, 1, 1); PG8_STAGE(PG8_SB(1, 0), b3, voffB); PG8_STAGE(PG8_SB(1, 1), b3 + hstep, voffB); PG8_STAGE(PG8_SA(1, 0), a3, voffA);
            PG8_WAIT_V(8); PG8_WAIT_L(0); PG8_BAR; PG8_MMA(1, 0, At, B0); PG8_MMA(1, 1, At, B1); PG8_BAR; PG8_SCHED;
            } else {
            PG8_LDB(B0, 0, 0); PG8_SCHED; PG8_LDA(At, 0, 0); PG8_STAGE(PG8_SA(1, 1), a1 + hstep, voffA);
            PG8_WAIT_L(8); PG8_BAR; PG8_WAIT_L(0); PG8_MMA(0, 0, At, B0); PG8_BAR; PG8_SCHED;
            PG8_LDB(B1, 0, 1); PG8_STAGE(PG8_SB(0, 0), b2, voffB);
            PG8_BAR; PG8_WAIT_L(0); PG8_MMA(0, 1, At, B1); PG8_BAR;
            PG8_LDA(At, 0, 1); PG8_STAGE(PG8_SA(0, 0), a2, voffA);
            PG8_BAR; PG8_WAIT_L(0); PG8_MMA(1, 0, At, B0); PG8_BAR; PG8_SCHED;
            PG8_STAGE(PG8_SB(0, 1), b2 + hstep, voffB);
            PG8_WAIT_V(6); PG8_BAR; PG8_MMA(1, 1, At, B1); PG8_BAR;
            PG8_LDB(B0, 1, 0); PG8_SCHED; PG8_LDA(At, 1, 0); PG8_STAGE(PG8_SA(0, 1), a2 + hstep, voffA);
            PG8_WAIT_L(8); PG8_BAR; PG8_WAIT_L(0); PG8_MMA(0, 0, At, B0); PG8_BAR; PG8_SCHED;
            PG8_LDB(B1, 1, 1); PG8_STAGE(PG8_SB(1, 0), b3, voffB);
            PG8_BAR; PG8_WAIT_L(0); PG8_MMA(0, 1, At, B1); PG8_BAR;
            PG8_LDA(At, 1, 1); PG8_STAGE(PG8_SA(1, 0), a3, voffA);
            PG8_BAR; PG8_WAIT_L(0); PG8_MMA(1, 0, At, B0); PG8_BAR; PG8_SCHED;
            PG8_STAGE(PG8_SB(1, 1), b3 + hstep, voffB);
            PG8_WAIT_V(6); PG8_BAR; PG8_MMA(1, 1, At, B1); PG8_BAR;
            }
        }
        if constexpr (ALIGN_EPI) { if (wr == 0) PG8_BAR; }
        if constexpr (!Epi::AFTER_DRAIN) { E(acc, cur, wr, wc, fr, fq); S.done(cur); }
        if (!has_next) break;
#pragma unroll
        for (int a = 0; a < 2; ++a)
#pragma unroll
            for (int b = 0; b < 2; ++b)
#pragma unroll
                for (int m = 0; m < 4; ++m)
#pragma unroll
                    for (int n = 0; n < 2; ++n) acc[a][b][m][n] = (f32x4){0.f, 0.f, 0.f, 0.f};
        cur = nxt; cA = nA; cB = nB; ++ui;
        if constexpr (ALIGN_EPI) { if (wr == 1) PG8_BAR; }
    }
    PG8_WAIT_V(0);
    if constexpr (!ALIGN_EPI) { if (wr == 0) PG8_BAR; }
    PG8_BAR;
    if constexpr (Epi::AFTER_DRAIN) { E.fused(acc, cur, wr, wc, fr, fq, lds, wid, lane); S.done(cur); }
#undef PG8_SA
#undef PG8_SB
#undef PG8_STAGE
#undef PG8_LDA
#undef PG8_LDB
#undef PG8_MMA
#undef PG8_WAIT_V
#undef PG8_WAIT_L
#undef PG8_BAR
#undef PG8_SCHED
}
}
namespace dattn {
#define DA_LAS __attribute__((address_space(3)))
typedef unsigned short bf16_t;
using bf16x8 = __attribute__((ext_vector_type(8))) short;
using s16x4  = __attribute__((ext_vector_type(4))) short;
using f32x16 = __attribute__((ext_vector_type(16))) float;
using u32x4  = __attribute__((ext_vector_type(4))) unsigned;
constexpr int NW = 8, QBLK = 32, KVBLK = 64, PITCH = 1024, LDO = 2048;
constexpr float SCALE = 0.125f;
constexpr float THR = 8.f;
constexpr int SHM_V = KVBLK * 128 * 2, SHM_K = KVBLK * 64 * 2;
constexpr int NSLOT = 3, OFF_V = 0, OFF_K = NSLOT * SHM_V, OFF_WS = NSLOT * (SHM_V + SHM_K), LDS_BYTES = OFF_WS + NW * 64 * 4;
#define DA_KSWZ(row, colB) ((row) * 128 + ((colB) ^ ((((row) >> 1) & 7) << 4)))
#define DA_SBAR() __builtin_amdgcn_sched_barrier(0)
__device__ __forceinline__ int crow(int r, int hi) { return (r & 3) + 8 * (r >> 2) + 4 * hi; }
typedef float cvt_f32x2 __attribute__((ext_vector_type(2))); typedef __bf16 cvt_bf16x2 __attribute__((ext_vector_type(2)));
__device__ __forceinline__ unsigned cvtpk(float lo, float hi) { const cvt_f32x2 v = {lo, hi}; return __builtin_bit_cast(unsigned, __builtin_convertvector(v, cvt_bf16x2)); }
#ifdef DA_THR2_TEST
constexpr float THR2 = DA_THR2_TEST;
#else
constexpr float THR2 = THR * 1.4426950408889634f;
#endif
__device__ __forceinline__ void glds16s(const void* sbase, unsigned voff, unsigned lds_dst) { unsigned keep;
  asm volatile("s_mov_b32 %0, m0\n\ts_mov_b32 m0, %3\n\ts_nop 0\n\tglobal_load_lds_dwordx4 %1, %2\n\ts_mov_b32 m0, %0" : "=&s"(keep) : "v"(voff), "s"(sbase), "s"(lds_dst) : "memory"); }
#define DA_WAIT_BAR(N) do { __builtin_amdgcn_sched_barrier(0); asm volatile("s_waitcnt vmcnt(" #N ") lgkmcnt(0)\n\ts_barrier" ::: "memory"); __builtin_amdgcn_sched_barrier(0); } while (0)
__device__ __forceinline__ int v_st(int k, int c) { const int kk = (k & ~0xC) | ((k & 4) << 1) | ((k & 8) >> 1); return ((kk >> 3) * 4 + (c >> 5)) * 512 + ((kk & 7) * 32 + (c & 31)) * 2; }
__device__ __forceinline__ int v_rd_base(int lane) { return ((lane & 3) << 3) | (((lane >> 2) & 3) << 6) | (((lane >> 4) & 1) << 5) | (((lane >> 5) & 1) << 8); }
constexpr int v_rd_off(int d0, int ks, int half) { return d0 * 512 + ks * 4096 + half * 2048; }
template <int OFF> __device__ __forceinline__ s16x4 tr_read(int vb) {
  s16x4 r; asm volatile("ds_read_b64_tr_b16 %0, %1 offset:%2" : "=&v"(r) : "v"(vb), "i"(OFF) : "memory"); return r;
}
#define DA_PK(L, H) (bf16x8){L[0], L[1], L[2], L[3], H[0], H[1], H[2], H[3]}
#define DA_LGKM(N) do { asm volatile("s_waitcnt lgkmcnt(" #N ")" ::: "memory"); DA_SBAR(); } while (0)
template <int OFF> __device__ __forceinline__ bf16x8 lds_rd128(int a) { bf16x8 r; asm volatile("ds_read_b128 %0, %1 offset:%2" : "=&v"(r) : "v"(a), "i"(OFF) : "memory"); return r; }
typedef float f32x4a __attribute__((ext_vector_type(4)));
typedef unsigned v2u16 __attribute__((ext_vector_type(2)));
struct KPre16 { bf16x8 k[4][2]; };
__device__ __forceinline__ void prefetch_k16(KPre16& P, int kbase, int fr, int fq) {
  const int sw = ((fr >> 1) & 7) << 4, a0 = kbase + fr * 128 + ((16 * fq) ^ sw), a1 = kbase + fr * 128 + ((64 + 16 * fq) ^ sw);
  P.k[0][0] = lds_rd128<0>(a0); P.k[1][0] = lds_rd128<2048>(a0); P.k[2][0] = lds_rd128<4096>(a0); P.k[3][0] = lds_rd128<6144>(a0);
  P.k[0][1] = lds_rd128<0>(a1); P.k[1][1] = lds_rd128<2048>(a1); P.k[2][1] = lds_rd128<4096>(a1); P.k[3][1] = lds_rd128<6144>(a1);
}
template <int S> __device__ __forceinline__ void prefetch_k16s(KPre16& P, int a0, int a1) {
  P.k[0][0] = lds_rd128<S * SHM_K + 0>(a0); P.k[1][0] = lds_rd128<S * SHM_K + 2048>(a0); P.k[2][0] = lds_rd128<S * SHM_K + 4096>(a0); P.k[3][0] = lds_rd128<S * SHM_K + 6144>(a0);
  P.k[0][1] = lds_rd128<S * SHM_K + 0>(a1); P.k[1][1] = lds_rd128<S * SHM_K + 2048>(a1); P.k[2][1] = lds_rd128<S * SHM_K + 4096>(a1); P.k[3][1] = lds_rd128<S * SHM_K + 6144>(a1);
}
__device__ __forceinline__ float xfq_max(float v) {
  auto r = __builtin_amdgcn_permlane16_swap(__float_as_uint(v), __float_as_uint(v), false, false); v = fmaxf(__uint_as_float(r[0]), __uint_as_float(r[1]));
  auto q = __builtin_amdgcn_permlane32_swap(__float_as_uint(v), __float_as_uint(v), false, false); return fmaxf(__uint_as_float(q[0]), __uint_as_float(q[1]));
}
__device__ __forceinline__ float xfq_sum(float v) {
  auto r = __builtin_amdgcn_permlane16_swap(__float_as_uint(v), __float_as_uint(v), false, false); v = __uint_as_float(r[0]) + __uint_as_float(r[1]);
  auto q = __builtin_amdgcn_permlane32_swap(__float_as_uint(v), __float_as_uint(v), false, false); return __uint_as_float(q[0]) + __uint_as_float(q[1]);
}
template <bool SAFE>
__device__ __forceinline__ void softmax16(f32x4a (&s)[2][4], float (&mhat)[2], bool first, float (&alpha)[2], bf16x8 (&pa)[2][2]) {
  if (SAFE) {
    float lm[2];
#pragma unroll
    for (int qb = 0; qb < 2; ++qb) { float m = fmaxf(s[qb][0][0], s[qb][0][1]);
#pragma unroll
      for (int kb = 0; kb < 4; ++kb)
#pragma unroll
        for (int j = (kb == 0 ? 2 : 0); j < 4; ++j) m = fmaxf(m, s[qb][kb][j]);
      lm[qb] = m; alpha[qb] = 1.f; }
    if (__builtin_expect(first || __any(mhat[0] != 0.f || mhat[1] != 0.f || fmaxf(lm[0], lm[1]) > THR2), 0)) {
#pragma unroll
      for (int qb = 0; qb < 2; ++qb) { const float ex = xfq_max(lm[qb]) - mhat[qb]; float dl = 0.f;
        if (first) { if (ex > THR2 || ex < -THR2) dl = ex; } else if (ex > THR2) dl = ex;
        mhat[qb] += dl;
#pragma unroll
        for (int kb = 0; kb < 4; ++kb) s[qb][kb] -= mhat[qb];
        alpha[qb] = first ? 1.f : __builtin_amdgcn_exp2f(-dl); }
    }
  }
#pragma unroll
  for (int qb = 0; qb < 2; ++qb) {
#pragma unroll
    for (int kb = 0; kb < 4; ++kb)
#pragma unroll
      for (int j = 0; j < 4; ++j) s[qb][kb][j] = __builtin_amdgcn_exp2f(s[qb][kb][j]);
#pragma unroll
    for (int g = 0; g < 2; ++g) { const u32x4 w = {cvtpk(s[qb][2 * g][0], s[qb][2 * g][1]), cvtpk(s[qb][2 * g][2], s[qb][2 * g][3]), cvtpk(s[qb][2 * g + 1][0], s[qb][2 * g + 1][1]), cvtpk(s[qb][2 * g + 1][2], s[qb][2 * g + 1][3])};
      pa[qb][g] = __builtin_bit_cast(bf16x8, w); }
  }
}
#define DA_W16(N) do { asm volatile("s_waitcnt lgkmcnt(" #N ")" ::: "memory"); DA_SBAR(); } while (0)
#define DA_RF16(J) do { vl[(J) & 7] = tr_read<VS * SHM_V + 8192 * ((J) >> 3)>(va[(J) & 7]); vh[(J) & 7] = tr_read<VS * SHM_V + 8192 * ((J) >> 3) + 4096>(va[(J) & 7]); DA_SBAR(); } while (0)
#define DA_PV16(J) do { const bf16x8 vf_ = DA_PK(vl[(J) & 7], vh[(J) & 7]); \
    o[0][(J) & 7] = __builtin_amdgcn_mfma_f32_16x16x32_bf16(vf_, pa[0][(J) >> 3], o[0][(J) & 7], 0, 0, 0); o[1][(J) & 7] = __builtin_amdgcn_mfma_f32_16x16x32_bf16(vf_, pa[1][(J) >> 3], o[1][(J) & 7], 0, 0, 0); } while (0)
struct NoDma16 { __device__ __forceinline__ void operator()() const {} };
template <bool HAS_QK, bool HAS_PV, int VS, class DMA = NoDma16>
__device__ __forceinline__ void m_seg16(f32x4a (&s)[2][4], KPre16& P, const bf16x8 (&qf)[2][2], f32x4a (&o)[2][8], f32x4a (&lacc)[2], const bf16x8& ones, const int (&va)[8], const bf16x8 (&pa)[2][2], DMA dma = NoDma16()) {
  s16x4 vl[8], vh[8];
  __builtin_amdgcn_s_setprio(2);
  if (HAS_QK) {
    const f32x4a z = {0.f, 0.f, 0.f, 0.f};
#define DA_QK16(KB, KS) do { s[0][KB] = __builtin_amdgcn_mfma_f32_16x16x32_bf16(P.k[KB][KS], qf[0][KS], (KS) == 0 ? z : s[0][KB], 0, 0, 0); \
    s[1][KB] = __builtin_amdgcn_mfma_f32_16x16x32_bf16(P.k[KB][KS], qf[1][KS], (KS) == 0 ? z : s[1][KB], 0, 0, 0); } while (0)
    DA_QK16(0, 0); dma(); DA_SBAR(); if (HAS_PV) DA_RF16(0); DA_QK16(1, 0); if (HAS_PV) DA_RF16(1); DA_QK16(2, 0); if (HAS_PV) DA_RF16(2); DA_QK16(3, 0); if (HAS_PV) DA_RF16(3);
    DA_QK16(0, 1); if (HAS_PV) DA_RF16(4); DA_QK16(1, 1); if (HAS_PV) DA_RF16(5); DA_QK16(2, 1); if (HAS_PV) DA_RF16(6); DA_QK16(3, 1); DA_SBAR();
#undef DA_QK16
  } else if (HAS_PV) { DA_RF16(0); DA_RF16(1); DA_RF16(2); DA_RF16(3); DA_RF16(4); DA_RF16(5); DA_RF16(6); }
  if (HAS_PV) {
    lacc[0] = __builtin_amdgcn_mfma_f32_16x16x32_bf16(ones, pa[0][0], lacc[0], 0, 0, 0); lacc[1] = __builtin_amdgcn_mfma_f32_16x16x32_bf16(ones, pa[1][0], lacc[1], 0, 0, 0);
    lacc[0] = __builtin_amdgcn_mfma_f32_16x16x32_bf16(ones, pa[0][1], lacc[0], 0, 0, 0); lacc[1] = __builtin_amdgcn_mfma_f32_16x16x32_bf16(ones, pa[1][1], lacc[1], 0, 0, 0);
    DA_SBAR();
    DA_W16(10); DA_PV16(0); DA_RF16(7);   DA_PV16(1); DA_RF16(8);   DA_W16(10); DA_PV16(2); DA_RF16(9);   DA_PV16(3); DA_RF16(10);
    DA_W16(10); DA_PV16(4); DA_RF16(11);  DA_PV16(5); DA_RF16(12);  DA_W16(10); DA_PV16(6); DA_RF16(13);  DA_PV16(7); DA_RF16(14);
    DA_W16(10); DA_PV16(8); DA_RF16(15);  DA_PV16(9); DA_SBAR();    DA_W16(8); DA_PV16(10); DA_SBAR();   DA_PV16(11); DA_SBAR();
    DA_W16(4); DA_PV16(12); DA_SBAR();    DA_PV16(13); DA_SBAR();    DA_W16(0); DA_PV16(14); DA_SBAR();    DA_PV16(15);
    asm volatile("" : "+v"(o[0][0]), "+v"(o[0][1]), "+v"(o[0][2]), "+v"(o[0][3]), "+v"(o[0][4]), "+v"(o[0][5]), "+v"(o[0][6]), "+v"(o[0][7]));
    asm volatile("" : "+v"(o[1][0]), "+v"(o[1][1]), "+v"(o[1][2]), "+v"(o[1][3]), "+v"(o[1][4]), "+v"(o[1][5]), "+v"(o[1][6]), "+v"(o[1][7]));
    asm volatile("" : "+v"(lacc[0]), "+v"(lacc[1]));
  }
  __builtin_amdgcn_s_setprio(0);
}
#undef DA_W16
#undef DA_RF16
#undef DA_PV16
template <bool SAFE>
__device__ __forceinline__ bool attn_unit16_body(const bf16_t* __restrict__ Qb, const bf16_t* __restrict__ Kh, const bf16_t* __restrict__ Vh, float* Ob, int seq, DA_LAS char* lds,
                                            bool second, float lam, float oscale, const float* __restrict__ subg, bf16_t* __restrict__ AOb) {
  int tid = threadIdx.x; asm volatile("" : "+v"(tid));
  const int wid = __builtin_amdgcn_readfirstlane(tid >> 6), lane = tid & 63, fr = lane & 15, fq = lane >> 4;
  const bool grpA = wid < 4;
  const unsigned lds0 = (unsigned)(size_t)lds;
  const int krow = 8 * wid + (lane >> 3), kpiece = (lane & 7) ^ ((krow >> 1) & 7);
  const unsigned ksrc = (unsigned)(krow * PITCH + kpiece * 8) * 2u;
  const int vr0 = 8 * wid + (lane >> 4), vr1 = vr0 + 4;
  const unsigned vsrc0 = (unsigned)(vr0 * PITCH + (((lane & 15) ^ (((vr0 & 3) << 2) | ((vr0 >> 2) & 3))) * 8)) * 2u;
  const unsigned vsrc1 = (unsigned)(vr1 * PITCH + (((lane & 15) ^ (((vr1 & 3) << 2) | ((vr1 >> 2) & 3))) * 8)) * 2u;
  const unsigned kdst = lds0 + OFF_K + wid * 1024, vdst = lds0 + OFF_V + wid * 2048;
#define DA_DMA_K(t, slot) glds16s(Kh + (long)(t) * KVBLK * PITCH, ksrc, (unsigned)__builtin_amdgcn_readfirstlane(kdst + (slot) * SHM_K))
#define DA_DMA_V(t, slot) do { glds16s(Vh + (long)(t) * KVBLK * PITCH, vsrc0, (unsigned)__builtin_amdgcn_readfirstlane(vdst + (slot) * SHM_V)); \
    glds16s(Vh + (long)(t) * KVBLK * PITCH, vsrc1, (unsigned)__builtin_amdgcn_readfirstlane(vdst + (slot) * SHM_V + 1024)); } while (0)
  const int NT = seq / KVBLK;
  DA_DMA_K(0, 0); DA_DMA_K(1, 1); DA_DMA_V(0, 0);
  float mhat[2] = {0.f, 0.f}, alpha[2] = {1.f, 1.f};
  f32x4a o[2][8] = {}; f32x4a lacc[2] = {}; f32x4a s[2][4] = {}; bf16x8 qf[2][2]; bf16x8 pa[2][2]; KPre16 P;
  bf16x8 ones; { const u32x4 w1 = {0x3f803f80u, 0x3f803f80u, 0x3f803f80u, 0x3f803f80u}; ones = __builtin_bit_cast(bf16x8, w1); asm volatile("" : "+v"(ones)); }
#pragma unroll
  for (int qb = 0; qb < 2; ++qb)
#pragma unroll
    for (int ks = 0; ks < 2; ++ks) qf[qb][ks] = *(const bf16x8*)(Qb + (long)(wid * QBLK + 16 * qb + fr) * PITCH + 32 * ks + 8 * fq);
  int va[8];
  { const int e = fr >> 2, pp = fr & 3, x = (e << 2) | fq;
#pragma unroll
    for (int db = 0; db < 8; ++db) va[db] = (int)(lds0 + OFF_V) + 256 * (4 * fq + e) + 16 * ((2 * db + (pp >> 1)) ^ x) + 8 * (pp & 1); }
  const int ksw = ((fr >> 1) & 7) << 4, ka0 = (int)(lds0 + OFF_K) + fr * 128 + ((16 * fq) ^ ksw), ka1 = (int)(lds0 + OFF_K) + fr * 128 + ((64 + 16 * fq) ^ ksw);
#define DA_PREF_K(slot) prefetch_k16s<slot>(P, ka0, ka1)
#define DA_RESC16() do { if (__any(alpha[0] < 1.f || alpha[1] < 1.f)) { _Pragma("unroll") for (int qb = 0; qb < 2; ++qb) { lacc[qb] *= alpha[qb]; _Pragma("unroll") for (int db = 0; db < 8; ++db) o[qb][db] *= alpha[qb]; } } } while (0)
#define DA_SEG_V(first) do { softmax16<SAFE>(s, mhat, (first), alpha, pa); asm volatile("" : "+v"(pa[0][0]), "+v"(pa[0][1]), "+v"(pa[1][0]), "+v"(pa[1][1])); if (SAFE) DA_RESC16(); } while (0)
  asm volatile("s_waitcnt vmcnt(3)" ::: "memory");
  DA_WAIT_BAR(3);
  int t = 1;
  if (grpA) {
    DA_DMA_K(2, 2); DA_DMA_V(1, 1);
    DA_PREF_K(0); DA_LGKM(0);
    m_seg16<true, false, 0>(s, P, qf, o, lacc, ones, va, pa);
    DA_WAIT_BAR(3);
    DA_PREF_K(1);
    DA_SEG_V(true);
    DA_WAIT_BAR(3);
    m_seg16<true, true, 0>(s, P, qf, o, lacc, ones, va, pa, [&]() { DA_DMA_K(3, 0); });
    DA_WAIT_BAR(3);
#define DA_BODY_A(T, M0, M1, M2) do { \
      DA_PREF_K(M1); \
      DA_SEG_V(false); \
      DA_DMA_V((T) + 1, M1); \
      if ((T) + 2 < NT) DA_WAIT_BAR(3); else DA_WAIT_BAR(2); \
      m_seg16<true, true, M0>(s, P, qf, o, lacc, ones, va, pa, [&]() { if ((T) + 3 < NT) DA_DMA_K((T) + 3, M0); }); \
      if ((T) + 3 < NT) DA_WAIT_BAR(3); else DA_WAIT_BAR(0); } while (0)
#pragma unroll 1
    for (; t + 3 < NT; t += 3) { DA_BODY_A(t, 1, 2, 0); DA_BODY_A(t + 1, 2, 0, 1); DA_BODY_A(t + 2, 0, 1, 2); }
    if (t + 1 < NT) { DA_BODY_A(t, 1, 2, 0); ++t; }
    if (t + 1 < NT) { DA_BODY_A(t, 2, 0, 1); ++t; }
#undef DA_BODY_A
    DA_SEG_V(false);
    DA_WAIT_BAR(0);
  } else {
    DA_DMA_K(2, 2); DA_DMA_V(1, 1);
    DA_PREF_K(0);
    DA_WAIT_BAR(3);
    m_seg16<true, false, 0>(s, P, qf, o, lacc, ones, va, pa);
    DA_WAIT_BAR(3);
    DA_PREF_K(1);
    __builtin_amdgcn_s_setprio(1); DA_SEG_V(true); __builtin_amdgcn_s_setprio(0);
    DA_DMA_V(2, 2);
    DA_WAIT_BAR(2);
#define DA_BODY_B(T, M0, M1, M2) do { \
      m_seg16<true, true, M2>(s, P, qf, o, lacc, ones, va, pa, [&]() { if ((T) + 2 < NT) DA_DMA_K((T) + 2, M2); }); \
      DA_WAIT_BAR(3); \
      DA_PREF_K(M1); \
      __builtin_amdgcn_s_setprio(1); DA_SEG_V(false); __builtin_amdgcn_s_setprio(0); \
      if ((T) + 2 < NT) { DA_DMA_V((T) + 2, M2); DA_WAIT_BAR(2); } else DA_WAIT_BAR(0); } while (0)
#pragma unroll 1
    for (; t + 3 < NT; t += 3) { DA_BODY_B(t, 1, 2, 0); DA_BODY_B(t + 1, 2, 0, 1); DA_BODY_B(t + 2, 0, 1, 2); }
    if (t + 1 < NT) { DA_BODY_B(t, 1, 2, 0); ++t; }
    if (t + 1 < NT) { DA_BODY_B(t, 2, 0, 1); ++t; }
#undef DA_BODY_B
    if ((NT - 2) % 3 == 0) m_seg16<true, true, 0>(s, P, qf, o, lacc, ones, va, pa); else if ((NT - 2) % 3 == 1) m_seg16<true, true, 1>(s, P, qf, o, lacc, ones, va, pa); else m_seg16<true, true, 2>(s, P, qf, o, lacc, ones, va, pa);
    DA_WAIT_BAR(0);
    __builtin_amdgcn_s_setprio(1); DA_SEG_V(false); __builtin_amdgcn_s_setprio(0);
  }
  if ((NT - 1) % 3 == 0) m_seg16<false, true, 0>(s, P, qf, o, lacc, ones, va, pa); else if ((NT - 1) % 3 == 1) m_seg16<false, true, 1>(s, P, qf, o, lacc, ones, va, pa); else m_seg16<false, true, 2>(s, P, qf, o, lacc, ones, va, pa);
  const float lsum[2] = {lacc[0][0], lacc[1][0]};
  int te = threadIdx.x; asm volatile("" : "+v"(te));
  const int wid_e = __builtin_amdgcn_readfirstlane(te >> 6), lane_e = te & 63, fr_e = lane_e & 15, fq_e = lane_e >> 4;
  if (!SAFE) {
    float om = 0.f;
#pragma unroll
    for (int qb = 0; qb < 2; ++qb)
#pragma unroll
      for (int db = 0; db < 8; ++db) om = fmaxf(fmaxf(om, fmaxf(fabsf(o[qb][db][0]), fabsf(o[qb][db][1]))), fmaxf(fabsf(o[qb][db][2]), fabsf(o[qb][db][3])));
#ifdef DA_TEST_FALLBACK
    const bool good = false;
#else
    const bool good = lsum[0] > 0x1p-100f && lsum[0] < 0x1p100f && lsum[1] > 0x1p-100f && lsum[1] < 0x1p100f && om < 0x1p120f;
#endif
    DA_LAS int* fl = (DA_LAS int*)(lds + OFF_WS);
    if (lane_e == 0) fl[wid_e] = __any(!good) ? 1 : 0;
    DA_WAIT_BAR(0);
    int bad = 0;
#pragma unroll
    for (int w = 0; w < NW; ++w) bad |= fl[w];
    if (__builtin_amdgcn_readfirstlane(bad)) { DA_WAIT_BAR(0); return false; }
  }
#pragma unroll
  for (int qb = 0; qb < 2; ++qb) {
    const float rl = __builtin_amdgcn_rcpf(lsum[qb]);
    const long row = wid_e * QBLK + 16 * qb + fr_e;
    if (!second) {
#pragma unroll
      for (int db = 0; db < 8; ++db) *(f32x4a*)(Ob + row * LDO + 16 * db + 4 * fq_e) = o[qb][db] * rl;
    } else {
      f32x4a d[8]; float ss = 0.f;
#pragma unroll
      for (int db = 0; db < 8; ++db) d[db] = *(const f32x4a*)(Ob + row * LDO + 16 * db + 4 * fq_e);
#pragma unroll
      for (int db = 0; db < 8; ++db) { d[db] = d[db] - (o[qb][db] * rl) * lam; ss += (d[db][0] * d[db][0] + d[db][1] * d[db][1]) + (d[db][2] * d[db][2] + d[db][3] * d[db][3]); }
      const float rs = oscale / sqrtf(xfq_sum(ss) * (1.0f / 128.0f) + 1e-5f);
#pragma unroll
      for (int db = 0; db < 8; ++db) { const f32x4a g = *(const f32x4a*)(subg + 16 * db + 4 * fq_e); const f32x4a v = d[db] * g * rs;
        const v2u16 w = {cvtpk(v[0], v[1]), cvtpk(v[2], v[3])}; *(v2u16*)(AOb + row * 1024 + 16 * db + 4 * fq_e) = w; }
    }
  }
  DA_WAIT_BAR(0);
  return true;
#undef DA_DMA_K
#undef DA_DMA_V
#undef DA_PREF_K
#undef DA_RESC16
#undef DA_SEG_V
}
__device__ __forceinline__ void attn_unit16(const bf16_t* __restrict__ Qb, const bf16_t* __restrict__ Kh, const bf16_t* __restrict__ Vh, float* Ob, int seq, DA_LAS char* lds,
                                            bool second, float lam, float oscale, const float* __restrict__ subg, bf16_t* __restrict__ AOb) {
#ifndef DA_FORCE_SAFE
  if (attn_unit16_body<false>(Qb, Kh, Vh, Ob, seq, lds, second, lam, oscale, subg, AOb)) return;
#endif
#ifndef DA_FORCE_FAST
  attn_unit16_body<true>(Qb, Kh, Vh, Ob, seq, lds, second, lam, oscale, subg, AOb);
#endif
}
}

constexpr int NWAVES = 8;
constexpr int SEQ = 16384, DM = 2048, FF = 5632, AW = 1024, NHEAD = 8, FW = 1024, NGRP = 8, GD = 128, DEPTH = 2;
constexpr int NMOD = 9 * DM;
constexpr int KSPLIT = 16;
constexpr float NORM_EPS = 1e-6f, SUBLN_EPS = 1e-5f;

constexpr size_t MiB = 1u << 20;
constexpr size_t WS_CTL = 0, CTL_ZERO_BYTES = 1 * MiB;
constexpr size_t WS_COS = 1 * MiB, WS_SIN = 3 * MiB;
constexpr size_t WS_DFTC = 5 * MiB, WS_DFTS = 5 * MiB + 32768, WS_TW = 5 * MiB + 65536;
constexpr size_t WS_MODP = 6 * MiB;
constexpr size_t WS_MODF = 9 * MiB;
constexpr size_t WS_LAM = WS_MODF + (size_t)DEPTH * 9 * DM * 4;
constexpr size_t WS_W = 10 * MiB, W_LAYER = 180 * MiB;
constexpr size_t W_1IN = 0, W_1OUT = 44 * MiB, W_MIX = 66 * MiB, W_AP = 98 * MiB, W_FP = 102 * MiB, W_MO = 106 * MiB, W_2IN = 114 * MiB, W_2OUT = 158 * MiB;
constexpr size_t WS_H = 370 * MiB, WS_Y = 434 * MiB, WS_ACT = 498 * MiB, WS_M1 = 674 * MiB, WS_O = 802 * MiB, WS_END = 930 * MiB;
constexpr size_t WS_TRE = WS_Y, WS_TIM = WS_Y + 32 * MiB;
constexpr size_t WS_GATE = WS_ACT;
constexpr size_t WS_Q = WS_M1, WS_K = WS_M1 + 32 * MiB, WS_V = WS_M1 + 64 * MiB, WS_U = WS_M1 + 96 * MiB;
constexpr size_t WS_AO = WS_M1, WS_YF = WS_M1 + 32 * MiB, WS_MG = WS_M1 + 64 * MiB;
constexpr size_t WS_TT = WS_O;
constexpr int CW_TMO = 0, CW_CODE = 1, CW_BAR = 4096, CW_CHK = 16384;

constexpr int RING_OFF = 0, PHASE_LDS = 143360;
constexpr int LDSCTL_OFF = PHASE_LDS, MISC_OFF = LDSCTL_OFF + 320;
constexpr int LDS_BYTES = 147456;
static_assert(MISC_OFF + 128 <= LDS_BYTES, "LDS map");

#define GAS __attribute__((address_space(1)))
#define LAS __attribute__((address_space(3)))
typedef unsigned short bf16;
typedef unsigned v4u __attribute__((ext_vector_type(4)));
typedef unsigned v2u __attribute__((ext_vector_type(2)));
typedef float f32x4 __attribute__((ext_vector_type(4)));
typedef float f32x16 __attribute__((ext_vector_type(16)));
typedef short bf16x8 __attribute__((ext_vector_type(8)));
typedef short s16x4 __attribute__((ext_vector_type(4)));
typedef GAS unsigned gu32;
#define RLX_AGENT __ATOMIC_RELAXED, __HIP_MEMORY_SCOPE_AGENT
#define LDS_WAIT() asm volatile("s_waitcnt lgkmcnt(0)" ::: "memory")
#define VM_WAIT() asm volatile("s_waitcnt vmcnt(0)" ::: "memory")
__device__ __forceinline__ unsigned f2bf(float f) { unsigned u = __builtin_bit_cast(unsigned, f); return (u + 0x7fffu + ((u >> 16) & 1u)) >> 16; }
__device__ __forceinline__ unsigned pk2(float lo, float hi) { return f2bf(lo) | (f2bf(hi) << 16); }
__device__ __forceinline__ float bfl(unsigned w) { return __builtin_bit_cast(float, w << 16); }
__device__ __forceinline__ float bfh(unsigned w) { return __builtin_bit_cast(float, w & 0xffff0000u); }
__device__ __forceinline__ float wave_sum(float v) {
#pragma unroll
    for (int o = 1; o < 64; o <<= 1) v += __shfl_xor(v, o);
    return v;
}
__device__ __forceinline__ void sincos_turns(double t, double& s, double& c) {
    t -= floor(t);
    const double q = floor(t * 4.0 + 0.5);
    const double x = (t - q * 0.25) * 6.283185307179586476925286766559;
    const double x2 = x * x;
    double sp = -1.0 / 1307674368000.0; sp = sp * x2 + 1.0 / 6227020800.0; sp = sp * x2 - 1.0 / 39916800.0; sp = sp * x2 + 1.0 / 362880.0; sp = sp * x2 - 1.0 / 5040.0; sp = sp * x2 + 1.0 / 120.0; sp = sp * x2 - 1.0 / 6.0; sp = sp * x2 + 1.0;
    const double sx = sp * x;
    double cp = 1.0 / 20922789888000.0; cp = cp * x2 - 1.0 / 87178291200.0; cp = cp * x2 + 1.0 / 479001600.0; cp = cp * x2 - 1.0 / 3628800.0; cp = cp * x2 + 1.0 / 40320.0; cp = cp * x2 - 1.0 / 720.0; cp = cp * x2 + 1.0 / 24.0; cp = cp * x2 - 0.5; cp = cp * x2 + 1.0;
    const int qi = ((int)q) & 3;
    s = (qi == 0) ? sx : (qi == 1) ? cp : (qi == 2) ? -sx : -cp;
    c = (qi == 0) ? cp : (qi == 1) ? -sx : (qi == 2) ? -cp : sx;
}
__constant__ float ROPE_INV_FREQ[32] = {1.f,0.749894261f,0.562341332f,0.421696514f,0.316227764f,0.237137377f,0.177827939f,0.133352131f,0.100000001f,0.0749894157f,0.0562341325f,0.0421696529f,0.0316227749f,0.0237137377f,0.0177827943f,0.0133352149f,0.00999999978f,0.00749894185f,0.00562341325f,0.00421696482f,0.00316227763f,0.00237137359f,0.00177827943f,0.00133352145f,0.00100000005f,0.000749894243f,0.000562341302f,0.000421696517f,0.000316227757f,0.00023713737f,0.00017782794f,0.00013335215f};

#define XB_TMO      128
#define XB_XCNT(j)  (256  + 64 * (j))
#define XB_XSUB(j)  (1280 + 64 * (j))
#define XB_XGEN(j)  (2304 + 64 * (j))
#define XB_TOP      3328
#define XB_TOPGEN   3392
#define XCD_BAR_WORDS 3456
#define XB_SPIN_CAP (1u << 21)

__device__ __forceinline__ unsigned xb_ld(unsigned* p)              { return __hip_atomic_load(p, __ATOMIC_RELAXED, __HIP_MEMORY_SCOPE_AGENT); }
__device__ __forceinline__ unsigned xb_add(unsigned* p, unsigned v) { return __hip_atomic_fetch_add(p, v, __ATOMIC_RELAXED, __HIP_MEMORY_SCOPE_AGENT); }
__device__ __forceinline__ unsigned xb_xcc_id() { return (unsigned)__builtin_amdgcn_s_getreg((3 << 11) | 20) & 0xFu; }
#define XB_SPIN(cond, bar) do { unsigned _sp = 0; while (cond) { __builtin_amdgcn_s_sleep(1); \
    if ((++_sp & 255u) == 0u) { if (xb_ld(&(bar)[XB_TMO])) break; if (_sp > XB_SPIN_CAP) { atomicAdd(&(bar)[XB_TMO], 1u); break; } } } } while (0)

struct XcdBarrier {
    unsigned* bar; unsigned x;
    volatile LAS unsigned* st;
};

__device__ __forceinline__ XcdBarrier xcd_barrier_post(unsigned* bar, volatile LAS unsigned* st) {
    XcdBarrier b; b.bar = bar; b.x = xb_xcc_id(); b.st = st;
    if (threadIdx.x == 0) (void)xb_add(&bar[XB_XCNT(b.x)], 1u);
    return b;
}
__device__ __forceinline__ void xcd_barrier_complete(unsigned* bar, unsigned x, unsigned& nloc, unsigned& nx) {
    const unsigned G = gridDim.x * gridDim.y * gridDim.z;
    unsigned sum, cnt, mine, sp = 0u;
    for (;;) {
        sum = 0u; cnt = 0u; mine = 0u;
#pragma unroll
        for (unsigned j = 0; j < 16; ++j) { const unsigned c = xb_ld(&bar[XB_XCNT(j)]); sum += c; cnt += (c > 0u) ? 1u : 0u; mine = (j == x) ? c : mine; }
        if (sum == G) break;
        __builtin_amdgcn_s_sleep(1);
        if ((++sp & 255u) == 0u) { if (xb_ld(&bar[XB_TMO])) break; if (sp > XB_SPIN_CAP) { atomicAdd(&bar[XB_TMO], 1u); break; } }
    }
    nloc = mine > 0u ? mine : 1u; nx = cnt > 0u ? cnt : 1u;
}

__device__ __forceinline__ void xcd_barrier(const XcdBarrier& b) {
    asm volatile("s_waitcnt vmcnt(0)" ::: "memory");
    __syncthreads();
    if (threadIdx.x == 0) {
        unsigned* bar = b.bar; unsigned bx = b.x; asm volatile("" : "+s"(bx));
        __builtin_amdgcn_s_waitcnt(0);
        unsigned nloc = b.st[0], nx = b.st[1];
        if (nloc == 0u) { xcd_barrier_complete(bar, bx, nloc, nx); b.st[0] = nloc; b.st[1] = nx; }
        const unsigned old = xb_add(&bar[XB_XSUB(bx)], 1u);
        const unsigned gen = old / nloc;
        if (old + 1u == (gen + 1u) * nloc) {
            __builtin_amdgcn_fence(__ATOMIC_RELEASE, "agent");
            asm volatile("s_waitcnt vmcnt(0)" ::: "memory");
            const unsigned og = xb_add(&bar[XB_TOP], 1u);
            const unsigned tg = og / nx;
            if (og + 1u == (tg + 1u) * nx) xb_add(&bar[XB_TOPGEN], 1u);
            else XB_SPIN(xb_ld(&bar[XB_TOPGEN]) == tg, bar);
            __builtin_amdgcn_fence(__ATOMIC_ACQUIRE, "agent");
            xb_add(&bar[XB_XGEN(bx)], 1u);
            asm volatile("s_waitcnt vmcnt(0)" ::: "memory");
        } else {
            XB_SPIN(xb_ld(&bar[XB_XGEN(bx)]) == gen, bar);
            __builtin_amdgcn_fence(__ATOMIC_ACQUIRE, "agent");
            asm volatile("s_waitcnt vmcnt(0)" ::: "memory");
        }
    }
    __syncthreads();
}
struct Frame {
    LAS unsigned char* lds;
    volatile LAS unsigned* MISC;
    gu32* ctl;
    int tid, lane, wave;
    int vcu, G;
    unsigned char* ws;
};

__device__ __forceinline__ int wt_row(int mode, int row_off, int n0) {
    if (mode == 1) { const int up = n0 >= FF ? 1 : 0, j = n0 - up * FF; return (j >> 7) * 256 + up * 128 + (j & 127); }
    if (mode == 2) { if (n0 < 2048) { const int ch = n0 >> 6, d = n0 & 63; return 256 * (ch >> 2) + 128 * (d >> 5) + 32 * (ch & 3) + (d & 31); } return n0; }
    return row_off + n0;
}
__device__ __forceinline__ void p0_transpose_item(const float* W, int K, int N, bf16* WT, int mode, int row_off, LAS float* scr, int item, int lane) {
    const int nblk = N / 32, kb = item / nblk, nb = item % nblk, k0 = 64 * kb, n0 = 32 * nb;
#pragma unroll 8
    for (int i = 0; i < 32; ++i) { const int kk = 2 * i + (lane >> 5); scr[kk * 33 + (lane & 31)] = W[(size_t)(k0 + kk) * N + n0 + (lane & 31)]; }
    LDS_WAIT(); asm volatile("" ::: "memory");
    const int c = lane & 7, rbase = wt_row(mode, row_off, n0);
#pragma unroll
    for (int j = 0; j < 4; ++j) { const int n = (lane >> 3) + 8 * j; const LAS float* s = scr + (8 * c) * 33 + n;
        v4u o; o.x = pk2(s[0 * 33], s[1 * 33]); o.y = pk2(s[2 * 33], s[3 * 33]); o.z = pk2(s[4 * 33], s[5 * 33]); o.w = pk2(s[6 * 33], s[7 * 33]);
        *(GAS v4u*)(WT + (size_t)(rbase + n) * K + k0 + 8 * c) = o; }
    LDS_WAIT(); asm volatile("" ::: "memory");
}
struct In18 { const float* p[18]; };
__device__ __forceinline__ void p0_prologue(Frame& F, const In18& in) {
    LAS float* scr = (LAS float*)(F.lds + RING_OFF + F.wave * 16384);
    const int gw = F.vcu * NWAVES + F.wave, NGW = F.G * NWAVES;
    constexpr int I0 = 32 * 352, I1 = 88 * 64, I2 = 32 * 128, I3 = 32 * 128, I4 = 16 * 64, I5 = 16 * 64, I6 = 32 * 64, IL = 2 * I0 + 2 * I1 + I2 + I3 + I4 + I5 + I6;
    for (int it = gw; it < DEPTH * IL; it += NGW) {
        const int l = it / IL; int r = it % IL;
        bf16* wl = (bf16*)(F.ws + WS_W + (size_t)l * W_LAYER);
        if (r < I0) { p0_transpose_item(in.p[6] + (size_t)l * DM * 2 * FF, DM, 2 * FF, (bf16*)((unsigned char*)wl + W_1IN), 1, 0, scr, r, F.lane); continue; } r -= I0;
        if (r < I1) { p0_transpose_item(in.p[7] + (size_t)l * FF * DM, FF, DM, (bf16*)((unsigned char*)wl + W_1OUT), 0, 0, scr, r, F.lane); continue; } r -= I1;
        if (r < I2) { p0_transpose_item(in.p[8] + (size_t)l * DM * 4096, DM, 4096, (bf16*)((unsigned char*)wl + W_MIX), 2, 0, scr, r, F.lane); continue; } r -= I2;
        if (r < I3) { p0_transpose_item(in.p[13] + (size_t)l * DM * 4096, DM, 4096, (bf16*)((unsigned char*)wl + W_MIX), 0, 4096, scr, r, F.lane); continue; } r -= I3;
        if (r < I4) { p0_transpose_item(in.p[11] + (size_t)l * AW * DM, AW, DM, (bf16*)((unsigned char*)wl + W_AP), 0, 0, scr, r, F.lane); continue; } r -= I4;
        if (r < I5) { p0_transpose_item(in.p[12] + (size_t)l * FW * DM, FW, DM, (bf16*)((unsigned char*)wl + W_FP), 0, 0, scr, r, F.lane); continue; } r -= I5;
        if (r < I6) { p0_transpose_item(in.p[15] + (size_t)l * DM * DM, DM, DM, (bf16*)((unsigned char*)wl + W_MO), 0, 0, scr, r, F.lane); continue; } r -= I6;
        if (r < I0) { p0_transpose_item(in.p[16] + (size_t)l * DM * 2 * FF, DM, 2 * FF, (bf16*)((unsigned char*)wl + W_2IN), 1, 0, scr, r, F.lane); continue; } r -= I0;
        p0_transpose_item(in.p[17] + (size_t)l * FF * DM, FF, DM, (bf16*)((unsigned char*)wl + W_2OUT), 0, 0, scr, r, F.lane);
    }
    {
        constexpr int NCB = NMOD / 256, KR = DM / KSPLIT;
        const float* cvec = in.p[1]; float* modp = (float*)(F.ws + WS_MODP);
        for (int it = gw; it < DEPTH * NCB * KSPLIT; it += NGW) {
            const int l = it / (NCB * KSPLIT), r = it % (NCB * KSPLIT), ks = r / NCB, cb = r % NCB, c0 = cb * 256 + 4 * F.lane, k0 = ks * KR;
            const float* W = in.p[2] + (size_t)l * DM * NMOD + (size_t)k0 * NMOD + c0;
            f32x4 acc = {0.f, 0.f, 0.f, 0.f};
#pragma unroll 8
            for (int k = 0; k < KR; ++k) { const float cv = cvec[k0 + k]; const float ca = cv * __builtin_amdgcn_rcpf(1.0f + __builtin_amdgcn_exp2f(cv * -1.4426950408889634f));
                const f32x4 w = *(const GAS f32x4*)(W + (size_t)k * NMOD); acc += w * ca; }
            *(GAS f32x4*)(modp + (size_t)(l * KSPLIT + ks) * NMOD + c0) = acc;
        }
    }
    {
        const int gt = F.vcu * (NWAVES * 64) + F.tid, NT = F.G * NWAVES * 64;
        float* cosT = (float*)(F.ws + WS_COS); float* sinT = (float*)(F.ws + WS_SIN);
        for (int idx = gt; idx < SEQ * 32; idx += NT) { const int pos = idx >> 5, i = idx & 31; const float ang = (float)pos * ROPE_INV_FREQ[i];
            double s, c; sincos_turns((double)ang * 0.15915494309189533576888376337251, s, c); cosT[idx] = (float)c; sinT[idx] = (float)s; }
        bf16* dC = (bf16*)(F.ws + WS_DFTC); bf16* dS = (bf16*)(F.ws + WS_DFTS); float* tw = (float*)(F.ws + WS_TW);
        for (int idx = gt; idx < 128 * 128; idx += NT) { const int a = idx >> 7, b = idx & 127; double s, c;
            sincos_turns((double)((a * b) & 127) * (1.0 / 128.0), s, c); dC[idx] = (bf16)f2bf((float)c); dS[idx] = (bf16)f2bf((float)s);
            sincos_turns((double)(a * b) * (1.0 / 16384.0), s, c); tw[2 * idx] = (float)c; tw[2 * idx + 1] = (float)s; }
    }
}
__device__ __forceinline__ void p1_modfin(Frame& F, const In18& in) {
    const int gt = F.vcu * (NWAVES * 64) + F.tid, NT = F.G * NWAVES * 64;
    const float* modp = (const float*)(F.ws + WS_MODP); float* modf = (float*)(F.ws + WS_MODF);
    for (int idx = gt; idx < DEPTH * 3 * DM; idx += NT) { const int l = idx / (3 * DM), s = (idx / DM) % 3, c = idx % DM, base = s * 3 * DM + c;
        float sh = in.p[3][l * NMOD + base], sc = in.p[3][l * NMOD + base + DM], gt_ = in.p[3][l * NMOD + base + 2 * DM];
        for (int ks = 0; ks < KSPLIT; ++ks) { const float* q = modp + (size_t)(l * KSPLIT + ks) * NMOD + base; sh += q[0]; sc += q[DM]; gt_ += q[2 * DM]; }
        const float gpre = in.p[4][(l * 3 + s) * DM + c], gpost = in.p[5][(l * 3 + s) * DM + c];
        float* o = modf + (size_t)((l * 3 + s) * 3) * DM + c;
        o[0] = gpre * (1.0f + sc); o[DM] = sh; o[2 * DM] = (s == 1 ? 1.0f : 0.5f) * gt_ * gpost; }
    if (blockIdx.x == 0 && F.wave < DEPTH) { const int l = F.wave; const float* lq = in.p[9] + l * 256;
        const float sa = wave_sum(lq[F.lane] * lq[64 + F.lane]), sb = wave_sum(lq[128 + F.lane] * lq[192 + F.lane]);
        const float linit = l == 0 ? 0.2f : 0.35550906758f;
        if (F.lane == 0) { float* lamv = (float*)(F.ws + WS_LAM); lamv[l] = __builtin_amdgcn_exp2f(sa * 1.4426950408889634f) - __builtin_amdgcn_exp2f(sb * 1.4426950408889634f) + linit; lamv[2 + l] = 1.0f - linit; } }
}
template <bool HAS_Y, bool HAS_H>
__device__ __forceinline__ void norm_phase(Frame& F, const float* xin, float* xout, const bf16* y, bf16* h, const float* Gv, const float* Av, const float* Bv) {
    int lane = F.lane; asm volatile("" : "+v"(lane));
    const int gw = F.vcu * NWAVES + F.wave, NGW = F.G * NWAVES;
    f32x4 g[8], a[8], b[8];
#pragma unroll
    for (int j = 0; j < 8; ++j) { if (HAS_Y) g[j] = *(const GAS f32x4*)(Gv + 4 * lane + 256 * j); if (HAS_H) { a[j] = *(const GAS f32x4*)(Av + 4 * lane + 256 * j); b[j] = *(const GAS f32x4*)(Bv + 4 * lane + 256 * j); } }
    for (int row = gw; row < SEQ; row += NGW) {
        f32x4 x[8];
#pragma unroll
        for (int j = 0; j < 8; ++j) x[j] = __builtin_nontemporal_load((const GAS f32x4*)(xin + (size_t)row * DM + 4 * lane + 256 * j));
        if (HAS_Y) {
            f32x4 yv[8]; float ss = 0.f;
#pragma unroll
            for (int j = 0; j < 8; ++j) { const v2u w = *(const GAS v2u*)(y + (size_t)row * DM + 4 * lane + 256 * j); yv[j] = (f32x4){bfl(w.x), bfh(w.x), bfl(w.y), bfh(w.y)};
                ss += (yv[j].x * yv[j].x + yv[j].y * yv[j].y) + (yv[j].z * yv[j].z + yv[j].w * yv[j].w); }
            const float ry = 1.0f / sqrtf(wave_sum(ss) * (1.0f / DM) + NORM_EPS);
#pragma unroll
            for (int j = 0; j < 8; ++j) x[j] = x[j] + g[j] * yv[j] * ry;
        }
        if (HAS_Y) {
#pragma unroll
            for (int j = 0; j < 8; ++j) __builtin_nontemporal_store(x[j], (GAS f32x4*)(xout + (size_t)row * DM + 4 * lane + 256 * j));
        }
        if (HAS_H) {
            float ss = 0.f;
#pragma unroll
            for (int j = 0; j < 8; ++j) ss += (x[j].x * x[j].x + x[j].y * x[j].y) + (x[j].z * x[j].z + x[j].w * x[j].w);
            const float rx = 1.0f / sqrtf(wave_sum(ss) * (1.0f / DM) + NORM_EPS);
#pragma unroll
            for (int j = 0; j < 8; ++j) { const f32x4 v = x[j] * rx * a[j] + b[j]; v2u w; w.x = pk2(v.x, v.y); w.y = pk2(v.z, v.w); *(GAS v2u*)(h + (size_t)row * DM + 4 * lane + 256 * j) = w; }
        }
    }
}
__device__ __forceinline__ void combine_phase(Frame& F, const float* O, bf16* AO, const float* subg, float lam, float oscale) {
    int lane = F.lane; asm volatile("" : "+v"(lane));
    const int gw = F.vcu * NWAVES + F.wave, NGW = F.G * NWAVES, hh = lane >> 3, e0 = (lane & 7) * 16;
    f32x4 g[4];
#pragma unroll
    for (int j = 0; j < 4; ++j) g[j] = *(const GAS f32x4*)(subg + e0 + 4 * j) * oscale;
    for (int row = gw; row < SEQ; row += NGW) {
        const float* p0 = O + (size_t)row * 2048 + hh * 256 + e0;
        f32x4 o[4]; float ss = 0.f;
#pragma unroll
        for (int j = 0; j < 4; ++j) { const f32x4 a = *(const GAS f32x4*)(p0 + 4 * j), b = *(const GAS f32x4*)(p0 + 128 + 4 * j); o[j] = a - b * lam; ss += (o[j].x * o[j].x + o[j].y * o[j].y) + (o[j].z * o[j].z + o[j].w * o[j].w); }
        ss += __shfl_xor(ss, 1); ss += __shfl_xor(ss, 2); ss += __shfl_xor(ss, 4);
        const float r = 1.0f / sqrtf(ss * (1.0f / 128.0f) + SUBLN_EPS);
        v4u w0, w1; { const f32x4 v0 = o[0] * r * g[0], v1 = o[1] * r * g[1], v2 = o[2] * r * g[2], v3 = o[3] * r * g[3];
            w0.x = pk2(v0.x, v0.y); w0.y = pk2(v0.z, v0.w); w0.z = pk2(v1.x, v1.y); w0.w = pk2(v1.z, v1.w); w1.x = pk2(v2.x, v2.y); w1.y = pk2(v2.z, v2.w); w1.z = pk2(v3.x, v3.y); w1.w = pk2(v3.z, v3.w); }
        bf16* op = AO + (size_t)row * 1024 + hh * 128 + e0;
        *(GAS v4u*)op = w0; *(GAS v4u*)(op + 8) = w1;
    }
}
template <int DD> __device__ __forceinline__ void fft_mm2(f32x16& aR, f32x16& aI, int vb, const bf16x8* Ca, const bf16x8* Sa) {
    using namespace dattn;
    const s16x4 l0 = tr_read<v_rd_off(DD, 0, 0)>(vb), h0 = tr_read<v_rd_off(DD, 0, 1)>(vb), l1 = tr_read<v_rd_off(DD, 1, 0)>(vb), h1 = tr_read<v_rd_off(DD, 1, 1)>(vb);
    const s16x4 l2 = tr_read<v_rd_off(DD, 2, 0)>(vb), h2 = tr_read<v_rd_off(DD, 2, 1)>(vb), l3 = tr_read<v_rd_off(DD, 3, 0)>(vb), h3 = tr_read<v_rd_off(DD, 3, 1)>(vb);
    asm volatile("s_waitcnt lgkmcnt(0)" ::: "memory"); __builtin_amdgcn_sched_barrier(0);
    const bf16x8 b0 = DA_PK(l0, h0), b1 = DA_PK(l1, h1), b2 = DA_PK(l2, h2), b3 = DA_PK(l3, h3);
    aR = __builtin_amdgcn_mfma_f32_32x32x16_bf16(Ca[0], b0, aR, 0, 0, 0); aI = __builtin_amdgcn_mfma_f32_32x32x16_bf16(Sa[0], b0, aI, 0, 0, 0);
    aR = __builtin_amdgcn_mfma_f32_32x32x16_bf16(Ca[1], b1, aR, 0, 0, 0); aI = __builtin_amdgcn_mfma_f32_32x32x16_bf16(Sa[1], b1, aI, 0, 0, 0);
    aR = __builtin_amdgcn_mfma_f32_32x32x16_bf16(Ca[2], b2, aR, 0, 0, 0); aI = __builtin_amdgcn_mfma_f32_32x32x16_bf16(Sa[2], b2, aI, 0, 0, 0);
    aR = __builtin_amdgcn_mfma_f32_32x32x16_bf16(Ca[3], b3, aR, 0, 0, 0); aI = __builtin_amdgcn_mfma_f32_32x32x16_bf16(Sa[3], b3, aI, 0, 0, 0);
}
__device__ __forceinline__ void fftA_phase(Frame& F, const bf16* U, bf16* TRE, bf16* TIM, const bf16* dftC, const bf16* dftS, const float* TW) {
    using namespace dattn;
    int tid = threadIdx.x; asm volatile("" : "+v"(tid));
    const int wid = __builtin_amdgcn_readfirstlane(tid >> 6), lane = tid & 63, r32 = lane & 31, hi = lane >> 5, kb = wid & 3, ch = wid >> 2;
    bf16x8 Cf[8], Sf[8];
#pragma unroll
    for (int i = 0; i < 8; ++i) { Cf[i] = *(const bf16x8*)(dftC + (32 * kb + r32) * 128 + 16 * i + 8 * hi); Sf[i] = *(const bf16x8*)(dftS + (32 * kb + r32) * 128 + 16 * i + 8 * hi); }
    const int sr = tid >> 4, sc = (tid & 15) * 8, vst0 = v_st(sr, sc), vst1 = v_st(32 + sr, sc);
    LAS unsigned char* L = F.lds + RING_OFF;
    const int vb = (int)(unsigned)(size_t)L + v_rd_base(lane) + ch * 1024;
    for (int unit = F.vcu; unit < 128 * NGRP; unit += F.G) {
        const int n2 = unit >> 3, g = unit & 7;
        const bf16* src = U + (size_t)n2 * 1024 + g * 128 + sc;
        const bf16x8 x0 = *(const bf16x8*)(src + (size_t)sr * 131072), x1 = *(const bf16x8*)(src + (size_t)(32 + sr) * 131072), x2 = *(const bf16x8*)(src + (size_t)(64 + sr) * 131072), x3 = *(const bf16x8*)(src + (size_t)(96 + sr) * 131072);
        *(LAS bf16x8*)(L + vst0) = x0; *(LAS bf16x8*)(L + vst1) = x1; *(LAS bf16x8*)(L + 16384 + vst0) = x2; *(LAS bf16x8*)(L + 16384 + vst1) = x3;
        LDS_WAIT(); __syncthreads();
        f32x16 PR[2] = {}, PI[2] = {};
        fft_mm2<0>(PR[0], PI[0], vb, Cf, Sf); fft_mm2<1>(PR[1], PI[1], vb, Cf, Sf);
        fft_mm2<0>(PR[0], PI[0], vb + 16384, Cf + 4, Sf + 4); fft_mm2<1>(PR[1], PI[1], vb + 16384, Cf + 4, Sf + 4);
        LDS_WAIT(); __syncthreads();
        const float* tw = TW + (size_t)(n2 * 128 + 32 * kb + 4 * hi) * 2;
#pragma unroll
        for (int rg = 0; rg < 4; ++rg) { const f32x4 t0 = *(const GAS f32x4*)(tw + 16 * rg), t1 = *(const GAS f32x4*)(tw + 16 * rg + 4);
            const float cc[4] = {t0.x, t0.z, t1.x, t1.z}, ss[4] = {t0.y, t0.w, t1.y, t1.w};
#pragma unroll
            for (int e = 0; e < 4; ++e) { const int r = 4 * rg + e, k1 = 32 * kb + 8 * rg + 4 * hi + e; const size_t rowo = (size_t)(k1 * 128 + n2) * 1024 + g * 128 + 64 * ch + r32;
#pragma unroll
                for (int dd = 0; dd < 2; ++dd) { const float pr = PR[dd][r], pi = PI[dd][r]; TRE[rowo + 32 * dd] = (bf16)f2bf(pr * cc[e] - pi * ss[e]); TIM[rowo + 32 * dd] = (bf16)f2bf(-(pr * ss[e] + pi * cc[e])); } } }
    }
}
__device__ __forceinline__ void fftB_phase(Frame& F, const bf16* TRE, const bf16* TIM, bf16* YF, const bf16* dftC, const bf16* dftS) {
    using namespace dattn;
    constexpr int WSTR = 272, OFF_WR = 65536, OFF_WI = 65536 + 128 * WSTR;
    constexpr float NORMF = 6.905339660024878e-4f;
    int tid = threadIdx.x; asm volatile("" : "+v"(tid));
    const int wid = __builtin_amdgcn_readfirstlane(tid >> 6), lane = tid & 63, r32 = lane & 31, hi = lane >> 5, kb = wid & 3, ch = wid >> 2;
    bf16x8 Cf[8], Sf[8];
#pragma unroll
    for (int i = 0; i < 8; ++i) { Cf[i] = *(const bf16x8*)(dftC + (32 * kb + r32) * 128 + 16 * i + 8 * hi); Sf[i] = *(const bf16x8*)(dftS + (32 * kb + r32) * 128 + 16 * i + 8 * hi); }
    const int sr = tid >> 4, sc = (tid & 15) * 8, vst0 = v_st(sr, sc), vst1 = v_st(32 + sr, sc);
    LAS unsigned char* L = F.lds + RING_OFF;
    const int vb = (int)(unsigned)(size_t)L + v_rd_base(lane) + ch * 1024;
    for (int unit = F.vcu; unit < 128 * NGRP; unit += F.G) {
        const int k1 = unit >> 3, g = unit & 7;
        const size_t so = (size_t)(k1 * 128) * 1024 + g * 128 + sc;
        bf16x8 zr[4], zi[4];
#pragma unroll
        for (int q = 0; q < 4; ++q) { zr[q] = *(const bf16x8*)(TRE + so + (size_t)(32 * q + sr) * 1024); zi[q] = *(const bf16x8*)(TIM + so + (size_t)(32 * q + sr) * 1024); }
        *(LAS bf16x8*)(L + vst0) = zr[0]; *(LAS bf16x8*)(L + vst1) = zr[1]; *(LAS bf16x8*)(L + 16384 + vst0) = zr[2]; *(LAS bf16x8*)(L + 16384 + vst1) = zr[3];
        *(LAS bf16x8*)(L + 32768 + vst0) = zi[0]; *(LAS bf16x8*)(L + 32768 + vst1) = zi[1]; *(LAS bf16x8*)(L + 49152 + vst0) = zi[2]; *(LAS bf16x8*)(L + 49152 + vst1) = zi[3];
        LDS_WAIT(); __syncthreads();
        f32x16 WR[2] = {}, WI[2] = {}, WX[2] = {};
        fft_mm2<0>(WR[0], WX[0], vb, Cf, Sf); fft_mm2<1>(WR[1], WX[1], vb, Cf, Sf);
        fft_mm2<0>(WR[0], WX[0], vb + 16384, Cf + 4, Sf + 4); fft_mm2<1>(WR[1], WX[1], vb + 16384, Cf + 4, Sf + 4);
        fft_mm2<0>(WI[0], WR[0], vb + 32768, Cf, Sf); fft_mm2<1>(WI[1], WR[1], vb + 32768, Cf, Sf);
        fft_mm2<0>(WI[0], WR[0], vb + 49152, Cf + 4, Sf + 4); fft_mm2<1>(WI[1], WR[1], vb + 49152, Cf + 4, Sf + 4);
        WI[0] -= WX[0]; WI[1] -= WX[1];
#pragma unroll
        for (int dd = 0; dd < 2; ++dd)
#pragma unroll
            for (int r = 0; r < 16; ++r) { const int k2 = 32 * kb + crow(r, hi), j = 64 * ch + 32 * dd + r32;
                *(LAS unsigned short*)(L + OFF_WR + k2 * WSTR + j * 2) = (unsigned short)f2bf(WR[dd][r]); *(LAS unsigned short*)(L + OFF_WI + k2 * WSTR + j * 2) = (unsigned short)f2bf(WI[dd][r]); }
        LDS_WAIT(); __syncthreads();
        f32x16 Y[2] = {};
#pragma unroll
        for (int kk = 0; kk < 2; ++kk) { const int rb = (64 * ch + 32 * kk + r32) * WSTR + 16 * hi;
#pragma unroll
            for (int jc = 0; jc < 8; ++jc) { const bf16x8 aR = *(const LAS bf16x8*)(L + OFF_WR + rb + 32 * jc), aI = *(const LAS bf16x8*)(L + OFF_WI + rb + 32 * jc);
                Y[kk] = __builtin_amdgcn_mfma_f32_32x32x16_bf16(aR, Cf[jc], Y[kk], 0, 0, 0); Y[kk] = __builtin_amdgcn_mfma_f32_32x32x16_bf16(aI, Sf[jc], Y[kk], 0, 0, 0); } }
#pragma unroll
        for (int kk = 0; kk < 2; ++kk)
#pragma unroll
            for (int r = 0; r < 16; ++r) { const int k2 = 64 * ch + 32 * kk + crow(r, hi); YF[(size_t)(k1 + 128 * k2) * 1024 + g * 128 + 32 * kb + r32] = (bf16)f2bf(Y[kk][r] * NORMF); }
    }
}
#ifndef PHMASK
#define PHMASK 0xffffffffu
#endif
#define PH(k) (((PHMASK) >> (k)) & 1u)
#ifndef PHREPM
#define PHREPM 0u
#endif
#define REP(k) _Pragma("unroll 1") for (int rep_ = 0; rep_ < (int)(1u + (((PHREPM) >> (k)) & 1u)); ++rep_)
struct Args { const float* in[18]; float* out; unsigned char* ws; };
__global__ void __launch_bounds__(NWAVES * 64, 2) enc_fwd(Args args) {
    extern __shared__ __attribute__((aligned(16))) unsigned char lds[];
    Frame F;
    F.lds = (LAS unsigned char*)lds;
    F.MISC = (volatile LAS unsigned*)(F.lds + MISC_OFF);
    F.tid = threadIdx.x; F.lane = F.tid & 63; F.wave = __builtin_amdgcn_readfirstlane(F.tid >> 6);
    F.G = gridDim.x; { const int bx = blockIdx.x; F.vcu = (F.G % 8 == 0) ? (bx % 8) * (F.G / 8) + bx / 8 : bx; }
    F.ws = args.ws;
    unsigned char* ws = args.ws;
    F.ctl = (gu32*)(ws + WS_CTL);
    In18 in;
#pragma unroll
    for (int i = 0; i < 18; ++i) in.p[i] = args.in[i];
    for (int u = F.tid; u < (LDS_BYTES - LDSCTL_OFF) / 4; u += NWAVES * 64) ((LAS unsigned*)(F.lds + LDSCTL_OFF))[u] = 0u;
    __syncthreads();
    XcdBarrier bar = xcd_barrier_post((unsigned*)(F.ctl + CW_BAR), F.MISC + 8);
#ifdef PROBE_BAR
    unsigned long long bar_ticks = 0ull;
#ifndef PROBE_BARSEL
#define PROBE_BARSEL 0xffffffffu
#endif
    int bar_ord = 0;
#define GRID_BAR() do { const unsigned long long w0_ = wall_clock64(); xcd_barrier(bar); if (((PROBE_BARSEL) >> bar_ord) & 1u) bar_ticks += wall_clock64() - w0_; ++bar_ord; } while (0)
#else
#define GRID_BAR() xcd_barrier(bar)
#endif

    float* const xres = args.out;
    bf16* const HB = (bf16*)(ws + WS_H); bf16* const YB = (bf16*)(ws + WS_Y); bf16* const ACT = (bf16*)(ws + WS_ACT);
    bf16* const QB = (bf16*)(ws + WS_Q); bf16* const KB = (bf16*)(ws + WS_K); bf16* const VB = (bf16*)(ws + WS_V); bf16* const UB = (bf16*)(ws + WS_U);
    bf16* const GB = (bf16*)(ws + WS_GATE); float* const OB = (float*)(ws + WS_O);
    bf16* const TRE = (bf16*)(ws + WS_TRE); bf16* const TIM = (bf16*)(ws + WS_TIM);
    bf16* const YF = (bf16*)(ws + WS_YF); bf16* const AO = (bf16*)(ws + WS_AO); bf16* const MG = (bf16*)(ws + WS_MG); bf16* const TT = (bf16*)(ws + WS_TT);
    const float* const modf = (const float*)(ws + WS_MODF); const float* const lamv = (const float*)(ws + WS_LAM);
    const float* const cosT = (const float*)(ws + WS_COS); const float* const sinT = (const float*)(ws + WS_SIN);
    const bf16* const dftC = (const bf16*)(ws + WS_DFTC); const bf16* const dftS = (const bf16*)(ws + WS_DFTS); const float* const TW = (const float*)(ws + WS_TW);
#define MODF(l, s, k) (modf + (size_t)(((l) * 3 + (s)) * 3 + (k)) * DM)

    REP(0) if (PH(0)) p0_prologue(F, in);
    GRID_BAR();
    REP(1) if (PH(1)) p1_modfin(F, in);
    GRID_BAR();
    REP(2) if (PH(2)) norm_phase<false, true>(F, in.p[0], nullptr, nullptr, HB, nullptr, MODF(0, 0, 0), MODF(0, 0, 1));
#ifdef PROBE_NORM2
    for (int q_ = 0; q_ < 4; ++q_) norm_phase<false, true>(F, in.p[0], xres, nullptr, HB, nullptr, MODF(0, 0, 0), MODF(0, 0, 1));
#endif
    GRID_BAR();

    for (int l = 0; l < DEPTH; ++l) {
        const unsigned char* wl = ws + WS_W + (size_t)l * W_LAYER;
        { pg8::Gemm g{HB, (const bf16*)(wl + W_1IN), SEQ, 2 * FF, DM}; pg8::StaticOrder S; S.init(SEQ, 2 * FF, F.G, (int)blockIdx.x);
          pg8::EpiSwiGLU E{ACT, FF};
          REP(3) if (PH(3)) pg8::gemm_phase<pg8::EpiSwiGLU, pg8::StaticOrder, false, true>(F.lds + RING_OFF, g, S, E);
#ifdef PROBE_G1X2
          __syncthreads(); pg8::gemm_phase<pg8::EpiSwiGLU, pg8::StaticOrder, false, true>(F.lds + RING_OFF, g, S, E);
#endif
          GRID_BAR(); }
        { pg8::Gemm g{ACT, (const bf16*)(wl + W_1OUT), SEQ, DM, FF}; pg8::StaticOrder S; S.init(SEQ, DM, F.G, (int)blockIdx.x);
          pg8::EpiPlain E{YB, DM};
          REP(4) if (PH(4)) pg8::gemm_phase<pg8::EpiPlain, pg8::StaticOrder, true, true>(F.lds + RING_OFF, g, S, E); GRID_BAR(); }
        if (PH(5)) norm_phase<true, true>(F, l == 0 ? in.p[0] : xres, xres, YB, HB, MODF(l, 0, 2), MODF(l, 1, 0), MODF(l, 1, 1)); GRID_BAR();
        { pg8::Gemm g{HB, (const bf16*)(wl + W_MIX), SEQ, 8192, DM}; pg8::StaticOrder S; S.init(SEQ, 8192, F.G, (int)blockIdx.x);
          pg8::EpiMix E{QB, KB, VB, UB, GB, cosT, sinT, in.p[14] + (size_t)l * 4096};
          REP(6) if (PH(6)) pg8::gemm_phase<pg8::EpiMix, pg8::StaticOrder, false, true>(F.lds + RING_OFF, g, S, E); GRID_BAR(); }
        {
            const int xcd = F.vcu >> 5, j = F.vcu & 31;
            REP(7) if (!PH(7)) {} else if (F.G == 256) {
#pragma unroll 1
                for (int i = 0; i < 4; ++i) { const int vh = 2 * xcd + (i >> 1), qb = (i & 1) * 32 + j;
                    dattn::attn_unit16(QB + (size_t)(qb * 256) * 1024 + vh * 64, KB + vh * 64, VB + (vh >> 1) * 128, OB + (size_t)(qb * 256) * 2048 + (2 * xcd) * 128, SEQ, (LAS char*)(F.lds + RING_OFF),
                                     i >= 2, lamv[l], lamv[2 + l], in.p[10] + (size_t)l * 128, AO + (size_t)(qb * 256) * 1024 + xcd * 128); }
            } else {
#pragma unroll 1
                for (int un = F.vcu; un < 1024; un += F.G) { const int vh = un >> 6, qb = un & 63;
                    dattn::attn_unit16(QB + (size_t)(qb * 256) * 1024 + vh * 64, KB + vh * 64, VB + (vh >> 1) * 128, OB + (size_t)(qb * 256) * 2048 + vh * 128, SEQ, (LAS char*)(F.lds + RING_OFF),
                                     false, 0.f, 0.f, nullptr, nullptr); }
            }
            REP(8) if (PH(8)) fftA_phase(F, UB, TRE, TIM, dftC, dftS, TW);
#ifdef PROBE_FFT2
            fftA_phase(F, UB, TRE, TIM, dftC, dftS, TW);
#endif
            GRID_BAR();
        }
        REP(9) if (PH(9)) fftB_phase(F, TRE, TIM, YF, dftC, dftS);
#ifdef PROBE_FFT2
        fftB_phase(F, TRE, TIM, YF, dftC, dftS);
#endif
        REP(10) if (PH(10) && F.G != 256) combine_phase(F, OB, AO, in.p[10] + (size_t)l * 128, lamv[l], lamv[2 + l]);
#ifdef PROBE_COMB2
        combine_phase(F, OB, AO, in.p[10] + (size_t)l * 128, lamv[l], lamv[2 + l]);
#endif
        GRID_BAR();
        { pg8::Gemm g{AO, (const bf16*)(wl + W_AP), SEQ, DM, AW}; pg8::StaticOrder S; S.init(SEQ, DM, F.G, (int)blockIdx.x);
          pg8::EpiGate E{GB, nullptr, TT};
          REP(11) if (PH(11)) pg8::gemm_phase<pg8::EpiGate, pg8::StaticOrder, true, true>(F.lds + RING_OFF, g, S, E);
          VM_WAIT(); __syncthreads(); }
        { pg8::Gemm g{YF, (const bf16*)(wl + W_FP), SEQ, DM, FW}; pg8::StaticOrder S; S.init(SEQ, DM, F.G, (int)blockIdx.x);
          pg8::EpiGate E{GB + 2048, TT, MG};
          REP(12) if (PH(12)) pg8::gemm_phase<pg8::EpiGate, pg8::StaticOrder, true, true>(F.lds + RING_OFF, g, S, E); GRID_BAR(); }
        { pg8::Gemm g{MG, (const bf16*)(wl + W_MO), SEQ, DM, DM}; pg8::StaticOrder S; S.init(SEQ, DM, F.G, (int)blockIdx.x);
          pg8::EpiPlain E{YB, DM};
          REP(13) if (PH(13)) pg8::gemm_phase<pg8::EpiPlain, pg8::StaticOrder, true, true>(F.lds + RING_OFF, g, S, E); GRID_BAR(); }
        if (PH(14)) norm_phase<true, true>(F, xres, xres, YB, HB, MODF(l, 1, 2), MODF(l, 2, 0), MODF(l, 2, 1)); GRID_BAR();
        { pg8::Gemm g{HB, (const bf16*)(wl + W_2IN), SEQ, 2 * FF, DM}; pg8::StaticOrder S; S.init(SEQ, 2 * FF, F.G, (int)blockIdx.x);
          pg8::EpiSwiGLU E{ACT, FF};
          REP(15) if (PH(15)) pg8::gemm_phase<pg8::EpiSwiGLU, pg8::StaticOrder, false, true>(F.lds + RING_OFF, g, S, E); GRID_BAR(); }
        { pg8::Gemm g{ACT, (const bf16*)(wl + W_2OUT), SEQ, DM, FF}; pg8::StaticOrder S; S.init(SEQ, DM, F.G, (int)blockIdx.x);
          pg8::EpiPlain E{YB, DM};
          REP(16) if (PH(16)) pg8::gemm_phase<pg8::EpiPlain, pg8::StaticOrder, true, true>(F.lds + RING_OFF, g, S, E); GRID_BAR(); }
        if (l + 1 < DEPTH) { if (PH(17)) norm_phase<true, true>(F, xres, xres, YB, HB, MODF(l, 2, 2), MODF(l + 1, 0, 0), MODF(l + 1, 0, 1)); GRID_BAR(); }
        else if (PH(17)) norm_phase<true, false>(F, xres, xres, YB, nullptr, MODF(l, 2, 2), nullptr, nullptr);
    }
#ifdef PROBE_BAR
    if (blockIdx.x == PROBE_BAR - 1 && F.tid == 0) { const unsigned long long w0 = wall_clock64(); while (wall_clock64() - w0 < bar_ticks) __builtin_amdgcn_s_sleep(8); }
#endif
#ifdef PROBE_GEMM
    if (blockIdx.x == 0 && F.tid == 0) { VM_WAIT(); const unsigned long long sm = __hip_atomic_load(&pg8::g_gp_sum, __ATOMIC_RELAXED, __HIP_MEMORY_SCOPE_AGENT); const unsigned cn = __hip_atomic_load(&pg8::g_gp_cnt, __ATOMIC_RELAXED, __HIP_MEMORY_SCOPE_AGENT);
        const unsigned long long avg = cn ? sm / cn : 0ull, ticks = avg * 20ull;
        const unsigned long long w0 = wall_clock64(); while (wall_clock64() - w0 < ticks) __builtin_amdgcn_s_sleep(8); }
#endif
    if (blockIdx.x == 0) { int t_ = threadIdx.x; asm volatile("" : "+v"(t_)); if (t_ < 64) { VM_WAIT(); if (__hip_atomic_load((gu32*)((unsigned*)(args.ws + WS_CTL) + CW_BAR + XB_TMO), RLX_AGENT) != 0u) { const float q = __builtin_nanf(""); for (int c = t_; c < DM; c += 64) args.out[c] = q; } } }
}

extern "C" void kernel_launch(void* const* d_in, const int* in_sizes, int n_in, void* d_out, int out_size, void* d_ws, size_t ws_size, hipStream_t stream) {
    static int grid = 0;
    if (grid == 0) {
        if (n_in != 18 || in_sizes[0] != SEQ * DM || out_size != SEQ * DM || ws_size < WS_END) { fprintf(stderr, "kernel_launch: unexpected shapes: n_in %d in0 %d out %d ws %zu (need %zu)\n", n_in, n_in > 0 ? in_sizes[0] : -1, out_size, ws_size, (size_t)WS_END); grid = -1; return; }
        int dev = 0, cus = 0, per_cu = 0;
        if (hipGetDevice(&dev) != hipSuccess || hipDeviceGetAttribute(&cus, hipDeviceAttributeMultiprocessorCount, dev) != hipSuccess) { grid = -1; return; }
        if (hipFuncSetAttribute((const void*)enc_fwd, hipFuncAttributeMaxDynamicSharedMemorySize, LDS_BYTES) != hipSuccess) { fprintf(stderr, "kernel_launch: hipFuncSetAttribute failed\n"); grid = -1; return; }
        if (hipOccupancyMaxActiveBlocksPerMultiprocessor(&per_cu, (const void*)enc_fwd, NWAVES * 64, LDS_BYTES) != hipSuccess || per_cu < 1) { fprintf(stderr, "kernel_launch: occupancy query reports %d blocks per CU\n", per_cu); }
        (void)hipGetLastError();
        grid = cus;
    }
    if (grid < 0) return;
#ifdef DBG_ZERO_WS
    if (hipMemsetAsync((char*)d_ws, 0, WS_END, stream) != hipSuccess) return;
#else
    if (hipMemsetAsync((char*)d_ws + WS_CTL, 0, CTL_ZERO_BYTES, stream) != hipSuccess) return;
#endif
    Args a{};
    for (int i = 0; i < 18; ++i) a.in[i] = (const float*)d_in[i];
    a.out = (float*)d_out; a.ws = (unsigned char*)d_ws;
    hipLaunchKernelGGL(enc_fwd, dim3(grid), dim3(NWAVES * 64), LDS_BYTES, stream, a);
    const hipError_t le = hipPeekAtLastError();
    if (le != hipSuccess) fprintf(stderr, "kernel_launch: launch failed: %s\n", hipGetErrorName(le));
}
```

```cpp
#include <hip/hip_runtime.h>
#include <hip/hip_bf16.h>
#include <cstdio>
#include <cstdint>
#include <cmath>
namespace pg8 {
#define PG8_LAS __attribute__((address_space(3)))
typedef unsigned short bf16_t;
typedef short bf16x8 __attribute__((ext_vector_type(8)));
typedef float f32x4 __attribute__((ext_vector_type(4)));
typedef unsigned u32x4 __attribute__((ext_vector_type(4)));
constexpr int BM = 256, BK = 64, HALF = 128, HTB = HALF * BK * 2  , STAGE_BYTES = 8 * HTB, NXCD = 8, WGM = 8;

__host__ __device__ __forceinline__ int lds_byte(int r, int c) { const int st = (r >> 4) * 2 + (c >> 5), rr = r & 15, cc = c & 31, ob = rr * 64 + cc * 2; return st * 1024 + (ob ^ (((ob >> 9) & 1) << 5)); }
__host__ __device__ __forceinline__ void stage_rc(int b, int& R, int& C) { const int st = b / 1024, sb = b % 1024, swz = sb ^ (((sb >> 9) & 1) << 5); R = (st >> 1) * 16 + swz / 64; C = (st & 1) * 32 + (swz % 64) / 2; }
__host__ __device__ __forceinline__ int perm32(int rho) { const int n = rho >> 4, i = rho & 15; return 8 * (i >> 2) + 4 * n + (i & 3); }

struct Unit { int pm, pn; };
struct Gemm { const bf16_t* A; const bf16_t* Bt; int M, N, K; };

struct StaticOrder {
    int nM, nN, nwg, G, c;
    __host__ __device__ void init(int M, int N, int G_, int c_) { nM = M / BM; nN = N / BM; nwg = nM * nN; G = G_; c = c_; }
    __host__ __device__ bool next(int i, Unit& u) const {
        const long L = (long)i * G + c; if (L >= nwg) return false;
        int wgid = (int)L; { const int q = nwg / NXCD, r = nwg % NXCD, xcd = wgid % NXCD, off = wgid / NXCD; wgid = (xcd < r ? xcd * (q + 1) : r * (q + 1) + (xcd - r) * q) + off; }
        const int nig = WGM * nN, gid = wgid / nig, fm = gid * WGM, gsz = (nM - fm) < WGM ? (nM - fm) : WGM;
        u.pm = fm + ((wgid % nig) % gsz); u.pn = (wgid % nig) / gsz; return true;
    }
    __device__ __forceinline__ void a_ready(const Unit&) const {}
    __device__ __forceinline__ void done(const Unit&) const {}
};

typedef float cvt_f32x2 __attribute__((ext_vector_type(2))); typedef __bf16 cvt_bf16x2 __attribute__((ext_vector_type(2)));
__device__ __forceinline__ unsigned cvt_pk_bf16(float lo, float hi) { const cvt_f32x2 v = {lo, hi}; return __builtin_bit_cast(unsigned, __builtin_convertvector(v, cvt_bf16x2)); }
typedef float f32x2 __attribute__((ext_vector_type(2)));
__device__ __forceinline__ float bf_lo(unsigned w) { return __builtin_bit_cast(float, w << 16); }
__device__ __forceinline__ float bf_hi(unsigned w) { return __builtin_bit_cast(float, w & 0xffff0000u); }
__device__ __forceinline__ float sigmoid_f(float v) { return __builtin_amdgcn_rcpf(1.0f + __builtin_amdgcn_exp2f(v * -1.4426950408889634f)); }
__device__ __forceinline__ u32x4 pack8(const f32x4 a, const f32x4 b) { u32x4 w; w.x = cvt_pk_bf16(a[0], a[1]); w.y = cvt_pk_bf16(a[2], a[3]); w.z = cvt_pk_bf16(b[0], b[1]); w.w = cvt_pk_bf16(b[2], b[3]); return w; }

struct EpiPlain {
    static constexpr bool PERM = true, AFTER_DRAIN = false; static constexpr int NST = 16;
    bf16_t* O; int ldc;
    __device__ __forceinline__ void operator()(const f32x4 (&acc)[2][2][4][2], const Unit& u, int wr, int wc, int fr, int fq) const {
        const int row0 = u.pm * BM + wr * 64 + fr, col0 = u.pn * BM + wc * 32 + 8 * fq;
#pragma unroll
        for (int ai = 0; ai < 2; ++ai)
#pragma unroll
            for (int m = 0; m < 4; ++m) { bf16_t* rowp = O + (size_t)(row0 + ai * HALF + m * 16) * ldc + col0;
#pragma unroll
                for (int bj = 0; bj < 2; ++bj) *(u32x4*)(rowp + bj * HALF) = pack8(acc[ai][bj][m][0], acc[ai][bj][m][1]); }
    }
};
struct EpiSwiGLU {
    static constexpr bool PERM = true, AFTER_DRAIN = false; static constexpr int NST = 8;
    bf16_t* O; int ldc;
    __device__ __forceinline__ void operator()(const f32x4 (&acc)[2][2][4][2], const Unit& u, int wr, int wc, int fr, int fq) const {
        const int row0 = u.pm * BM + wr * 64 + fr, col0 = u.pn * HALF + wc * 32 + 8 * fq;
#pragma unroll
        for (int ai = 0; ai < 2; ++ai)
#pragma unroll
            for (int m = 0; m < 4; ++m) { bf16_t* rowp = O + (size_t)(row0 + ai * HALF + m * 16) * ldc + col0;
                f32x4 o[2];
#pragma unroll
                for (int n = 0; n < 2; ++n) { const f32x4 g = acc[ai][0][m][n], up = acc[ai][1][m][n];
#pragma unroll
                    for (int e = 0; e < 4; ++e) o[n][e] = g[e] * sigmoid_f(g[e]) * up[e]; }
                *(u32x4*)rowp = pack8(o[0], o[1]); }
    }
};
struct EpiMix {
    static constexpr bool PERM = true, AFTER_DRAIN = false; static constexpr int NST = 16;
    bf16_t *Q, *K, *V, *U, *G; const float* cosT; const float* sinT; const float* gbias;
    __device__ __forceinline__ void operator()(const f32x4 (&acc)[2][2][4][2], const Unit& u, int wr, int wc, int fr, int fq) const {
        const int pn = u.pn, row0 = u.pm * BM + wr * 64 + fr;
        if (pn < 8) {
            bf16_t* base = (pn < 4 ? Q : K) + ((pn & 3) * 4 + wc) * 64 + 8 * fq;
            const float qs = pn < 4 ? 0.18033688011112042f : 1.0f;
#pragma unroll
            for (int ai = 0; ai < 2; ++ai) {
                f32x4 cc[4][2], ss[4][2];
#pragma unroll
                for (int m = 0; m < 4; ++m) { const int row = row0 + ai * HALF + m * 16;
                    cc[m][0] = *(const f32x4*)(cosT + (size_t)row * 32 + 8 * fq); cc[m][1] = *(const f32x4*)(cosT + (size_t)row * 32 + 8 * fq + 4);
                    ss[m][0] = *(const f32x4*)(sinT + (size_t)row * 32 + 8 * fq); ss[m][1] = *(const f32x4*)(sinT + (size_t)row * 32 + 8 * fq + 4); }
#pragma unroll
                for (int m = 0; m < 4; ++m) { const int row = row0 + ai * HALF + m * 16;
                    const f32x4 c0 = cc[m][0], c1 = cc[m][1], s0 = ss[m][0], s1 = ss[m][1];
                    const f32x4 x1a = acc[ai][0][m][0], x1b = acc[ai][0][m][1], x2a = acc[ai][1][m][0], x2b = acc[ai][1][m][1];
                    const f32x4 o1a = (x1a * c0 - x2a * s0) * qs, o1b = (x1b * c1 - x2b * s1) * qs, o2a = (x2a * c0 + x1a * s0) * qs, o2b = (x2b * c1 + x1b * s1) * qs;
                    bf16_t* rowp = base + (size_t)row * 1024;
                    *(u32x4*)rowp = pack8(o1a, o1b); *(u32x4*)(rowp + 32) = pack8(o2a, o2b); }
            }
        } else if (pn < 16) {
            bf16_t* base = (pn < 12 ? V : U) + (pn & 3) * BM + wc * 32 + 8 * fq;
#pragma unroll
            for (int ai = 0; ai < 2; ++ai)
#pragma unroll
                for (int m = 0; m < 4; ++m) { bf16_t* rowp = base + (size_t)(row0 + ai * HALF + m * 16) * 1024;
#pragma unroll
                    for (int bj = 0; bj < 2; ++bj) *(u32x4*)(rowp + bj * HALF) = pack8(acc[ai][bj][m][0], acc[ai][bj][m][1]); }
        } else {
            const int col0 = (pn - 16) * BM + wc * 32 + 8 * fq;
            f32x4 bv[2][2];
#pragma unroll
            for (int bj = 0; bj < 2; ++bj)
#pragma unroll
                for (int n = 0; n < 2; ++n) bv[bj][n] = *(const f32x4*)(gbias + col0 + bj * HALF + 4 * n);
#pragma unroll
            for (int ai = 0; ai < 2; ++ai)
#pragma unroll
                for (int m = 0; m < 4; ++m) { bf16_t* rowp = G + (size_t)(row0 + ai * HALF + m * 16) * 4096 + col0;
#pragma unroll
                    for (int bj = 0; bj < 2; ++bj) { f32x4 o[2];
#pragma unroll
                        for (int n = 0; n < 2; ++n) { const f32x4 v = acc[ai][bj][m][n] + bv[bj][n];
#pragma unroll
                            for (int e = 0; e < 4; ++e) o[n][e] = sigmoid_f(v[e]); }
                        *(u32x4*)(rowp + bj * HALF) = pack8(o[0], o[1]); } }
        }
    }
};
struct EpiGate {
    static constexpr bool PERM = true, AFTER_DRAIN = false; static constexpr int NST = 16;
    const bf16_t* gate; const bf16_t* addend; bf16_t* O;
    __device__ __forceinline__ void operator()(const f32x4 (&acc)[2][2][4][2], const Unit& u, int wr, int wc, int fr, int fq) const {
        const int row0 = u.pm * BM + wr * 64 + fr, col0 = u.pn * BM + wc * 32 + 8 * fq;
#pragma unroll
        for (int ai = 0; ai < 2; ++ai) {
            u32x4 gw[4][2], tw[4][2];
#pragma unroll
            for (int m = 0; m < 4; ++m)
#pragma unroll
                for (int bj = 0; bj < 2; ++bj) { const size_t row = (size_t)(row0 + ai * HALF + m * 16);
                    gw[m][bj] = *(const u32x4*)(gate + row * 4096 + col0 + bj * HALF);
                    if (addend) tw[m][bj] = *(const u32x4*)(addend + row * 2048 + col0 + bj * HALF); }
#pragma unroll
            for (int m = 0; m < 4; ++m)
#pragma unroll
                for (int bj = 0; bj < 2; ++bj) { const size_t row = (size_t)(row0 + ai * HALF + m * 16); const u32x4 g = gw[m][bj];
                    f32x4 a = acc[ai][bj][m][0], b = acc[ai][bj][m][1];
                    a[0] *= bf_lo(g.x); a[1] *= bf_hi(g.x); a[2] *= bf_lo(g.y); a[3] *= bf_hi(g.y); b[0] *= bf_lo(g.z); b[1] *= bf_hi(g.z); b[2] *= bf_lo(g.w); b[3] *= bf_hi(g.w);
                    if (addend) { const u32x4 t = tw[m][bj];
                        a[0] += bf_lo(t.x); a[1] += bf_hi(t.x); a[2] += bf_lo(t.y); a[3] += bf_hi(t.y); b[0] += bf_lo(t.z); b[1] += bf_hi(t.z); b[2] += bf_lo(t.w); b[3] += bf_hi(t.w); }
                    *(u32x4*)(O + row * 2048 + col0 + bj * HALF) = pack8(a, b); }
        }
    }
};

template <class Epi, class Sched, bool ALIGN_EPI = false, bool SP2 = false>
__device__ __forceinline__ void gemm_phase(PG8_LAS unsigned char* lds, const Gemm g, const Sched& S, const Epi& E) {
    int tid = threadIdx.x; asm volatile("" : "+v"(tid));
    const int wid = __builtin_amdgcn_readfirstlane(tid >> 6), lane = tid & 63, wr = wid >> 2, wc = wid & 3, fr = lane & 15, fq = lane >> 4;
    const int K = g.K, nt = K / BK;
    unsigned voffA[2], voffB[2];
#pragma unroll
    for (int i = 0; i < 2; ++i) { int R, C; stage_rc(tid * 16 + i * 8192, R, C); const int Rb = Epi::PERM ? ((R & ~31) + perm32(R & 31)) : R;
        voffA[i] = (unsigned)(R * K + C) * 2u; voffB[i] = (unsigned)(Rb * K + C) * 2u; }
    const size_t kstep = (size_t)(BK * 2);
    const size_t hstep = (size_t)HALF * K * 2;
    const size_t tstep = 2 * hstep;
    const unsigned ldsw = (unsigned)wid * 1024u;
    const unsigned ldsbase = (unsigned)(size_t)lds + ldsw;
    const int aoff = lds_byte(wr * 64 + fr, fq * 8), boff = lds_byte(wc * 32 + fr, fq * 8);
#define PG8_SA(b, h) (((b) * 2 + (h)) * HTB)
#define PG8_SB(b, h) ((4 + (b) * 2 + (h)) * HTB)
#define PG8_STAGE(bufoff, gbase, voff) do { unsigned m1_; \
        asm volatile("s_mov_b32 m0, %3\n\ts_add_u32 %0, %3, 0x2000\n\tglobal_load_lds_dwordx4 %1, %4\n\ts_mov_b32 m0, %0\n\ts_nop 0\n\tglobal_load_lds_dwordx4 %2, %4" \
                     : "=&s"(m1_) : "v"((voff)[0]), "v"((voff)[1]), "s"((unsigned)__builtin_amdgcn_readfirstlane((int)(ldsbase + (unsigned)(bufoff)))), "s"((const char*)(gbase)) : "memory", "m0", "scc"); } while (0)
#define PG8_LDA(dst, b, h) do { _Pragma("unroll") for (int m = 0; m < 4; ++m) _Pragma("unroll") for (int k = 0; k < 2; ++k) dst[m][k] = *(const PG8_LAS bf16x8*)(lds + PG8_SA(b, h) + aoff + m * 2048 + k * 1024); } while (0)
#define PG8_LDB(dst, b, h) do { _Pragma("unroll") for (int n = 0; n < 2; ++n) _Pragma("unroll") for (int k = 0; k < 2; ++k) dst[n][k] = *(const PG8_LAS bf16x8*)(lds + PG8_SB(b, h) + boff + n * 2048 + k * 1024); } while (0)
#define PG8_MMA(ai, bj, At, Bt) do { __builtin_amdgcn_s_setprio(1); _Pragma("unroll") for (int m = 0; m < 4; ++m) _Pragma("unroll") for (int n = 0; n < 2; ++n) _Pragma("unroll") for (int k = 0; k < 2; ++k) \
        acc[ai][bj][m][n] = __builtin_amdgcn_mfma_f32_16x16x32_bf16(Bt[n][k], At[m][k], acc[ai][bj][m][n], 0, 0, 0); __builtin_amdgcn_s_setprio(0); } while (0)
#define PG8_WAIT_V(n) asm volatile("s_waitcnt vmcnt(" #n ")" ::: "memory")
#define PG8_WAIT_L(n) asm volatile("s_waitcnt lgkmcnt(" #n ")" ::: "memory")
#define PG8_BAR __builtin_amdgcn_s_barrier()
#define PG8_SCHED __builtin_amdgcn_sched_barrier(0)
    Unit cur, nxt; int ui = 0;
    if (!S.next(0, cur)) return;
    f32x4 acc[2][2][4][2];
#pragma unroll
    for (int a = 0; a < 2; ++a)
#pragma unroll
        for (int b = 0; b < 2; ++b)
#pragma unroll
            for (int m = 0; m < 4; ++m)
#pragma unroll
                for (int n = 0; n < 2; ++n) acc[a][b][m][n] = (f32x4){0.f, 0.f, 0.f, 0.f};
    bf16x8 At[4][2], B0[2][2], B1[2][2];
    const char* cA = (const char*)g.A + (size_t)cur.pm * tstep; const char* cB = (const char*)g.Bt + (size_t)cur.pn * tstep;
    S.a_ready(cur);
    if constexpr (SP2) {
        PG8_STAGE(PG8_SB(0, 0), cB, voffB); PG8_STAGE(PG8_SB(0, 1), cB + hstep, voffB); PG8_STAGE(PG8_SA(0, 0), cA, voffA); PG8_STAGE(PG8_SA(0, 1), cA + hstep, voffA);
        if (wr == 1) PG8_BAR;
        PG8_WAIT_V(2); PG8_BAR;
        PG8_STAGE(PG8_SB(1, 0), cB + kstep, voffB); PG8_STAGE(PG8_SA(1, 0), cA + kstep, voffA); PG8_STAGE(PG8_SB(1, 1), cB + hstep + kstep, voffB);
        PG8_WAIT_V(6); PG8_BAR;
    } else {
        PG8_STAGE(PG8_SB(0, 0), cB, voffB); PG8_STAGE(PG8_SA(0, 0), cA, voffA); PG8_STAGE(PG8_SB(0, 1), cB + hstep, voffB); PG8_STAGE(PG8_SA(0, 1), cA + hstep, voffA);
        if (wr == 1) PG8_BAR;
        PG8_WAIT_V(4); PG8_BAR;
        PG8_STAGE(PG8_SB(1, 0), cB + kstep, voffB); PG8_STAGE(PG8_SA(1, 0), cA + kstep, voffA); PG8_STAGE(PG8_SB(1, 1), cB + hstep + kstep, voffB);
        PG8_WAIT_V(6); PG8_BAR;
    }
    for (;;) {
        const bool has_next = S.next(ui + 1, nxt);
        const char* nA = has_next ? (const char*)g.A + (size_t)nxt.pm * tstep : cA; const char* nB = has_next ? (const char*)g.Bt + (size_t)nxt.pn * tstep : cB;
        for (int t = 0; t < nt; t += 2) {
            const bool last = (t == nt - 2);
            const char* a1 = cA + (size_t)(t + 1) * kstep;
            const char* a2 = last ? nA : cA + (size_t)(t + 2) * kstep; const char* b2 = last ? nB : cB + (size_t)(t + 2) * kstep;
            const char* a3 = a2 + kstep; const char* b3 = b2 + kstep;
            if (last && has_next) S.a_ready(nxt);
            if constexpr (SP2) {
            PG8_LDB(B0, 0, 0); PG8_LDB(B1, 0, 1); PG8_SCHED; PG8_LDA(At, 0, 0); PG8_STAGE(PG8_SA(1, 1), a1 + hstep, voffA);
            PG8_WAIT_V(8); PG8_WAIT_L(0); PG8_BAR; PG8_MMA(0, 0, At, B0); PG8_MMA(0, 1, At, B1); PG8_BAR; PG8_SCHED;
            PG8_LDA(At, 0, 1); PG8_STAGE(PG8_SB(0, 0), b2, voffB); PG8_STAGE(PG8_SB(0, 1), b2 + hstep, voffB); PG8_STAGE(PG8_SA(0, 0), a2, voffA);
            PG8_WAIT_V(8); PG8_WAIT_L(0); PG8_BAR; PG8_MMA(1, 0, At, B0); PG8_MMA(1, 1, At, B1); PG8_BAR; PG8_SCHED;
            PG8_LDB(B0, 1, 0); PG8_LDB(B1, 1, 1); PG8_SCHED; PG8_LDA(At, 1, 0); PG8_STAGE(PG8_SA(0, 1), a2 + hstep, voffA);
            PG8_WAIT_V(8); PG8_WAIT_L(0); PG8_BAR; PG8_MMA(0, 0, At, B0); PG8_MMA(0, 1, At, B1); PG8_BAR; PG8_SCHED;
            PG8_LDA(At, 1, 1); PG8_STAGE(PG8_SB(1, 0), b3, voffB); PG8_STAGE(PG8_SB(1, 1), b3 + hstep, voffB); PG8_STAGE(PG8_SA(1, 0), a3, voffA);
            PG8_WAIT_V(8); PG8_WAIT_L(0); PG8_BAR; PG8_MMA(1, 0, At, B0); PG8_MMA(1, 1, At, B1); PG8_BAR; PG8_SCHED;
            } else {
            PG8_LDB(B0, 0, 0); PG8_SCHED; PG8_LDA(At, 0, 0); PG8_STAGE(PG8_SA(1, 1), a1 + hstep, voffA);
            PG8_WAIT_L(8); PG8_BAR; PG8_WAIT_L(0); PG8_MMA(0, 0, At, B0); PG8_BAR; PG8_SCHED;
            PG8_LDB(B1, 0, 1); PG8_STAGE(PG8_SB(0, 0), b2, voffB);
            PG8_BAR; PG8_WAIT_L(0); PG8_MMA(0, 1, At, B1); PG8_BAR;
            PG8_LDA(At, 0, 1); PG8_STAGE(PG8_SA(0, 0), a2, voffA);
            PG8_BAR; PG8_WAIT_L(0); PG8_MMA(1, 0, At, B0); PG8_BAR; PG8_SCHED;
            PG8_STAGE(PG8_SB(0, 1), b2 + hstep, voffB);
            PG8_WAIT_V(6); PG8_BAR; PG8_MMA(1, 1, At, B1); PG8_BAR;
            PG8_LDB(B0, 1, 0); PG8_SCHED; PG8_LDA(At, 1, 0); PG8_STAGE(PG8_SA(0, 1), a2 + hstep, voffA);
            PG8_WAIT_L(8); PG8_BAR; PG8_WAIT_L(0); PG8_MMA(0, 0, At, B0); PG8_BAR; PG8_SCHED;
            PG8_LDB(B1, 1, 1); PG8_STAGE(PG8_SB(1, 0), b3, voffB);
            PG8_BAR; PG8_WAIT_L(0); PG8_MMA(0, 1, At, B1); PG8_BAR;
            PG8_LDA(At, 1, 1); PG8_STAGE(PG8_SA(1, 0), a3, voffA);
            PG8_BAR; PG8_WAIT_L(0); PG8_MMA(1, 0, At, B0); PG8_BAR; PG8_SCHED;
            PG8_STAGE(PG8_SB(1, 1), b3 + hstep, voffB);
            PG8_WAIT_V(6); PG8_BAR; PG8_MMA(1, 1, At, B1); PG8_BAR;
            }
        }
        if constexpr (ALIGN_EPI) { if (wr == 0) PG8_BAR; }
        if constexpr (!Epi::AFTER_DRAIN) { E(acc, cur, wr, wc, fr, fq); S.done(cur); }
        if (!has_next) break;
#pragma unroll
        for (int a = 0; a < 2; ++a)
#pragma unroll
            for (int b = 0; b < 2; ++b)
#pragma unroll
                for (int m = 0; m < 4; ++m)
#pragma unroll
                    for (int n = 0; n < 2; ++n) acc[a][b][m][n] = (f32x4){0.f, 0.f, 0.f, 0.f};
        cur = nxt; cA = nA; cB = nB; ++ui;
        if constexpr (ALIGN_EPI) { if (wr == 1) PG8_BAR; }
    }
    PG8_WAIT_V(0);
    if constexpr (!ALIGN_EPI) { if (wr == 0) PG8_BAR; }
    PG8_BAR;
    if constexpr (Epi::AFTER_DRAIN) { E.fused(acc, cur, wr, wc, fr, fq, lds, wid, lane); S.done(cur); }
#undef PG8_SA
#undef PG8_SB
#undef PG8_STAGE
#undef PG8_LDA
#undef PG8_LDB
#undef PG8_MMA
#undef PG8_WAIT_V
#undef PG8_WAIT_L
#undef PG8_BAR
#undef PG8_SCHED
}
}
namespace dattn {
#define DA_LAS __attribute__((address_space(3)))
typedef unsigned short bf16_t;
using bf16x8 = __attribute__((ext_vector_type(8))) short;
using s16x4  = __attribute__((ext_vector_type(4))) short;
using f32x16 = __attribute__((ext_vector_type(16))) float;
using u32x4  = __attribute__((ext_vector_type(4))) unsigned;
constexpr int NW = 8, QBLK = 32, KVBLK = 64, PITCH = 1024, LDO = 2048;
constexpr float SCALE = 0.125f;
constexpr float THR = 8.f;
constexpr int SHM_V = KVBLK * 128 * 2, SHM_K = KVBLK * 64 * 2;
constexpr int NSLOT = 3, OFF_V = 0, OFF_K = NSLOT * SHM_V, OFF_WS = NSLOT * (SHM_V + SHM_K), LDS_BYTES = OFF_WS + NW * 64 * 4;
#define DA_KSWZ(row, colB) ((row) * 128 + ((colB) ^ ((((row) >> 1) & 7) << 4)))
#define DA_SBAR() __builtin_amdgcn_sched_barrier(0)
__device__ __forceinline__ int crow(int r, int hi) { return (r & 3) + 8 * (r >> 2) + 4 * hi; }
typedef float cvt_f32x2 __attribute__((ext_vector_type(2))); typedef __bf16 cvt_bf16x2 __attribute__((ext_vector_type(2)));
__device__ __forceinline__ unsigned cvtpk(float lo, float hi) { const cvt_f32x2 v = {lo, hi}; return __builtin_bit_cast(unsigned, __builtin_convertvector(v, cvt_bf16x2)); }
#ifdef DA_THR2_TEST
constexpr float THR2 = DA_THR2_TEST;
#else
constexpr float THR2 = THR * 1.4426950408889634f;
#endif
__device__ __forceinline__ void glds16s(const void* sbase, unsigned voff, unsigned lds_dst) { unsigned keep;
  asm volatile("s_mov_b32 %0, m0\n\ts_mov_b32 m0, %3\n\ts_nop 0\n\tglobal_load_lds_dwordx4 %1, %2\n\ts_mov_b32 m0, %0" : "=&s"(keep) : "v"(voff), "s"(sbase), "s"(lds_dst) : "memory"); }
#define DA_WAIT_BAR(N) do { __builtin_amdgcn_sched_barrier(0); asm volatile("s_waitcnt vmcnt(" #N ") lgkmcnt(0)\n\ts_barrier" ::: "memory"); __builtin_amdgcn_sched_barrier(0); } while (0)
__device__ __forceinline__ int v_st(int k, int c) { const int kk = (k & ~0xC) | ((k & 4) << 1) | ((k & 8) >> 1); return ((kk >> 3) * 4 + (c >> 5)) * 512 + ((kk & 7) * 32 + (c & 31)) * 2; }
__device__ __forceinline__ int v_rd_base(int lane) { return ((lane & 3) << 3) | (((lane >> 2) & 3) << 6) | (((lane >> 4) & 1) << 5) | (((lane >> 5) & 1) << 8); }
constexpr int v_rd_off(int d0, int ks, int half) { return d0 * 512 + ks * 4096 + half * 2048; }
template <int OFF> __device__ __forceinline__ s16x4 tr_read(int vb) {
  s16x4 r; asm volatile("ds_read_b64_tr_b16 %0, %1 offset:%2" : "=&v"(r) : "v"(vb), "i"(OFF) : "memory"); return r;
}
#define DA_PK(L, H) (bf16x8){L[0], L[1], L[2], L[3], H[0], H[1], H[2], H[3]}
#define DA_LGKM(N) do { asm volatile("s_waitcnt lgkmcnt(" #N ")" ::: "memory"); DA_SBAR(); } while (0)
template <int OFF> __device__ __forceinline__ bf16x8 lds_rd128(int a) { bf16x8 r; asm volatile("ds_read_b128 %0, %1 offset:%2" : "=&v"(r) : "v"(a), "i"(OFF) : "memory"); return r; }
typedef float f32x4a __attribute__((ext_vector_type(4)));
typedef unsigned v2u16 __attribute__((ext_vector_type(2)));
struct KPre16 { bf16x8 k[4][2]; };
__device__ __forceinline__ void prefetch_k16(KPre16& P, int kbase, int fr, int fq) {
  const int sw = ((fr >> 1) & 7) << 4, a0 = kbase + fr * 128 + ((16 * fq) ^ sw), a1 = kbase + fr * 128 + ((64 + 16 * fq) ^ sw);
  P.k[0][0] = lds_rd128<0>(a0); P.k[1][0] = lds_rd128<2048>(a0); P.k[2][0] = lds_rd128<4096>(a0); P.k[3][0] = lds_rd128<6144>(a0);
  P.k[0][1] = lds_rd128<0>(a1); P.k[1][1] = lds_rd128<2048>(a1); P.k[2][1] = lds_rd128<4096>(a1); P.k[3][1] = lds_rd128<6144>(a1);
}
template <int S> __device__ __forceinline__ void prefetch_k16s(KPre16& P, int a0, int a1) {
  P.k[0][0] = lds_rd128<S * SHM_K + 0>(a0); P.k[1][0] = lds_rd128<S * SHM_K + 2048>(a0); P.k[2][0] = lds_rd128<S * SHM_K + 4096>(a0); P.k[3][0] = lds_rd128<S * SHM_K + 6144>(a0);
  P.k[0][1] = lds_rd128<S * SHM_K + 0>(a1); P.k[1][1] = lds_rd128<S * SHM_K + 2048>(a1); P.k[2][1] = lds_rd128<S * SHM_K + 4096>(a1); P.k[3][1] = lds_rd128<S * SHM_K + 6144>(a1);
}
__device__ __forceinline__ float xfq_max(float v) {
  auto r = __builtin_amdgcn_permlane16_swap(__float_as_uint(v), __float_as_uint(v), false, false); v = fmaxf(__uint_as_float(r[0]), __uint_as_float(r[1]));
  auto q = __builtin_amdgcn_permlane32_swap(__float_as_uint(v), __float_as_uint(v), false, false); return fmaxf(__uint_as_float(q[0]), __uint_as_float(q[1]));
}
__device__ __forceinline__ float xfq_sum(float v) {
  auto r = __builtin_amdgcn_permlane16_swap(__float_as_uint(v), __float_as_uint(v), false, false); v = __uint_as_float(r[0]) + __uint_as_float(r[1]);
  auto q = __builtin_amdgcn_permlane32_swap(__float_as_uint(v), __float_as_uint(v), false, false); return __uint_as_float(q[0]) + __uint_as_float(q[1]);
}
template <bool SAFE>
__device__ __forceinline__ void softmax16(f32x4a (&s)[2][4], float (&mhat)[2], bool first, float (&alpha)[2], bf16x8 (&pa)[2][2]) {
  if (SAFE) {
    float lm[2];
#pragma unroll
    for (int qb = 0; qb < 2; ++qb) { float m = fmaxf(s[qb][0][0], s[qb][0][1]);
#pragma unroll
      for (int kb = 0; kb < 4; ++kb)
#pragma unroll
        for (int j = (kb == 0 ? 2 : 0); j < 4; ++j) m = fmaxf(m, s[qb][kb][j]);
      lm[qb] = m; alpha[qb] = 1.f; }
    if (__builtin_expect(first || __any(mhat[0] != 0.f || mhat[1] != 0.f || fmaxf(lm[0], lm[1]) > THR2), 0)) {
#pragma unroll
      for (int qb = 0; qb < 2; ++qb) { const float ex = xfq_max(lm[qb]) - mhat[qb]; float dl = 0.f;
        if (first) { if (ex > THR2 || ex < -THR2) dl = ex; } else if (ex > THR2) dl = ex;
        mhat[qb] += dl;
#pragma unroll
        for (int kb = 0; kb < 4; ++kb) s[qb][kb] -= mhat[qb];
        alpha[qb] = first ? 1.f : __builtin_amdgcn_exp2f(-dl); }
    }
  }
#pragma unroll
  for (int qb = 0; qb < 2; ++qb) {
#pragma unroll
    for (int kb = 0; kb < 4; ++kb)
#pragma unroll
      for (int j = 0; j < 4; ++j) s[qb][kb][j] = __builtin_amdgcn_exp2f(s[qb][kb][j]);
#pragma unroll
    for (int g = 0; g < 2; ++g) { const u32x4 w = {cvtpk(s[qb][2 * g][0], s[qb][2 * g][1]), cvtpk(s[qb][2 * g][2], s[qb][2 * g][3]), cvtpk(s[qb][2 * g + 1][0], s[qb][2 * g + 1][1]), cvtpk(s[qb][2 * g + 1][2], s[qb][2 * g + 1][3])};
      pa[qb][g] = __builtin_bit_cast(bf16x8, w); }
  }
}
#define DA_W16(N) do { asm volatile("s_waitcnt lgkmcnt(" #N ")" ::: "memory"); DA_SBAR(); } while (0)
#define DA_RF16(J) do { vl[(J) & 7] = tr_read<VS * SHM_V + 8192 * ((J) >> 3)>(va[(J) & 7]); vh[(J) & 7] = tr_read<VS * SHM_V + 8192 * ((J) >> 3) + 4096>(va[(J) & 7]); DA_SBAR(); } while (0)
#define DA_PV16(J) do { const bf16x8 vf_ = DA_PK(vl[(J) & 7], vh[(J) & 7]); \
    o[0][(J) & 7] = __builtin_amdgcn_mfma_f32_16x16x32_bf16(vf_, pa[0][(J) >> 3], o[0][(J) & 7], 0, 0, 0); o[1][(J) & 7] = __builtin_amdgcn_mfma_f32_16x16x32_bf16(vf_, pa[1][(J) >> 3], o[1][(J) & 7], 0, 0, 0); } while (0)
struct NoDma16 { __device__ __forceinline__ void operator()() const {} };
template <bool HAS_QK, bool HAS_PV, int VS, class DMA = NoDma16>
__device__ __forceinline__ void m_seg16(f32x4a (&s)[2][4], KPre16& P, const bf16x8 (&qf)[2][2], f32x4a (&o)[2][8], f32x4a (&lacc)[2], const bf16x8& ones, const int (&va)[8], const bf16x8 (&pa)[2][2], DMA dma = NoDma16()) {
  s16x4 vl[8], vh[8];
  __builtin_amdgcn_s_setprio(2);
  if (HAS_QK) {
    const f32x4a z = {0.f, 0.f, 0.f, 0.f};
#define DA_QK16(KB, KS) do { s[0][KB] = __builtin_amdgcn_mfma_f32_16x16x32_bf16(P.k[KB][KS], qf[0][KS], (KS) == 0 ? z : s[0][KB], 0, 0, 0); \
    s[1][KB] = __builtin_amdgcn_mfma_f32_16x16x32_bf16(P.k[KB][KS], qf[1][KS], (KS) == 0 ? z : s[1][KB], 0, 0, 0); } while (0)
    DA_QK16(0, 0); dma(); DA_SBAR(); if (HAS_PV) DA_RF16(0); DA_QK16(1, 0); if (HAS_PV) DA_RF16(1); DA_QK16(2, 0); if (HAS_PV) DA_RF16(2); DA_QK16(3, 0); if (HAS_PV) DA_RF16(3);
    DA_QK16(0, 1); if (HAS_PV) DA_RF16(4); DA_QK16(1, 1); if (HAS_PV) DA_RF16(5); DA_QK16(2, 1); if (HAS_PV) DA_RF16(6); DA_QK16(3, 1); DA_SBAR();
#undef DA_QK16
  } else if (HAS_PV) { DA_RF16(0); DA_RF16(1); DA_RF16(2); DA_RF16(3); DA_RF16(4); DA_RF16(5); DA_RF16(6); }
  if (HAS_PV) {
    lacc[0] = __builtin_amdgcn_mfma_f32_16x16x32_bf16(ones, pa[0][0], lacc[0], 0, 0, 0); lacc[1] = __builtin_amdgcn_mfma_f32_16x16x32_bf16(ones, pa[1][0], lacc[1], 0, 0, 0);
    lacc[0] = __builtin_amdgcn_mfma_f32_16x16x32_bf16(ones, pa[0][1], lacc[0], 0, 0, 0); lacc[1] = __builtin_amdgcn_mfma_f32_16x16x32_bf16(ones, pa[1][1], lacc[1], 0, 0, 0);
    DA_SBAR();
    DA_W16(10); DA_PV16(0); DA_RF16(7);   DA_PV16(1); DA_RF16(8);   DA_W16(10); DA_PV16(2); DA_RF16(9);   DA_PV16(3); DA_RF16(10);
    DA_W16(10); DA_PV16(4); DA_RF16(11);  DA_PV16(5); DA_RF16(12);  DA_W16(10); DA_PV16(6); DA_RF16(13);  DA_PV16(7); DA_RF16(14);
    DA_W16(10); DA_PV16(8); DA_RF16(15);  DA_PV16(9); DA_SBAR();    DA_W16(8); DA_PV16(10); DA_SBAR();   DA_PV16(11); DA_SBAR();
    DA_W16(4); DA_PV16(12); DA_SBAR();    DA_PV16(13); DA_SBAR();    DA_W16(0); DA_PV16(14); DA_SBAR();    DA_PV16(15);
    asm volatile("" : "+v"(o[0][0]), "+v"(o[0][1]), "+v"(o[0][2]), "+v"(o[0][3]), "+v"(o[0][4]), "+v"(o[0][5]), "+v"(o[0][6]), "+v"(o[0][7]));
    asm volatile("" : "+v"(o[1][0]), "+v"(o[1][1]), "+v"(o[1][2]), "+v"(o[1][3]), "+v"(o[1][4]), "+v"(o[1][5]), "+v"(o[1][6]), "+v"(o[1][7]));
    asm volatile("" : "+v"(lacc[0]), "+v"(lacc[1]));
  }
  __builtin_amdgcn_s_setprio(0);
}
#undef DA_W16
#undef DA_RF16
#undef DA_PV16
template <bool SAFE>
__device__ __forceinline__ bool attn_unit16_body(const bf16_t* __restrict__ Qb, const bf16_t* __restrict__ Kh, const bf16_t* __restrict__ Vh, float* Ob, int seq, DA_LAS char* lds,
                                            bool second, float lam, float oscale, const float* __restrict__ subg, bf16_t* __restrict__ AOb) {
  int tid = threadIdx.x; asm volatile("" : "+v"(tid));
  const int wid = __builtin_amdgcn_readfirstlane(tid >> 6), lane = tid & 63, fr = lane & 15, fq = lane >> 4;
  const bool grpA = wid < 4;
  const unsigned lds0 = (unsigned)(size_t)lds;
  const int krow = 8 * wid + (lane >> 3), kpiece = (lane & 7) ^ ((krow >> 1) & 7);
  const unsigned ksrc = (unsigned)(krow * PITCH + kpiece * 8) * 2u;
  const int vr0 = 8 * wid + (lane >> 4), vr1 = vr0 + 4;
  const unsigned vsrc0 = (unsigned)(vr0 * PITCH + (((lane & 15) ^ (((vr0 & 3) << 2) | ((vr0 >> 2) & 3))) * 8)) * 2u;
  const unsigned vsrc1 = (unsigned)(vr1 * PITCH + (((lane & 15) ^ (((vr1 & 3) << 2) | ((vr1 >> 2) & 3))) * 8)) * 2u;
  const unsigned kdst = lds0 + OFF_K + wid * 1024, vdst = lds0 + OFF_V + wid * 2048;
#define DA_DMA_K(t, slot) glds16s(Kh + (long)(t) * KVBLK * PITCH, ksrc, (unsigned)__builtin_amdgcn_readfirstlane(kdst + (slot) * SHM_K))
#define DA_DMA_V(t, slot) do { glds16s(Vh + (long)(t) * KVBLK * PITCH, vsrc0, (unsigned)__builtin_amdgcn_readfirstlane(vdst + (slot) * SHM_V)); \
    glds16s(Vh + (long)(t) * KVBLK * PITCH, vsrc1, (unsigned)__builtin_amdgcn_readfirstlane(vdst + (slot) * SHM_V + 1024)); } while (0)
  const int NT = seq / KVBLK;
  DA_DMA_K(0, 0); DA_DMA_K(1, 1); DA_DMA_V(0, 0);
  float mhat[2] = {0.f, 0.f}, alpha[2] = {1.f, 1.f};
  f32x4a o[2][8] = {}; f32x4a lacc[2] = {}; f32x4a s[2][4] = {}; bf16x8 qf[2][2]; bf16x8 pa[2][2]; KPre16 P;
  bf16x8 ones; { const u32x4 w1 = {0x3f803f80u, 0x3f803f80u, 0x3f803f80u, 0x3f803f80u}; ones = __builtin_bit_cast(bf16x8, w1); asm volatile("" : "+v"(ones)); }
#pragma unroll
  for (int qb = 0; qb < 2; ++qb)
#pragma unroll
    for (int ks = 0; ks < 2; ++ks) qf[qb][ks] = *(const bf16x8*)(Qb + (long)(wid * QBLK + 16 * qb + fr) * PITCH + 32 * ks + 8 * fq);
  int va[8];
  { const int e = fr >> 2, pp = fr & 3, x = (e << 2) | fq;
#pragma unroll
    for (int db = 0; db < 8; ++db) va[db] = (int)(lds0 + OFF_V) + 256 * (4 * fq + e) + 16 * ((2 * db + (pp >> 1)) ^ x) + 8 * (pp & 1); }
  const int ksw = ((fr >> 1) & 7) << 4, ka0 = (int)(lds0 + OFF_K) + fr * 128 + ((16 * fq) ^ ksw), ka1 = (int)(lds0 + OFF_K) + fr * 128 + ((64 + 16 * fq) ^ ksw);
#define DA_PREF_K(slot) prefetch_k16s<slot>(P, ka0, ka1)
#define DA_RESC16() do { if (__any(alpha[0] < 1.f || alpha[1] < 1.f)) { _Pragma("unroll") for (int qb = 0; qb < 2; ++qb) { lacc[qb] *= alpha[qb]; _Pragma("unroll") for (int db = 0; db < 8; ++db) o[qb][db] *= alpha[qb]; } } } while (0)
#define DA_SEG_V(first) do { softmax16<SAFE>(s, mhat, (first), alpha, pa); asm volatile("" : "+v"(pa[0][0]), "+v"(pa[0][1]), "+v"(pa[1][0]), "+v"(pa[1][1])); if (SAFE) DA_RESC16(); } while (0)
  asm volatile("s_waitcnt vmcnt(3)" ::: "memory");
  DA_WAIT_BAR(3);
  int t = 1;
  if (grpA) {
    DA_DMA_K(2, 2); DA_DMA_V(1, 1);
    DA_PREF_K(0); DA_LGKM(0);
    m_seg16<true, false, 0>(s, P, qf, o, lacc, ones, va, pa);
    DA_WAIT_BAR(3);
    DA_PREF_K(1);
    DA_SEG_V(true);
    DA_WAIT_BAR(3);
    m_seg16<true, true, 0>(s, P, qf, o, lacc, ones, va, pa, [&]() { DA_DMA_K(3, 0); });
    DA_WAIT_BAR(3);
#define DA_BODY_A(T, M0, M1, M2) do { \
      DA_PREF_K(M1); \
      DA_SEG_V(false); \
      DA_DMA_V((T) + 1, M1); \
      if ((T) + 2 < NT) DA_WAIT_BAR(3); else DA_WAIT_BAR(2); \
      m_seg16<true, true, M0>(s, P, qf, o, lacc, ones, va, pa, [&]() { if ((T) + 3 < NT) DA_DMA_K((T) + 3, M0); }); \
      if ((T) + 3 < NT) DA_WAIT_BAR(3); else DA_WAIT_BAR(0); } while (0)
#pragma unroll 1
    for (; t + 3 < NT; t += 3) { DA_BODY_A(t, 1, 2, 0); DA_BODY_A(t + 1, 2, 0, 1); DA_BODY_A(t + 2, 0, 1, 2); }
    if (t + 1 < NT) { DA_BODY_A(t, 1, 2, 0); ++t; }
    if (t + 1 < NT) { DA_BODY_A(t, 2, 0, 1); ++t; }
#undef DA_BODY_A
    DA_SEG_V(false);
    DA_WAIT_BAR(0);
  } else {
    DA_DMA_K(2, 2); DA_DMA_V(1, 1);
    DA_PREF_K(0);
    DA_WAIT_BAR(3);
    m_seg16<true, false, 0>(s, P, qf, o, lacc, ones, va, pa);
    DA_WAIT_BAR(3);
    DA_PREF_K(1);
    __builtin_amdgcn_s_setprio(1); DA_SEG_V(true); __builtin_amdgcn_s_setprio(0);
    DA_DMA_V(2, 2);
    DA_WAIT_BAR(2);
#define DA_BODY_B(T, M0, M1, M2) do { \
      m_seg16<true, true, M2>(s, P, qf, o, lacc, ones, va, pa, [&]() { if ((T) + 2 < NT) DA_DMA_K((T) + 2, M2); }); \
      DA_WAIT_BAR(3); \
      DA_PREF_K(M1); \
      __builtin_amdgcn_s_setprio(1); DA_SEG_V(false); __builtin_amdgcn_s_setprio(0); \
      if ((T) + 2 < NT) { DA_DMA_V((T) + 2, M2); DA_WAIT_BAR(2); } else DA_WAIT_BAR(0); } while (0)
#pragma unroll 1
    for (; t + 3 < NT; t += 3) { DA_BODY_B(t, 1, 2, 0); DA_BODY_B(t + 1, 2, 0, 1); DA_BODY_B(t + 2, 0, 1, 2); }
    if (t + 1 < NT) { DA_BODY_B(t, 1, 2, 0); ++t; }
    if (t + 1 < NT) { DA_BODY_B(t, 2, 0, 1); ++t; }
#undef DA_BODY_B
    if ((NT - 2) % 3 == 0) m_seg16<true, true, 0>(s, P, qf, o, lacc, ones, va, pa); else if ((NT - 2) % 3 == 1) m_seg16<true, true, 1>(s, P, qf, o, lacc, ones, va, pa); else m_seg16<true, true, 2>(s, P, qf, o, lacc, ones, va, pa);
    DA_WAIT_BAR(0);
    __builtin_amdgcn_s_setprio(1); DA_SEG_V(false); __builtin_amdgcn_s_setprio(0);
  }
  if ((NT - 1) % 3 == 0) m_seg16<false, true, 0>(s, P, qf, o, lacc, ones, va, pa); else if ((NT - 1) % 3 == 1) m_seg16<false, true, 1>(s, P, qf, o, lacc, ones, va, pa); else m_seg16<false, true, 2>(s, P, qf, o, lacc, ones, va, pa);
  const float lsum[2] = {lacc[0][0], lacc[1][0]};
  int te = threadIdx.x; asm volatile("" : "+v"(te));
  const int wid_e = __builtin_amdgcn_readfirstlane(te >> 6), lane_e = te & 63, fr_e = lane_e & 15, fq_e = lane_e >> 4;
  if (!SAFE) {
    float om = 0.f;
#pragma unroll
    for (int qb = 0; qb < 2; ++qb)
#pragma unroll
      for (int db = 0; db < 8; ++db) om = fmaxf(fmaxf(om, fmaxf(fabsf(o[qb][db][0]), fabsf(o[qb][db][1]))), fmaxf(fabsf(o[qb][db][2]), fabsf(o[qb][db][3])));
#ifdef DA_TEST_FALLBACK
    const bool good = false;
#else
    const bool good = lsum[0] > 0x1p-100f && lsum[0] < 0x1p100f && lsum[1] > 0x1p-100f && lsum[1] < 0x1p100f && om < 0x1p120f;
#endif
    DA_LAS int* fl = (DA_LAS int*)(lds + OFF_WS);
    if (lane_e == 0) fl[wid_e] = __any(!good) ? 1 : 0;
    DA_WAIT_BAR(0);
    int bad = 0;
#pragma unroll
    for (int w = 0; w < NW; ++w) bad |= fl[w];
    if (__builtin_amdgcn_readfirstlane(bad)) { DA_WAIT_BAR(0); return false; }
  }
#pragma unroll
  for (int qb = 0; qb < 2; ++qb) {
    const float rl = __builtin_amdgcn_rcpf(lsum[qb]);
    const long row = wid_e * QBLK + 16 * qb + fr_e;
    if (!second) {
#pragma unroll
      for (int db = 0; db < 8; ++db) *(f32x4a*)(Ob + row * LDO + 16 * db + 4 * fq_e) = o[qb][db] * rl;
    } else {
      f32x4a d[8]; float ss = 0.f;
#pragma unroll
      for (int db = 0; db < 8; ++db) d[db] = *(const f32x4a*)(Ob + row * LDO + 16 * db + 4 * fq_e);
#pragma unroll
      for (int db = 0; db < 8; ++db) { d[db] = d[db] - (o[qb][db] * rl) * lam; ss += (d[db][0] * d[db][0] + d[db][1] * d[db][1]) + (d[db][2] * d[db][2] + d[db][3] * d[db][3]); }
      const float rs = oscale / sqrtf(xfq_sum(ss) * (1.0f / 128.0f) + 1e-5f);
#pragma unroll
      for (int db = 0; db < 8; ++db) { const f32x4a g = *(const f32x4a*)(subg + 16 * db + 4 * fq_e); const f32x4a v = d[db] * g * rs;
        const v2u16 w = {cvtpk(v[0], v[1]), cvtpk(v[2], v[3])}; *(v2u16*)(AOb + row * 1024 + 16 * db + 4 * fq_e) = w; }
    }
  }
  DA_WAIT_BAR(0);
  return true;
#undef DA_DMA_K
#undef DA_DMA_V
#undef DA_PREF_K
#undef DA_RESC16
#undef DA_SEG_V
}
__device__ __forceinline__ void attn_unit16(const bf16_t* __restrict__ Qb, const bf16_t* __restrict__ Kh, const bf16_t* __restrict__ Vh, float* Ob, int seq, DA_LAS char* lds,
                                            bool second, float lam, float oscale, const float* __restrict__ subg, bf16_t* __restrict__ AOb) {
#ifndef DA_FORCE_SAFE
  if (attn_unit16_body<false>(Qb, Kh, Vh, Ob, seq, lds, second, lam, oscale, subg, AOb)) return;
#endif
#ifndef DA_FORCE_FAST
  attn_unit16_body<true>(Qb, Kh, Vh, Ob, seq, lds, second, lam, oscale, subg, AOb);
#endif
}
}

constexpr int NWAVES = 8;
constexpr int SEQ = 16384, DM = 2048, FF = 5632, AW = 1024, NHEAD = 8, FW = 1024, NGRP = 8, GD = 128, DEPTH = 2;
constexpr int NMOD = 9 * DM;
constexpr int KSPLIT = 16;
constexpr float NORM_EPS = 1e-6f, SUBLN_EPS = 1e-5f;

constexpr size_t MiB = 1u << 20;
constexpr size_t WS_CTL = 0, CTL_ZERO_BYTES = 1 * MiB;
constexpr size_t WS_COS = 1 * MiB, WS_SIN = 3 * MiB;
constexpr size_t WS_DFTC = 5 * MiB, WS_DFTS = 5 * MiB + 32768, WS_TW = 5 * MiB + 65536;
constexpr size_t WS_MODP = 6 * MiB;
constexpr size_t WS_MODF = 9 * MiB;
constexpr size_t WS_LAM = WS_MODF + (size_t)DEPTH * 9 * DM * 4;
constexpr size_t WS_W = 10 * MiB, W_LAYER = 180 * MiB;
constexpr size_t W_1IN = 0, W_1OUT = 44 * MiB, W_MIX = 66 * MiB, W_AP = 98 * MiB, W_FP = 102 * MiB, W_MO = 106 * MiB, W_2IN = 114 * MiB, W_2OUT = 158 * MiB;
constexpr size_t WS_H = 370 * MiB, WS_Y = 434 * MiB, WS_ACT = 498 * MiB, WS_M1 = 674 * MiB, WS_O = 802 * MiB, WS_END = 930 * MiB;
constexpr size_t WS_TRE = WS_Y, WS_TIM = WS_Y + 32 * MiB;
constexpr size_t WS_GATE = WS_ACT;
constexpr size_t WS_Q = WS_M1, WS_K = WS_M1 + 32 * MiB, WS_V = WS_M1 + 64 * MiB, WS_U = WS_M1 + 96 * MiB;
constexpr size_t WS_AO = WS_M1, WS_YF = WS_M1 + 32 * MiB, WS_MG = WS_M1 + 64 * MiB;
constexpr size_t WS_TT = WS_O;
constexpr int CW_TMO = 0, CW_CODE = 1, CW_BAR = 4096, CW_CHK = 16384;

constexpr int RING_OFF = 0, PHASE_LDS = 143360;
constexpr int LDSCTL_OFF = PHASE_LDS, MISC_OFF = LDSCTL_OFF + 320;
constexpr int LDS_BYTES = 147456;
static_assert(MISC_OFF + 128 <= LDS_BYTES, "LDS map");

#define GAS __attribute__((address_space(1)))
#define LAS __attribute__((address_space(3)))
typedef unsigned short bf16;
typedef unsigned v4u __attribute__((ext_vector_type(4)));
typedef unsigned v2u __attribute__((ext_vector_type(2)));
typedef float f32x4 __attribute__((ext_vector_type(4)));
typedef float f32x16 __attribute__((ext_vector_type(16)));
typedef short bf16x8 __attribute__((ext_vector_type(8)));
typedef short s16x4 __attribute__((ext_vector_type(4)));
typedef GAS unsigned gu32;
#define RLX_AGENT __ATOMIC_RELAXED, __HIP_MEMORY_SCOPE_AGENT
#define LDS_WAIT() asm volatile("s_waitcnt lgkmcnt(0)" ::: "memory")
#define VM_WAIT() asm volatile("s_waitcnt vmcnt(0)" ::: "memory")
__device__ __forceinline__ unsigned f2bf(float f) { unsigned u = __builtin_bit_cast(unsigned, f); return (u + 0x7fffu + ((u >> 16) & 1u)) >> 16; }
__device__ __forceinline__ unsigned pk2(float lo, float hi) { return f2bf(lo) | (f2bf(hi) << 16); }
__device__ __forceinline__ float bfl(unsigned w) { return __builtin_bit_cast(float, w << 16); }
__device__ __forceinline__ float bfh(unsigned w) { return __builtin_bit_cast(float, w & 0xffff0000u); }
__device__ __forceinline__ float wave_sum(float v) {
#pragma unroll
    for (int o = 1; o < 64; o <<= 1) v += __shfl_xor(v, o);
    return v;
}
__device__ __forceinline__ void sincos_turns(double t, double& s, double& c) {
    t -= floor(t);
    const double q = floor(t * 4.0 + 0.5);
    const double x = (t - q * 0.25) * 6.283185307179586476925286766559;
    const double x2 = x * x;
    double sp = -1.0 / 1307674368000.0; sp = sp * x2 + 1.0 / 6227020800.0; sp = sp * x2 - 1.0 / 39916800.0; sp = sp * x2 + 1.0 / 362880.0; sp = sp * x2 - 1.0 / 5040.0; sp = sp * x2 + 1.0 / 120.0; sp = sp * x2 - 1.0 / 6.0; sp = sp * x2 + 1.0;
    const double sx = sp * x;
    double cp = 1.0 / 20922789888000.0; cp = cp * x2 - 1.0 / 87178291200.0; cp = cp * x2 + 1.0 / 479001600.0; cp = cp * x2 - 1.0 / 3628800.0; cp = cp * x2 + 1.0 / 40320.0; cp = cp * x2 - 1.0 / 720.0; cp = cp * x2 + 1.0 / 24.0; cp = cp * x2 - 0.5; cp = cp * x2 + 1.0;
    const int qi = ((int)q) & 3;
    s = (qi == 0) ? sx : (qi == 1) ? cp : (qi == 2) ? -sx : -cp;
    c = (qi == 0) ? cp : (qi == 1) ? -sx : (qi == 2) ? -cp : sx;
}
__constant__ float ROPE_INV_FREQ[32] = {1.f,0.749894261f,0.562341332f,0.421696514f,0.316227764f,0.237137377f,0.177827939f,0.133352131f,0.100000001f,0.0749894157f,0.0562341325f,0.0421696529f,0.0316227749f,0.0237137377f,0.0177827943f,0.0133352149f,0.00999999978f,0.00749894185f,0.00562341325f,0.00421696482f,0.00316227763f,0.00237137359f,0.00177827943f,0.00133352145f,0.00100000005f,0.000749894243f,0.000562341302f,0.000421696517f,0.000316227757f,0.00023713737f,0.00017782794f,0.00013335215f};

#define XB_TMO      128
#define XB_XCNT(j)  (256  + 64 * (j))
#define XB_XSUB(j)  (1280 + 64 * (j))
#define XB_XGEN(j)  (2304 + 64 * (j))
#define XB_TOP      3328
#define XB_TOPGEN   3392
#define XCD_BAR_WORDS 3456
#define XB_SPIN_CAP (1u << 21)

__device__ __forceinline__ unsigned xb_ld(unsigned* p)              { return __hip_atomic_load(p, __ATOMIC_RELAXED, __HIP_MEMORY_SCOPE_AGENT); }
__device__ __forceinline__ unsigned xb_add(unsigned* p, unsigned v) { return __hip_atomic_fetch_add(p, v, __ATOMIC_RELAXED, __HIP_MEMORY_SCOPE_AGENT); }
__device__ __forceinline__ unsigned xb_xcc_id() { return (unsigned)__builtin_amdgcn_s_getreg((3 << 11) | 20) & 0xFu; }
#define XB_SPIN(cond, bar) do { unsigned _sp = 0; while (cond) { __builtin_amdgcn_s_sleep(1); \
    if ((++_sp & 255u) == 0u) { if (xb_ld(&(bar)[XB_TMO])) break; if (_sp > XB_SPIN_CAP) { atomicAdd(&(bar)[XB_TMO], 1u); break; } } } } while (0)

struct XcdBarrier {
    unsigned* bar; unsigned x;
    volatile LAS unsigned* st;
};

__device__ __forceinline__ XcdBarrier xcd_barrier_post(unsigned* bar, volatile LAS unsigned* st) {
    XcdBarrier b; b.bar = bar; b.x = xb_xcc_id(); b.st = st;
    if (threadIdx.x == 0) (void)xb_add(&bar[XB_XCNT(b.x)], 1u);
    return b;
}
__device__ __forceinline__ void xcd_barrier_complete(unsigned* bar, unsigned x, unsigned& nloc, unsigned& nx) {
    const unsigned G = gridDim.x * gridDim.y * gridDim.z;
    unsigned sum, cnt, mine, sp = 0u;
    for (;;) {
        sum = 0u; cnt = 0u; mine = 0u;
#pragma unroll
        for (unsigned j = 0; j < 16; ++j) { const unsigned c = xb_ld(&bar[XB_XCNT(j)]); sum += c; cnt += (c > 0u) ? 1u : 0u; mine = (j == x) ? c : mine; }
        if (sum == G) break;
        __builtin_amdgcn_s_sleep(1);
        if ((++sp & 255u) == 0u) { if (xb_ld(&bar[XB_TMO])) break; if (sp > XB_SPIN_CAP) { atomicAdd(&bar[XB_TMO], 1u); break; } }
    }
    nloc = mine > 0u ? mine : 1u; nx = cnt > 0u ? cnt : 1u;
}

__device__ __forceinline__ void xcd_barrier(const XcdBarrier& b) {
    asm volatile("s_waitcnt vmcnt(0)" ::: "memory");
    __syncthreads();
    if (threadIdx.x == 0) {
        unsigned* bar = b.bar; unsigned bx = b.x; asm volatile("" : "+s"(bx));
        __builtin_amdgcn_s_waitcnt(0);
        unsigned nloc = b.st[0], nx = b.st[1];
        if (nloc == 0u) { xcd_barrier_complete(bar, bx, nloc, nx); b.st[0] = nloc; b.st[1] = nx; }
        const unsigned old = xb_add(&bar[XB_XSUB(bx)], 1u);
        const unsigned gen = old / nloc;
        if (old + 1u == (gen + 1u) * nloc) {
            __builtin_amdgcn_fence(__ATOMIC_RELEASE, "agent");
            asm volatile("s_waitcnt vmcnt(0)" ::: "memory");
            const unsigned og = xb_add(&bar[XB_TOP], 1u);
            const unsigned tg = og / nx;
            if (og + 1u == (tg + 1u) * nx) xb_add(&bar[XB_TOPGEN], 1u);
            else XB_SPIN(xb_ld(&bar[XB_TOPGEN]) == tg, bar);
            __builtin_amdgcn_fence(__ATOMIC_ACQUIRE, "agent");
            xb_add(&bar[XB_XGEN(bx)], 1u);
            asm volatile("s_waitcnt vmcnt(0)" ::: "memory");
        } else {
            XB_SPIN(xb_ld(&bar[XB_XGEN(bx)]) == gen, bar);
            __builtin_amdgcn_fence(__ATOMIC_ACQUIRE, "agent");
            asm volatile("s_waitcnt vmcnt(0)" ::: "memory");
        }
    }
    __syncthreads();
}
struct Frame {
    LAS unsigned char* lds;
    volatile LAS unsigned* MISC;
    gu32* ctl;
    int tid, lane, wave;
    int vcu, G;
    unsigned char* ws;
};

__device__ __forceinline__ int wt_row(int mode, int row_off, int n0) {
    if (mode == 1) { const int up = n0 >= FF ? 1 : 0, j = n0 - up * FF; return (j >> 7) * 256 + up * 128 + (j & 127); }
    if (mode == 2) { if (n0 < 2048) { const int ch = n0 >> 6, d = n0 & 63; return 256 * (ch >> 2) + 128 * (d >> 5) + 32 * (ch & 3) + (d & 31); } return n0; }
    return row_off + n0;
}
__device__ __forceinline__ void p0_transpose_item(const float* W, int K, int N, bf16* WT, int mode, int row_off, LAS float* scr, int item, int lane) {
    const int nblk = N / 32, kb = item / nblk, nb = item % nblk, k0 = 64 * kb, n0 = 32 * nb;
#pragma unroll 8
    for (int i = 0; i < 32; ++i) { const int kk = 2 * i + (lane >> 5); scr[kk * 33 + (lane & 31)] = W[(size_t)(k0 + kk) * N + n0 + (lane & 31)]; }
    LDS_WAIT(); asm volatile("" ::: "memory");
    const int c = lane & 7, rbase = wt_row(mode, row_off, n0);
#pragma unroll
    for (int j = 0; j < 4; ++j) { const int n = (lane >> 3) + 8 * j; const LAS float* s = scr + (8 * c) * 33 + n;
        v4u o; o.x = pk2(s[0 * 33], s[1 * 33]); o.y = pk2(s[2 * 33], s[3 * 33]); o.z = pk2(s[4 * 33], s[5 * 33]); o.w = pk2(s[6 * 33], s[7 * 33]);
        *(GAS v4u*)(WT + (size_t)(rbase + n) * K + k0 + 8 * c) = o; }
    LDS_WAIT(); asm volatile("" ::: "memory");
}
struct In18 { const float* p[18]; };
__device__ __forceinline__ void p0_prologue(Frame& F, const In18& in) {
    LAS float* scr = (LAS float*)(F.lds + RING_OFF + F.wave * 16384);
    const int gw = F.vcu * NWAVES + F.wave, NGW = F.G * NWAVES;
    constexpr int I0 = 32 * 352, I1 = 88 * 64, I2 = 32 * 128, I3 = 32 * 128, I4 = 16 * 64, I5 = 16 * 64, I6 = 32 * 64, IL = 2 * I0 + 2 * I1 + I2 + I3 + I4 + I5 + I6;
    for (int it = gw; it < DEPTH * IL; it += NGW) {
        const int l = it / IL; int r = it % IL;
        bf16* wl = (bf16*)(F.ws + WS_W + (size_t)l * W_LAYER);
        if (r < I0) { p0_transpose_item(in.p[6] + (size_t)l * DM * 2 * FF, DM, 2 * FF, (bf16*)((unsigned char*)wl + W_1IN), 1, 0, scr, r, F.lane); continue; } r -= I0;
        if (r < I1) { p0_transpose_item(in.p[7] + (size_t)l * FF * DM, FF, DM, (bf16*)((unsigned char*)wl + W_1OUT), 0, 0, scr, r, F.lane); continue; } r -= I1;
        if (r < I2) { p0_transpose_item(in.p[8] + (size_t)l * DM * 4096, DM, 4096, (bf16*)((unsigned char*)wl + W_MIX), 2, 0, scr, r, F.lane); continue; } r -= I2;
        if (r < I3) { p0_transpose_item(in.p[13] + (size_t)l * DM * 4096, DM, 4096, (bf16*)((unsigned char*)wl + W_MIX), 0, 4096, scr, r, F.lane); continue; } r -= I3;
        if (r < I4) { p0_transpose_item(in.p[11] + (size_t)l * AW * DM, AW, DM, (bf16*)((unsigned char*)wl + W_AP), 0, 0, scr, r, F.lane); continue; } r -= I4;
        if (r < I5) { p0_transpose_item(in.p[12] + (size_t)l * FW * DM, FW, DM, (bf16*)((unsigned char*)wl + W_FP), 0, 0, scr, r, F.lane); continue; } r -= I5;
        if (r < I6) { p0_transpose_item(in.p[15] + (size_t)l * DM * DM, DM, DM, (bf16*)((unsigned char*)wl + W_MO), 0, 0, scr, r, F.lane); continue; } r -= I6;
        if (r < I0) { p0_transpose_item(in.p[16] + (size_t)l * DM * 2 * FF, DM, 2 * FF, (bf16*)((unsigned char*)wl + W_2IN), 1, 0, scr, r, F.lane); continue; } r -= I0;
        p0_transpose_item(in.p[17] + (size_t)l * FF * DM, FF, DM, (bf16*)((unsigned char*)wl + W_2OUT), 0, 0, scr, r, F.lane);
    }
    {
        constexpr int NCB = NMOD / 256, KR = DM / KSPLIT;
        const float* cvec = in.p[1]; float* modp = (float*)(F.ws + WS_MODP);
        for (int it = gw; it < DEPTH * NCB * KSPLIT; it += NGW) {
            const int l = it / (NCB * KSPLIT), r = it % (NCB * KSPLIT), ks = r / NCB, cb = r % NCB, c0 = cb * 256 + 4 * F.lane, k0 = ks * KR;
            const float* W = in.p[2] + (size_t)l * DM * NMOD + (size_t)k0 * NMOD + c0;
            f32x4 acc = {0.f, 0.f, 0.f, 0.f};
#pragma unroll 8
            for (int k = 0; k < KR; ++k) { const float cv = cvec[k0 + k]; const float ca = cv * __builtin_amdgcn_rcpf(1.0f + __builtin_amdgcn_exp2f(cv * -1.4426950408889634f));
                const f32x4 w = *(const GAS f32x4*)(W + (size_t)k * NMOD); acc += w * ca; }
            *(GAS f32x4*)(modp + (size_t)(l * KSPLIT + ks) * NMOD + c0) = acc;
        }
    }
    {
        const int gt = F.vcu * (NWAVES * 64) + F.tid, NT = F.G * NWAVES * 64;
        float* cosT = (float*)(F.ws + WS_COS); float* sinT = (float*)(F.ws + WS_SIN);
        for (int idx = gt; idx < SEQ * 32; idx += NT) { const int pos = idx >> 5, i = idx & 31; const float ang = (float)pos * ROPE_INV_FREQ[i];
            double s, c; sincos_turns((double)ang * 0.15915494309189533576888376337251, s, c); cosT[idx] = (float)c; sinT[idx] = (float)s; }
        bf16* dC = (bf16*)(F.ws + WS_DFTC); bf16* dS = (bf16*)(F.ws + WS_DFTS); float* tw = (float*)(F.ws + WS_TW);
        for (int idx = gt; idx < 128 * 128; idx += NT) { const int a = idx >> 7, b = idx & 127; double s, c;
            sincos_turns((double)((a * b) & 127) * (1.0 / 128.0), s, c); dC[idx] = (bf16)f2bf((float)c); dS[idx] = (bf16)f2bf((float)s);
            sincos_turns((double)(a * b) * (1.0 / 16384.0), s, c); tw[2 * idx] = (float)c; tw[2 * idx + 1] = (float)s; }
    }
}
__device__ __forceinline__ void p1_modfin(Frame& F, const In18& in) {
    const int gt = F.vcu * (NWAVES * 64) + F.tid, NT = F.G * NWAVES * 64;
    const float* modp = (const float*)(F.ws + WS_MODP); float* modf = (float*)(F.ws + WS_MODF);
    for (int idx = gt; idx < DEPTH * 3 * DM; idx += NT) { const int l = idx / (3 * DM), s = (idx / DM) % 3, c = idx % DM, base = s * 3 * DM + c;
        float sh = in.p[3][l * NMOD + base], sc = in.p[3][l * NMOD + base + DM], gt_ = in.p[3][l * NMOD + base + 2 * DM];
        for (int ks = 0; ks < KSPLIT; ++ks) { const float* q = modp + (size_t)(l * KSPLIT + ks) * NMOD + base; sh += q[0]; sc += q[DM]; gt_ += q[2 * DM]; }
        const float gpre = in.p[4][(l * 3 + s) * DM + c], gpost = in.p[5][(l * 3 + s) * DM + c];
        float* o = modf + (size_t)((l * 3 + s) * 3) * DM + c;
        o[0] = gpre * (1.0f + sc); o[DM] = sh; o[2 * DM] = (s == 1 ? 1.0f : 0.5f) * gt_ * gpost; }
    if (blockIdx.x == 0 && F.wave < DEPTH) { const int l = F.wave; const float* lq = in.p[9] + l * 256;
        const float sa = wave_sum(lq[F.lane] * lq[64 + F.lane]), sb = wave_sum(lq[128 + F.lane] * lq[192 + F.lane]);
        const float linit = l == 0 ? 0.2f : 0.35550906758f;
        if (F.lane == 0) { float* lamv = (float*)(F.ws + WS_LAM); lamv[l] = __builtin_amdgcn_exp2f(sa * 1.4426950408889634f) - __builtin_amdgcn_exp2f(sb * 1.4426950408889634f) + linit; lamv[2 + l] = 1.0f - linit; } }
}
template <bool HAS_Y, bool HAS_H>
__device__ __forceinline__ void norm_phase(Frame& F, const float* xin, float* xout, const bf16* y, bf16* h, const float* Gv, const float* Av, const float* Bv) {
    int lane = F.lane; asm volatile("" : "+v"(lane));
    const int gw = F.vcu * NWAVES + F.wave, NGW = F.G * NWAVES;
    f32x4 g[8], a[8], b[8];
#pragma unroll
    for (int j = 0; j < 8; ++j) { if (HAS_Y) g[j] = *(const GAS f32x4*)(Gv + 4 * lane + 256 * j); if (HAS_H) { a[j] = *(const GAS f32x4*)(Av + 4 * lane + 256 * j); b[j] = *(const GAS f32x4*)(Bv + 4 * lane + 256 * j); } }
    for (int row = gw; row < SEQ; row += NGW) {
        f32x4 x[8];
#pragma unroll
        for (int j = 0; j < 8; ++j) x[j] = __builtin_nontemporal_load((const GAS f32x4*)(xin + (size_t)row * DM + 4 * lane + 256 * j));
        if (HAS_Y) {
            f32x4 yv[8]; float ss = 0.f;
#pragma unroll
            for (int j = 0; j < 8; ++j) { const v2u w = *(const GAS v2u*)(y + (size_t)row * DM + 4 * lane + 256 * j); yv[j] = (f32x4){bfl(w.x), bfh(w.x), bfl(w.y), bfh(w.y)};
                ss += (yv[j].x * yv[j].x + yv[j].y * yv[j].y) + (yv[j].z * yv[j].z + yv[j].w * yv[j].w); }
            const float ry = 1.0f / sqrtf(wave_sum(ss) * (1.0f / DM) + NORM_EPS);
#pragma unroll
            for (int j = 0; j < 8; ++j) x[j] = x[j] + g[j] * yv[j] * ry;
        }
        if (HAS_Y) {
#pragma unroll
            for (int j = 0; j < 8; ++j) __builtin_nontemporal_store(x[j], (GAS f32x4*)(xout + (size_t)row * DM + 4 * lane + 256 * j));
        }
        if (HAS_H) {
            float ss = 0.f;
#pragma unroll
            for (int j = 0; j < 8; ++j) ss += (x[j].x * x[j].x + x[j].y * x[j].y) + (x[j].z * x[j].z + x[j].w * x[j].w);
            const float rx = 1.0f / sqrtf(wave_sum(ss) * (1.0f / DM) + NORM_EPS);
#pragma unroll
            for (int j = 0; j < 8; ++j) { const f32x4 v = x[j] * rx * a[j] + b[j]; v2u w; w.x = pk2(v.x, v.y); w.y = pk2(v.z, v.w); *(GAS v2u*)(h + (size_t)row * DM + 4 * lane + 256 * j) = w; }
        }
    }
}
__device__ __forceinline__ void combine_phase(Frame& F, const float* O, bf16* AO, const float* subg, float lam, float oscale) {
    int lane = F.lane; asm volatile("" : "+v"(lane));
    const int gw = F.vcu * NWAVES + F.wave, NGW = F.G * NWAVES, hh = lane >> 3, e0 = (lane & 7) * 16;
    f32x4 g[4];
#pragma unroll
    for (int j = 0; j < 4; ++j) g[j] = *(const GAS f32x4*)(subg + e0 + 4 * j) * oscale;
    for (int row = gw; row < SEQ; row += NGW) {
        const float* p0 = O + (size_t)row * 2048 + hh * 256 + e0;
        f32x4 o[4]; float ss = 0.f;
#pragma unroll
        for (int j = 0; j < 4; ++j) { const f32x4 a = *(const GAS f32x4*)(p0 + 4 * j), b = *(const GAS f32x4*)(p0 + 128 + 4 * j); o[j] = a - b * lam; ss += (o[j].x * o[j].x + o[j].y * o[j].y) + (o[j].z * o[j].z + o[j].w * o[j].w); }
        ss += __shfl_xor(ss, 1); ss += __shfl_xor(ss, 2); ss += __shfl_xor(ss, 4);
        const float r = 1.0f / sqrtf(ss * (1.0f / 128.0f) + SUBLN_EPS);
        v4u w0, w1; { const f32x4 v0 = o[0] * r * g[0], v1 = o[1] * r * g[1], v2 = o[2] * r * g[2], v3 = o[3] * r * g[3];
            w0.x = pk2(v0.x, v0.y); w0.y = pk2(v0.z, v0.w); w0.z = pk2(v1.x, v1.y); w0.w = pk2(v1.z, v1.w); w1.x = pk2(v2.x, v2.y); w1.y = pk2(v2.z, v2.w); w1.z = pk2(v3.x, v3.y); w1.w = pk2(v3.z, v3.w); }
        bf16* op = AO + (size_t)row * 1024 + hh * 128 + e0;
        *(GAS v4u*)op = w0; *(GAS v4u*)(op + 8) = w1;
    }
}
template <int DD> __device__ __forceinline__ void fft_mm2(f32x16& aR, f32x16& aI, int vb, const bf16x8* Ca, const bf16x8* Sa) {
    using namespace dattn;
    const s16x4 l0 = tr_read<v_rd_off(DD, 0, 0)>(vb), h0 = tr_read<v_rd_off(DD, 0, 1)>(vb), l1 = tr_read<v_rd_off(DD, 1, 0)>(vb), h1 = tr_read<v_rd_off(DD, 1, 1)>(vb);
    const s16x4 l2 = tr_read<v_rd_off(DD, 2, 0)>(vb), h2 = tr_read<v_rd_off(DD, 2, 1)>(vb), l3 = tr_read<v_rd_off(DD, 3, 0)>(vb), h3 = tr_read<v_rd_off(DD, 3, 1)>(vb);
    asm volatile("s_waitcnt lgkmcnt(0)" ::: "memory"); __builtin_amdgcn_sched_barrier(0);
    const bf16x8 b0 = DA_PK(l0, h0), b1 = DA_PK(l1, h1), b2 = DA_PK(l2, h2), b3 = DA_PK(l3, h3);
    aR = __builtin_amdgcn_mfma_f32_32x32x16_bf16(Ca[0], b0, aR, 0, 0, 0); aI = __builtin_amdgcn_mfma_f32_32x32x16_bf16(Sa[0], b0, aI, 0, 0, 0);
    aR = __builtin_amdgcn_mfma_f32_32x32x16_bf16(Ca[1], b1, aR, 0, 0, 0); aI = __builtin_amdgcn_mfma_f32_32x32x16_bf16(Sa[1], b1, aI, 0, 0, 0);
    aR = __builtin_amdgcn_mfma_f32_32x32x16_bf16(Ca[2], b2, aR, 0, 0, 0); aI = __builtin_amdgcn_mfma_f32_32x32x16_bf16(Sa[2], b2, aI, 0, 0, 0);
    aR = __builtin_amdgcn_mfma_f32_32x32x16_bf16(Ca[3], b3, aR, 0, 0, 0); aI = __builtin_amdgcn_mfma_f32_32x32x16_bf16(Sa[3], b3, aI, 0, 0, 0);
}
__device__ __forceinline__ void fftA_phase(Frame& F, const bf16* U, bf16* TRE, bf16* TIM, const bf16* dftC, const bf16* dftS, const float* TW) {
    using namespace dattn;
    int tid = threadIdx.x; asm volatile("" : "+v"(tid));
    const int wid = __builtin_amdgcn_readfirstlane(tid >> 6), lane = tid & 63, r32 = lane & 31, hi = lane >> 5, kb = wid & 3, ch = wid >> 2;
    bf16x8 Cf[8], Sf[8];
#pragma unroll
    for (int i = 0; i < 8; ++i) { Cf[i] = *(const bf16x8*)(dftC + (32 * kb + r32) * 128 + 16 * i + 8 * hi); Sf[i] = *(const bf16x8*)(dftS + (32 * kb + r32) * 128 + 16 * i + 8 * hi); }
    const int sr = tid >> 4, sc = (tid & 15) * 8, vst0 = v_st(sr, sc), vst1 = v_st(32 + sr, sc);
    LAS unsigned char* L = F.lds + RING_OFF;
    const int vb = (int)(unsigned)(size_t)L + v_rd_base(lane) + ch * 1024;
    for (int unit = F.vcu; unit < 128 * NGRP; unit += F.G) {
        const int n2 = unit >> 3, g = unit & 7;
        const bf16* src = U + (size_t)n2 * 1024 + g * 128 + sc;
        const bf16x8 x0 = *(const bf16x8*)(src + (size_t)sr * 131072), x1 = *(const bf16x8*)(src + (size_t)(32 + sr) * 131072), x2 = *(const bf16x8*)(src + (size_t)(64 + sr) * 131072), x3 = *(const bf16x8*)(src + (size_t)(96 + sr) * 131072);
        *(LAS bf16x8*)(L + vst0) = x0; *(LAS bf16x8*)(L + vst1) = x1; *(LAS bf16x8*)(L + 16384 + vst0) = x2; *(LAS bf16x8*)(L + 16384 + vst1) = x3;
        LDS_WAIT(); __syncthreads();
        f32x16 PR[2] = {}, PI[2] = {};
        fft_mm2<0>(PR[0], PI[0], vb, Cf, Sf); fft_mm2<1>(PR[1], PI[1], vb, Cf, Sf);
        fft_mm2<0>(PR[0], PI[0], vb + 16384, Cf + 4, Sf + 4); fft_mm2<1>(PR[1], PI[1], vb + 16384, Cf + 4, Sf + 4);
        LDS_WAIT(); __syncthreads();
        const float* tw = TW + (size_t)(n2 * 128 + 32 * kb + 4 * hi) * 2;
#pragma unroll
        for (int rg = 0; rg < 4; ++rg) { const f32x4 t0 = *(const GAS f32x4*)(tw + 16 * rg), t1 = *(const GAS f32x4*)(tw + 16 * rg + 4);
            const float cc[4] = {t0.x, t0.z, t1.x, t1.z}, ss[4] = {t0.y, t0.w, t1.y, t1.w};
#pragma unroll
            for (int e = 0; e < 4; ++e) { const int r = 4 * rg + e, k1 = 32 * kb + 8 * rg + 4 * hi + e; const size_t rowo = (size_t)(k1 * 128 + n2) * 1024 + g * 128 + 64 * ch + r32;
#pragma unroll
                for (int dd = 0; dd < 2; ++dd) { const float pr = PR[dd][r], pi = PI[dd][r]; TRE[rowo + 32 * dd] = (bf16)f2bf(pr * cc[e] - pi * ss[e]); TIM[rowo + 32 * dd] = (bf16)f2bf(-(pr * ss[e] + pi * cc[e])); } } }
    }
}
__device__ __forceinline__ void fftB_phase(Frame& F, const bf16* TRE, const bf16* TIM, bf16* YF, const bf16* dftC, const bf16* dftS) {
    using namespace dattn;
    constexpr int WSTR = 272, OFF_WR = 65536, OFF_WI = 65536 + 128 * WSTR;
    constexpr float NORMF = 6.905339660024878e-4f;
    int tid = threadIdx.x; asm volatile("" : "+v"(tid));
    const int wid = __builtin_amdgcn_readfirstlane(tid >> 6), lane = tid & 63, r32 = lane & 31, hi = lane >> 5, kb = wid & 3, ch = wid >> 2;
    bf16x8 Cf[8], Sf[8];
#pragma unroll
    for (int i = 0; i < 8; ++i) { Cf[i] = *(const bf16x8*)(dftC + (32 * kb + r32) * 128 + 16 * i + 8 * hi); Sf[i] = *(const bf16x8*)(dftS + (32 * kb + r32) * 128 + 16 * i + 8 * hi); }
    const int sr = tid >> 4, sc = (tid & 15) * 8, vst0 = v_st(sr, sc), vst1 = v_st(32 + sr, sc);
    LAS unsigned char* L = F.lds + RING_OFF;
    const int vb = (int)(unsigned)(size_t)L + v_rd_base(lane) + ch * 1024;
    for (int unit = F.vcu; unit < 128 * NGRP; unit += F.G) {
        const int k1 = unit >> 3, g = unit & 7;
        const size_t so = (size_t)(k1 * 128) * 1024 + g * 128 + sc;
        bf16x8 zr[4], zi[4];
#pragma unroll
        for (int q = 0; q < 4; ++q) { zr[q] = *(const bf16x8*)(TRE + so + (size_t)(32 * q + sr) * 1024); zi[q] = *(const bf16x8*)(TIM + so + (size_t)(32 * q + sr) * 1024); }
        *(LAS bf16x8*)(L + vst0) = zr[0]; *(LAS bf16x8*)(L + vst1) = zr[1]; *(LAS bf16x8*)(L + 16384 + vst0) = zr[2]; *(LAS bf16x8*)(L + 16384 + vst1) = zr[3];
        *(LAS bf16x8*)(L + 32768 + vst0) = zi[0]; *(LAS bf16x8*)(L + 32768 + vst1) = zi[1]; *(LAS bf16x8*)(L + 49152 + vst0) = zi[2]; *(LAS bf16x8*)(L + 49152 + vst1) = zi[3];
        LDS_WAIT(); __syncthreads();
        f32x16 WR[2] = {}, WI[2] = {}, WX[2] = {};
        fft_mm2<0>(WR[0], WX[0], vb, Cf, Sf); fft_mm2<1>(WR[1], WX[1], vb, Cf, Sf);
        fft_mm2<0>(WR[0], WX[0], vb + 16384, Cf + 4, Sf + 4); fft_mm2<1>(WR[1], WX[1], vb + 16384, Cf + 4, Sf + 4);
        fft_mm2<0>(WI[0], WR[0], vb + 32768, Cf, Sf); fft_mm2<1>(WI[1], WR[1], vb + 32768, Cf, Sf);
        fft_mm2<0>(WI[0], WR[0], vb + 49152, Cf + 4, Sf + 4); fft_mm2<1>(WI[1], WR[1], vb + 49152, Cf + 4, Sf + 4);
        WI[0] -= WX[0]; WI[1] -= WX[1];
#pragma unroll
        for (int dd = 0; dd < 2; ++dd)
#pragma unroll
            for (int r = 0; r < 16; ++r) { const int k2 = 32 * kb + crow(r, hi), j = 64 * ch + 32 * dd + r32;
                *(LAS unsigned short*)(L + OFF_WR + k2 * WSTR + j * 2) = (unsigned short)f2bf(WR[dd][r]); *(LAS unsigned short*)(L + OFF_WI + k2 * WSTR + j * 2) = (unsigned short)f2bf(WI[dd][r]); }
        LDS_WAIT(); __syncthreads();
        f32x16 Y[2] = {};
#pragma unroll
        for (int kk = 0; kk < 2; ++kk) { const int rb = (64 * ch + 32 * kk + r32) * WSTR + 16 * hi;
#pragma unroll
            for (int jc = 0; jc < 8; ++jc) { const bf16x8 aR = *(const LAS bf16x8*)(L + OFF_WR + rb + 32 * jc), aI = *(const LAS bf16x8*)(L + OFF_WI + rb + 32 * jc);
                Y[kk] = __builtin_amdgcn_mfma_f32_32x32x16_bf16(aR, Cf[jc], Y[kk], 0, 0, 0); Y[kk] = __builtin_amdgcn_mfma_f32_32x32x16_bf16(aI, Sf[jc], Y[kk], 0, 0, 0); } }
#pragma unroll
        for (int kk = 0; kk < 2; ++kk)
#pragma unroll
            for (int r = 0; r < 16; ++r) { const int k2 = 64 * ch + 32 * kk + crow(r, hi); YF[(size_t)(k1 + 128 * k2) * 1024 + g * 128 + 32 * kb + r32] = (bf16)f2bf(Y[kk][r] * NORMF); }
    }
}
#ifndef PHMASK
#define PHMASK 0xffffffffu
#endif
#define PH(k) (((PHMASK) >> (k)) & 1u)
#ifndef PHREPM
#define PHREPM 0u
#endif
#define REP(k) _Pragma("unroll 1") for (int rep_ = 0; rep_ < (int)(1u + (((PHREPM) >> (k)) & 1u)); ++rep_)
struct Args { const float* in[18]; float* out; unsigned char* ws; };
__global__ void __launch_bounds__(NWAVES * 64, 2) enc_fwd(Args args) {
    extern __shared__ __attribute__((aligned(16))) unsigned char lds[];
    Frame F;
    F.lds = (LAS unsigned char*)lds;
    F.MISC = (volatile LAS unsigned*)(F.lds + MISC_OFF);
    F.tid = threadIdx.x; F.lane = F.tid & 63; F.wave = __builtin_amdgcn_readfirstlane(F.tid >> 6);
    F.G = gridDim.x; { const int bx = blockIdx.x; F.vcu = (F.G % 8 == 0) ? (bx % 8) * (F.G / 8) + bx / 8 : bx; }
    F.ws = args.ws;
    unsigned char* ws = args.ws;
    F.ctl = (gu32*)(ws + WS_CTL);
    In18 in;
#pragma unroll
    for (int i = 0; i < 18; ++i) in.p[i] = args.in[i];
    for (int u = F.tid; u < (LDS_BYTES - LDSCTL_OFF) / 4; u += NWAVES * 64) ((LAS unsigned*)(F.lds + LDSCTL_OFF))[u] = 0u;
    __syncthreads();
    XcdBarrier bar = xcd_barrier_post((unsigned*)(F.ctl + CW_BAR), F.MISC + 8);
#ifdef PROBE_BAR
    unsigned long long bar_ticks = 0ull;
#ifndef PROBE_BARSEL
#define PROBE_BARSEL 0xffffffffu
#endif
    int bar_ord = 0;
#define GRID_BAR() do { const unsigned long long w0_ = wall_clock64(); xcd_barrier(bar); if (((PROBE_BARSEL) >> bar_ord) & 1u) bar_ticks += wall_clock64() - w0_; ++bar_ord; } while (0)
#else
#define GRID_BAR() xcd_barrier(bar)
#endif

    float* const xres = args.out;
    bf16* const HB = (bf16*)(ws + WS_H); bf16* const YB = (bf16*)(ws + WS_Y); bf16* const ACT = (bf16*)(ws + WS_ACT);
    bf16* const QB = (bf16*)(ws + WS_Q); bf16* const KB = (bf16*)(ws + WS_K); bf16* const VB = (bf16*)(ws + WS_V); bf16* const UB = (bf16*)(ws + WS_U);
    bf16* const GB = (bf16*)(ws + WS_GATE); float* const OB = (float*)(ws + WS_O);
    bf16* const TRE = (bf16*)(ws + WS_TRE); bf16* const TIM = (bf16*)(ws + WS_TIM);
    bf16* const YF = (bf16*)(ws + WS_YF); bf16* const AO = (bf16*)(ws + WS_AO); bf16* const MG = (bf16*)(ws + WS_MG); bf16* const TT = (bf16*)(ws + WS_TT);
    const float* const modf = (const float*)(ws + WS_MODF); const float* const lamv = (const float*)(ws + WS_LAM);
    const float* const cosT = (const float*)(ws + WS_COS); const float* const sinT = (const float*)(ws + WS_SIN);
    const bf16* const dftC = (const bf16*)(ws + WS_DFTC); const bf16* const dftS = (const bf16*)(ws + WS_DFTS); const float* const TW = (const float*)(ws + WS_TW);
#define MODF(l, s, k) (modf + (size_t)(((l) * 3 + (s)) * 3 + (k)) * DM)

    REP(0) if (PH(0)) p0_prologue(F, in);
    GRID_BAR();
    REP(1) if (PH(1)) p1_modfin(F, in);
    GRID_BAR();
    REP(2) if (PH(2)) norm_phase<false, true>(F, in.p[0], nullptr, nullptr, HB, nullptr, MODF(0, 0, 0), MODF(0, 0, 1));
#ifdef PROBE_NORM2
    for (int q_ = 0; q_ < 4; ++q_) norm_phase<false, true>(F, in.p[0], xres, nullptr, HB, nullptr, MODF(0, 0, 0), MODF(0, 0, 1));
#endif
    GRID_BAR();

    for (int l = 0; l < DEPTH; ++l) {
        const unsigned char* wl = ws + WS_W + (size_t)l * W_LAYER;
        { pg8::Gemm g{HB, (const bf16*)(wl + W_1IN), SEQ, 2 * FF, DM}; pg8::StaticOrder S; S.init(SEQ, 2 * FF, F.G, (int)blockIdx.x);
          pg8::EpiSwiGLU E{ACT, FF};
          REP(3) if (PH(3)) pg8::gemm_phase<pg8::EpiSwiGLU, pg8::StaticOrder, false, true>(F.lds + RING_OFF, g, S, E);
#ifdef PROBE_G1X2
          __syncthreads(); pg8::gemm_phase<pg8::EpiSwiGLU, pg8::StaticOrder, false, true>(F.lds + RING_OFF, g, S, E);
#endif
          GRID_BAR(); }
        { pg8::Gemm g{ACT, (const bf16*)(wl + W_1OUT), SEQ, DM, FF}; pg8::StaticOrder S; S.init(SEQ, DM, F.G, (int)blockIdx.x);
          pg8::EpiPlain E{YB, DM};
          REP(4) if (PH(4)) pg8::gemm_phase<pg8::EpiPlain, pg8::StaticOrder, true, true>(F.lds + RING_OFF, g, S, E); GRID_BAR(); }
        if (PH(5)) norm_phase<true, true>(F, l == 0 ? in.p[0] : xres, xres, YB, HB, MODF(l, 0, 2), MODF(l, 1, 0), MODF(l, 1, 1)); GRID_BAR();
        { pg8::Gemm g{HB, (const bf16*)(wl + W_MIX), SEQ, 8192, DM}; pg8::StaticOrder S; S.init(SEQ, 8192, F.G, (int)blockIdx.x);
          pg8::EpiMix E{QB, KB, VB, UB, GB, cosT, sinT, in.p[14] + (size_t)l * 4096};
          REP(6) if (PH(6)) pg8::gemm_phase<pg8::EpiMix, pg8::StaticOrder, false, true>(F.lds + RING_OFF, g, S, E); GRID_BAR(); }
        {
            const int xcd = F.vcu >> 5, j = F.vcu & 31;
            REP(7) if (!PH(7)) {} else if (F.G == 256) {
#pragma unroll 1
                for (int i = 0; i < 4; ++i) { const int vh = 2 * xcd + (i >> 1), qb = (i & 1) * 32 + j;
                    dattn::attn_unit16(QB + (size_t)(qb * 256) * 1024 + vh * 64, KB + vh * 64, VB + (vh >> 1) * 128, OB + (size_t)(qb * 256) * 2048 + (2 * xcd) * 128, SEQ, (LAS char*)(F.lds + RING_OFF),
                                     i >= 2, lamv[l], lamv[2 + l], in.p[10] + (size_t)l * 128, AO + (size_t)(qb * 256) * 1024 + xcd * 128); }
            } else {
#pragma unroll 1
                for (int un = F.vcu; un < 1024; un += F.G) { const int vh = un >> 6, qb = un & 63;
                    dattn::attn_unit16(QB + (size_t)(qb * 256) * 1024 + vh * 64, KB + vh * 64, VB + (vh >> 1) * 128, OB + (size_t)(qb * 256) * 2048 + vh * 128, SEQ, (LAS char*)(F.lds + RING_OFF),
                                     false, 0.f, 0.f, nullptr, nullptr); }
            }
            REP(8) if (PH(8)) fftA_phase(F, UB, TRE, TIM, dftC, dftS, TW);
#ifdef PROBE_FFT2
            fftA_phase(F, UB, TRE, TIM, dftC, dftS, TW);
#endif
            GRID_BAR();
        }
        REP(9) if (PH(9)) fftB_phase(F, TRE, TIM, YF, dftC, dftS);
#ifdef PROBE_FFT2
        fftB_phase(F, TRE, TIM, YF, dftC, dftS);
#endif
        REP(10) if (PH(10) && F.G != 256) combine_phase(F, OB, AO, in.p[10] + (size_t)l * 128, lamv[l], lamv[2 + l]);
#ifdef PROBE_COMB2
        combine_phase(F, OB, AO, in.p[10] + (size_t)l * 128, lamv[l], lamv[2 + l]);
#endif
        GRID_BAR();
        { pg8::Gemm g{AO, (const bf16*)(wl + W_AP), SEQ, DM, AW}; pg8::StaticOrder S; S.init(SEQ, DM, F.G, (int)blockIdx.x);
          pg8::EpiGate E{GB, nullptr, TT};
          REP(11) if (PH(11)) pg8::gemm_phase<pg8::EpiGate, pg8::StaticOrder, true, true>(F.lds + RING_OFF, g, S, E);
          VM_WAIT(); __syncthreads(); }
        { pg8::Gemm g{YF, (const bf16*)(wl + W_FP), SEQ, DM, FW}; pg8::StaticOrder S; S.init(SEQ, DM, F.G, (int)blockIdx.x);
          pg8::EpiGate E{GB + 2048, TT, MG};
          REP(12) if (PH(12)) pg8::gemm_phase<pg8::EpiGate, pg8::StaticOrder, true, true>(F.lds + RING_OFF, g, S, E); GRID_BAR(); }
        { pg8::Gemm g{MG, (const bf16*)(wl + W_MO), SEQ, DM, DM}; pg8::StaticOrder S; S.init(SEQ, DM, F.G, (int)blockIdx.x);
          pg8::EpiPlain E{YB, DM};
          REP(13) if (PH(13)) pg8::gemm_phase<pg8::EpiPlain, pg8::StaticOrder, true, true>(F.lds + RING_OFF, g, S, E); GRID_BAR(); }
        if (PH(14)) norm_phase<true, true>(F, xres, xres, YB, HB, MODF(l, 1, 2), MODF(l, 2, 0), MODF(l, 2, 1)); GRID_BAR();
        { pg8::Gemm g{HB, (const bf16*)(wl + W_2IN), SEQ, 2 * FF, DM}; pg8::StaticOrder S; S.init(SEQ, 2 * FF, F.G, (int)blockIdx.x);
          pg8::EpiSwiGLU E{ACT, FF};
          REP(15) if (PH(15)) pg8::gemm_phase<pg8::EpiSwiGLU, pg8::StaticOrder, false, true>(F.lds + RING_OFF, g, S, E); GRID_BAR(); }
        { pg8::Gemm g{ACT, (const bf16*)(wl + W_2OUT), SEQ, DM, FF}; pg8::StaticOrder S; S.init(SEQ, DM, F.G, (int)blockIdx.x);
          pg8::EpiPlain E{YB, DM};
          REP(16) if (PH(16)) pg8::gemm_phase<pg8::EpiPlain, pg8::StaticOrder, true, true>(F.lds + RING_OFF, g, S, E); GRID_BAR(); }
        if (l + 1 < DEPTH) { if (PH(17)) norm_phase<true, true>(F, xres, xres, YB, HB, MODF(l, 2, 2), MODF(l + 1, 0, 0), MODF(l + 1, 0, 1)); GRID_BAR(); }
        else if (PH(17)) norm_phase<true, false>(F, xres, xres, YB, nullptr, MODF(l, 2, 2), nullptr, nullptr);
    }
#ifdef PROBE_BAR
    if (blockIdx.x == PROBE_BAR - 1 && F.tid == 0) { const unsigned long long w0 = wall_clock64(); while (wall_clock64() - w0 < bar_ticks) __builtin_amdgcn_s_sleep(8); }
#endif
#ifdef PROBE_GEMM
    if (blockIdx.x == 0 && F.tid == 0) { VM_WAIT(); const unsigned long long sm = __hip_atomic_load(&pg8::g_gp_sum, __ATOMIC_RELAXED, __HIP_MEMORY_SCOPE_AGENT); const unsigned cn = __hip_atomic_load(&pg8::g_gp_cnt, __ATOMIC_RELAXED, __HIP_MEMORY_SCOPE_AGENT);
        const unsigned long long avg = cn ? sm / cn : 0ull, ticks = avg * 20ull;
        const unsigned long long w0 = wall_clock64(); while (wall_clock64() - w0 < ticks) __builtin_amdgcn_s_sleep(8); }
#endif
    if (blockIdx.x == 0) { int t_ = threadIdx.x; asm volatile("" : "+v"(t_)); if (t_ < 64) { VM_WAIT(); if (__hip_atomic_load((gu32*)((unsigned*)(args.ws + WS_CTL) + CW_BAR + XB_TMO), RLX_AGENT) != 0u) { const float q = __builtin_nanf(""); for (int c = t_; c < DM; c += 64) args.out[c] = q; } } }
}

extern "C" void kernel_launch(void* const* d_in, const int* in_sizes, int n_in, void* d_out, int out_size, void* d_ws, size_t ws_size, hipStream_t stream) {
    static int grid = 0;
    if (grid == 0) {
        if (n_in != 18 || in_sizes[0] != SEQ * DM || out_size != SEQ * DM || ws_size < WS_END) { fprintf(stderr, "kernel_launch: unexpected shapes: n_in %d in0 %d out %d ws %zu (need %zu)\n", n_in, n_in > 0 ? in_sizes[0] : -1, out_size, ws_size, (size_t)WS_END); grid = -1; return; }
        int dev = 0, cus = 0, per_cu = 0;
        if (hipGetDevice(&dev) != hipSuccess || hipDeviceGetAttribute(&cus, hipDeviceAttributeMultiprocessorCount, dev) != hipSuccess) { grid = -1; return; }
        if (hipFuncSetAttribute((const void*)enc_fwd, hipFuncAttributeMaxDynamicSharedMemorySize, LDS_BYTES) != hipSuccess) { fprintf(stderr, "kernel_launch: hipFuncSetAttribute failed\n"); grid = -1; return; }
        if (hipOccupancyMaxActiveBlocksPerMultiprocessor(&per_cu, (const void*)enc_fwd, NWAVES * 64, LDS_BYTES) != hipSuccess || per_cu < 1) { fprintf(stderr, "kernel_launch: occupancy query reports %d blocks per CU\n", per_cu); }
        (void)hipGetLastError();
        grid = cus;
    }
    if (grid < 0) return;
#ifdef DBG_ZERO_WS
    if (hipMemsetAsync((char*)d_ws, 0, WS_END, stream) != hipSuccess) return;
#else
    if (hipMemsetAsync((char*)d_ws + WS_CTL, 0, CTL_ZERO_BYTES, stream) != hipSuccess) return;
#endif
    Args a{};
    for (int i = 0; i < 18; ++i) a.in[i] = (const float*)d_in[i];
    a.out = (float*)d_out; a.ws = (unsigned char*)d_ws;
    hipLaunchKernelGGL(enc_fwd, dim3(grid), dim3(NWAVES * 64), LDS_BYTES, stream, a);
    const hipError_t le = hipPeekAtLastError();
    if (le != hipSuccess) fprintf(stderr, "kernel_launch: launch failed: %s\n", hipGetErrorName(le));
}
```
